# Optimizing an MI355X kernel written in HIP

```python
import math
import jax, jax.numpy as jnp
from jax import lax
import numpy as np

D_MODEL = 1024
BATCH = 4
SEQ = 8192
DEPTH = 1
DEC_BATCH = 32
DEC_SEQ = 8
PAST_LEN = 16384
PAGE_SIZE = 128

HEAD_DIM = 64
N_ATT_HEADS = 12
ATT_WIDTH = N_ATT_HEADS * HEAD_DIM
CONV_WIDTH = D_MODEL - ATT_WIDTH
MIX_WIDTH = ATT_WIDTH + CONV_WIDTH
CONV_K = 31
DILATED_BRANCHES = ((128, 1), (512, 4), (2048, 16))
MAX_WINDOW = 2048
N_BUCKETS = 32
MAX_EXACT = N_BUCKETS // 2
MAX_DISTANCE = 2048
N_MEM = 256
X_HEADS = 4
X_HEAD_DIM = D_MODEL // X_HEADS
D_FF = -(-(8 * D_MODEL) // (3 * 256)) * 256
EPS = 1e-6
ATT_SCALE = HEAD_DIM ** -0.5
X_SCALE = X_HEAD_DIM ** -0.5

kernel_name = 'hybrid_dilated_conformer_decoder_step'


def rmsnorm(x, g):
    xf = x.astype(jnp.float32)
    xf = xf * lax.rsqrt(jnp.mean(xf * xf, axis=-1, keepdims=True) + EPS)
    return (xf * g.astype(jnp.float32)).astype(x.dtype)


def layernorm(x, g, b):
    xf = x.astype(jnp.float32)
    mu = jnp.mean(xf, axis=-1, keepdims=True)
    xc = xf - mu
    var = jnp.mean(xc * xc, axis=-1, keepdims=True)
    return (xc * lax.rsqrt(var + EPS) * g.astype(jnp.float32) + b.astype(jnp.float32)).astype(x.dtype)


def t5_bucket(dist):
    n = dist.astype(jnp.int32)
    nf = jnp.maximum(n, MAX_EXACT).astype(jnp.float32)
    large = MAX_EXACT + (jnp.log(nf / MAX_EXACT) / math.log(MAX_DISTANCE / MAX_EXACT)
                         * (N_BUCKETS - MAX_EXACT)).astype(jnp.int32)
    large = jnp.minimum(large, N_BUCKETS - 1)
    return jnp.where(n < MAX_EXACT, n, large)


def rel_bias(table, dist):
    return jnp.moveaxis(table[t5_bucket(dist)], -1, 0).astype(jnp.float32)


def masked_softmax_stats(s, valid):
    s = jnp.where(valid, s, -jnp.inf)
    m = jnp.max(s, axis=-1, keepdims=True)
    p = jnp.exp(s - m)
    den = jnp.sum(p, axis=-1, keepdims=True)
    return p / den, (m + jnp.log(den))[..., 0]


def combine_branches(outs, lses):
    lse = jnp.stack(lses, 0)
    w = jnp.exp(lse - jnp.max(lse, axis=0, keepdims=True))
    w = w / jnp.sum(w, axis=0, keepdims=True)
    o = jnp.sum(w[..., None] * jnp.stack(outs, 0).astype(jnp.float32), axis=0)
    return o.astype(outs[0].dtype)


def dilated_branch_prompt(q, k, v, table, dilation, steps):
    S, H, hd = q.shape
    L = S // dilation
    nb = -(-L // steps)
    Lp = nb * steps

    def to_blocks(t):
        t = t.reshape(L, dilation, H, hd).transpose(1, 0, 2, 3)
        t = jnp.pad(t, ((0, 0), (0, Lp - L), (0, 0), (0, 0)))
        return t.reshape(dilation, nb, steps, H, hd)

    def with_prev(t):
        prev = jnp.pad(t[:, :-1], ((0, 0), (1, 0), (0, 0), (0, 0), (0, 0)))
        return jnp.concatenate([prev, t], axis=2)

    qb = to_blocks(q)
    kk = with_prev(to_blocks(k))
    vv = with_prev(to_blocks(v))
    qi = jnp.arange(steps)[:, None]
    kj = jnp.arange(2 * steps)[None, :]
    sub_dist = steps + qi - kj
    band = (sub_dist >= 0) & (sub_dist <= steps)
    blk = jnp.arange(nb)[:, None, None]
    valid = band[None] & (blk * steps + kj[None] - steps >= 0)
    bias = rel_bias(table, dilation * jnp.maximum(sub_dist, 0))
    s = jnp.einsum('gnqhd,gnkhd->gnhqk', qb, kk).astype(jnp.float32) * ATT_SCALE + bias[None, None]
    p, lse = masked_softmax_stats(s, valid[None, :, None])
    o = jnp.einsum('gnhqk,gnkhd->gnqhd', p.astype(v.dtype), vv)
    o = o.reshape(dilation, Lp, H, hd)[:, :L].transpose(1, 0, 2, 3).reshape(S, H, hd)
    lse = lse.transpose(0, 1, 3, 2).reshape(dilation, Lp, H)[:, :L].transpose(1, 0, 2).reshape(S, H)
    return o, lse


def dilated_attention_prompt(q, k, v, table):
    def one(args):
        qs, ks, vs = args
        outs, lses = [], []
        for window, dil in DILATED_BRANCHES:
            o, l = dilated_branch_prompt(qs, ks, vs, table, dil, window // dil)
            outs.append(o)
            lses.append(l)
        return combine_branches(outs, lses)
    return lax.map(one, (q, k, v))


def dilated_attention_sample(q, kc, vc, table, buf_len):
    T = q.shape[1]
    outs, lses = [], []
    for window, dil in DILATED_BRANCHES:
        steps = window // dil
        i = jnp.arange(T)[:, None]
        j = jnp.arange(steps + 1)
        idx = buf_len + i - j[None, :] * dil
        valid = idx >= 0
        idxc = jnp.maximum(idx, 0)
        kg = kc[:, idxc]
        vg = vc[:, idxc]
        bias = rel_bias(table, j * dil)
        s = jnp.einsum('bthd,btjhd->bhtj', q, kg).astype(jnp.float32) * ATT_SCALE + bias[None, :, None, :]
        p, lse = masked_softmax_stats(s, valid[None, None])
        outs.append(jnp.einsum('bhtj,btjhd->bthd', p.astype(vc.dtype), vg))
        lses.append(lse.transpose(0, 2, 1))
    return combine_branches(outs, lses)


def mixer_inputs(h, w_in):
    N, T, _ = h.shape
    q, k, v, a, g = jnp.split(h @ w_in, [ATT_WIDTH, 2 * ATT_WIDTH, 3 * ATT_WIDTH,
                                         3 * ATT_WIDTH + CONV_WIDTH], axis=-1)
    shp = (N, T, N_ATT_HEADS, HEAD_DIM)
    u = a * jax.nn.sigmoid(g)
    return q.reshape(shp), k.reshape(shp), v.reshape(shp), u


def causal_dwconv(u_full, conv_w, conv_b):
    y = lax.conv_general_dilated(u_full, conv_w[:, None, :].astype(u_full.dtype), window_strides=(1,),
                                 padding='VALID', dimension_numbers=('NWC', 'WIO', 'NWC'),
                                 feature_group_count=CONV_WIDTH)
    return y + conv_b


def mixer_outputs(att, u_full, conv_w, conv_b, ln_g, ln_b, w_out):
    N, T = att.shape[:2]
    c = jax.nn.silu(layernorm(causal_dwconv(u_full, conv_w, conv_b), ln_g, ln_b))
    return jnp.concatenate([att.reshape(N, T, ATT_WIDTH), c], axis=-1) @ w_out


def mem_kv(mem, g, w_k, w_v):
    N, M, _ = mem.shape
    m = rmsnorm(mem, g)
    return ((m @ w_k).reshape(N, M, X_HEADS, X_HEAD_DIM),
            (m @ w_v).reshape(N, M, X_HEADS, X_HEAD_DIM))


def cross_attend(h, mk, mv, w_q, w_o):
    N, T, _ = h.shape
    q = (h @ w_q).reshape(N, T, X_HEADS, X_HEAD_DIM)
    s = jnp.einsum('bthd,bmhd->bhtm', q, mk).astype(jnp.float32) * X_SCALE
    p = jax.nn.softmax(s, axis=-1).astype(mv.dtype)
    o = jnp.einsum('bhtm,bmhd->bthd', p, mv).reshape(N, T, X_HEADS * X_HEAD_DIM)
    return o @ w_o


def swiglu(h, w_gate, w_up, w_down):
    return (jax.nn.silu(h @ w_gate) * (h @ w_up)) @ w_down


def setup_inputs(seed: int = 0) -> dict:
    key = jax.random.key(seed)
    ks = jax.random.split(key, 32)
    f32 = jnp.float32
    buf_len = min(MAX_WINDOW, PAST_LEN)

    def nrm(k, shape, scale=1.0):
        return jax.random.normal(k, shape, f32) * scale

    def gain(k, shape):
        return 1.0 + 0.05 * jax.random.normal(k, shape, f32)

    return {
        'x_prompt': nrm(ks[0], (BATCH, SEQ, D_MODEL)),
        'x_sample': nrm(ks[1], (DEC_BATCH, DEC_SEQ, D_MODEL)),
        'mem_prompt': nrm(ks[2], (BATCH, N_MEM, D_MODEL)),
        'cache_win_k': nrm(ks[3], (DEPTH, DEC_BATCH, buf_len, N_ATT_HEADS, HEAD_DIM)),
        'cache_win_v': nrm(ks[4], (DEPTH, DEC_BATCH, buf_len, N_ATT_HEADS, HEAD_DIM)),
        'cache_conv': nrm(ks[5], (DEPTH, DEC_BATCH, CONV_K - 1, CONV_WIDTH), 0.5),
        'cache_mem_k': nrm(ks[6], (DEPTH, DEC_BATCH, N_MEM, X_HEADS, X_HEAD_DIM)),
        'cache_mem_v': nrm(ks[7], (DEPTH, DEC_BATCH, N_MEM, X_HEADS, X_HEAD_DIM)),
        'rpb_table': nrm(ks[8], (N_BUCKETS, N_ATT_HEADS), 0.5),
        'norm_mix_g': gain(ks[9], (DEPTH, D_MODEL)),
        'w_in': nrm(ks[10], (DEPTH, D_MODEL, 3 * ATT_WIDTH + 2 * CONV_WIDTH), D_MODEL ** -0.5),
        'conv_w': nrm(ks[11], (DEPTH, CONV_K, CONV_WIDTH), CONV_K ** -0.5),
        'conv_b': nrm(ks[12], (DEPTH, CONV_WIDTH), 0.02),
        'conv_ln_g': gain(ks[13], (DEPTH, CONV_WIDTH)),
        'conv_ln_b': nrm(ks[14], (DEPTH, CONV_WIDTH), 0.02),
        'w_out': nrm(ks[15], (DEPTH, MIX_WIDTH, D_MODEL), MIX_WIDTH ** -0.5),
        'norm_x_g': gain(ks[16], (DEPTH, D_MODEL)),
        'norm_mem_g': gain(ks[17], (DEPTH, D_MODEL)),
        'w_xq': nrm(ks[18], (DEPTH, D_MODEL, X_HEADS * X_HEAD_DIM), D_MODEL ** -0.5),
        'w_xk': nrm(ks[19], (DEPTH, D_MODEL, X_HEADS * X_HEAD_DIM), D_MODEL ** -0.5),
        'w_xv': nrm(ks[20], (DEPTH, D_MODEL, X_HEADS * X_HEAD_DIM), D_MODEL ** -0.5),
        'w_xo': nrm(ks[21], (DEPTH, X_HEADS * X_HEAD_DIM, D_MODEL), (X_HEADS * X_HEAD_DIM) ** -0.5),
        'norm_ffn_g': gain(ks[22], (DEPTH, D_MODEL)),
        'w_ffn_gate': nrm(ks[23], (DEPTH, D_MODEL, D_FF), D_MODEL ** -0.5),
        'w_ffn_up': nrm(ks[24], (DEPTH, D_MODEL, D_FF), D_MODEL ** -0.5),
        'w_ffn_down': nrm(ks[25], (DEPTH, D_FF, D_MODEL), D_FF ** -0.5),
        'norm_final_g': gain(ks[26], (D_MODEL,)),
    }


def reference(x_prompt, x_sample, mem_prompt, cache_win_k, cache_win_v, cache_conv,
              cache_mem_k, cache_mem_v, rpb_table, norm_mix_g, w_in, conv_w, conv_b,
              conv_ln_g, conv_ln_b, w_out, norm_x_g, norm_mem_g, w_xq, w_xk, w_xv, w_xo,
              norm_ffn_g, w_ffn_gate, w_ffn_up, w_ffn_down, norm_final_g):
    buf_len = cache_win_k.shape[2]
    keep_p = min(MAX_WINDOW, x_prompt.shape[1])
    xp, xs = x_prompt, x_sample
    p_wk, p_wv, p_conv, p_mk, p_mv = [], [], [], [], []
    s_wk, s_wv, s_conv = [], [], []
    for l in range(DEPTH):
        q, k, v, u = mixer_inputs(rmsnorm(xp, norm_mix_g[l]), w_in[l])
        att = dilated_attention_prompt(q, k, v, rpb_table)
        u_full = jnp.pad(u, ((0, 0), (CONV_K - 1, 0), (0, 0)))
        xp = xp + mixer_outputs(att, u_full, conv_w[l], conv_b[l], conv_ln_g[l], conv_ln_b[l], w_out[l])
        p_wk.append(k[:, -keep_p:])
        p_wv.append(v[:, -keep_p:])
        p_conv.append(u_full[:, -(CONV_K - 1):])
        mk, mv = mem_kv(mem_prompt, norm_mem_g[l], w_xk[l], w_xv[l])
        p_mk.append(mk)
        p_mv.append(mv)
        xp = xp + cross_attend(rmsnorm(xp, norm_x_g[l]), mk, mv, w_xq[l], w_xo[l])
        xp = xp + swiglu(rmsnorm(xp, norm_ffn_g[l]), w_ffn_gate[l], w_ffn_up[l], w_ffn_down[l])

        q, k, v, u = mixer_inputs(rmsnorm(xs, norm_mix_g[l]), w_in[l])
        kc = jnp.concatenate([cache_win_k[l].astype(k.dtype), k], axis=1)
        vc = jnp.concatenate([cache_win_v[l].astype(v.dtype), v], axis=1)
        att = dilated_attention_sample(q, kc, vc, rpb_table, buf_len)
        u_full = jnp.concatenate([cache_conv[l].astype(u.dtype), u], axis=1)
        xs = xs + mixer_outputs(att, u_full, conv_w[l], conv_b[l], conv_ln_g[l], conv_ln_b[l], w_out[l])
        s_wk.append(kc[:, -buf_len:])
        s_wv.append(vc[:, -buf_len:])
        s_conv.append(u_full[:, -(CONV_K - 1):])
        xs = xs + cross_attend(rmsnorm(xs, norm_x_g[l]), cache_mem_k[l], cache_mem_v[l], w_xq[l], w_xo[l])
        xs = xs + swiglu(rmsnorm(xs, norm_ffn_g[l]), w_ffn_gate[l], w_ffn_up[l], w_ffn_down[l])

    y_prompt = rmsnorm(xp, norm_final_g)
    y_sample = rmsnorm(xs, norm_final_g)
    return (y_prompt, y_sample,
            jnp.stack(p_wk), jnp.stack(p_wv), jnp.stack(p_conv), jnp.stack(p_mk), jnp.stack(p_mv),
            jnp.stack(s_wk), jnp.stack(s_wv), jnp.stack(s_conv))
```

```cpp
#include <hip/hip_runtime.h>
#include <hip/hip_cooperative_groups.h>
#include <cstdio>
#include <cstdint>
namespace cg = cooperative_groups;

#ifndef MK_COOP
#define MK_COOP 1
#endif

#define LAS __attribute__((address_space(3)))
typedef unsigned short bf16_t;
typedef short bf16x8 __attribute__((ext_vector_type(8)));
typedef short s16x4 __attribute__((ext_vector_type(4)));
typedef float f32x2 __attribute__((ext_vector_type(2)));
typedef float f32x4 __attribute__((ext_vector_type(4)));
typedef float f32x16 __attribute__((ext_vector_type(16)));
typedef unsigned u32x2 __attribute__((ext_vector_type(2)));
typedef unsigned u32x4 __attribute__((ext_vector_type(4)));
typedef __bf16 bf16x2_t __attribute__((ext_vector_type(2)));

__device__ __forceinline__ unsigned pkbf(float lo, float hi) { f32x2 v = {lo, hi}; bf16x2_t b = __builtin_convertvector(v, bf16x2_t); return __builtin_bit_cast(unsigned, b); }
__device__ __forceinline__ float bf_lo(unsigned w) { return __uint_as_float(w << 16); }
__device__ __forceinline__ float bf_hi(unsigned w) { return __uint_as_float(w & 0xffff0000u); }
__device__ __forceinline__ int fresh_lane() { int t = __builtin_amdgcn_mbcnt_hi(~0u, __builtin_amdgcn_mbcnt_lo(~0u, 0u)); asm volatile("" : "+v"(t)); return t; }
__device__ __forceinline__ float fast_exp2(float x) { return __builtin_amdgcn_exp2f(x); }
__device__ __forceinline__ float fast_rcp(float x) { return __builtin_amdgcn_rcpf(x); }

constexpr int DM = 1024, NBATCH = 4, SEQ = 8192, MP = NBATCH * SEQ;
constexpr int NSEQ = 32, TS = 8, MSMP = NSEQ * TS;
constexpr int MTOK = MP + MSMP;
constexpr int NMEM = 256, MMEM = NBATCH * NMEM;
constexpr int MALL = MTOK + MMEM;
constexpr int AW = 768, CWD = 256, NIN = 2816, DFF = 2816, NH = 12, HD = 64;
constexpr int WBUF = 2048;
constexpr float EPS = 1e-6f;
constexpr float LOG2E = 1.4426950408889634f;
constexpr float QSCALE = 0.125f * LOG2E;
constexpr float XQSCALE = 0.0625f * LOG2E;

constexpr size_t OFF_Y = 0;
constexpr size_t OFF_PWK = 33816576, OFF_PWV = 40108032, OFF_PCONV = 46399488, OFF_PMK = 46430208, OFF_PMV = 47478784;
constexpr size_t OFF_SWK = 48527360, OFF_SWV = 98859008, OFF_SCONV = 149190656, OUT_TOTAL = 149436416;

constexpr size_t MiB = 1u << 20;
constexpr size_t WS_CTL = 0, CTL_ZERO_BYTES = 65536;
constexpr size_t WS_WALL = 2 * MiB;
constexpr size_t WS_WOUT = 12 * MiB, WS_WXQ = 14 * MiB, WS_WXO = 16 * MiB;
constexpr size_t WS_WGU = 18 * MiB;
constexpr size_t WS_WDN = 30 * MiB;
constexpr size_t WS_XN = 36 * MiB;
constexpr size_t WS_QB = 104 * MiB, WS_KB = 154 * MiB, WS_VB = 204 * MiB;
constexpr size_t WS_U = 254 * MiB;
constexpr size_t WS_OP = 288 * MiB;
constexpr size_t OP_STRIDE = (size_t)MTOK * AW;
constexpr size_t WS_LSE = 434 * MiB;
constexpr size_t LSE_STRIDE = (size_t)MTOK * NH;
constexpr size_t WS_ATT = 440 * MiB;
constexpr size_t WS_X1 = 506 * MiB;
constexpr size_t WS_SSQ = 636 * MiB;
constexpr size_t SSQ_STRIDE = (size_t)MTOK * 16;
constexpr size_t WS_MKB = 644 * MiB, WS_MVT = 646 * MiB;
constexpr size_t WS_LSUM = 648 * MiB;
constexpr size_t WS_XQ = 353 * MiB;
constexpr size_t WS_PB = 652 * MiB;
constexpr size_t WS_XO = 288 * MiB;
constexpr size_t WS_H = 104 * MiB;
constexpr size_t WS_TABG = 651 * MiB;
constexpr size_t WS_SLOT = 650 * MiB;
constexpr size_t WS_END = 716 * MiB;

namespace pg8 {
constexpr int BM = 256, BK = 64, HALF = 128, HTB = HALF * BK * 2, STAGE_BYTES = 8 * HTB, NXCD = 8, WGM = 8;
__host__ __device__ __forceinline__ int lds_byte(int r, int c) { const int st = (r >> 4) * 2 + (c >> 5), rr = r & 15, cc = c & 31, ob = rr * 64 + cc * 2; return st * 1024 + (ob ^ (((ob >> 9) & 1) << 5)); }
__host__ __device__ __forceinline__ void stage_rc(int b, int& R, int& C) { const int st = b / 1024, sb = b % 1024, swz = sb ^ (((sb >> 9) & 1) << 5); R = (st >> 1) * 16 + swz / 64; C = (st & 1) * 32 + (swz % 64) / 2; }
__host__ __device__ __forceinline__ int perm32(int rho) { const int n = rho >> 4, i = rho & 15; return 8 * (i >> 2) + 4 * n + (i & 3); }

struct Unit { int pm, pn, kind; };
struct Cfg { int K, lda, ldb; };

template <class Epi, class Sched, bool ALIGN_EPI>
__device__ __forceinline__ void gemm_phase(LAS unsigned char* lds, const Cfg g, const Sched& S, const Epi& E, const int wid) {
    const int lane = fresh_lane(), tid = wid * 64 + lane, wr = wid >> 2, wc = wid & 3, fr = lane & 15, fq = lane >> 4;
    const int K = g.K, nt = K / BK;
    unsigned voffA[2], voffB[2];
#pragma unroll
    for (int i = 0; i < 2; ++i) { int R, C; stage_rc(tid * 16 + i * 8192, R, C); const int Rb = (R & ~31) + perm32(R & 31);
        voffA[i] = (unsigned)(R * g.lda + C) * 2u; voffB[i] = (unsigned)(Rb * g.ldb + C) * 2u; }
    const size_t kstep = (size_t)(BK * 2);
    const size_t hA = (size_t)HALF * g.lda * 2, hB = (size_t)HALF * g.ldb * 2;
    const unsigned ldsw = (unsigned)wid * 1024u;
    const int aoff = lds_byte(wr * 64 + fr, fq * 8), boff = lds_byte(wc * 32 + fr, fq * 8);
#define PG8_SA(b, h) (((b) * 2 + (h)) * HTB)
#define PG8_SB(b, h) ((4 + (b) * 2 + (h)) * HTB)
#define PG8_STAGE(bufoff, gbase, voff) do { _Pragma("unroll") for (int _i = 0; _i < 2; ++_i) \
        __builtin_amdgcn_global_load_lds((const unsigned*)((const char*)(gbase) + (voff)[_i]), (LAS unsigned*)(lds + (bufoff) + ldsw + _i * 8192), 16, 0, 0); } while (0)
#define PG8_LDA(dst, b, h) do { _Pragma("unroll") for (int m = 0; m < 4; ++m) _Pragma("unroll") for (int k = 0; k < 2; ++k) dst[m][k] = *(const LAS bf16x8*)(lds + PG8_SA(b, h) + aoff + m * 2048 + k * 1024); } while (0)
#define PG8_LDB(dst, b, h) do { _Pragma("unroll") for (int n = 0; n < 2; ++n) _Pragma("unroll") for (int k = 0; k < 2; ++k) dst[n][k] = *(const LAS bf16x8*)(lds + PG8_SB(b, h) + boff + n * 2048 + k * 1024); } while (0)
#define PG8_MMA(ai, bj, At, Bt) do { __builtin_amdgcn_s_setprio(1); _Pragma("unroll") for (int m = 0; m < 4; ++m) _Pragma("unroll") for (int n = 0; n < 2; ++n) _Pragma("unroll") for (int k = 0; k < 2; ++k) \
        acc[ai][bj][m][n] = __builtin_amdgcn_mfma_f32_16x16x32_bf16(Bt[n][k], At[m][k], acc[ai][bj][m][n], 0, 0, 0); __builtin_amdgcn_s_setprio(0); } while (0)
#define PG8_WAIT_V(n) asm volatile("s_waitcnt vmcnt(" #n ")" ::: "memory")
#define PG8_WAIT_L(n) asm volatile("s_waitcnt lgkmcnt(" #n ")" ::: "memory")
#define PG8_BAR __builtin_amdgcn_s_barrier()
#define PG8_SCHED __builtin_amdgcn_sched_barrier(0)
    Unit cur, nxt; int ui = 0;
    if (!S.next(0, cur)) return;
    f32x4 acc[2][2][4][2];
    E.init(acc, cur, wr, wc, fr, fq);
    bf16x8 At[4][2], B0[2][2], B1[2][2];
    const char* cA = S.aptr(cur); const char* cB = S.bptr(cur);
    PG8_STAGE(PG8_SB(0, 0), cB, voffB); PG8_STAGE(PG8_SB(0, 1), cB + hB, voffB); PG8_STAGE(PG8_SA(0, 0), cA, voffA); PG8_STAGE(PG8_SA(0, 1), cA + hA, voffA);
    if (wr == 1) PG8_BAR;
    PG8_WAIT_V(2); PG8_BAR;
    PG8_STAGE(PG8_SB(1, 0), cB + kstep, voffB); PG8_STAGE(PG8_SA(1, 0), cA + kstep, voffA); PG8_STAGE(PG8_SB(1, 1), cB + hB + kstep, voffB);
    PG8_WAIT_V(6); PG8_BAR;
    for (;;) {
        const bool has_next = S.next(ui + 1, nxt);
        const char* nA = has_next ? S.aptr(nxt) : cA; const char* nB = has_next ? S.bptr(nxt) : cB;
#pragma unroll 1
        for (int t = 0; t < nt; t += 2) {
            const bool last = (t == nt - 2);
            const char* a1 = cA + (size_t)(t + 1) * kstep;
            const char* a2 = last ? nA : cA + (size_t)(t + 2) * kstep; const char* b2 = last ? nB : cB + (size_t)(t + 2) * kstep;
            const char* a3 = a2 + kstep; const char* b3 = b2 + kstep;
            PG8_LDB(B0, 0, 0); PG8_LDB(B1, 0, 1); PG8_SCHED; PG8_LDA(At, 0, 0); PG8_STAGE(PG8_SA(1, 1), a1 + hA, voffA);
            PG8_WAIT_V(8); PG8_WAIT_L(0); PG8_BAR; PG8_MMA(0, 0, At, B0); PG8_MMA(0, 1, At, B1); PG8_BAR; PG8_SCHED;
            PG8_LDA(At, 0, 1); PG8_STAGE(PG8_SB(0, 0), b2, voffB); PG8_STAGE(PG8_SB(0, 1), b2 + hB, voffB); PG8_STAGE(PG8_SA(0, 0), a2, voffA);
            PG8_WAIT_V(8); PG8_WAIT_L(0); PG8_BAR; PG8_MMA(1, 0, At, B0); PG8_MMA(1, 1, At, B1); PG8_BAR; PG8_SCHED;
            PG8_LDB(B0, 1, 0); PG8_LDB(B1, 1, 1); PG8_SCHED; PG8_LDA(At, 1, 0); PG8_STAGE(PG8_SA(0, 1), a2 + hA, voffA);
            PG8_WAIT_V(8); PG8_WAIT_L(0); PG8_BAR; PG8_MMA(0, 0, At, B0); PG8_MMA(0, 1, At, B1); PG8_BAR; PG8_SCHED;
            PG8_LDA(At, 1, 1); PG8_STAGE(PG8_SB(1, 0), b3, voffB); PG8_STAGE(PG8_SB(1, 1), b3 + hB, voffB); PG8_STAGE(PG8_SA(1, 0), a3, voffA);
            PG8_WAIT_V(8); PG8_WAIT_L(0); PG8_BAR; PG8_MMA(1, 0, At, B0); PG8_MMA(1, 1, At, B1); PG8_BAR; PG8_SCHED;
        }
        if constexpr (ALIGN_EPI) { if (wr == 0) PG8_BAR; }
        E(acc, cur, wr, wc, fr, fq);
        if (!has_next) break;
        E.init(acc, nxt, wr, wc, fr, fq);
        cur = nxt; cA = nA; cB = nB; ++ui;
        if constexpr (ALIGN_EPI) { if (wr == 1) PG8_BAR; }
    }
    PG8_WAIT_V(0);
    if constexpr (!ALIGN_EPI) { if (wr == 0) PG8_BAR; }
    PG8_BAR;
#undef PG8_SA
#undef PG8_SB
#undef PG8_STAGE
#undef PG8_LDA
#undef PG8_LDB
#undef PG8_MMA
#undef PG8_WAIT_V
#undef PG8_WAIT_L
#undef PG8_BAR
#undef PG8_SCHED
}

__device__ __forceinline__ void swz_tile(int L, int nM, int nN, int& pm, int& pn) {
    const int nwg = nM * nN; int wgid = L;
    { const int q = nwg / NXCD, r = nwg % NXCD, xcd = wgid % NXCD, off = wgid / NXCD; wgid = (xcd < r ? xcd * (q + 1) : r * (q + 1) + (xcd - r) * q) + off; }
    const int nig = WGM * nN, gid = wgid / nig, fm = gid * WGM, gsz = (nM - fm) < WGM ? (nM - fm) : WGM;
    pm = fm + ((wgid % nig) % gsz); pn = (wgid % nig) / gsz;
}
struct SchedGrid {
    int nM, nN, G, c; const char* A; const char* B; size_t tA, tB;
    __device__ __forceinline__ bool next(int i, Unit& u) const { const long L = (long)i * G + c; if (L >= (long)nM * nN) return false; swz_tile((int)L, nM, nN, u.pm, u.pn); u.kind = 0; return true; }
    __device__ __forceinline__ const char* aptr(const Unit& u) const { return A + (size_t)u.pm * tA; }
    __device__ __forceinline__ const char* bptr(const Unit& u) const { return B + (size_t)u.pn * tB; }
};
struct SchedMem {
    int c; const char* XN; const char* W;
    static constexpr size_t TS_ = (size_t)256 * 1024 * 2;
    __device__ __forceinline__ bool next(int i, Unit& u) const {
        if (i > 0 || c < 0 || c >= 48) return false;
        if (c < 32) { u.pm = 129 + (c >> 3); u.pn = 11 + (c & 7); u.kind = 1; } else { const int f = c - 32; u.pm = f >> 2; u.pn = f & 3; u.kind = 2; }
        return true;
    }
    __device__ __forceinline__ const char* aptr(const Unit& u) const { return u.kind == 2 ? W + (size_t)(15 + u.pm) * TS_ : XN + (size_t)u.pm * TS_; }
    __device__ __forceinline__ const char* bptr(const Unit& u) const { return u.kind == 2 ? XN + (size_t)(129 + u.pn) * TS_ : W + (size_t)u.pn * TS_; }
};
struct SchedX {
    int G, c; const char* A; const char* B; int bmode;
    __device__ __forceinline__ bool next(int i, Unit& u) const { const long L = (long)i * G + c; if (L >= 512) return false; u.pm = (int)L >> 2; u.pn = (int)L & 3; u.kind = 0; return true; }
    __device__ __forceinline__ const char* aptr(const Unit& u) const { return A + ((size_t)u.pm * 256 * 1024 + (size_t)u.pn * 256) * 2; }
    __device__ __forceinline__ const char* bptr(const Unit& u) const { const int b = u.pm >> 5; return bmode == 0 ? B + ((size_t)b * 256 * 1024 + (size_t)u.pn * 256) * 2 : B + ((size_t)u.pn * 256 * 1024 + (size_t)b * 256) * 2; }
};

struct SchedPanel {
    int G, vcu; const char* A; const char* B; size_t tA, tB;
    __device__ __forceinline__ bool next(int i, Unit& u) const { const int L = i * G + vcu; if (L >= 516) return false; u.pm = L >> 2; u.pn = L & 3; u.kind = 0; return true; }
    __device__ __forceinline__ const char* aptr(const Unit& u) const { return A + (size_t)u.pm * tA; }
    __device__ __forceinline__ const char* bptr(const Unit& u) const { return B + (size_t)u.pn * tB; }
};
struct SchedXL {
    int nl, rk, xi, nx; const char* A; const char* B; size_t tA, tB; int skip128;
    __device__ __forceinline__ bool next(int i, Unit& u) const { const int Lx = i * nl + rk, pm = xi + nx * (Lx >> 2); if (pm >= 129 || (skip128 && pm == 128)) return false; u.pm = pm; u.pn = Lx & 3; u.kind = 0; return true; }
    __device__ __forceinline__ const char* aptr(const Unit& u) const { return A + (size_t)u.pm * tA; }
    __device__ __forceinline__ const char* bptr(const Unit& u) const { return B + (size_t)u.pn * tB; }
};
struct SchedOne {
    int pm, pn; const char* A; const char* B; size_t tA, tB;
    __device__ __forceinline__ bool next(int i, Unit& u) const { if (i > 0) return false; u.pm = pm; u.pn = pn; u.kind = 0; return true; }
    __device__ __forceinline__ const char* aptr(const Unit& u) const { return A + (size_t)u.pm * tA; }
    __device__ __forceinline__ const char* bptr(const Unit& u) const { return B + (size_t)u.pn * tB; }
};
struct SchedXL22 {
    int nl, rk, xi, nx; const char* A; const char* B; size_t tA, tB;
    __device__ __forceinline__ bool next(int i, Unit& u) const { const int Lx = i * nl + rk, q = Lx / 22, pm = xi + nx * q; if (pm >= 129) return false; u.pm = pm; u.pn = Lx - q * 22; u.kind = 0; return true; }
    __device__ __forceinline__ const char* aptr(const Unit& u) const { return A + (size_t)u.pm * tA; }
    __device__ __forceinline__ const char* bptr(const Unit& u) const { return B + (size_t)u.pn * tB; }
};
struct SchedXLs {
    int nl, rk, xi, nx; const char* A; const char* B; int bmode;
    __device__ __forceinline__ bool next(int i, Unit& u) const {
        int idx = 0;
#pragma unroll 1
        for (int j = 0; j < 16; ++j) { const int Lx = j * nl + rk, pm = xi + nx * (Lx >> 2); if (pm >= 129) break; if (pm == 128) continue;
            if (idx == i) { u.pm = pm; u.pn = Lx & 3; u.kind = 0; return true; } ++idx; }
        return false;
    }
    __device__ __forceinline__ const char* aptr(const Unit& u) const { return A + ((size_t)u.pm * 256 * 1024 + (size_t)u.pn * 256) * 2; }
    __device__ __forceinline__ const char* bptr(const Unit& u) const { const int b = u.pm >> 5; return bmode == 0 ? B + ((size_t)b * 256 * 1024 + (size_t)u.pn * 256) * 2 : B + ((size_t)u.pn * 256 * 1024 + (size_t)b * 256) * 2; }
};
struct SchedXs {
    int G, c; const char* A; const char* B; int bmode;
    __device__ __forceinline__ bool next(int i, Unit& u) const {
        int idx = 0;
#pragma unroll
        for (int j = 0; j < 3; ++j) { const int L = j * G + c; if (L >= 516) break; int pm, pn; swz_tile(L, 129, 4, pm, pn); if (pm == 128) continue;
            if (idx == i) { u.pm = pm; u.pn = pn; u.kind = 0; return true; } ++idx; }
        return false;
    }
    __device__ __forceinline__ const char* aptr(const Unit& u) const { return A + ((size_t)u.pm * 256 * 1024 + (size_t)u.pn * 256) * 2; }
    __device__ __forceinline__ const char* bptr(const Unit& u) const { const int b = u.pm >> 5; return bmode == 0 ? B + ((size_t)b * 256 * 1024 + (size_t)u.pn * 256) * 2 : B + ((size_t)u.pn * 256 * 1024 + (size_t)b * 256) * 2; }
};

#define EPI_ARGS const f32x4 (&acc)[2][2][4][2], const Unit& u, int wr, int wc, int fr, int fq
#define EPI_ZERO_INIT __device__ __forceinline__ void init(f32x4 (&acc)[2][2][4][2], const Unit&, int, int, int, int) const { \
    _Pragma("unroll") for (int a = 0; a < 2; ++a) _Pragma("unroll") for (int b = 0; b < 2; ++b) _Pragma("unroll") for (int m = 0; m < 4; ++m) _Pragma("unroll") for (int n = 0; n < 2; ++n) acc[a][b][m][n] = (f32x4){0.f, 0.f, 0.f, 0.f}; }
struct EpiIn {
    unsigned char* ws; float* out;
    EPI_ZERO_INIT
    __device__ __forceinline__ void operator()(EPI_ARGS) const {
        const int lr0 = wr * 64 + fr, lc0 = wc * 32 + 8 * fq;
        const int pm = u.pm, pn = u.pn;
        const bool smp = (pm == 128);
#ifdef P1_NO_QKV
        if (false) {
#else
        if (pn < 9) {
#endif
            const int sec = pn / 3, cb = (pn - sec * 3) * 256 + lc0;
            bf16_t* dst = (bf16_t*)(ws + (sec == 0 ? WS_QB : (sec == 1 ? WS_KB : WS_VB)));
            const float sc = sec == 0 ? QSCALE : 1.f;
#pragma unroll
            for (int ai = 0; ai < 2; ++ai)
#pragma unroll
                for (int m = 0; m < 4; ++m) {
                    bf16_t* rowp = dst + ((size_t)pm * 256 + lr0 + 128 * ai + 16 * m) * AW + cb;
#pragma unroll
                    for (int bj = 0; bj < 2; ++bj) {
                        const f32x4 v0 = acc[ai][bj][m][0] * sc, v1 = acc[ai][bj][m][1] * sc;
                        u32x4 w; w.x = pkbf(v0[0], v0[1]); w.y = pkbf(v0[2], v0[3]); w.z = pkbf(v1[0], v1[1]); w.w = pkbf(v1[2], v1[3]);
                        *(u32x4*)(rowp + bj * 128) = w;
                    }
                }
            if (sec > 0 && (smp || (pm & 31) >= 24)) {
                float* fb; size_t sa, sm;
                if (smp) { fb = out + (sec == 1 ? OFF_SWK : OFF_SWV) + ((size_t)(8 * wr + (fr >> 3)) * WBUF + (WBUF - TS) + (fr & 7)) * AW + cb; sa = (size_t)16 * WBUF * AW; sm = (size_t)2 * WBUF * AW; }
                else { fb = out + (sec == 1 ? OFF_PWK : OFF_PWV) + ((size_t)(pm >> 5) * WBUF + ((pm & 31) - 24) * 256 + lr0) * AW + cb; sa = (size_t)128 * AW; sm = (size_t)16 * AW; }
#pragma unroll
                for (int ai = 0; ai < 2; ++ai)
#pragma unroll
                    for (int m = 0; m < 4; ++m)
#pragma unroll
                        for (int bj = 0; bj < 2; ++bj) { float* fp = fb + ai * sa + m * sm + bj * 128; *(f32x4*)fp = acc[ai][bj][m][0]; *(f32x4*)(fp + 4) = acc[ai][bj][m][1]; }
            }
#ifdef P1_NO_GLU
        } else if (false) {
#else
        } else {
#endif
            const int c0 = (pn - 9) * 128 + lc0;
            float* U = (float*)(ws + WS_U);
#pragma unroll
            for (int ai = 0; ai < 2; ++ai)
#pragma unroll
                for (int m = 0; m < 4; ++m) {
                    const size_t grow = (size_t)pm * 256 + lr0 + 128 * ai + 16 * m;
#pragma unroll
                    for (int n = 0; n < 2; ++n) {
                        const f32x4 a = acc[ai][0][m][n], gg = acc[ai][1][m][n]; f32x4 uu;
#pragma unroll
                        for (int e = 0; e < 4; ++e) uu[e] = a[e] * fast_rcp(1.f + fast_exp2(-gg[e] * LOG2E));
                        *(f32x4*)(U + grow * CWD + c0 + 4 * n) = uu;
                    }
                }
            if (smp) {
                float* fb = out + OFF_SCONV + ((size_t)(8 * wr + (fr >> 3)) * 30 + 22 + (fr & 7)) * CWD + c0;
#pragma unroll
                for (int ai = 0; ai < 2; ++ai)
#pragma unroll
                    for (int m = 0; m < 4; ++m)
#pragma unroll
                        for (int n = 0; n < 2; ++n) {
                            const f32x4 a = acc[ai][0][m][n], gg = acc[ai][1][m][n]; f32x4 uu;
#pragma unroll
                            for (int e = 0; e < 4; ++e) uu[e] = a[e] * fast_rcp(1.f + fast_exp2(-gg[e] * LOG2E));
                            *(f32x4*)(fb + (size_t)(16 * ai + 2 * m) * 30 * CWD + 4 * n) = uu;
                        }
            } else if ((pm & 31) == 31 && wr == 1) {
#pragma unroll
                for (int m = 2; m < 4; ++m) {
                    const int lr = lr0 + 128 + 16 * m;
                    if (lr >= 226) {
                        float* fb = out + OFF_PCONV + ((size_t)(pm >> 5) * 30 + (lr - 226)) * CWD + c0;
#pragma unroll
                        for (int n = 0; n < 2; ++n) {
                            const f32x4 a = acc[1][0][m][n], gg = acc[1][1][m][n]; f32x4 uu;
#pragma unroll
                            for (int e = 0; e < 4; ++e) uu[e] = a[e] * fast_rcp(1.f + fast_exp2(-gg[e] * LOG2E));
                            *(f32x4*)(fb + 4 * n) = uu;
                        }
                    }
                }
            }
        }
    }
};
struct EpiMem {
    unsigned char* ws; float* out;
    EPI_ZERO_INIT
    __device__ __forceinline__ void operator()(EPI_ARGS) const {
        const int lr0 = wr * 64 + fr, lc0 = wc * 32 + 8 * fq;
        if (u.kind == 1) {
            const int sec = (u.pn - 11) >> 2, cb = ((u.pn - 11) & 3) * 256 + lc0;
            float* fo = out + (sec ? OFF_PMV : OFF_PMK); bf16_t* MKB = (bf16_t*)(ws + WS_MKB);
#pragma unroll
            for (int ai = 0; ai < 2; ++ai)
#pragma unroll
                for (int m = 0; m < 4; ++m) {
                    const size_t mr = (size_t)(u.pm - 129) * 256 + lr0 + 128 * ai + 16 * m;
#pragma unroll
                    for (int bj = 0; bj < 2; ++bj) {
                        const f32x4 v0 = acc[ai][bj][m][0], v1 = acc[ai][bj][m][1];
                        float* fp = fo + mr * 1024 + cb + bj * 128; *(f32x4*)fp = v0; *(f32x4*)(fp + 4) = v1;
                        if (sec == 0) { u32x4 w; w.x = pkbf(v0[0], v0[1]); w.y = pkbf(v0[2], v0[3]); w.z = pkbf(v1[0], v1[1]); w.w = pkbf(v1[2], v1[3]); *(u32x4*)(MKB + mr * 1024 + cb + bj * 128) = w; }
                    }
                }
        } else {
            bf16_t* MVT = (bf16_t*)(ws + WS_MVT);
#pragma unroll
            for (int ai = 0; ai < 2; ++ai)
#pragma unroll
                for (int m = 0; m < 4; ++m) {
                    const size_t nr = (size_t)u.pm * 256 + lr0 + 128 * ai + 16 * m;
#pragma unroll
                    for (int bj = 0; bj < 2; ++bj) {
                        const f32x4 v0 = acc[ai][bj][m][0], v1 = acc[ai][bj][m][1];
                        u32x4 w; w.x = pkbf(v0[0], v0[1]); w.y = pkbf(v0[2], v0[3]); w.z = pkbf(v1[0], v1[1]); w.w = pkbf(v1[2], v1[3]);
                        *(u32x4*)(MVT + nr * 1024 + u.pn * 256 + lc0 + bj * 128) = w;
                    }
                }
        }
    }
};
__device__ __forceinline__ void init_from_xn(f32x4 (&acc)[2][2][4][2], const bf16_t* XN, const float* g, const Unit& u, int wr, int wc, int fr, int fq) {
    const int lr0 = wr * 64 + fr, c0 = u.pn * 256 + wc * 32 + 8 * fq;
    f32x4 rg[2][2];
#pragma unroll
    for (int bj = 0; bj < 2; ++bj)
#pragma unroll
        for (int n = 0; n < 2; ++n) { const f32x4 gg = *(const f32x4*)(g + c0 + bj * 128 + 4 * n); rg[bj][n] = (f32x4){fast_rcp(gg[0]), fast_rcp(gg[1]), fast_rcp(gg[2]), fast_rcp(gg[3])}; }
#pragma unroll
    for (int ai = 0; ai < 2; ++ai)
#pragma unroll
        for (int m = 0; m < 4; ++m) {
            const unsigned ro = (unsigned)((u.pm * 256 + lr0 + 128 * ai + 16 * m) * DM + c0) * 2u;
#pragma unroll
            for (int bj = 0; bj < 2; ++bj) { const u32x4 w = *(const u32x4*)((const char*)XN + ro + bj * 256);
                acc[ai][bj][m][0] = (f32x4){bf_lo(w.x), bf_hi(w.x), bf_lo(w.y), bf_hi(w.y)} * rg[bj][0];
                acc[ai][bj][m][1] = (f32x4){bf_lo(w.z), bf_hi(w.z), bf_lo(w.w), bf_hi(w.w)} * rg[bj][1]; }
        }
}
template <bool RESX> struct EpiRes {
    const float* resP; const float* resS; const float* gp; bf16_t* XN; const float* g; float* SSQ;
    __device__ __forceinline__ void init(f32x4 (&acc)[2][2][4][2], const Unit& u, int wr, int wc, int fr, int fq) const {
        if (RESX) {
            const int lr0 = wr * 64 + fr, c0 = u.pn * 256 + wc * 32 + 8 * fq;
            const float* res = (u.pm == 128) ? resS - (size_t)MP * DM : resP;
#pragma unroll
            for (int ai = 0; ai < 2; ++ai)
#pragma unroll
                for (int m = 0; m < 4; ++m) {
                    const float* rp = res + ((size_t)u.pm * 256 + lr0 + 128 * ai + 16 * m) * DM + c0;
#pragma unroll
                    for (int bj = 0; bj < 2; ++bj) { acc[ai][bj][m][0] = *(const f32x4*)(rp + bj * 128); acc[ai][bj][m][1] = *(const f32x4*)(rp + bj * 128 + 4); }
                }
        } else init_from_xn(acc, XN, gp, u, wr, wc, fr, fq);
    }
    __device__ __forceinline__ void operator()(EPI_ARGS) const {
        const int lr0 = wr * 64 + fr, c0 = u.pn * 256 + wc * 32 + 8 * fq;
        f32x4 gv[2][2];
#pragma unroll
        for (int bj = 0; bj < 2; ++bj)
#pragma unroll
            for (int n = 0; n < 2; ++n) gv[bj][n] = *(const f32x4*)(g + c0 + bj * 128 + 4 * n);
#pragma unroll
        for (int ai = 0; ai < 2; ++ai)
#pragma unroll
            for (int m = 0; m < 4; ++m) {
                const size_t grow = (size_t)u.pm * 256 + lr0 + 128 * ai + 16 * m; const size_t off = grow * DM + c0;
                float ss = 0.f;
#pragma unroll
                for (int bj = 0; bj < 2; ++bj) {
                    f32x4 x0 = acc[ai][bj][m][0], x1 = acc[ai][bj][m][1];
                    ss += (x0[0] * x0[0] + x0[1] * x0[1]) + (x0[2] * x0[2] + x0[3] * x0[3]) + (x1[0] * x1[0] + x1[1] * x1[1]) + (x1[2] * x1[2] + x1[3] * x1[3]);
                    x0 = x0 * gv[bj][0]; x1 = x1 * gv[bj][1];
                    u32x4 w; w.x = pkbf(x0[0], x0[1]); w.y = pkbf(x0[2], x0[3]); w.z = pkbf(x1[0], x1[1]); w.w = pkbf(x1[2], x1[3]);
                    *(u32x4*)(XN + off + bj * 128) = w;
                }
                ss += __shfl_xor(ss, 16); ss += __shfl_xor(ss, 32);
                if (fq == 0) SSQ[grow * 16 + u.pn * 4 + wc] = ss;
            }
    }
};
struct EpiFinal {
    const bf16_t* XN; const float* gp; float* Y; const float* g; float* slots; unsigned* cnt; LAS float* xl; int wave;
    __device__ __forceinline__ void init(f32x4 (&acc)[2][2][4][2], const Unit& u, int wr, int wc, int fr, int fq) const { init_from_xn(acc, XN, gp, u, wr, wc, fr, fq); }
    __device__ __forceinline__ void operator()(EPI_ARGS) const {
        const int lr0 = wr * 64 + fr, c0 = u.pn * 256 + wc * 32 + 8 * fq;
        const int lane = fr + 16 * fq;
#pragma unroll
        for (int ai = 0; ai < 2; ++ai)
#pragma unroll
            for (int m = 0; m < 4; ++m) {
                float ss = 0.f;
#pragma unroll
                for (int bj = 0; bj < 2; ++bj)
#pragma unroll
                    for (int n = 0; n < 2; ++n) { const f32x4 x = acc[ai][bj][m][n]; ss += (x[0] * x[0] + x[1] * x[1]) + (x[2] * x[2] + x[3] * x[3]); }
                ss += __shfl_xor(ss, 16); ss += __shfl_xor(ss, 32);
                if (fq == 0) xl[(lr0 + 128 * ai + 16 * m) * 4 + wc] = ss;
            }
        asm volatile("s_waitcnt lgkmcnt(0)" ::: "memory"); __builtin_amdgcn_s_barrier(); asm volatile("" ::: "memory");
        const int row = wave * 32 + (lane & 31);
        if (lane < 32) { const f32x4 q4 = *(const LAS f32x4*)(xl + row * 4);
            __hip_atomic_store(slots + ((size_t)u.pm * 256 + row) * 4 + u.pn, (q4[0] + q4[1]) + (q4[2] + q4[3]), __ATOMIC_RELAXED, __HIP_MEMORY_SCOPE_AGENT); }
        asm volatile("s_waitcnt vmcnt(0)" ::: "memory");
        if (lane == 0) __hip_atomic_fetch_add(cnt + 64 * u.pm, 1u, __ATOMIC_RELAXED, __HIP_MEMORY_SCOPE_AGENT);
        if (wave == 0) {
            unsigned sp = 0;
            while ((unsigned)__builtin_amdgcn_readfirstlane(__hip_atomic_load(cnt + 64 * u.pm, __ATOMIC_RELAXED, __HIP_MEMORY_SCOPE_AGENT)) < 32u) { __builtin_amdgcn_s_sleep(2); if (++sp > (1u << 21)) break; }
            __builtin_amdgcn_fence(__ATOMIC_ACQUIRE, "agent");
        }
        asm volatile("s_waitcnt vmcnt(0) lgkmcnt(0)" ::: "memory"); __builtin_amdgcn_s_barrier(); asm volatile("" ::: "memory");
        if (lane < 32) { const float* sl = slots + ((size_t)u.pm * 256 + row) * 4; float t = 0.f;
#pragma unroll
            for (int k = 0; k < 4; ++k) t += __hip_atomic_load(sl + k, __ATOMIC_RELAXED, __HIP_MEMORY_SCOPE_AGENT);
            xl[1024 + row] = 1.0f / sqrtf(t * (1.0f / DM) + EPS); }
        asm volatile("s_waitcnt vmcnt(0) lgkmcnt(0)" ::: "memory"); __builtin_amdgcn_s_barrier(); asm volatile("" ::: "memory");
#pragma unroll
        for (int ai = 0; ai < 2; ++ai)
#pragma unroll
            for (int m = 0; m < 4; ++m) {
                const int lr = lr0 + 128 * ai + 16 * m; const float rs = xl[1024 + lr]; float* yp = Y + ((size_t)u.pm * 256 + lr) * DM + c0;
#pragma unroll
                for (int bj = 0; bj < 2; ++bj) { const f32x4 g0 = *(const f32x4*)(g + c0 + bj * 128), g1 = *(const f32x4*)(g + c0 + bj * 128 + 4);
                    *(f32x4*)(yp + bj * 128) = acc[ai][bj][m][0] * rs * g0; *(f32x4*)(yp + bj * 128 + 4) = acc[ai][bj][m][1] * rs * g1; }
                asm volatile("" ::: "memory");
            }
        asm volatile("s_waitcnt lgkmcnt(0)" ::: "memory"); __builtin_amdgcn_s_barrier(); asm volatile("" ::: "memory");
    }
};
__device__ __forceinline__ float row_rstd(const float* SSQ, size_t grow) {
    const f32x4* p = (const f32x4*)(SSQ + grow * 16); const f32x4 a = p[0], b = p[1], c = p[2], d = p[3];
    const float s = ((a[0] + a[1]) + (a[2] + a[3])) + ((b[0] + b[1]) + (b[2] + b[3])) + ((c[0] + c[1]) + (c[2] + c[3])) + ((d[0] + d[1]) + (d[2] + d[3]));
    return 1.0f / sqrtf(s * (1.0f / DM) + EPS);
}
__device__ __forceinline__ void rows_rstd8(const float* SSQ, size_t row0, int fq, float (&rs)[2][4]) {
    f32x4 pre[2][4];
#pragma unroll
    for (int ai = 0; ai < 2; ++ai)
#pragma unroll
        for (int m = 0; m < 4; ++m) pre[ai][m] = *(const f32x4*)(SSQ + (row0 + 128 * ai + 16 * m) * 16 + fq * 4);
    __builtin_amdgcn_sched_barrier(0);
#pragma unroll
    for (int ai = 0; ai < 2; ++ai)
#pragma unroll
        for (int m = 0; m < 4; ++m) { float sq = (pre[ai][m][0] + pre[ai][m][1]) + (pre[ai][m][2] + pre[ai][m][3]); sq += __shfl_xor(sq, 16); sq += __shfl_xor(sq, 32);
            rs[ai][m] = 1.0f / sqrtf(sq * (1.0f / DM) + EPS); }
}
struct EpiScale {
    bf16_t* O; const float* SSQ; float sc;
    EPI_ZERO_INIT
    __device__ __forceinline__ void operator()(EPI_ARGS) const {
        const int lr0 = wr * 64 + fr, c0 = u.pn * 256 + wc * 32 + 8 * fq;
        float rsv[2][4]; rows_rstd8(SSQ, (size_t)u.pm * 256 + lr0, fq, rsv);
#pragma unroll
        for (int ai = 0; ai < 2; ++ai)
#pragma unroll
            for (int m = 0; m < 4; ++m) {
                const size_t grow = (size_t)u.pm * 256 + lr0 + 128 * ai + 16 * m; const float rs = rsv[ai][m] * sc;
#pragma unroll
                for (int bj = 0; bj < 2; ++bj) {
                    const f32x4 v0 = acc[ai][bj][m][0] * rs, v1 = acc[ai][bj][m][1] * rs;
                    u32x4 w; w.x = pkbf(v0[0], v0[1]); w.y = pkbf(v0[2], v0[3]); w.z = pkbf(v1[0], v1[1]); w.w = pkbf(v1[2], v1[3]);
                    *(u32x4*)(O + grow * DM + c0 + bj * 128) = w;
                }
            }
    }
};
struct EpiSwiGLU {
    bf16_t* H; const float* SSQ;
    EPI_ZERO_INIT
    __device__ __forceinline__ void operator()(EPI_ARGS) const {
        const int lr0 = wr * 64 + fr, c0 = u.pn * 128 + wc * 32 + 8 * fq;
        float rsv[2][4]; rows_rstd8(SSQ, (size_t)u.pm * 256 + lr0, fq, rsv);
#pragma unroll
        for (int ai = 0; ai < 2; ++ai)
#pragma unroll
            for (int m = 0; m < 4; ++m) {
                const size_t grow = (size_t)u.pm * 256 + lr0 + 128 * ai + 16 * m; const float rs = rsv[ai][m];
                float hv[8];
#pragma unroll
                for (int n = 0; n < 2; ++n)
#pragma unroll
                    for (int e = 0; e < 4; ++e) { const float gt = acc[ai][0][m][n][e] * rs, up = acc[ai][1][m][n][e] * rs; hv[4 * n + e] = gt * fast_rcp(1.f + fast_exp2(-gt * LOG2E)) * up; }
                u32x4 w; w.x = pkbf(hv[0], hv[1]); w.y = pkbf(hv[2], hv[3]); w.z = pkbf(hv[4], hv[5]); w.w = pkbf(hv[6], hv[7]);
                *(u32x4*)(H + grow * DFF + c0) = w;
            }
    }
};
struct EpiSoftmax {
    bf16_t* P; float* LSUM; LAS float* xch;
    EPI_ZERO_INIT
    __device__ __forceinline__ void operator()(EPI_ARGS) const {
        const int lr0 = wr * 64 + fr, c0 = u.pn * 256 + wc * 32 + 8 * fq;
#pragma unroll
        for (int ai = 0; ai < 2; ++ai)
#pragma unroll
            for (int m = 0; m < 4; ++m) {
                float v = -3.0e38f;
#pragma unroll
                for (int bj = 0; bj < 2; ++bj)
#pragma unroll
                    for (int n = 0; n < 2; ++n) { const f32x4 x = acc[ai][bj][m][n]; v = fmaxf(v, fmaxf(fmaxf(x[0], x[1]), fmaxf(x[2], x[3]))); }
                v = fmaxf(v, __shfl_xor(v, 16)); v = fmaxf(v, __shfl_xor(v, 32));
                if (fq == 0) xch[(lr0 + 128 * ai + 16 * m) * 4 + wc] = v;
            }
        asm volatile("s_waitcnt lgkmcnt(0)" ::: "memory"); __builtin_amdgcn_s_barrier(); asm volatile("" ::: "memory");
#pragma unroll
        for (int ai = 0; ai < 2; ++ai)
#pragma unroll
            for (int m = 0; m < 4; ++m) {
                const f32x4 q4 = *(const LAS f32x4*)(xch + (lr0 + 128 * ai + 16 * m) * 4); const float mx = fmaxf(fmaxf(q4[0], q4[1]), fmaxf(q4[2], q4[3]));
                const size_t grow = (size_t)u.pm * 256 + lr0 + 128 * ai + 16 * m; float ss = 0.f;
#pragma unroll
                for (int bj = 0; bj < 2; ++bj) {
                    f32x4 p0, p1;
#pragma unroll
                    for (int e = 0; e < 4; ++e) { p0[e] = fast_exp2(acc[ai][bj][m][0][e] - mx); p1[e] = fast_exp2(acc[ai][bj][m][1][e] - mx); }
                    ss += ((p0[0] + p0[1]) + (p0[2] + p0[3])) + ((p1[0] + p1[1]) + (p1[2] + p1[3]));
                    u32x4 w; w.x = pkbf(p0[0], p0[1]); w.y = pkbf(p0[2], p0[3]); w.z = pkbf(p1[0], p1[1]); w.w = pkbf(p1[2], p1[3]);
                    *(u32x4*)(P + grow * DM + c0 + bj * 128) = w;
                }
                ss += __shfl_xor(ss, 16); ss += __shfl_xor(ss, 32);
                if (fq == 0) LSUM[grow * 16 + u.pn * 4 + wc] = ss;
                asm volatile("" ::: "memory"); __builtin_amdgcn_sched_barrier(0);
            }
    }
};
struct EpiPV {
    bf16_t* O; const float* LSUM;
    EPI_ZERO_INIT
    __device__ __forceinline__ void operator()(EPI_ARGS) const {
        const int lr0 = wr * 64 + fr, c0 = u.pn * 256 + wc * 32 + 8 * fq;
        f32x4 pre[2][4];
#pragma unroll
        for (int ai = 0; ai < 2; ++ai)
#pragma unroll
            for (int m = 0; m < 4; ++m) pre[ai][m] = *(const f32x4*)(LSUM + ((size_t)u.pm * 256 + lr0 + 128 * ai + 16 * m) * 16 + u.pn * 4);
        __builtin_amdgcn_sched_barrier(0);
#pragma unroll
        for (int ai = 0; ai < 2; ++ai)
#pragma unroll
            for (int m = 0; m < 4; ++m) {
                const size_t grow = (size_t)u.pm * 256 + lr0 + 128 * ai + 16 * m;
                const f32x4 l4 = pre[ai][m]; const float rs = 1.0f / ((l4[0] + l4[1]) + (l4[2] + l4[3]));
#pragma unroll
                for (int bj = 0; bj < 2; ++bj) {
                    const f32x4 v0 = acc[ai][bj][m][0] * rs, v1 = acc[ai][bj][m][1] * rs;
                    u32x4 w; w.x = pkbf(v0[0], v0[1]); w.y = pkbf(v0[2], v0[3]); w.z = pkbf(v1[0], v1[1]); w.w = pkbf(v1[2], v1[3]);
                    *(u32x4*)(O + grow * DM + c0 + bj * 128) = w;
                }
            }
    }
};
}

#define XB_TMO      128
#define XB_XCNT(j)  (256  + 64 * (j))
#define XB_XSUB(j)  (1280 + 64 * (j))
#define XB_XGEN(j)  (2304 + 64 * (j))
#define XB_TOP      3328
#define XB_TOPGEN   3392
#define XCD_BAR_WORDS 3456
#define XB_SPIN_CAP (1u << 18)
__device__ __forceinline__ unsigned xb_ld(unsigned* p)              { return __hip_atomic_load(p, __ATOMIC_RELAXED, __HIP_MEMORY_SCOPE_AGENT); }
__device__ __forceinline__ unsigned xb_add(unsigned* p, unsigned v) { return __hip_atomic_fetch_add(p, v, __ATOMIC_RELAXED, __HIP_MEMORY_SCOPE_AGENT); }
__device__ __forceinline__ unsigned xb_xcc_id() { return (unsigned)__builtin_amdgcn_s_getreg((3 << 11) | 20) & 0xFu; }
#define XB_SPIN(cond, bar) do { unsigned _sp = 0; while (cond) { __builtin_amdgcn_s_sleep(1); \
    if ((++_sp & 255u) == 0u) { if (xb_ld(&(bar)[XB_TMO])) break; if (_sp > XB_SPIN_CAP) { atomicAdd(&(bar)[XB_TMO], 1u); break; } } } } while (0)
struct XcdBarrier { unsigned* bar; unsigned x; volatile LAS unsigned* st; };
__device__ __forceinline__ XcdBarrier xcd_barrier_post(unsigned* bar, volatile LAS unsigned* st) {
    XcdBarrier b; b.bar = bar; b.x = xb_xcc_id(); b.st = st;
    if (threadIdx.x == 0) st[3] = xb_add(&bar[XB_XCNT(b.x)], 1u);
    return b;
}
__device__ __forceinline__ void xcd_barrier_complete(unsigned* bar, unsigned x, unsigned& nloc, unsigned& nx, unsigned& xi) {
    const unsigned G = gridDim.x * gridDim.y * gridDim.z;
    unsigned sum, cnt, mine, sp = 0u;
    for (;;) {
        sum = 0u; cnt = 0u; mine = 0u; xi = 0u;
#pragma unroll
        for (unsigned j = 0; j < 16; ++j) { const unsigned c = xb_ld(&bar[XB_XCNT(j)]); sum += c; cnt += (c > 0u) ? 1u : 0u; mine = (j == x) ? c : mine; xi += (c > 0u && j < x) ? 1u : 0u; }
        if (sum == G) break;
        __builtin_amdgcn_s_sleep(1);
        if ((++sp & 255u) == 0u) { if (xb_ld(&bar[XB_TMO])) break; if (sp > XB_SPIN_CAP) { atomicAdd(&bar[XB_TMO], 1u); break; } }
    }
    nloc = mine > 0u ? mine : 1u; nx = cnt > 0u ? cnt : 1u;
}
__device__ __forceinline__ void xcd_barrier(const XcdBarrier& b) {
    asm volatile("s_waitcnt vmcnt(0)" ::: "memory");
    __syncthreads();
    if (threadIdx.x == 0) {
        unsigned* bar = b.bar;
        __builtin_amdgcn_s_waitcnt(0);
        unsigned nloc = b.st[0], nx = b.st[1];
        if (nloc == 0u) { unsigned xi; xcd_barrier_complete(bar, b.x, nloc, nx, xi); b.st[0] = nloc; b.st[1] = nx; b.st[2] = xi; }
        const unsigned old = xb_add(&bar[XB_XSUB(b.x)], 1u);
        const unsigned gen = old / nloc;
        if (old + 1u == (gen + 1u) * nloc) {
            __builtin_amdgcn_fence(__ATOMIC_RELEASE, "agent");
            asm volatile("s_waitcnt vmcnt(0)" ::: "memory");
            const unsigned og = xb_add(&bar[XB_TOP], 1u);
            const unsigned tg = og / nx;
            if (og + 1u == (tg + 1u) * nx) xb_add(&bar[XB_TOPGEN], 1u);
            else XB_SPIN(xb_ld(&bar[XB_TOPGEN]) == tg, bar);
            __builtin_amdgcn_fence(__ATOMIC_ACQUIRE, "agent");
            xb_add(&bar[XB_XGEN(b.x)], 1u);
            asm volatile("s_waitcnt vmcnt(0)" ::: "memory");
        } else {
            XB_SPIN(xb_ld(&bar[XB_XGEN(b.x)]) == gen, bar);
            __builtin_amdgcn_fence(__ATOMIC_ACQUIRE, "agent");
            asm volatile("s_waitcnt vmcnt(0)" ::: "memory");
        }
    }
    __syncthreads();
}

#define XL_SUB(j) (3584 + 64 * (j))
#define XL_GEN(j) (12416 + 64 * (j))
__device__ __forceinline__ void xl_barrier(const XcdBarrier& b) {
    asm volatile("s_waitcnt vmcnt(0)" ::: "memory");
    __syncthreads();
    if (threadIdx.x == 0) {
        unsigned* bar = b.bar; const unsigned nloc = b.st[0], xd = b.st[2] & 7u;
        const unsigned old = xb_add(&bar[XL_SUB(xd)], 1u), gen = old / nloc;
        if (old + 1u == (gen + 1u) * nloc) xb_add(&bar[XL_GEN(xd)], 1u);
        else XB_SPIN(xb_ld(&bar[XL_GEN(xd)]) == gen, bar);
        __builtin_amdgcn_fence(__ATOMIC_ACQUIRE, "agent");
        asm volatile("s_waitcnt vmcnt(0)" ::: "memory");
    }
    __syncthreads();
}

constexpr int RING_BYTES = 131072;
constexpr int XCH_OFF = RING_BYTES;
constexpr int MISC_OFF = RING_BYTES + 6144;
constexpr int LDS_BYTES = RING_BYTES + 8192;
constexpr int ATT_V_OFF = 0, ATT_WBUF = 12800, ATT_TAB_OFF = 8 * ATT_WBUF, ATT_CW_OFF = 65536;

struct Params {
    const float* in[27]; float* out; unsigned char* ws; int ph_lo, ph_hi, coop, pad;
};

__device__ __forceinline__ float wave_sum(float v) {
#pragma unroll
    for (int o = 1; o < 64; o <<= 1) v += __shfl_xor(v, o);
    return v;
}
__device__ __forceinline__ void transpose_item(const float* W, int K, int N, bf16_t* WT, int item, int mode, LAS float* scr, int lane) {
    const int nblk = N / 32, kb = item / nblk, nb = item % nblk, k0 = 64 * kb, n0 = 32 * nb;
    int r0 = n0;
    if (mode == 1) { if (n0 >= 2304) { const int isg = n0 >= 2560, cch = n0 - (isg ? 2560 : 2304); r0 = 2304 + (cch >> 7) * 256 + isg * 128 + (cch & 127); } }
    else if (mode == 2) r0 = (n0 >> 7) * 256 + (n0 & 127);
    else if (mode == 3) r0 = (n0 >> 7) * 256 + 128 + (n0 & 127);
    float wv[32];
#pragma unroll
    for (int i = 0; i < 32; ++i) wv[i] = W[(size_t)(k0 + 2 * i + (lane >> 5)) * N + n0 + (lane & 31)];
#pragma unroll
    for (int i = 0; i < 32; ++i) scr[(2 * i + (lane >> 5)) * 33 + (lane & 31)] = wv[i];
    asm volatile("s_waitcnt lgkmcnt(0)" ::: "memory");
    const int c = lane & 7;
#pragma unroll
    for (int j = 0; j < 4; ++j) { const int n = (lane >> 3) + 8 * j; const LAS float* s = scr + (8 * c) * 33 + n;
        u32x4 o; o.x = pkbf(s[0 * 33], s[1 * 33]); o.y = pkbf(s[2 * 33], s[3 * 33]); o.z = pkbf(s[4 * 33], s[5 * 33]); o.w = pkbf(s[6 * 33], s[7 * 33]);
        *(u32x4*)(WT + (size_t)(r0 + n) * K + k0 + 8 * c) = o; }
    asm volatile("s_waitcnt lgkmcnt(0)" ::: "memory");
}
template <int NR> __device__ __forceinline__ void rms_rows_bf16(const float* const (&xrow)[NR], const float* g, bf16_t* const (&orow)[NR], int lane) {
    f32x4 v[NR][4];
#pragma unroll
    for (int r = 0; r < NR; ++r)
#pragma unroll
        for (int j = 0; j < 4; ++j) v[r][j] = ((const f32x4*)xrow[r] + lane)[64 * j];
    const f32x4* gr = (const f32x4*)g + lane;
    f32x4 gg[4];
#pragma unroll
    for (int j = 0; j < 4; ++j) gg[j] = gr[64 * j];
#pragma unroll
    for (int r = 0; r < NR; ++r) {
        float s = 0.f;
#pragma unroll
        for (int j = 0; j < 4; ++j) s += (v[r][j][0] * v[r][j][0] + v[r][j][1] * v[r][j][1]) + (v[r][j][2] * v[r][j][2] + v[r][j][3] * v[r][j][3]);
        const float rstd = 1.0f / sqrtf(wave_sum(s) * (1.0f / DM) + EPS);
        u32x2* o8 = (u32x2*)orow[r] + lane;
#pragma unroll
        for (int j = 0; j < 4; ++j) { u32x2 w; w.x = pkbf(v[r][j][0] * rstd * gg[j][0], v[r][j][1] * rstd * gg[j][1]); w.y = pkbf(v[r][j][2] * rstd * gg[j][2], v[r][j][3] * rstd * gg[j][3]); o8[64 * j] = w; }
    }
}

namespace att {
__device__ __forceinline__ int crow(int r, int hi) { return (r & 3) + 8 * (r >> 2) + 4 * hi; }
struct Ctx {
    const bf16_t *QB, *KB, *VB; const float *CK, *CV;
    bf16_t* OP; float* LSE; bf16_t* ATT;
};
__device__ __forceinline__ bf16x8 ld8_bf16(const bf16_t* p) { return *(const bf16x8*)p; }
__device__ __forceinline__ bf16x8 ld8_f32(const float* p) {
    const f32x4 a = *(const f32x4*)p, b = *(const f32x4*)(p + 4); u32x4 w; w.x = pkbf(a[0], a[1]); w.y = pkbf(a[2], a[3]); w.z = pkbf(b[0], b[1]); w.w = pkbf(b[2], b[3]);
    return __builtin_bit_cast(bf16x8, w);
}
template <int MODE> __device__ __forceinline__ bf16x8 ld_kv(const bf16_t* B16, const float* C32, int bq, int h, int dil, int r, int idx, int doff, bool newrows) {
    if (MODE == 0) { const int ii = idx < 0 ? 0 : idx; return ld8_bf16(B16 + ((size_t)bq * SEQ + r + (size_t)dil * ii) * AW + h * HD + doff); }
    int p = r + dil * idx;
    if (!newrows) return ld8_f32(C32 + (((size_t)bq * WBUF + p) * NH + h) * HD + doff);
    p = p > (WBUF + TS - 1) ? (WBUF + TS - 1) : p;
    return ld8_bf16(B16 + ((size_t)MP + bq * TS + (p - WBUF)) * AW + h * HD + doff);
}
template <int MODE> __device__ __forceinline__ void ld_kv4(bf16x8 (&dst)[4], const bf16_t* B16, const float* C32, int bq, int h, int dil, int r, int idx0, int doff, bool newrows) {
    if (MODE == 1 && !newrows) {
        f32x4 raw[4][2];
#pragma unroll
        for (int i = 0; i < 4; ++i) { const float* p = C32 + (((size_t)bq * WBUF + (r + dil * (idx0 + 8 * i))) * NH + h) * HD + doff; raw[i][0] = *(const f32x4*)p; raw[i][1] = *(const f32x4*)(p + 4); }
        __builtin_amdgcn_sched_barrier(0);
#pragma unroll
        for (int i = 0; i < 4; ++i) { u32x4 w; w.x = pkbf(raw[i][0][0], raw[i][0][1]); w.y = pkbf(raw[i][0][2], raw[i][0][3]); w.z = pkbf(raw[i][1][0], raw[i][1][1]); w.w = pkbf(raw[i][1][2], raw[i][1][3]);
            dst[i] = __builtin_bit_cast(bf16x8, w); }
    } else {
#pragma unroll
        for (int i = 0; i < 4; ++i) dst[i] = ld_kv<MODE>(B16, C32, bq, h, dil, r, idx0 + 8 * i, doff, newrows);
    }
}
template <int MODE> __device__ __forceinline__ void wave_block(const Ctx& c, int bq, int h, int g, int dil, int r, int i0, int nq, const LAS float* tab, LAS unsigned char* wbuf) {
    const int lane = fresh_lane(), r32 = lane & 31, hi = lane >> 5;
    const int vkey = lane >> 3, vch = lane & 7;
    const bool qvalid = r32 < nq; const int qq = qvalid ? r32 : 0;
    size_t qtok;
    if (MODE == 0) qtok = (size_t)bq * SEQ + r + (size_t)dil * (i0 + qq);
    else qtok = (size_t)MP + bq * TS + (r + dil * (i0 + qq) - WBUF);
    LAS unsigned char* kb = wbuf; LAS unsigned char* vbuf = wbuf + 4608;
    bf16x8 qv[4];
#pragma unroll
    for (int i = 0; i < 4; ++i) { int qi = 8 * i + vkey; qi = qi < nq ? qi : 0;
        const size_t tk = (MODE == 0) ? (size_t)bq * SEQ + r + (size_t)dil * (i0 + qi) : (size_t)MP + bq * TS + (r + dil * (i0 + qi) - WBUF);
        qv[i] = ld8_bf16(c.QB + tk * AW + h * HD + vch * 8); }
    bf16x8 kr[5][4];
    constexpr int KA = (MODE == 0) ? 5 : 2;
#pragma unroll
    for (int s = 0; s < KA; ++s)
        ld_kv4<MODE>(kr[s], c.KB, c.CK, bq, h, dil, r, i0 - 128 + 32 * s + vkey, vch * 8, s == 4);
#pragma unroll
    for (int i = 0; i < 4; ++i) *(LAS bf16x8*)(kb + (8 * i + vkey) * 144 + vch * 16) = qv[i];
    bf16x8 qr[4];
#pragma unroll
    for (int d0 = 0; d0 < 4; ++d0) qr[d0] = *(const LAS bf16x8*)(kb + r32 * 144 + d0 * 32 + hi * 16);
    f32x16 S[5];
#pragma unroll
    for (int s = 0; s < 5; ++s) {
        if (MODE != 0 && s + KA < 5) {
            ld_kv4<MODE>(kr[s + KA], c.KB, c.CK, bq, h, dil, r, i0 - 128 + 32 * (s + KA) + vkey, vch * 8, s + KA == 4);
        }
#pragma unroll
        for (int i = 0; i < 4; ++i) *(LAS bf16x8*)(kb + (8 * i + vkey) * 144 + vch * 16) = kr[s][i];
        bf16x8 kf[4];
#pragma unroll
        for (int d0 = 0; d0 < 4; ++d0) kf[d0] = *(const LAS bf16x8*)(kb + r32 * 144 + d0 * 32 + hi * 16);
        f32x16 a = {};
#pragma unroll
        for (int d0 = 0; d0 < 4; ++d0) a = __builtin_amdgcn_mfma_f32_32x32x16_bf16(kf[d0], qr[d0], a, 0, 0, 0);
        S[s] = a;
        __builtin_amdgcn_sched_barrier(0);
    }
    bf16x8 vr[5][4];
#pragma unroll
    for (int s = 0; s < KA; ++s)
        ld_kv4<MODE>(vr[s], c.VB, c.CV, bq, h, dil, r, i0 - 128 + 32 * s + vkey, vch * 8, s == 4);
    __builtin_amdgcn_sched_barrier(0);
    const LAS float* tb = tab + 159 + r32 - 4 * hi;
#pragma unroll
    for (int s = 0; s < 5; ++s)
#pragma unroll
        for (int rr = 0; rr < 16; ++rr) S[s][rr] += tb[-(32 * s + (rr & 3) + 8 * (rr >> 2))];
    if (MODE == 0 && i0 < 128) {
#pragma unroll
        for (int s = 0; s < 5; ++s)
#pragma unroll
            for (int rr = 0; rr < 16; ++rr) if (i0 - 128 + 32 * s + crow(rr, hi) < 0) S[s][rr] = -1e30f;
    }
    float mx = -3.0e38f;
#pragma unroll
    for (int s = 0; s < 5; ++s)
#pragma unroll
        for (int rr = 0; rr < 16; ++rr) mx = fmaxf(mx, S[s][rr]);
    mx = fmaxf(mx, __shfl_xor(mx, 32));
    float l = 0.f;
#pragma unroll
    for (int s = 0; s < 5; ++s)
#pragma unroll
        for (int rr = 0; rr < 16; ++rr) { const float p = fast_exp2(S[s][rr] - mx); S[s][rr] = p; l += p; }
    l += __shfl_xor(l, 32);
    f32x16 o[2]; o[0] = (f32x16){}; o[1] = (f32x16){};
    const int vrd = (4 * hi + ((lane & 15) >> 2)) * 64 + ((lane >> 4) & 1) * 32 + (lane & 3) * 8;
    __builtin_amdgcn_sched_barrier(0);
#pragma unroll
    for (int s = 0; s < 5; ++s) {
        LAS unsigned char* vb = vbuf + (s & 1) * 4096;
#pragma unroll
        for (int i = 0; i < 4; ++i) *(LAS bf16x8*)(vb + (vch >> 2) * 2048 + (8 * i + vkey) * 64 + (vch & 3) * 16) = vr[s][i];
        if (MODE != 0 && s + KA < 5) {
            ld_kv4<MODE>(vr[s + KA], c.VB, c.CV, bq, h, dil, r, i0 - 128 + 32 * (s + KA) + vkey, vch * 8, s + KA == 4);
        }
#pragma unroll
        for (int sp = 0; sp < 2; ++sp) {
            u32x4 pw; pw.x = pkbf(S[s][8 * sp + 0], S[s][8 * sp + 1]); pw.y = pkbf(S[s][8 * sp + 2], S[s][8 * sp + 3]); pw.z = pkbf(S[s][8 * sp + 4], S[s][8 * sp + 5]); pw.w = pkbf(S[s][8 * sp + 6], S[s][8 * sp + 7]);
            const bf16x8 pf = __builtin_bit_cast(bf16x8, pw);
#pragma unroll
            for (int dt = 0; dt < 2; ++dt) {
                const s16x4 lo = __builtin_bit_cast(s16x4, __builtin_amdgcn_ds_read_tr16_b64_v4i16((LAS s16x4*)(vb + vrd + dt * 2048 + sp * 1024)));
                const s16x4 hh = __builtin_bit_cast(s16x4, __builtin_amdgcn_ds_read_tr16_b64_v4i16((LAS s16x4*)(vb + vrd + dt * 2048 + sp * 1024 + 512)));
                const bf16x8 vf = (bf16x8){lo[0], lo[1], lo[2], lo[3], hh[0], hh[1], hh[2], hh[3]};
                o[dt] = __builtin_amdgcn_mfma_f32_32x32x16_bf16(vf, pf, o[dt], 0, 0, 0);
            }
        }
        __builtin_amdgcn_sched_barrier(0);
    }
    {
        const float inv = 1.0f / l;
#pragma unroll
        for (int dt = 0; dt < 2; ++dt)
#pragma unroll
            for (int rg = 0; rg < 4; ++rg) { u32x2 w; w.x = pkbf(o[dt][4 * rg] * inv, o[dt][4 * rg + 1] * inv); w.y = pkbf(o[dt][4 * rg + 2] * inv, o[dt][4 * rg + 3] * inv);
                *(LAS u32x2*)(kb + r32 * 144 + (32 * dt + 8 * rg + 4 * hi) * 2) = w; }
        if (qvalid && hi == 0) c.LSE[(size_t)g * LSE_STRIDE + qtok * NH + h] = mx + __log2f(l);
#pragma unroll
        for (int i = 0; i < 4; ++i) { const int qi = 8 * i + vkey;
            if (qi < nq) {
                const size_t tk = (MODE == 0) ? (size_t)bq * SEQ + r + (size_t)dil * (i0 + qi) : (size_t)MP + bq * TS + (r + dil * (i0 + qi) - WBUF);
                *(u32x4*)(c.OP + (size_t)g * OP_STRIDE + tk * AW + h * HD + vch * 8) = *(const LAS u32x4*)(kb + qi * 144 + vch * 16);
            } }
    }
}
struct PDesc { int b, h, g, dil, r, i0; };
__device__ __forceinline__ unsigned ptok(const PDesc& d, int idx) { return (unsigned)(d.b * SEQ + d.r + d.dil * idx); }
__device__ __forceinline__ bf16x8 ld8_off(const bf16_t* base, unsigned byte_off) { return *(const bf16x8*)((const char*)base + byte_off); }
__device__ __forceinline__ void p_load_q(const Ctx& c, const PDesc& d, bf16x8 (&qv)[4], int vkey, int vch) {
    const unsigned o0 = (ptok(d, d.i0 + vkey) * AW + d.h * HD + vch * 8) * 2u, st = (unsigned)(8 * d.dil * AW * 2);
#pragma unroll
    for (int i = 0; i < 4; ++i) qv[i] = ld8_off(c.QB, o0 + i * st);
}
__device__ __forceinline__ void p_load_kv(const bf16_t* B, const PDesc& d, int s, bf16x8 (&x)[4], int vkey, int vch) {
    const unsigned cb = (unsigned)((d.b * SEQ + d.r) * AW + d.h * HD + vch * 8) * 2u, st = (unsigned)(d.dil * AW * 2);
#pragma unroll
    for (int i = 0; i < 4; ++i) { int idx = d.i0 - 128 + 32 * s + 8 * i + vkey; idx = idx < 0 ? 0 : idx; x[i] = ld8_off(B, cb + (unsigned)idx * st); }
}
__device__ __forceinline__ void pblock(const Ctx& c, const PDesc& cur, const PDesc& nxt, bool has_next, bf16x8 (&qv)[4], bf16x8 (&kr)[5][4], const LAS float* tabs, LAS unsigned char* wbuf) {
    const int lane = fresh_lane(), r32 = lane & 31, hi = lane >> 5, vkey = lane >> 3, vch = lane & 7;
    LAS unsigned char* vbuf = wbuf;
    LAS unsigned char* kb = wbuf + 8192;
    const int kwr = vkey * 128 + ((vch ^ (vkey & 7)) << 4);
    const int krd0 = r32 * 128, kx = r32 & 7;
    const int i0 = cur.i0;
#pragma unroll
    for (int i = 0; i < 4; ++i) *(LAS bf16x8*)(kb + (8 * i + vkey) * 144 + vch * 16) = qv[i];
    bf16x8 qr[4];
#pragma unroll
    for (int d0 = 0; d0 < 4; ++d0) qr[d0] = *(const LAS bf16x8*)(kb + r32 * 144 + d0 * 32 + hi * 16);
    f32x16 S[5];
    bf16x8 vr[5][4];
    p_load_kv(c.KB, cur, 2, kr[2], vkey, vch); p_load_kv(c.KB, cur, 3, kr[3], vkey, vch); p_load_kv(c.KB, cur, 4, kr[4], vkey, vch);
#pragma unroll
    for (int s = 0; s < 5; ++s) {
        LAS unsigned char* kp = vbuf + (s & 1) * 4096;
#pragma unroll
        for (int i = 0; i < 4; ++i) *(LAS bf16x8*)(kp + i * 1024 + kwr) = kr[s][i];
        if (s < 3) p_load_kv(c.VB, cur, s, vr[s], vkey, vch);
        bf16x8 kf[4];
#pragma unroll
        for (int d0 = 0; d0 < 4; ++d0) kf[d0] = *(const LAS bf16x8*)(kp + krd0 + (((2 * d0 + hi) ^ kx) << 4));
        f32x16 a = {};
#pragma unroll
        for (int d0 = 0; d0 < 4; ++d0) a = __builtin_amdgcn_mfma_f32_32x32x16_bf16(kf[d0], qr[d0], a, 0, 0, 0);
        S[s] = a;
    }
    __builtin_amdgcn_sched_barrier(0);
    const LAS float* tb = tabs + (cur.g * 12 + cur.h) * 192 + 159 + r32 - 4 * hi;
#pragma unroll
    for (int s = 0; s < 5; ++s)
#pragma unroll
        for (int rr = 0; rr < 16; ++rr) S[s][rr] += tb[-(32 * s + (rr & 3) + 8 * (rr >> 2))];
    if (i0 < 128) {
#pragma unroll
        for (int s = 0; s < 5; ++s)
#pragma unroll
            for (int rr = 0; rr < 16; ++rr) if (i0 - 128 + 32 * s + crow(rr, hi) < 0) S[s][rr] = -1e30f;
    }
    float mx = -3.0e38f;
#pragma unroll
    for (int s = 0; s < 5; ++s)
#pragma unroll
        for (int rr = 0; rr < 16; ++rr) mx = fmaxf(mx, S[s][rr]);
    mx = fmaxf(mx, __shfl_xor(mx, 32));
    float l = 0.f;
    bf16x8 pf[5][2];
#pragma unroll
    for (int s = 0; s < 5; ++s) {
#pragma unroll
        for (int rr = 0; rr < 16; ++rr) { const float p = fast_exp2(S[s][rr] - mx); S[s][rr] = p; l += p; }
#pragma unroll
        for (int sp = 0; sp < 2; ++sp) { u32x4 pw; pw.x = pkbf(S[s][8 * sp + 0], S[s][8 * sp + 1]); pw.y = pkbf(S[s][8 * sp + 2], S[s][8 * sp + 3]); pw.z = pkbf(S[s][8 * sp + 4], S[s][8 * sp + 5]); pw.w = pkbf(S[s][8 * sp + 6], S[s][8 * sp + 7]);
            pf[s][sp] = __builtin_bit_cast(bf16x8, pw); asm volatile("" : "+v"(pf[s][sp])); }
    }
    l += __shfl_xor(l, 32);
    __builtin_amdgcn_sched_barrier(0);
    p_load_kv(c.VB, cur, 3, vr[3], vkey, vch); p_load_kv(c.VB, cur, 4, vr[4], vkey, vch);
    f32x16 o[2]; o[0] = (f32x16){}; o[1] = (f32x16){};
    const int vrd = (4 * hi + ((lane & 15) >> 2)) * 64 + ((lane >> 4) & 1) * 32 + (lane & 3) * 8;
    __builtin_amdgcn_sched_barrier(0);
#pragma unroll
    for (int s = 0; s < 5; ++s) {
        LAS unsigned char* vb = vbuf + (s & 1) * 4096;
#pragma unroll
        for (int i = 0; i < 4; ++i) *(LAS bf16x8*)(vb + (vch >> 2) * 2048 + (8 * i + vkey) * 64 + (vch & 3) * 16) = vr[s][i];
        if (has_next && s < 2) p_load_kv(c.KB, nxt, s, kr[s], vkey, vch);
        if (has_next && s == 2) p_load_q(c, nxt, qv, vkey, vch);
#pragma unroll
        for (int sp = 0; sp < 2; ++sp)
#pragma unroll
            for (int dt = 0; dt < 2; ++dt) {
                const s16x4 lo = __builtin_bit_cast(s16x4, __builtin_amdgcn_ds_read_tr16_b64_v4i16((LAS s16x4*)(vb + vrd + dt * 2048 + sp * 1024)));
                const s16x4 hh = __builtin_bit_cast(s16x4, __builtin_amdgcn_ds_read_tr16_b64_v4i16((LAS s16x4*)(vb + vrd + dt * 2048 + sp * 1024 + 512)));
                const bf16x8 vf = (bf16x8){lo[0], lo[1], lo[2], lo[3], hh[0], hh[1], hh[2], hh[3]};
                o[dt] = __builtin_amdgcn_mfma_f32_32x32x16_bf16(vf, pf[s][sp], o[dt], 0, 0, 0);
            }
    }
    __builtin_amdgcn_sched_barrier(0);
    {
        const float inv = 1.0f / l;
#pragma unroll
        for (int dt = 0; dt < 2; ++dt)
#pragma unroll
            for (int rg = 0; rg < 4; ++rg) { u32x2 w; w.x = pkbf(o[dt][4 * rg] * inv, o[dt][4 * rg + 1] * inv); w.y = pkbf(o[dt][4 * rg + 2] * inv, o[dt][4 * rg + 3] * inv);
                *(LAS u32x2*)(kb + r32 * 144 + (32 * dt + 8 * rg + 4 * hi) * 2) = w; }
        if (hi == 0) c.LSE[(size_t)cur.g * LSE_STRIDE + (size_t)ptok(cur, i0 + r32) * NH + cur.h] = mx + __log2f(l);
#pragma unroll
        for (int i = 0; i < 4; ++i) { const int qi = 8 * i + vkey;
            *(u32x4*)(c.OP + (size_t)cur.g * OP_STRIDE + (size_t)ptok(cur, i0 + qi) * AW + cur.h * HD + vch * 8) = *(const LAS u32x4*)(kb + qi * 144 + vch * 16); }
    }
}
struct TDesc { int b, h, g, dil, r, j0; };
constexpr int TK_OFF = 0, TV_OFF = 49152, TB_OFF = 98304, TT_OFF = TB_OFF + 8 * 4608;
__device__ __forceinline__ void glds16(const void* sbase, unsigned voff, unsigned lds_dst) { unsigned keep;
    asm volatile("s_mov_b32 %0, m0\n\ts_mov_b32 m0, %3\n\ts_nop 4\n\tglobal_load_lds_dwordx4 %1, %2\n\ts_mov_b32 m0, %0" : "=&s"(keep) : "v"(voff), "s"(sbase), "s"(lds_dst) : "memory"); }
__device__ __forceinline__ void glds4(const void* sbase, unsigned voff, unsigned lds_dst) { unsigned keep;
    asm volatile("s_mov_b32 %0, m0\n\ts_mov_b32 m0, %3\n\ts_nop 4\n\tglobal_load_lds_dword %1, %2\n\ts_mov_b32 m0, %0" : "=&s"(keep) : "v"(voff), "s"(sbase), "s"(lds_dst) : "memory"); }
__device__ __forceinline__ void t_issue_tab(const float* tabg, const TDesc& d, LAS unsigned char* lds, int wave, int lane) {
    if (wave < 3) glds4(tabg, (unsigned)(((d.g * 12 + d.h) * 192 + wave * 64 + lane) * 4), (unsigned)__builtin_amdgcn_readfirstlane((int)((unsigned)(uintptr_t)lds + TT_OFF + wave * 256)));
}
__device__ __forceinline__ void t_issue_k(const Ctx& c, const TDesc& d, LAS unsigned char* lds, int wave, int lane) {
    const int rr = lane >> 3, ch = (lane & 7) ^ ((4 * (wave & 1) + (rr >> 1)) & 7);
    const unsigned cb = (unsigned)((d.b * SEQ + d.r) * AW + d.h * HD + ch * 8) * 2u, st = (unsigned)(d.dil * AW * 2);
    const unsigned l0 = (unsigned)(uintptr_t)lds + TK_OFF;
#pragma unroll
    for (int i = 0; i < 6; ++i) { const int e = wave + 8 * i; int idx = d.j0 - 128 + 8 * e + rr; idx = idx < 0 ? 0 : idx;
        glds16(c.KB, cb + (unsigned)idx * st, (unsigned)__builtin_amdgcn_readfirstlane((int)(l0 + e * 1024))); }
}
__device__ __forceinline__ void t_issue_v(const Ctx& c, const TDesc& d, LAS unsigned char* lds, int wave, int lane) {
    const int kq = lane >> 2, q4 = lane & 3;
    const unsigned cb = (unsigned)((d.b * SEQ + d.r) * AW + d.h * HD + q4 * 8) * 2u, st = (unsigned)(d.dil * AW * 2);
    const unsigned l0 = (unsigned)(uintptr_t)lds + TV_OFF;
#pragma unroll
    for (int i = 0; i < 6; ++i) { const int e = 6 * wave + i, hf = e / 24, e24 = e - hf * 24; int idx = d.j0 - 128 + 16 * e24 + kq; idx = idx < 0 ? 0 : idx;
        glds16(c.VB, cb + (unsigned)idx * st + (unsigned)hf * 64u, (unsigned)__builtin_amdgcn_readfirstlane((int)(l0 + e * 1024))); }
}
__device__ __forceinline__ void t_issue_q(const Ctx& c, const TDesc& d, LAS unsigned char* lds, int wave, int lane) {
    const int rr = lane >> 3, i0 = d.j0 + 32 * wave;
    const unsigned qo0 = ((unsigned)(d.b * SEQ + d.r + d.dil * (i0 + rr)) * AW + d.h * HD) * 2u, qst = (unsigned)(8 * d.dil * AW * 2);
    const unsigned l0 = (unsigned)(uintptr_t)lds + TB_OFF + wave * 4608;
#pragma unroll
    for (int i = 0; i < 4; ++i) { const int ch = (lane & 7) ^ ((4 * (i & 1) + (rr >> 1)) & 7);
        glds16(c.QB, qo0 + i * qst + ch * 16, (unsigned)__builtin_amdgcn_readfirstlane((int)(l0 + i * 1024))); }
}
struct TOut { f32x16 o[2]; float l, mx; };
__device__ __forceinline__ void* sgpr_ptr(const void* p) { const unsigned long long u = (unsigned long long)(uintptr_t)p;
    const unsigned lo = (unsigned)__builtin_amdgcn_readfirstlane((int)(unsigned)u), hi = (unsigned)__builtin_amdgcn_readfirstlane((int)(unsigned)(u >> 32));
    return (void*)(uintptr_t)(((unsigned long long)hi << 32) | lo); }
__device__ __forceinline__ void gst16(void* sbase, unsigned voff, u32x4 v) { asm volatile("s_nop 4\n\tglobal_store_dwordx4 %0, %1, %2\n\ts_nop 1" :: "v"(voff), "v"(v), "s"(sbase) : "memory"); }
__device__ __forceinline__ void gst4(void* sbase, unsigned voff, float v) { asm volatile("s_nop 4\n\tglobal_store_dword %0, %1, %2\n\ts_nop 1" :: "v"(voff), "v"(v), "s"(sbase) : "memory"); }
__device__ __forceinline__ void t_out1(const TOut& po, LAS unsigned char* kb, int r32, int hi) {
    const float inv = 1.0f / po.l;
#pragma unroll
    for (int dt = 0; dt < 2; ++dt)
#pragma unroll
        for (int rg = 0; rg < 4; ++rg) { u32x2 w; w.x = pkbf(po.o[dt][4 * rg] * inv, po.o[dt][4 * rg + 1] * inv); w.y = pkbf(po.o[dt][4 * rg + 2] * inv, po.o[dt][4 * rg + 3] * inv);
            *(LAS u32x2*)(kb + r32 * 144 + (32 * dt + 8 * rg + 4 * hi) * 2) = w; }
}
__device__ __forceinline__ void t_out2(const Ctx& c, const TDesc& d, const TOut& po, const LAS unsigned char* kb, int wave, int r32, int hi, int vkey, int vch, u32x4 (&ow)[4]) {
    const int i0 = d.j0 + 32 * wave;
#pragma unroll
    for (int i = 0; i < 4; ++i) ow[i] = *(const LAS u32x4*)(kb + (8 * i + vkey) * 144 + vch * 16);
    const unsigned tq = (unsigned)(d.b * SEQ + d.r + d.dil * (i0 + r32));
    if (hi == 0) gst4(sgpr_ptr(c.LSE + (size_t)d.g * LSE_STRIDE + d.h), tq * (unsigned)(NH * 4), po.mx + __log2f(po.l));
}
__device__ __forceinline__ void t_out3(const Ctx& c, const TDesc& d, int wave, int vkey, int vch, const u32x4 (&ow)[4]) {
    const int i0 = d.j0 + 32 * wave; void* ob = sgpr_ptr(c.OP + (size_t)d.g * OP_STRIDE + d.h * HD);
#pragma unroll
    for (int i = 0; i < 4; ++i) { const int qi = 8 * i + vkey; const unsigned tk = (unsigned)(d.b * SEQ + d.r + d.dil * (i0 + qi));
        gst16(ob, tk * (unsigned)(AW * 2) + (unsigned)(vch * 16), ow[i]); }
}
__device__ __forceinline__ void t_unit(const Ctx& c, const TDesc& prv, const TDesc& cur, const TDesc& nxt, bool has_next, const float* tabg, LAS unsigned char* lds, int wave, TOut& po) {
    const int lane = fresh_lane(), r32 = lane & 31, hi = lane >> 5, vkey = lane >> 3, vch = lane & 7;
    LAS unsigned char* qb = lds + TB_OFF + wave * 4608;
    const LAS float* tt = (const LAS float*)(lds + TT_OFF);
    const int i0 = cur.j0 + 32 * wave;
    asm volatile("s_waitcnt vmcnt(6) lgkmcnt(0)\n\ts_barrier" ::: "memory");
    const int kx = (r32 >> 1) & 7;
    bf16x8 qr[4];
#pragma unroll
    for (int d0 = 0; d0 < 4; ++d0) qr[d0] = *(const LAS bf16x8*)(qb + r32 * 128 + (((2 * d0 + hi) ^ kx) << 4));
    asm volatile("" ::: "memory");
    t_out1(po, qb, r32, hi);
    f32x16 S[5];
    const LAS float* tb = tt + 159 + r32 - 4 * hi;
    const LAS unsigned char* kt = lds + TK_OFF + (32 * wave + r32) * 128;
    float mx;
    {   bf16x8 kf[4];
#pragma unroll
        for (int d0 = 0; d0 < 4; ++d0) kf[d0] = *(const LAS bf16x8*)(kt + 4 * 4096 + (((2 * d0 + hi) ^ kx) << 4));
        f32x16 a = {};
#pragma unroll
        for (int d0 = 0; d0 < 4; ++d0) a = __builtin_amdgcn_mfma_f32_32x32x16_bf16(kf[d0], qr[d0], a, 0, 0, 0);
#pragma unroll
        for (int rr = 0; rr < 16; ++rr) a[rr] += tb[-(128 + (rr & 3) + 8 * (rr >> 2))];
        float m1 = fmaxf(fmaxf(a[0], a[1]), a[2]);
#pragma unroll
        for (int rr = 3; rr < 15; rr += 2) m1 = fmaxf(fmaxf(m1, a[rr]), a[rr + 1]);
        m1 = fmaxf(m1, a[15]);
        mx = fmaxf(m1, __shfl_xor(m1, 32));
        S[4] = a; }
    u32x4 ow[4];
    asm volatile("" ::: "memory");
    t_out2(c, prv, po, qb, wave, r32, hi, vkey, vch, ow);
#pragma unroll
    for (int s = 0; s < 4; ++s) {
        bf16x8 kf[4];
#pragma unroll
        for (int d0 = 0; d0 < 4; ++d0) kf[d0] = *(const LAS bf16x8*)(kt + s * 4096 + (((2 * d0 + hi) ^ kx) << 4));
        f32x16 a;
#pragma unroll
        for (int rr = 0; rr < 16; ++rr) a[rr] = tb[-(32 * s + (rr & 3) + 8 * (rr >> 2))] - mx;
#pragma unroll
        for (int d0 = 0; d0 < 4; ++d0) a = __builtin_amdgcn_mfma_f32_32x32x16_bf16(kf[d0], qr[d0], a, 0, 0, 0);
        S[s] = a;
        if (s == 0) { asm volatile("" ::: "memory"); t_out3(c, prv, wave, vkey, vch, ow); }
    }
    asm volatile("s_waitcnt vmcnt(5) lgkmcnt(0)\n\ts_barrier" ::: "memory");
    if (has_next) { t_issue_tab(tabg, nxt, lds, wave, lane); t_issue_k(c, nxt, lds, wave, lane); t_issue_q(c, nxt, lds, wave, lane); }
    if (i0 < 128) {
#pragma unroll
        for (int s = 0; s < 5; ++s)
#pragma unroll
            for (int rr = 0; rr < 16; ++rr) if (i0 - 128 + 32 * s + crow(rr, hi) < 0) S[s][rr] = -1e30f;
    }
    bf16x8 pf[5][2];
#pragma unroll
    for (int s = 0; s < 5; ++s) {
#pragma unroll
        for (int rr = 0; rr < 16; ++rr) S[s][rr] = fast_exp2(s == 4 ? S[s][rr] - mx : S[s][rr]);
#pragma unroll
        for (int sp = 0; sp < 2; ++sp) { u32x4 pw; pw.x = pkbf(S[s][8 * sp + 0], S[s][8 * sp + 1]); pw.y = pkbf(S[s][8 * sp + 2], S[s][8 * sp + 3]); pw.z = pkbf(S[s][8 * sp + 4], S[s][8 * sp + 5]); pw.w = pkbf(S[s][8 * sp + 6], S[s][8 * sp + 7]);
            pf[s][sp] = __builtin_bit_cast(bf16x8, pw); asm volatile("" : "+v"(pf[s][sp])); }
    }
    f32x16 o[2]; o[0] = (f32x16){}; o[1] = (f32x16){};
    f32x16 ol = {};
    const bf16x8 ones = __builtin_bit_cast(bf16x8, (u32x4){0x3F803F80u, 0x3F803F80u, 0x3F803F80u, 0x3F803F80u});
    const LAS unsigned char* vt = lds + TV_OFF + (32 * wave + 4 * hi + ((lane & 15) >> 2)) * 64 + ((lane >> 4) & 1) * 32 + (lane & 3) * 8;
#pragma unroll
    for (int s = 0; s < 5; ++s)
#pragma unroll
        for (int sp = 0; sp < 2; ++sp)
#pragma unroll
            for (int dt = 0; dt < 2; ++dt) {
                const s16x4 lo = __builtin_bit_cast(s16x4, __builtin_amdgcn_ds_read_tr16_b64_v4i16((LAS s16x4*)(vt + dt * 24576 + s * 2048 + sp * 1024)));
                const s16x4 hh = __builtin_bit_cast(s16x4, __builtin_amdgcn_ds_read_tr16_b64_v4i16((LAS s16x4*)(vt + dt * 24576 + s * 2048 + sp * 1024 + 512)));
                const bf16x8 vf = (bf16x8){lo[0], lo[1], lo[2], lo[3], hh[0], hh[1], hh[2], hh[3]};
                o[dt] = __builtin_amdgcn_mfma_f32_32x32x16_bf16(vf, pf[s][sp], o[dt], 0, 0, 0);
                if (dt == 1) ol = __builtin_amdgcn_mfma_f32_32x32x16_bf16(ones, pf[s][sp], ol, 0, 0, 0);
            }
    const float l = ol[0];
    asm volatile("s_waitcnt lgkmcnt(0)\n\ts_barrier" ::: "memory");
    if (has_next) t_issue_v(c, nxt, lds, wave, lane);
    po.o[0] = o[0]; po.o[1] = o[1]; po.l = l; po.mx = mx;
}
__device__ __forceinline__ void t_flush(const Ctx& c, const TDesc& d, const TOut& po, LAS unsigned char* lds, int wave) {
    const int lane = fresh_lane(), r32 = lane & 31, hi = lane >> 5, vkey = lane >> 3, vch = lane & 7;
    LAS unsigned char* qb = lds + TB_OFF + wave * 4608;
    u32x4 ow[4];
    t_out1(po, qb, r32, hi); t_out2(c, d, po, qb, wave, r32, hi, vkey, vch, ow); t_out3(c, d, wave, vkey, vch, ow);
}
template <int NQ> __device__ __forceinline__ void sample_vblock(const Ctx& c, int n, int h, int g, int dil, int r, int i0, const LAS float* tab, LAS float* sbuf) {
    const int lane = fresh_lane(), sub = lane & 15, rgp = lane >> 4;
    constexpr int NT = (NQ + 3) / 4, NSA = 32 + NT;
    f32x4 q4[NQ];
#pragma unroll
    for (int qq = 0; qq < NQ; ++qq) { const size_t row = (size_t)MP + n * TS + (r + dil * (i0 + qq) - WBUF);
        const u32x2 w = *(const u32x2*)(c.QB + row * AW + h * HD + 4 * sub); q4[qq] = (f32x4){bf_lo(w.x), bf_hi(w.x), bf_lo(w.y), bf_hi(w.y)}; }
    const unsigned cbase = (unsigned)((((n * WBUF) + r + dil * (i0 - 128 + rgp)) * NH + h) * HD + 4 * sub) * 4u, cstep = (unsigned)(4 * dil * NH * HD * 4);
    auto new_row = [&](const bf16_t* B16, int tt) -> f32x4 { const int tc = tt < NQ ? tt : NQ - 1;
        const u32x2 w = *(const u32x2*)(B16 + ((size_t)MP + n * TS + (r + dil * (i0 + tc) - WBUF)) * AW + h * HD + 4 * sub);
        return (f32x4){bf_lo(w.x), bf_hi(w.x), bf_lo(w.y), bf_hi(w.y)}; };
    auto score = [&](const f32x4 kv, int kk) {
#pragma unroll
        for (int qq = 0; qq < NQ; ++qq) {
            float d = (kv[0] * q4[qq][0] + kv[1] * q4[qq][1]) + (kv[2] * q4[qq][2] + kv[3] * q4[qq][3]);
            d += __shfl_xor(d, 1); d += __shfl_xor(d, 2); d += __shfl_xor(d, 4); d += __shfl_xor(d, 8);
            if (sub == 0) sbuf[qq * 136 + kk] = (kk < 128 + NQ) ? d + tab[159 + qq - kk] : -1e30f;
        } };
    {   f32x4 nk[NT];
#pragma unroll
        for (int i = 0; i < NT; ++i) nk[i] = new_row(c.KB, 4 * i + rgp);
        {   f32x4 kv[32];
#pragma unroll
            for (int i = 0; i < 32; ++i) kv[i] = *(const f32x4*)((const char*)c.CK + cbase + (unsigned)i * cstep);
#pragma unroll
            for (int i = 0; i < 32; ++i) score(kv[i], 4 * i + rgp);
        }
#pragma unroll
        for (int i = 0; i < NT; ++i) score(nk[i], 128 + 4 * i + rgp);
    }
    asm volatile("s_waitcnt lgkmcnt(0)" ::: "memory");
    float lq[NQ], lse[NQ];
#pragma unroll
    for (int qq = 0; qq < NQ; ++qq) {
        float v[3]; float mx = -3.0e38f;
#pragma unroll
        for (int j = 0; j < 3; ++j) { const int kk = lane + 64 * j; v[j] = (kk < 4 * NSA) ? sbuf[qq * 136 + kk] : -1e30f; mx = fmaxf(mx, v[j]); }
#pragma unroll
        for (int o = 1; o < 64; o <<= 1) mx = fmaxf(mx, __shfl_xor(mx, o));
        float sm = 0.f;
#pragma unroll
        for (int j = 0; j < 3; ++j) { const int kk = lane + 64 * j; const float pv = fast_exp2(v[j] - mx); sm += pv; if (kk < 4 * NSA) sbuf[qq * 136 + kk] = pv; }
        sm = wave_sum(sm); lq[qq] = sm; lse[qq] = mx + __log2f(sm);
    }
    asm volatile("s_waitcnt lgkmcnt(0)" ::: "memory");
    f32x4 oa[NQ];
#pragma unroll
    for (int qq = 0; qq < NQ; ++qq) oa[qq] = (f32x4){0.f, 0.f, 0.f, 0.f};
    {   f32x4 nv[NT];
#pragma unroll
        for (int i = 0; i < NT; ++i) nv[i] = new_row(c.VB, 4 * i + rgp);
        {   f32x4 vv[32];
#pragma unroll
            for (int i = 0; i < 32; ++i) vv[i] = *(const f32x4*)((const char*)c.CV + cbase + (unsigned)i * cstep);
#pragma unroll
            for (int i = 0; i < 32; ++i) { const int kk = 4 * i + rgp;
#pragma unroll
                for (int qq = 0; qq < NQ; ++qq) { const float pv = sbuf[qq * 136 + kk]; oa[qq] += vv[i] * pv; } }
        }
#pragma unroll
        for (int i = 0; i < NT; ++i) { const int kk = 128 + 4 * i + rgp;
#pragma unroll
            for (int qq = 0; qq < NQ; ++qq) { const float pv = sbuf[qq * 136 + kk]; oa[qq] += nv[i] * pv; } }
    }
#pragma unroll
    for (int qq = 0; qq < NQ; ++qq) {
#pragma unroll
        for (int e = 0; e < 4; ++e) { float x = oa[qq][e]; x += __shfl_xor(x, 16); x += __shfl_xor(x, 32); oa[qq][e] = x; }
        const size_t tok = (size_t)MP + n * TS + (r + dil * (i0 + qq) - WBUF);
        if (rgp == 0) { const float inv = 1.0f / lq[qq]; u32x2 w; w.x = pkbf(oa[qq][0] * inv, oa[qq][1] * inv); w.y = pkbf(oa[qq][2] * inv, oa[qq][3] * inv);
            *(u32x2*)(c.OP + (size_t)g * OP_STRIDE + tok * AW + h * HD + 4 * sub) = w;
            if (sub == 0) c.LSE[(size_t)g * LSE_STRIDE + tok * NH + h] = lse[qq]; }
    }
    asm volatile("s_waitcnt lgkmcnt(0)" ::: "memory");
}
template <int NP> __device__ __forceinline__ void merge_pieces(const Ctx& c, size_t tok0, size_t tstride, int h, int piece) {
    float ls[NP][3]; u32x4 ov[NP][3];
#pragma unroll
    for (int q = 0; q < NP; ++q)
#pragma unroll
        for (int g = 0; g < 3; ++g) { const size_t tok = tok0 + q * tstride; ls[q][g] = c.LSE[(size_t)g * LSE_STRIDE + tok * NH + h]; ov[q][g] = *(const u32x4*)(c.OP + (size_t)g * OP_STRIDE + tok * AW + h * HD + piece * 8); }
#pragma unroll
    for (int q = 0; q < NP; ++q) {
        const float M = fmaxf(fmaxf(ls[q][0], ls[q][1]), ls[q][2]);
        float w0 = fast_exp2(ls[q][0] - M), w1 = fast_exp2(ls[q][1] - M), w2 = fast_exp2(ls[q][2] - M); const float inv = 1.0f / (w0 + w1 + w2); w0 *= inv; w1 *= inv; w2 *= inv;
        u32x4 o;
#pragma unroll
        for (int e = 0; e < 4; ++e) {
            const float lo = w0 * bf_lo(ov[q][0][e]) + w1 * bf_lo(ov[q][1][e]) + w2 * bf_lo(ov[q][2][e]);
            const float hi_ = w0 * bf_hi(ov[q][0][e]) + w1 * bf_hi(ov[q][1][e]) + w2 * bf_hi(ov[q][2][e]);
            o[e] = pkbf(lo, hi_);
        }
        *(u32x4*)(c.ATT + (tok0 + q * tstride) * DM + h * HD + piece * 8) = o;
    }
}
__device__ __forceinline__ void copy_slot(const float* ck, const float* cv, float* out, int sl, int lane) {
    const int sq = sl / 576, j0 = (sl - sq * 576) * 680, which = sq >> 5, n = sq & 31;
    const f32x4* src = (const f32x4*)((which ? cv : ck) + (size_t)n * WBUF * AW + (size_t)TS * AW) + j0 + lane;
    f32x4* dst = (f32x4*)(out + (which ? OFF_SWV : OFF_SWK) + (size_t)n * WBUF * AW) + j0 + lane;
    f32x4 v[11];
#pragma unroll
    for (int i = 0; i < 10; ++i) v[i] = __builtin_nontemporal_load(src + 64 * i);
    if (lane < 40) v[10] = __builtin_nontemporal_load(src + 640);
#pragma unroll
    for (int i = 0; i < 10; ++i) __builtin_nontemporal_store(v[i], dst + 64 * i);
    if (lane < 40) __builtin_nontemporal_store(v[10], dst + 640);
}
__device__ __forceinline__ void copy_range(const float* ck, const float* cv, float* out, unsigned first, unsigned count, int widx, int nw, int tid) {
    constexpr unsigned PER = (unsigned)(WBUF - TS) * AW / 4;
    const unsigned end = first + count;
    for (unsigned i0 = first + (unsigned)widx * 4096u + tid; i0 < end; i0 += (unsigned)nw * 4096u) {
        f32x4 v[8];
#pragma unroll
        for (int k = 0; k < 8; ++k) { const unsigned i = i0 + 512u * k; if (i < end) { const unsigned sq = i / PER, j = i - sq * PER, which = sq >> 5, n = sq & 31;
            v[k] = __builtin_nontemporal_load((const f32x4*)((which ? cv : ck) + (size_t)n * WBUF * AW + (size_t)TS * AW) + j); } }
#pragma unroll
        for (int k = 0; k < 8; ++k) { const unsigned i = i0 + 512u * k; if (i < end) { const unsigned sq = i / PER, j = i - sq * PER, which = sq >> 5, n = sq & 31;
            __builtin_nontemporal_store(v[k], (f32x4*)(out + (which ? OFF_SWV : OFF_SWK) + (size_t)n * WBUF * AW) + j); } }
    }
}
}

template <int NTW, bool SAMPLE> __device__ __forceinline__ void conv_unit(const float* U, const float* cache_conv, int seq, int t0, LAS float* tile, const LAS float* cw,
                                                                          const float* cb, const float* lg, const float* lb, bf16_t* ATT, int tid, int lane, int wave) {
    constexpr int NROW = 8 * NTW + 30;
    const size_t rowbase = SAMPLE ? (size_t)MP + (size_t)seq * TS : (size_t)seq * SEQ;
    for (int idx = tid; idx < NROW * 64; idx += 512) {
        const int rr = idx >> 6, c4 = idx & 63, tau = rr - 30; f32x4 v = (f32x4){0.f, 0.f, 0.f, 0.f};
        if (SAMPLE) { v = tau < 0 ? *(const f32x4*)(cache_conv + ((size_t)seq * 30 + (30 + tau)) * CWD + 4 * c4) : *(const f32x4*)(U + (rowbase + tau) * CWD + 4 * c4); }
        else if (t0 + tau >= 0) v = *(const f32x4*)(U + (rowbase + t0 + tau) * CWD + 4 * c4);
        *(LAS f32x4*)(tile + rr * CWD + 4 * c4) = v;
    }
    __syncthreads();
    f32x4 acc[NTW], uw[NTW];
    const LAS float* tw = tile + (NTW * wave) * CWD + 4 * lane;
#pragma unroll
    for (int i = 0; i < NTW; ++i) { acc[i] = (f32x4){0.f, 0.f, 0.f, 0.f}; uw[i] = *(const LAS f32x4*)(tw + i * CWD); }
#pragma unroll 1
    for (int j = 0; j < 31; ++j) {
        const f32x4 w = *(const LAS f32x4*)(cw + j * CWD + 4 * lane);
        const f32x4 nx = *(const LAS f32x4*)(tw + (NTW + j) * CWD);
#pragma unroll
        for (int i = 0; i < NTW; ++i) acc[i] += w * uw[i];
#pragma unroll
        for (int i = 0; i + 1 < NTW; ++i) uw[i] = uw[i + 1];
        uw[NTW - 1] = nx;
    }
    const f32x4 bv = *(const f32x4*)(cb + 4 * lane), gv = *(const f32x4*)(lg + 4 * lane), lv = *(const f32x4*)(lb + 4 * lane);
#pragma unroll
    for (int i = 0; i < NTW; ++i) {
        f32x4 y = acc[i] + bv;
        const float mean = wave_sum((y[0] + y[1]) + (y[2] + y[3])) * (1.0f / CWD);
        y = y - mean;
        const float var = wave_sum((y[0] * y[0] + y[1] * y[1]) + (y[2] * y[2] + y[3] * y[3])) * (1.0f / CWD);
        const float rstd = 1.0f / sqrtf(var + EPS);
        f32x4 z = y * rstd * gv + lv;
#pragma unroll
        for (int e = 0; e < 4; ++e) z[e] = z[e] * fast_rcp(1.f + fast_exp2(-z[e] * LOG2E));
        u32x2 w; w.x = pkbf(z[0], z[1]); w.y = pkbf(z[2], z[3]);
        *(u32x2*)(ATT + (rowbase + t0 + NTW * wave + i) * DM + AW + 4 * lane) = w;
    }
    __syncthreads();
}

__global__ void __launch_bounds__(512, 2) fwd_kernel(Params p) {
    extern __shared__ __attribute__((aligned(16))) unsigned char lds_raw[];
    LAS unsigned char* lds = (LAS unsigned char*)lds_raw;
    const int G = gridDim.x, bid = blockIdx.x;
    const int wave = __builtin_amdgcn_readfirstlane(threadIdx.x >> 6);
#define PHASE_IDS const int lane = fresh_lane(), tid = wave * 64 + lane; (void)tid
    unsigned char* ws = p.ws; float* out = p.out;
    bf16_t* WALL = (bf16_t*)(ws + WS_WALL); bf16_t* WOUT = (bf16_t*)(ws + WS_WOUT); bf16_t* WXQ = (bf16_t*)(ws + WS_WXQ); bf16_t* WXO = (bf16_t*)(ws + WS_WXO);
    bf16_t* WGU = (bf16_t*)(ws + WS_WGU); bf16_t* WDN = (bf16_t*)(ws + WS_WDN); bf16_t* XN = (bf16_t*)(ws + WS_XN);
    bf16_t* QB = (bf16_t*)(ws + WS_QB); bf16_t* KB = (bf16_t*)(ws + WS_KB); bf16_t* VB = (bf16_t*)(ws + WS_VB); float* U = (float*)(ws + WS_U);
    bf16_t* OP = (bf16_t*)(ws + WS_OP); float* LSE = (float*)(ws + WS_LSE); bf16_t* ATT = (bf16_t*)(ws + WS_ATT); float* X1 = (float*)(ws + WS_X1);
    float* SSQ = (float*)(ws + WS_SSQ); bf16_t* MKB = (bf16_t*)(ws + WS_MKB); bf16_t* MVT = (bf16_t*)(ws + WS_MVT); float* LSUM = (float*)(ws + WS_LSUM);
    bf16_t* XQ = (bf16_t*)(ws + WS_XQ); bf16_t* PB = (bf16_t*)(ws + WS_PB); bf16_t* XO = (bf16_t*)(ws + WS_XO); bf16_t* HB = (bf16_t*)(ws + WS_H);
    const int lo = p.ph_lo, hi = p.ph_hi;
    if (threadIdx.x < 4) ((volatile LAS unsigned*)(lds + MISC_OFF))[threadIdx.x] = 0u;
    __syncthreads();
    XcdBarrier xbar; xbar.bar = (unsigned*)(ws + WS_CTL); xbar.x = 0; xbar.st = nullptr;
    if (p.coop) xbar = xcd_barrier_post((unsigned*)(ws + WS_CTL), (volatile LAS unsigned*)(lds + MISC_OFF));
#ifndef PH_MASK
#define PH_MASK 0x7ff
#endif
#define IN(k) (((PH_MASK >> (k)) & 1) && lo <= (k) && (k) < hi)
#ifndef PROBE_DUP
#define PROBE_DUP 0
#endif
#define REP(k) for (int rep_ = 0; rep_ <= ((PROBE_DUP >> (k)) & 1); ++rep_)
#define REPSYNC if (rep_) xcd_barrier(xbar)
#define SEAM(k) do { if (IN(k) && IN((k) + 1)) { if (p.coop == 2) cg::this_grid().sync(); else xcd_barrier(xbar); } } while (0)

    if (IN(0)) REP(0) {
        REPSYNC;
        PHASE_IDS;
        LAS float* scr = (LAS float*)(lds + wave * 16384);
        const int gw = bid * 8 + wave, NGW = G * 8;
        constexpr int I_IN = 16 * 88, I_SQ = 16 * 32, I_FF = 16 * 88, I_DN = 44 * 32;
        constexpr int NITEMS = I_IN + 5 * I_SQ + 2 * I_FF + I_DN;
        for (int it = gw; it < NITEMS; it += NGW) {
            int r = it;
            if (r < I_IN) { transpose_item(p.in[10], DM, NIN, WALL, r, 1, scr, lane); continue; } r -= I_IN;
            if (r < I_SQ) { transpose_item(p.in[19], DM, DM, WALL + (size_t)2816 * DM, r, 0, scr, lane); continue; } r -= I_SQ;
            if (r < I_SQ) { transpose_item(p.in[20], DM, DM, WALL + (size_t)3840 * DM, r, 0, scr, lane); continue; } r -= I_SQ;
            if (r < I_SQ) { transpose_item(p.in[15], DM, DM, WOUT, r, 0, scr, lane); continue; } r -= I_SQ;
            if (r < I_SQ) { transpose_item(p.in[18], DM, DM, WXQ, r, 0, scr, lane); continue; } r -= I_SQ;
            if (r < I_SQ) { transpose_item(p.in[21], DM, DM, WXO, r, 0, scr, lane); continue; } r -= I_SQ;
            if (r < I_FF) { transpose_item(p.in[23], DM, DFF, WGU, r, 2, scr, lane); continue; } r -= I_FF;
            if (r < I_FF) { transpose_item(p.in[24], DM, DFF, WGU, r, 3, scr, lane); continue; } r -= I_FF;
            transpose_item(p.in[25], DFF, DM, WDN, r, 0, scr, lane);
        }
        for (int m0 = gw * 4; m0 < MALL; m0 += NGW * 4) {
            const float* base; const float* g;
            if (m0 < MP) { base = p.in[0] + (size_t)m0 * DM; g = p.in[9]; }
            else if (m0 < MTOK) { base = p.in[1] + (size_t)(m0 - MP) * DM; g = p.in[9]; }
            else { base = p.in[2] + (size_t)(m0 - MTOK) * DM; g = p.in[17]; }
            const float* const xr[4] = {base, base + DM, base + 2 * DM, base + 3 * DM};
            bf16_t* ob = XN + (size_t)m0 * DM; bf16_t* const orr[4] = {ob, ob + DM, ob + 2 * DM, ob + 3 * DM};
            rms_rows_bf16<4>(xr, g, orr, lane);
        }
        if (bid == 0) {
            float* tabg = (float*)(ws + WS_TABG);
            for (int i = tid; i < 36 * 192; i += 512) {
                const int gh = i / 192, e = i - gh * 192, g = gh / 12, h = gh - g * 12, dist = e - 31; float v = -1e30f;
                if (dist >= 0 && dist <= 128) { const int n = dist << (2 * g); int bk;
                    if (n < 16) bk = n; else { const float vv = logf((float)n / 16.0f) / 4.852030263919617f * 16.0f; bk = 16 + (int)vv; bk = bk > 31 ? 31 : bk; }
                    v = p.in[8][bk * NH + h] * LOG2E; }
                tabg[i] = v;
            }
        }
        {
            constexpr int CPER = (30 - TS) * CWD / 4;
            for (int i = bid * 512 + tid; i < NSEQ * CPER; i += G * 512) { const int n = i / CPER, j = i - n * CPER;
                ((f32x4*)(out + OFF_SCONV + (size_t)n * 30 * CWD))[j] = ((const f32x4*)(p.in[5] + (size_t)n * 30 * CWD + TS * CWD))[j]; }
        }
    }
    SEAM(0);
    if (IN(1)) REP(1) {
        REPSYNC;
#ifndef P1_NO_MAIN
        { pg8::SchedGrid S{129, 11, G, bid, (const char*)XN, (const char*)WALL, (size_t)256 * DM * 2, (size_t)256 * DM * 2};
          pg8::EpiIn E{ws, out};
          pg8::gemm_phase<pg8::EpiIn, pg8::SchedGrid, true>(lds, pg8::Cfg{DM, DM, DM}, S, E, wave); }
#endif
#ifndef P1_NO_MEM
        { const int cfirst = (129 * 11) % G;
          pg8::SchedMem S{(bid - cfirst + G) % G, (const char*)XN, (const char*)WALL};
          pg8::EpiMem E{ws, out};
          pg8::gemm_phase<pg8::EpiMem, pg8::SchedMem, true>(lds, pg8::Cfg{DM, DM, DM}, S, E, wave); }
        if (bid >= 187 && rep_ == 0) { PHASE_IDS; att::copy_range(p.in[3], p.in[4], out, 0u, 2000000u, bid - 187, G - 187, tid); }
#endif
    }
    SEAM(1);
    if (IN(2)) REP(2) {
        REPSYNC;
        PHASE_IDS;
        LAS float* tab = (LAS float*)(lds + ATT_TAB_OFF); LAS float* cw = (LAS float*)(lds + ATT_CW_OFF);
#ifndef MK_TILE_ATT
#define MK_TILE_ATT 1
#endif
        const float* tabg = (const float*)(ws + WS_TABG);
#if !MK_TILE_ATT
        for (int i = tid; i < 36 * 192; i += 512) tab[i] = tabg[i];
        __syncthreads();
#endif
        att::Ctx c{QB, KB, VB, p.in[3], p.in[4], OP, LSE, ATT};
        LAS unsigned char* vbuf = lds + ATT_V_OFF + wave * ATT_WBUF;
#ifndef PROBE_P2
#define PROBE_P2 0
#endif
#if MK_TILE_ATT
        {
            const int nl2 = __builtin_amdgcn_readfirstlane((int)((volatile LAS unsigned*)(lds + MISC_OFF))[0]), nx2 = __builtin_amdgcn_readfirstlane((int)((volatile LAS unsigned*)(lds + MISC_OFF))[1]);
            const int xi2 = __builtin_amdgcn_readfirstlane((int)((volatile LAS unsigned*)(lds + MISC_OFF))[2]), rk2 = __builtin_amdgcn_readfirstlane((int)((volatile LAS unsigned*)(lds + MISC_OFF))[3]);
            const int npair = (48 - xi2 + nx2 - 1) / nx2, nun = npair * 96;
            auto mk = [&](int Lx) -> att::TDesc { att::TDesc d; const int pair = Lx / 96, u = Lx - pair * 96, pp = xi2 + nx2 * pair; d.b = pp / 12; d.h = pp - d.b * 12; d.g = u >> 5; const int cj = u & 31;
                if (d.g == 0) { d.dil = 1; d.r = 0; d.j0 = 256 * cj; } else if (d.g == 1) { d.dil = 4; d.r = cj >> 3; d.j0 = 256 * (cj & 7); } else { d.dil = 16; d.r = cj >> 1; d.j0 = 256 * (cj & 1); }
                return d; };
            int Lx = rk2;
            att::TDesc cur = mk(Lx < nun ? Lx : 0), prv = cur;
            att::TOut po; po.o[0] = (f32x16){}; po.o[1] = (f32x16){}; po.l = 1.f; po.mx = 0.f;
            const bool any = Lx < nun;
            __builtin_amdgcn_s_waitcnt(0x0070);
            if (any) { att::t_issue_tab(tabg, cur, lds, wave, lane);
                att::t_issue_k(c, cur, lds, wave, lane); att::t_issue_q(c, cur, lds, wave, lane); att::t_issue_v(c, cur, lds, wave, lane); }
            while (Lx < nun) {
                const int Lx2 = Lx + nl2; const bool has_next = Lx2 < nun;
                const att::TDesc nxt = mk(has_next ? Lx2 : Lx);
                att::t_unit(c, prv, cur, nxt, has_next, tabg, lds, wave, po);
                prv = cur; cur = nxt; Lx = Lx2;
            }
            if (any) att::t_flush(c, prv, po, lds, wave);
            xl_barrier(xbar);
            for (int k = 0; k < npair; ++k) { const int pp = xi2 + nx2 * k, b = pp / 12, h = pp - b * 12;
                for (int ck = rk2; ck < 32; ck += nl2) att::merge_pieces<4>(c, (size_t)b * SEQ + ck * 256 + (tid >> 3), 64, h, tid & 7); }
            __syncthreads();
            for (int i = tid; i < 36 * 192; i += 512) tab[i] = tabg[i];
            __syncthreads();
        }
#endif
#if !defined(P2_NO_PROMPT) && !MK_TILE_ATT
        for (int rp_ = 0; rp_ <= (PROBE_P2 & 1) + ((PROBE_P2 >> 3) & 1); ++rp_) {
            auto mkdesc = [&](int un, int it) -> att::PDesc {
                att::PDesc d; d.b = un / 192; const int rem = un - d.b * 192; d.h = rem >> 4; const int ch = rem & 15; d.g = it >> 4; const int j = it & 15;
                if (d.g == 0) { d.dil = 1; d.r = 0; d.i0 = ch * 512 + 32 * j; } else if (d.g == 1) { d.dil = 4; d.r = j >> 2; d.i0 = ch * 128 + 32 * (j & 3); } else { d.dil = 16; d.r = j; d.i0 = ch * 32; }
                return d; };
            bf16x8 qv[4], kr[5][4];
            const int vkey_ = lane >> 3, vch_ = lane & 7;
            const int vcu = (G % 8 == 0) ? (bid & 7) * (G >> 3) + (bid >> 3) : bid;
            int un = vcu, it = wave;
            att::PDesc cur = mkdesc(un < 768 ? un : 0, it);
            if (un < 768) { att::p_load_q(c, cur, qv, vkey_, vch_);
#pragma unroll
                for (int s5 = 0; s5 < 2; ++s5) att::p_load_kv(c.KB, cur, s5, kr[s5], vkey_, vch_); }
            while (un < 768) {
                int un2 = un, it2 = it + 8; if (it2 >= 48) { it2 = wave; un2 = un + G; }
                const bool has_next = un2 < 768;
                const att::PDesc nxt = mkdesc(has_next ? un2 : un, has_next ? it2 : it);
                att::pblock(c, cur, nxt, has_next, qv, kr, tab, vbuf);
                if (un2 != un) {
                    __syncthreads();
                    const int b = un / 192, rem = un - b * 192, h = rem >> 4, ch = rem & 15;
#pragma unroll 1
                    for (int ps = 0; ps < 8; ps += 4) att::merge_pieces<4>(c, (size_t)b * SEQ + ch * 512 + ps * 64 + (tid >> 3), 64, h, tid & 7);
                }
                cur = nxt; un = un2; it = it2;
            }
        }
#endif
        {
            unsigned* cq = (unsigned*)(ws + WS_CTL) + 13200;
            volatile LAS unsigned* qw = (volatile LAS unsigned*)(lds + MISC_OFF) + 8;
            constexpr unsigned NSU = NSEQ * NH, NIT = NSU + 1024 + NSEQ;
            unsigned tk_ = 0;
            if (threadIdx.x == 0) { tk_ = xb_add(cq, 1u); qw[0] = tk_; }
            __syncthreads();
            unsigned q = (unsigned)__builtin_amdgcn_readfirstlane((int)qw[0]);
            bool conv_ready = false;
            while (q < NIT) {
                __syncthreads();
                if (threadIdx.x == 0) tk_ = xb_add(cq, 1u);
                if (q < NSU) {
                    const int n = (int)q / NH, h = (int)q - n * NH;
                    if (wave == 0) att::wave_block<1>(c, n, h, 0, 1, 0, 2048, 8, tab + (0 * 12 + h) * 192, vbuf);
                    else for (int it = wave; it < 13; it += 7) {
                        LAS float* sb = (LAS float*)vbuf;
                        if (it < 5) att::sample_vblock<2>(c, n, h, 1, 4, it - 1, 512, tab + (1 * 12 + h) * 192, sb);
                        else att::sample_vblock<1>(c, n, h, 2, 16, it - 5, 128, tab + (2 * 12 + h) * 192, sb);
                    }
                    __syncthreads();
                    if (tid < 64) att::merge_pieces<1>(c, (size_t)MP + n * TS + (tid >> 3), 0, h, tid & 7);
                } else {
                    if (!conv_ready) { __syncthreads(); for (int i = tid; i < 31 * CWD; i += 512) cw[i] = p.in[11][i]; conv_ready = true; }
                    const int un = (int)(q - NSU);
                    if (un < 1024) conv_unit<4, false>(U, p.in[5], un >> 8, (un & 255) * 32, (LAS float*)(lds + ATT_V_OFF), cw, p.in[12], p.in[13], p.in[14], ATT, tid, lane, wave);
                    else conv_unit<1, true>(U, p.in[5], un - 1024, 0, (LAS float*)(lds + ATT_V_OFF), cw, p.in[12], p.in[13], p.in[14], ATT, tid, lane, wave);
                }
                if (threadIdx.x == 0) qw[0] = tk_;
                __syncthreads();
                q = (unsigned)__builtin_amdgcn_readfirstlane((int)qw[0]);
            }
        }
    }
    SEAM(2);
    const int nl = __builtin_amdgcn_readfirstlane((int)((volatile LAS unsigned*)(lds + MISC_OFF))[0]), nx = __builtin_amdgcn_readfirstlane((int)((volatile LAS unsigned*)(lds + MISC_OFF))[1]);
    const int xi = __builtin_amdgcn_readfirstlane((int)((volatile LAS unsigned*)(lds + MISC_OFF))[2]), rk = __builtin_amdgcn_readfirstlane((int)((volatile LAS unsigned*)(lds + MISC_OFF))[3]);
    unsigned* xq_flag = (unsigned*)(ws + WS_CTL) + 3520; unsigned* xo_flag = (unsigned*)(ws + WS_CTL) + 13000;
    bool own128 = false;
    { for (int j = 0; j < 16; ++j) { const int Lx = j * nl + rk, pm = xi + nx * (Lx >> 2); if (pm >= 129) break; own128 |= (pm == 128); } }
    if (IN(3)) {
        pg8::SchedXL S{nl, rk, xi, nx, (const char*)ATT, (const char*)WOUT, (size_t)256 * DM * 2, (size_t)256 * DM * 2, 0};
        pg8::EpiRes<true> E{p.in[0], p.in[1], nullptr, XN, p.in[16], SSQ};
        pg8::gemm_phase<pg8::EpiRes<true>, pg8::SchedXL, true>(lds, pg8::Cfg{DM, DM, DM}, S, E, wave);
    }
    xl_barrier(xbar);
    if (IN(4)) {
        {   pg8::SchedXL S{nl, rk, xi, nx, (const char*)XN, (const char*)WXQ, (size_t)256 * DM * 2, (size_t)256 * DM * 2, 0};
            pg8::EpiScale E{XQ, SSQ, XQSCALE};
            pg8::gemm_phase<pg8::EpiScale, pg8::SchedXL, true>(lds, pg8::Cfg{DM, DM, DM}, S, E, wave); }
        if (own128 && threadIdx.x == 0) { __builtin_amdgcn_fence(__ATOMIC_RELEASE, "agent"); asm volatile("s_waitcnt vmcnt(0)" ::: "memory"); (void)xb_add(xq_flag, 1u); }
        {   pg8::SchedXLs S{nl, rk, xi, nx, (const char*)XQ, (const char*)MKB, 0};
            pg8::EpiSoftmax E{PB, LSUM, (LAS float*)(lds + XCH_OFF)};
            pg8::gemm_phase<pg8::EpiSoftmax, pg8::SchedXLs, true>(lds, pg8::Cfg{256, DM, DM}, S, E, wave); }
        {   pg8::SchedXLs S{nl, rk, xi, nx, (const char*)PB, (const char*)MVT, 1};
            pg8::EpiPV E{XO, LSUM};
            pg8::gemm_phase<pg8::EpiPV, pg8::SchedXLs, true>(lds, pg8::Cfg{256, DM, DM}, S, E, wave); }
        PHASE_IDS;
        if (threadIdx.x == 0) { unsigned sp = 0; while (xb_ld(xq_flag) < 4u) { __builtin_amdgcn_s_sleep(2); if (++sp > (1u << 22)) break; }
            __builtin_amdgcn_fence(__ATOMIC_ACQUIRE, "agent"); asm volatile("s_waitcnt vmcnt(0)" ::: "memory"); }
        LAS float* qs = (LAS float*)lds;
        LAS float* sc = (LAS float*)(lds + 4096);
        LAS float* red = (LAS float*)(lds + 8192);
        for (int un = bid; un < NSEQ * 4 * 2; un += G) {
            const int n = un >> 3, h = (un >> 1) & 3, half = un & 1;
            __syncthreads();
            for (int i = tid; i < 4 * 256; i += 512) { const int t = i >> 8, d = i & 255; qs[i] = __uint_as_float((unsigned)XQ[((size_t)MP + n * TS + 4 * half + t) * DM + h * 256 + d] << 16); }
            __syncthreads();
            const float* Kc = p.in[6] + ((size_t)n * NMEM * 4 + h) * 256; const float* Vc = p.in[7] + ((size_t)n * NMEM * 4 + h) * 256;
            f32x4 qv[4];
#pragma unroll
            for (int t = 0; t < 4; ++t) qv[t] = *(const LAS f32x4*)(qs + t * 256 + 4 * lane);
#pragma unroll 1
            for (int mb = 0; mb < 2; ++mb) {
                f32x4 kv[16];
#pragma unroll
                for (int k = 0; k < 16; ++k) kv[k] = *(const f32x4*)(Kc + (size_t)(wave * 32 + mb * 16 + k) * 1024 + 4 * lane);
#pragma unroll
                for (int k = 0; k < 16; ++k) {
                    float pt[4];
#pragma unroll
                    for (int t = 0; t < 4; ++t) pt[t] = wave_sum((kv[k][0] * qv[t][0] + kv[k][1] * qv[t][1]) + (kv[k][2] * qv[t][2] + kv[k][3] * qv[t][3]));
                    if (lane == 0) *(LAS f32x4*)(sc + (wave * 32 + mb * 16 + k) * 4) = (f32x4){pt[0], pt[1], pt[2], pt[3]};
                }
            }
            __syncthreads();
            if (wave < 4) {
                const int t = wave; float v[4]; float mx = -3.0e38f;
#pragma unroll
                for (int j = 0; j < 4; ++j) { v[j] = sc[(lane + 64 * j) * 4 + t]; mx = fmaxf(mx, v[j]); }
#pragma unroll
                for (int o = 1; o < 64; o <<= 1) mx = fmaxf(mx, __shfl_xor(mx, o));
                float sm = 0.f;
#pragma unroll
                for (int j = 0; j < 4; ++j) { v[j] = fast_exp2(v[j] - mx); sm += v[j]; }
                sm = wave_sum(sm); const float inv = 1.0f / sm;
#pragma unroll
                for (int j = 0; j < 4; ++j) sc[(lane + 64 * j) * 4 + t] = v[j] * inv;
            }
            __syncthreads();
            {
                const int d = tid & 255, mh = tid >> 8; f32x4 o = (f32x4){0.f, 0.f, 0.f, 0.f};
                const float* vp = Vc + (size_t)(mh * 128) * 1024 + d; const LAS float* pp = sc + (mh * 128) * 4;
#pragma unroll 1
                for (int m0 = 0; m0 < 128; m0 += 32) {
                    float vv[32];
#pragma unroll
                    for (int m = 0; m < 32; ++m) vv[m] = vp[(size_t)(m0 + m) * 1024];
#pragma unroll
                    for (int m = 0; m < 32; ++m) { const f32x4 pw = *(const LAS f32x4*)(pp + (m0 + m) * 4); o += pw * vv[m]; }
                }
                if (mh == 1) *(LAS f32x4*)(red + d * 4) = o;
                __syncthreads();
                if (mh == 0) { o += *(const LAS f32x4*)(red + d * 4);
#pragma unroll
                    for (int e = 0; e < 4; ++e) { const unsigned mine = pkbf(o[e], 0.f) & 0xffffu, nb = (unsigned)__shfl_down((int)mine, 1);
                        if (!(d & 1)) __hip_atomic_store((unsigned*)(XO + ((size_t)MP + n * TS + 4 * half + e) * DM + h * 256 + d), mine | (nb << 16), __ATOMIC_RELAXED, __HIP_MEMORY_SCOPE_AGENT); } }
            }
            asm volatile("s_waitcnt vmcnt(0)" ::: "memory"); __syncthreads();
            if (threadIdx.x == 0) (void)xb_add(xo_flag, 1u);
        }
        __syncthreads();
    }
    xl_barrier(xbar);
    if (IN(7)) {
        if (own128) {
            if (threadIdx.x == 0) { unsigned sp = 0; while (xb_ld(xo_flag) < (unsigned)(NSEQ * 8)) { __builtin_amdgcn_s_sleep(2); if (++sp > (1u << 22)) break; }
                __builtin_amdgcn_fence(__ATOMIC_ACQUIRE, "agent"); asm volatile("s_waitcnt vmcnt(0)" ::: "memory"); }
            __syncthreads();
        }
        pg8::SchedXL S{nl, rk, xi, nx, (const char*)XO, (const char*)WXO, (size_t)256 * DM * 2, (size_t)256 * DM * 2, 0};
        pg8::EpiRes<false> E{nullptr, nullptr, p.in[16], XN, p.in[22], SSQ + SSQ_STRIDE};
        pg8::gemm_phase<pg8::EpiRes<false>, pg8::SchedXL, true>(lds, pg8::Cfg{DM, DM, DM}, S, E, wave);
    }
    xl_barrier(xbar);
    const int xi0 = 128 % nx;
    const int xi9 = (nx > 1 && nl >= 4) ? (xi0 + 1) % nx : xi0;
    unsigned* h_flag = (unsigned*)(ws + WS_CTL) + 13064;
    if (IN(8)) {
        pg8::SchedXL22 S{nl, rk, xi, nx, (const char*)XN, (const char*)WGU, (size_t)256 * DM * 2, (size_t)256 * DM * 2};
        pg8::EpiSwiGLU E{HB, SSQ + SSQ_STRIDE};
        pg8::gemm_phase<pg8::EpiSwiGLU, pg8::SchedXL22, true>(lds, pg8::Cfg{DM, DM, DM}, S, E, wave);
        bool had = false;
        for (int j = 0; j < 16; ++j) { const int Lx = j * nl + rk, pm = xi + nx * (Lx / 22); if (pm >= 129) break; had |= (pm == 128); }
        if (had && threadIdx.x == 0) { __builtin_amdgcn_fence(__ATOMIC_RELEASE, "agent"); asm volatile("s_waitcnt vmcnt(0)" ::: "memory"); (void)xb_add(h_flag, 1u); }
    }
    xl_barrier(xbar);
    if (IN(9)) {
        pg8::EpiFinal E{XN, p.in[22], out + OFF_Y, p.in[26], (float*)(ws + WS_SLOT), (unsigned*)(ws + WS_CTL) + 4096, (LAS float*)(lds + XCH_OFF), wave};
        {   pg8::SchedXL S{nl, rk, xi, nx, (const char*)HB, (const char*)WDN, (size_t)256 * DFF * 2, (size_t)256 * DFF * 2, 1};
            pg8::gemm_phase<pg8::EpiFinal, pg8::SchedXL, true>(lds, pg8::Cfg{DFF, DFF, DFF}, S, E, wave); }
        if (xi == xi9 && rk < 4) {
            if (threadIdx.x == 0) { unsigned sp = 0; while (xb_ld(h_flag) < 22u) { __builtin_amdgcn_s_sleep(2); if (++sp > (1u << 22)) break; }
                __builtin_amdgcn_fence(__ATOMIC_ACQUIRE, "agent"); asm volatile("s_waitcnt vmcnt(0)" ::: "memory"); }
            __syncthreads();
            pg8::SchedOne S{128, rk, (const char*)HB, (const char*)WDN, (size_t)256 * DFF * 2, (size_t)256 * DFF * 2};
            pg8::gemm_phase<pg8::EpiFinal, pg8::SchedOne, true>(lds, pg8::Cfg{DFF, DFF, DFF}, S, E, wave);
        }
    }
    {   const bool all = (nx <= 1);
        int before = 0; for (int x = 0; x < xi; ++x) if (x != xi0) before += (x == xi9 && xi9 != xi0) ? nl - 4 : nl;
        const int mine = (xi == xi9 && xi9 != xi0) ? rk - 4 : rk;
        const int nwk = all ? nl : (nx - 1) * nl - (xi9 != xi0 ? 4 : 0), widx = all ? rk : before + mine;
        if (all || (xi != xi0 && mine >= 0)) { PHASE_IDS; att::copy_range(p.in[3], p.in[4], out, 2000000u, 23067520u, widx, nwk, tid); } }
#undef IN
#undef SEAM
}

extern "C" void kernel_launch(void* const* d_in, const int* in_sizes, int n_in, void* d_out, int out_size, void* d_ws, size_t ws_size, hipStream_t stream) {
    static int grid = 0;
    if (grid == 0) {
        if (n_in != 27 || (size_t)out_size != OUT_TOTAL || ws_size < WS_END) { fprintf(stderr, "kernel_launch: unexpected shapes: n_in %d out %d ws %zu\n", n_in, out_size, ws_size); grid = -1; return; }
        int dev = 0, cus = 0, per_cu = 0;
        (void)hipGetDevice(&dev); (void)hipDeviceGetAttribute(&cus, hipDeviceAttributeMultiprocessorCount, dev);
        if (hipFuncSetAttribute((const void*)fwd_kernel, hipFuncAttributeMaxDynamicSharedMemorySize, LDS_BYTES) != hipSuccess) { fprintf(stderr, "kernel_launch: hipFuncSetAttribute failed\n"); grid = -1; return; }
        if (hipOccupancyMaxActiveBlocksPerMultiprocessor(&per_cu, (const void*)fwd_kernel, 512, LDS_BYTES) != hipSuccess || per_cu < 1) { fprintf(stderr, "kernel_launch: occupancy query failed (%d)\n", per_cu); (void)hipGetLastError(); per_cu = 1; }
        grid = cus * 1;
        if (per_cu < 1) grid = -1;
    }
    if (grid < 0) return;
    Params p{};
    for (int i = 0; i < 27; ++i) p.in[i] = (const float*)d_in[i];
    p.out = (float*)d_out; p.ws = (unsigned char*)d_ws;
#if MK_COOP
    if (hipMemsetAsync((char*)d_ws + WS_CTL, 0, CTL_ZERO_BYTES, stream) != hipSuccess) { fprintf(stderr, "kernel_launch: memset of the barrier words failed\n"); return; }
    p.ph_lo = 0; p.ph_hi = 11; p.coop = 1;
    void* args[] = {&p};
    hipError_t e = hipLaunchCooperativeKernel((const void*)fwd_kernel, dim3(grid), dim3(512), args, LDS_BYTES, stream);
    if (e != hipSuccess) fprintf(stderr, "cooperative launch failed: %s (grid %d)\n", hipGetErrorString(e), grid);
#else
    for (int ph = 0; ph < 11; ++ph) {
        p.ph_lo = ph; p.ph_hi = ph + 1; p.coop = 0;
        hipLaunchKernelGGL(fwd_kernel, dim3(grid), dim3(512), LDS_BYTES, stream, p);
    }
#endif
}
```

```cpp
#include <hip/hip_runtime.h>
#include <hip/hip_cooperative_groups.h>
#include <cstdio>
#include <cstdint>
namespace cg = cooperative_groups;

#ifndef MK_COOP
#define MK_COOP 1
#endif

#define LAS __attribute__((address_space(3)))
typedef unsigned short bf16_t;
typedef short bf16x8 __attribute__((ext_vector_type(8)));
typedef short s16x4 __attribute__((ext_vector_type(4)));
typedef float f32x2 __attribute__((ext_vector_type(2)));
typedef float f32x4 __attribute__((ext_vector_type(4)));
typedef float f32x16 __attribute__((ext_vector_type(16)));
typedef unsigned u32x2 __attribute__((ext_vector_type(2)));
typedef unsigned u32x4 __attribute__((ext_vector_type(4)));
typedef __bf16 bf16x2_t __attribute__((ext_vector_type(2)));

__device__ __forceinline__ unsigned pkbf(float lo, float hi) { f32x2 v = {lo, hi}; bf16x2_t b = __builtin_convertvector(v, bf16x2_t); return __builtin_bit_cast(unsigned, b); }
__device__ __forceinline__ float bf_lo(unsigned w) { return __uint_as_float(w << 16); }
__device__ __forceinline__ float bf_hi(unsigned w) { return __uint_as_float(w & 0xffff0000u); }
__device__ __forceinline__ int fresh_lane() { int t = __builtin_amdgcn_mbcnt_hi(~0u, __builtin_amdgcn_mbcnt_lo(~0u, 0u)); asm volatile("" : "+v"(t)); return t; }
__device__ __forceinline__ float fast_exp2(float x) { return __builtin_amdgcn_exp2f(x); }
__device__ __forceinline__ float fast_rcp(float x) { return __builtin_amdgcn_rcpf(x); }

constexpr int DM = 1024, NBATCH = 4, SEQ = 8192, MP = NBATCH * SEQ;
constexpr int NSEQ = 32, TS = 8, MSMP = NSEQ * TS;
constexpr int MTOK = MP + MSMP;
constexpr int NMEM = 256, MMEM = NBATCH * NMEM;
constexpr int MALL = MTOK + MMEM;
constexpr int AW = 768, CWD = 256, NIN = 2816, DFF = 2816, NH = 12, HD = 64;
constexpr int WBUF = 2048;
constexpr float EPS = 1e-6f;
constexpr float LOG2E = 1.4426950408889634f;
constexpr float QSCALE = 0.125f * LOG2E;
constexpr float XQSCALE = 0.0625f * LOG2E;

constexpr size_t OFF_Y = 0;
constexpr size_t OFF_PWK = 33816576, OFF_PWV = 40108032, OFF_PCONV = 46399488, OFF_PMK = 46430208, OFF_PMV = 47478784;
constexpr size_t OFF_SWK = 48527360, OFF_SWV = 98859008, OFF_SCONV = 149190656, OUT_TOTAL = 149436416;

constexpr size_t MiB = 1u << 20;
constexpr size_t WS_CTL = 0, CTL_ZERO_BYTES = 65536;
constexpr size_t WS_WALL = 2 * MiB;
constexpr size_t WS_WOUT = 12 * MiB, WS_WXQ = 14 * MiB, WS_WXO = 16 * MiB;
constexpr size_t WS_WGU = 18 * MiB;
constexpr size_t WS_WDN = 30 * MiB;
constexpr size_t WS_XN = 36 * MiB;
constexpr size_t WS_QB = 104 * MiB, WS_KB = 154 * MiB, WS_VB = 204 * MiB;
constexpr size_t WS_U = 254 * MiB;
constexpr size_t WS_OP = 288 * MiB;
constexpr size_t OP_STRIDE = (size_t)MTOK * AW;
constexpr size_t WS_LSE = 434 * MiB;
constexpr size_t LSE_STRIDE = (size_t)MTOK * NH;
constexpr size_t WS_ATT = 440 * MiB;
constexpr size_t WS_X1 = 506 * MiB;
constexpr size_t WS_SSQ = 636 * MiB;
constexpr size_t SSQ_STRIDE = (size_t)MTOK * 16;
constexpr size_t WS_MKB = 644 * MiB, WS_MVT = 646 * MiB;
constexpr size_t WS_LSUM = 648 * MiB;
constexpr size_t WS_XQ = 353 * MiB;
constexpr size_t WS_PB = 652 * MiB;
constexpr size_t WS_XO = 288 * MiB;
constexpr size_t WS_H = 104 * MiB;
constexpr size_t WS_TABG = 651 * MiB;
constexpr size_t WS_SLOT = 650 * MiB;
constexpr size_t WS_END = 716 * MiB;

namespace pg8 {
constexpr int BM = 256, BK = 64, HALF = 128, HTB = HALF * BK * 2, STAGE_BYTES = 8 * HTB, NXCD = 8, WGM = 8;
__host__ __device__ __forceinline__ int lds_byte(int r, int c) { const int st = (r >> 4) * 2 + (c >> 5), rr = r & 15, cc = c & 31, ob = rr * 64 + cc * 2; return st * 1024 + (ob ^ (((ob >> 9) & 1) << 5)); }
__host__ __device__ __forceinline__ void stage_rc(int b, int& R, int& C) { const int st = b / 1024, sb = b % 1024, swz = sb ^ (((sb >> 9) & 1) << 5); R = (st >> 1) * 16 + swz / 64; C = (st & 1) * 32 + (swz % 64) / 2; }
__host__ __device__ __forceinline__ int perm32(int rho) { const int n = rho >> 4, i = rho & 15; return 8 * (i >> 2) + 4 * n + (i & 3); }

struct Unit { int pm, pn, kind; };
struct Cfg { int K, lda, ldb; };

template <class Epi, class Sched, bool ALIGN_EPI>
__device__ __forceinline__ void gemm_phase(LAS unsigned char* lds, const Cfg g, const Sched& S, const Epi& E, const int wid) {
    const int lane = fresh_lane(), tid = wid * 64 + lane, wr = wid >> 2, wc = wid & 3, fr = lane & 15, fq = lane >> 4;
    const int K = g.K, nt = K / BK;
    unsigned voffA[2], voffB[2];
#pragma unroll
    for (int i = 0; i < 2; ++i) { int R, C; stage_rc(tid * 16 + i * 8192, R, C); const int Rb = (R & ~31) + perm32(R & 31);
        voffA[i] = (unsigned)(R * g.lda + C) * 2u; voffB[i] = (unsigned)(Rb * g.ldb + C) * 2u; }
    const size_t kstep = (size_t)(BK * 2);
    const size_t hA = (size_t)HALF * g.lda * 2, hB = (size_t)HALF * g.ldb * 2;
    const unsigned ldsw = (unsigned)wid * 1024u;
    const int aoff = lds_byte(wr * 64 + fr, fq * 8), boff = lds_byte(wc * 32 + fr, fq * 8);
#define PG8_SA(b, h) (((b) * 2 + (h)) * HTB)
#define PG8_SB(b, h) ((4 + (b) * 2 + (h)) * HTB)
#define PG8_STAGE(bufoff, gbase, voff) do { _Pragma("unroll") for (int _i = 0; _i < 2; ++_i) \
        __builtin_amdgcn_global_load_lds((const unsigned*)((const char*)(gbase) + (voff)[_i]), (LAS unsigned*)(lds + (bufoff) + ldsw + _i * 8192), 16, 0, 0); } while (0)
#define PG8_LDA(dst, b, h) do { _Pragma("unroll") for (int m = 0; m < 4; ++m) _Pragma("unroll") for (int k = 0; k < 2; ++k) dst[m][k] = *(const LAS bf16x8*)(lds + PG8_SA(b, h) + aoff + m * 2048 + k * 1024); } while (0)
#define PG8_LDB(dst, b, h) do { _Pragma("unroll") for (int n = 0; n < 2; ++n) _Pragma("unroll") for (int k = 0; k < 2; ++k) dst[n][k] = *(const LAS bf16x8*)(lds + PG8_SB(b, h) + boff + n * 2048 + k * 1024); } while (0)
#define PG8_MMA(ai, bj, At, Bt) do { __builtin_amdgcn_s_setprio(1); _Pragma("unroll") for (int m = 0; m < 4; ++m) _Pragma("unroll") for (int n = 0; n < 2; ++n) _Pragma("unroll") for (int k = 0; k < 2; ++k) \
        acc[ai][bj][m][n] = __builtin_amdgcn_mfma_f32_16x16x32_bf16(Bt[n][k], At[m][k], acc[ai][bj][m][n], 0, 0, 0); __builtin_amdgcn_s_setprio(0); } while (0)
#define PG8_WAIT_V(n) asm volatile("s_waitcnt vmcnt(" #n ")" ::: "memory")
#define PG8_WAIT_L(n) asm volatile("s_waitcnt lgkmcnt(" #n ")" ::: "memory")
#define PG8_BAR __builtin_amdgcn_s_barrier()
#define PG8_SCHED __builtin_amdgcn_sched_barrier(0)
    Unit cur, nxt; int ui = 0;
    if (!S.next(0, cur)) return;
    f32x4 acc[2][2][4][2];
    E.init(acc, cur, wr, wc, fr, fq);
    bf16x8 At[4][2], B0[2][2], B1[2][2];
    const char* cA = S.aptr(cur); const char* cB = S.bptr(cur);
    PG8_STAGE(PG8_SB(0, 0), cB, voffB); PG8_STAGE(PG8_SB(0, 1), cB + hB, voffB); PG8_STAGE(PG8_SA(0, 0), cA, voffA); PG8_STAGE(PG8_SA(0, 1), cA + hA, voffA);
    if (wr == 1) PG8_BAR;
    PG8_WAIT_V(2); PG8_BAR;
    PG8_STAGE(PG8_SB(1, 0), cB + kstep, voffB); PG8_STAGE(PG8_SA(1, 0), cA + kstep, voffA); PG8_STAGE(PG8_SB(1, 1), cB + hB + kstep, voffB);
    PG8_WAIT_V(6); PG8_BAR;
    for (;;) {
        const bool has_next = S.next(ui + 1, nxt);
        const char* nA = has_next ? S.aptr(nxt) : cA; const char* nB = has_next ? S.bptr(nxt) : cB;
#pragma unroll 1
        for (int t = 0; t < nt; t += 2) {
            const bool last = (t == nt - 2);
            const char* a1 = cA + (size_t)(t + 1) * kstep;
            const char* a2 = last ? nA : cA + (size_t)(t + 2) * kstep; const char* b2 = last ? nB : cB + (size_t)(t + 2) * kstep;
            const char* a3 = a2 + kstep; const char* b3 = b2 + kstep;
            PG8_LDB(B0, 0, 0); PG8_LDB(B1, 0, 1); PG8_SCHED; PG8_LDA(At, 0, 0); PG8_STAGE(PG8_SA(1, 1), a1 + hA, voffA);
            PG8_WAIT_V(8); PG8_WAIT_L(0); PG8_BAR; PG8_MMA(0, 0, At, B0); PG8_MMA(0, 1, At, B1); PG8_BAR; PG8_SCHED;
            PG8_LDA(At, 0, 1); PG8_STAGE(PG8_SB(0, 0), b2, voffB); PG8_STAGE(PG8_SB(0, 1), b2 + hB, voffB); PG8_STAGE(PG8_SA(0, 0), a2, voffA);
            PG8_WAIT_V(8); PG8_WAIT_L(0); PG8_BAR; PG8_MMA(1, 0, At, B0); PG8_MMA(1, 1, At, B1); PG8_BAR; PG8_SCHED;
            PG8_LDB(B0, 1, 0); PG8_LDB(B1, 1, 1); PG8_SCHED; PG8_LDA(At, 1, 0); PG8_STAGE(PG8_SA(0, 1), a2 + hA, voffA);
            PG8_WAIT_V(8); PG8_WAIT_L(0); PG8_BAR; PG8_MMA(0, 0, At, B0); PG8_MMA(0, 1, At, B1); PG8_BAR; PG8_SCHED;
            PG8_LDA(At, 1, 1); PG8_STAGE(PG8_SB(1, 0), b3, voffB); PG8_STAGE(PG8_SB(1, 1), b3 + hB, voffB); PG8_STAGE(PG8_SA(1, 0), a3, voffA);
            PG8_WAIT_V(8); PG8_WAIT_L(0); PG8_BAR; PG8_MMA(1, 0, At, B0); PG8_MMA(1, 1, At, B1); PG8_BAR; PG8_SCHED;
        }
        if constexpr (ALIGN_EPI) { if (wr == 0) PG8_BAR; }
        E(acc, cur, wr, wc, fr, fq);
        if (!has_next) break;
        E.init(acc, nxt, wr, wc, fr, fq);
        cur = nxt; cA = nA; cB = nB; ++ui;
        if constexpr (ALIGN_EPI) { if (wr == 1) PG8_BAR; }
    }
    PG8_WAIT_V(0);
    if constexpr (!ALIGN_EPI) { if (wr == 0) PG8_BAR; }
    PG8_BAR;
#undef PG8_SA
#undef PG8_SB
#undef PG8_STAGE
#undef PG8_LDA
#undef PG8_LDB
#undef PG8_MMA
#undef PG8_WAIT_V
#undef PG8_WAIT_L
#undef PG8_BAR
#undef PG8_SCHED
}

__device__ __forceinline__ void swz_tile(int L, int nM, int nN, int& pm, int& pn) {
    const int nwg = nM * nN; int wgid = L;
    { const int q = nwg / NXCD, r = nwg % NXCD, xcd = wgid % NXCD, off = wgid / NXCD; wgid = (xcd < r ? xcd * (q + 1) : r * (q + 1) + (xcd - r) * q) + off; }
    const int nig = WGM * nN, gid = wgid / nig, fm = gid * WGM, gsz = (nM - fm) < WGM ? (nM - fm) : WGM;
    pm = fm + ((wgid % nig) % gsz); pn = (wgid % nig) / gsz;
}
struct SchedGrid {
    int nM, nN, G, c; const char* A; const char* B; size_t tA, tB;
    __device__ __forceinline__ bool next(int i, Unit& u) const { const long L = (long)i * G + c; if (L >= (long)nM * nN) return false; swz_tile((int)L, nM, nN, u.pm, u.pn); u.kind = 0; return true; }
    __device__ __forceinline__ const char* aptr(const Unit& u) const { return A + (size_t)u.pm * tA; }
    __device__ __forceinline__ const char* bptr(const Unit& u) const { return B + (size_t)u.pn * tB; }
};
struct SchedMem {
    int c; const char* XN; const char* W;
    static constexpr size_t TS_ = (size_t)256 * 1024 * 2;
    __device__ __forceinline__ bool next(int i, Unit& u) const {
        if (i > 0 || c < 0 || c >= 48) return false;
        if (c < 32) { u.pm = 129 + (c >> 3); u.pn = 11 + (c & 7); u.kind = 1; } else { const int f = c - 32; u.pm = f >> 2; u.pn = f & 3; u.kind = 2; }
        return true;
    }
    __device__ __forceinline__ const char* aptr(const Unit& u) const { return u.kind == 2 ? W + (size_t)(15 + u.pm) * TS_ : XN + (size_t)u.pm * TS_; }
    __device__ __forceinline__ const char* bptr(const Unit& u) const { return u.kind == 2 ? XN + (size_t)(129 + u.pn) * TS_ : W + (size_t)u.pn * TS_; }
};
struct SchedX {
    int G, c; const char* A; const char* B; int bmode;
    __device__ __forceinline__ bool next(int i, Unit& u) const { const long L = (long)i * G + c; if (L >= 512) return false; u.pm = (int)L >> 2; u.pn = (int)L & 3; u.kind = 0; return true; }
    __device__ __forceinline__ const char* aptr(const Unit& u) const { return A + ((size_t)u.pm * 256 * 1024 + (size_t)u.pn * 256) * 2; }
    __device__ __forceinline__ const char* bptr(const Unit& u) const { const int b = u.pm >> 5; return bmode == 0 ? B + ((size_t)b * 256 * 1024 + (size_t)u.pn * 256) * 2 : B + ((size_t)u.pn * 256 * 1024 + (size_t)b * 256) * 2; }
};

struct SchedPanel {
    int G, vcu; const char* A; const char* B; size_t tA, tB;
    __device__ __forceinline__ bool next(int i, Unit& u) const { const int L = i * G + vcu; if (L >= 516) return false; u.pm = L >> 2; u.pn = L & 3; u.kind = 0; return true; }
    __device__ __forceinline__ const char* aptr(const Unit& u) const { return A + (size_t)u.pm * tA; }
    __device__ __forceinline__ const char* bptr(const Unit& u) const { return B + (size_t)u.pn * tB; }
};
struct SchedXL {
    int nl, rk, xi, nx; const char* A; const char* B; size_t tA, tB; int skip128;
    __device__ __forceinline__ bool next(int i, Unit& u) const { const int Lx = i * nl + rk, pm = xi + nx * (Lx >> 2); if (pm >= 129 || (skip128 && pm == 128)) return false; u.pm = pm; u.pn = Lx & 3; u.kind = 0; return true; }
    __device__ __forceinline__ const char* aptr(const Unit& u) const { return A + (size_t)u.pm * tA; }
    __device__ __forceinline__ const char* bptr(const Unit& u) const { return B + (size_t)u.pn * tB; }
};
struct SchedOne {
    int pm, pn; const char* A; const char* B; size_t tA, tB;
    __device__ __forceinline__ bool next(int i, Unit& u) const { if (i > 0) return false; u.pm = pm; u.pn = pn; u.kind = 0; return true; }
    __device__ __forceinline__ const char* aptr(const Unit& u) const { return A + (size_t)u.pm * tA; }
    __device__ __forceinline__ const char* bptr(const Unit& u) const { return B + (size_t)u.pn * tB; }
};
struct SchedXL22 {
    int nl, rk, xi, nx; const char* A; const char* B; size_t tA, tB;
    __device__ __forceinline__ bool next(int i, Unit& u) const { const int Lx = i * nl + rk, q = Lx / 22, pm = xi + nx * q; if (pm >= 129) return false; u.pm = pm; u.pn = Lx - q * 22; u.kind = 0; return true; }
    __device__ __forceinline__ const char* aptr(const Unit& u) const { return A + (size_t)u.pm * tA; }
    __device__ __forceinline__ const char* bptr(const Unit& u) const { return B + (size_t)u.pn * tB; }
};
struct SchedXLs {
    int nl, rk, xi, nx; const char* A; const char* B; int bmode;
    __device__ __forceinline__ bool next(int i, Unit& u) const {
        int idx = 0;
#pragma unroll 1
        for (int j = 0; j < 16; ++j) { const int Lx = j * nl + rk, pm = xi + nx * (Lx >> 2); if (pm >= 129) break; if (pm == 128) continue;
            if (idx == i) { u.pm = pm; u.pn = Lx & 3; u.kind = 0; return true; } ++idx; }
        return false;
    }
    __device__ __forceinline__ const char* aptr(const Unit& u) const { return A + ((size_t)u.pm * 256 * 1024 + (size_t)u.pn * 256) * 2; }
    __device__ __forceinline__ const char* bptr(const Unit& u) const { const int b = u.pm >> 5; return bmode == 0 ? B + ((size_t)b * 256 * 1024 + (size_t)u.pn * 256) * 2 : B + ((size_t)u.pn * 256 * 1024 + (size_t)b * 256) * 2; }
};
struct SchedXs {
    int G, c; const char* A; const char* B; int bmode;
    __device__ __forceinline__ bool next(int i, Unit& u) const {
        int idx = 0;
#pragma unroll
        for (int j = 0; j < 3; ++j) { const int L = j * G + c; if (L >= 516) break; int pm, pn; swz_tile(L, 129, 4, pm, pn); if (pm == 128) continue;
            if (idx == i) { u.pm = pm; u.pn = pn; u.kind = 0; return true; } ++idx; }
        return false;
    }
    __device__ __forceinline__ const char* aptr(const Unit& u) const { return A + ((size_t)u.pm * 256 * 1024 + (size_t)u.pn * 256) * 2; }
    __device__ __forceinline__ const char* bptr(const Unit& u) const { const int b = u.pm >> 5; return bmode == 0 ? B + ((size_t)b * 256 * 1024 + (size_t)u.pn * 256) * 2 : B + ((size_t)u.pn * 256 * 1024 + (size_t)b * 256) * 2; }
};

#define EPI_ARGS const f32x4 (&acc)[2][2][4][2], const Unit& u, int wr, int wc, int fr, int fq
#define EPI_ZERO_INIT __device__ __forceinline__ void init(f32x4 (&acc)[2][2][4][2], const Unit&, int, int, int, int) const { \
    _Pragma("unroll") for (int a = 0; a < 2; ++a) _Pragma("unroll") for (int b = 0; b < 2; ++b) _Pragma("unroll") for (int m = 0; m < 4; ++m) _Pragma("unroll") for (int n = 0; n < 2; ++n) acc[a][b][m][n] = (f32x4){0.f, 0.f, 0.f, 0.f}; }
struct EpiIn {
    unsigned char* ws; float* out;
    EPI_ZERO_INIT
    __device__ __forceinline__ void operator()(EPI_ARGS) const {
        const int lr0 = wr * 64 + fr, lc0 = wc * 32 + 8 * fq;
        const int pm = u.pm, pn = u.pn;
        const bool smp = (pm == 128);
#ifdef P1_NO_QKV
        if (false) {
#else
        if (pn < 9) {
#endif
            const int sec = pn / 3, cb = (pn - sec * 3) * 256 + lc0;
            bf16_t* dst = (bf16_t*)(ws + (sec == 0 ? WS_QB : (sec == 1 ? WS_KB : WS_VB)));
            const float sc = sec == 0 ? QSCALE : 1.f;
#pragma unroll
            for (int ai = 0; ai < 2; ++ai)
#pragma unroll
                for (int m = 0; m < 4; ++m) {
                    bf16_t* rowp = dst + ((size_t)pm * 256 + lr0 + 128 * ai + 16 * m) * AW + cb;
#pragma unroll
                    for (int bj = 0; bj < 2; ++bj) {
                        const f32x4 v0 = acc[ai][bj][m][0] * sc, v1 = acc[ai][bj][m][1] * sc;
                        u32x4 w; w.x = pkbf(v0[0], v0[1]); w.y = pkbf(v0[2], v0[3]); w.z = pkbf(v1[0], v1[1]); w.w = pkbf(v1[2], v1[3]);
                        *(u32x4*)(rowp + bj * 128) = w;
                    }
                }
            if (sec > 0 && (smp || (pm & 31) >= 24)) {
                float* fb; size_t sa, sm;
                if (smp) { fb = out + (sec == 1 ? OFF_SWK : OFF_SWV) + ((size_t)(8 * wr + (fr >> 3)) * WBUF + (WBUF - TS) + (fr & 7)) * AW + cb; sa = (size_t)16 * WBUF * AW; sm = (size_t)2 * WBUF * AW; }
                else { fb = out + (sec == 1 ? OFF_PWK : OFF_PWV) + ((size_t)(pm >> 5) * WBUF + ((pm & 31) - 24) * 256 + lr0) * AW + cb; sa = (size_t)128 * AW; sm = (size_t)16 * AW; }
#pragma unroll
                for (int ai = 0; ai < 2; ++ai)
#pragma unroll
                    for (int m = 0; m < 4; ++m)
#pragma unroll
                        for (int bj = 0; bj < 2; ++bj) { float* fp = fb + ai * sa + m * sm + bj * 128; *(f32x4*)fp = acc[ai][bj][m][0]; *(f32x4*)(fp + 4) = acc[ai][bj][m][1]; }
            }
#ifdef P1_NO_GLU
        } else if (false) {
#else
        } else {
#endif
            const int c0 = (pn - 9) * 128 + lc0;
            float* U = (float*)(ws + WS_U);
#pragma unroll
            for (int ai = 0; ai < 2; ++ai)
#pragma unroll
                for (int m = 0; m < 4; ++m) {
                    const size_t grow = (size_t)pm * 256 + lr0 + 128 * ai + 16 * m;
#pragma unroll
                    for (int n = 0; n < 2; ++n) {
                        const f32x4 a = acc[ai][0][m][n], gg = acc[ai][1][m][n]; f32x4 uu;
#pragma unroll
                        for (int e = 0; e < 4; ++e) uu[e] = a[e] * fast_rcp(1.f + fast_exp2(-gg[e] * LOG2E));
                        *(f32x4*)(U + grow * CWD + c0 + 4 * n) = uu;
                    }
                }
            if (smp) {
                float* fb = out + OFF_SCONV + ((size_t)(8 * wr + (fr >> 3)) * 30 + 22 + (fr & 7)) * CWD + c0;
#pragma unroll
                for (int ai = 0; ai < 2; ++ai)
#pragma unroll
                    for (int m = 0; m < 4; ++m)
#pragma unroll
                        for (int n = 0; n < 2; ++n) {
                            const f32x4 a = acc[ai][0][m][n], gg = acc[ai][1][m][n]; f32x4 uu;
#pragma unroll
                            for (int e = 0; e < 4; ++e) uu[e] = a[e] * fast_rcp(1.f + fast_exp2(-gg[e] * LOG2E));
                            *(f32x4*)(fb + (size_t)(16 * ai + 2 * m) * 30 * CWD + 4 * n) = uu;
                        }
            } else if ((pm & 31) == 31 && wr == 1) {
#pragma unroll
                for (int m = 2; m < 4; ++m) {
                    const int lr = lr0 + 128 + 16 * m;
                    if (lr >= 226) {
                        float* fb = out + OFF_PCONV + ((size_t)(pm >> 5) * 30 + (lr - 226)) * CWD + c0;
#pragma unroll
                        for (int n = 0; n < 2; ++n) {
                            const f32x4 a = acc[1][0][m][n], gg = acc[1][1][m][n]; f32x4 uu;
#pragma unroll
                            for (int e = 0; e < 4; ++e) uu[e] = a[e] * fast_rcp(1.f + fast_exp2(-gg[e] * LOG2E));
                            *(f32x4*)(fb + 4 * n) = uu;
                        }
                    }
                }
            }
        }
    }
};
struct EpiMem {
    unsigned char* ws; float* out;
    EPI_ZERO_INIT
    __device__ __forceinline__ void operator()(EPI_ARGS) const {
        const int lr0 = wr * 64 + fr, lc0 = wc * 32 + 8 * fq;
        if (u.kind == 1) {
            const int sec = (u.pn - 11) >> 2, cb = ((u.pn - 11) & 3) * 256 + lc0;
            float* fo = out + (sec ? OFF_PMV : OFF_PMK); bf16_t* MKB = (bf16_t*)(ws + WS_MKB);
#pragma unroll
            for (int ai = 0; ai < 2; ++ai)
#pragma unroll
                for (int m = 0; m < 4; ++m) {
                    const size_t mr = (size_t)(u.pm - 129) * 256 + lr0 + 128 * ai + 16 * m;
#pragma unroll
                    for (int bj = 0; bj < 2; ++bj) {
                        const f32x4 v0 = acc[ai][bj][m][0], v1 = acc[ai][bj][m][1];
                        float* fp = fo + mr * 1024 + cb + bj * 128; *(f32x4*)fp = v0; *(f32x4*)(fp + 4) = v1;
                        if (sec == 0) { u32x4 w; w.x = pkbf(v0[0], v0[1]); w.y = pkbf(v0[2], v0[3]); w.z = pkbf(v1[0], v1[1]); w.w = pkbf(v1[2], v1[3]); *(u32x4*)(MKB + mr * 1024 + cb + bj * 128) = w; }
                    }
                }
        } else {
            bf16_t* MVT = (bf16_t*)(ws + WS_MVT);
#pragma unroll
            for (int ai = 0; ai < 2; ++ai)
#pragma unroll
                for (int m = 0; m < 4; ++m) {
                    const size_t nr = (size_t)u.pm * 256 + lr0 + 128 * ai + 16 * m;
#pragma unroll
                    for (int bj = 0; bj < 2; ++bj) {
                        const f32x4 v0 = acc[ai][bj][m][0], v1 = acc[ai][bj][m][1];
                        u32x4 w; w.x = pkbf(v0[0], v0[1]); w.y = pkbf(v0[2], v0[3]); w.z = pkbf(v1[0], v1[1]); w.w = pkbf(v1[2], v1[3]);
                        *(u32x4*)(MVT + nr * 1024 + u.pn * 256 + lc0 + bj * 128) = w;
                    }
                }
        }
    }
};
__device__ __forceinline__ void init_from_xn(f32x4 (&acc)[2][2][4][2], const bf16_t* XN, const float* g, const Unit& u, int wr, int wc, int fr, int fq) {
    const int lr0 = wr * 64 + fr, c0 = u.pn * 256 + wc * 32 + 8 * fq;
    f32x4 rg[2][2];
#pragma unroll
    for (int bj = 0; bj < 2; ++bj)
#pragma unroll
        for (int n = 0; n < 2; ++n) { const f32x4 gg = *(const f32x4*)(g + c0 + bj * 128 + 4 * n); rg[bj][n] = (f32x4){fast_rcp(gg[0]), fast_rcp(gg[1]), fast_rcp(gg[2]), fast_rcp(gg[3])}; }
#pragma unroll
    for (int ai = 0; ai < 2; ++ai)
#pragma unroll
        for (int m = 0; m < 4; ++m) {
            const unsigned ro = (unsigned)((u.pm * 256 + lr0 + 128 * ai + 16 * m) * DM + c0) * 2u;
#pragma unroll
            for (int bj = 0; bj < 2; ++bj) { const u32x4 w = *(const u32x4*)((const char*)XN + ro + bj * 256);
                acc[ai][bj][m][0] = (f32x4){bf_lo(w.x), bf_hi(w.x), bf_lo(w.y), bf_hi(w.y)} * rg[bj][0];
                acc[ai][bj][m][1] = (f32x4){bf_lo(w.z), bf_hi(w.z), bf_lo(w.w), bf_hi(w.w)} * rg[bj][1]; }
        }
}
template <bool RESX> struct EpiRes {
    const float* resP; const float* resS; const float* gp; bf16_t* XN; const float* g; float* SSQ;
    __device__ __forceinline__ void init(f32x4 (&acc)[2][2][4][2], const Unit& u, int wr, int wc, int fr, int fq) const {
        if (RESX) {
            const int lr0 = wr * 64 + fr, c0 = u.pn * 256 + wc * 32 + 8 * fq;
            const float* res = (u.pm == 128) ? resS - (size_t)MP * DM : resP;
#pragma unroll
            for (int ai = 0; ai < 2; ++ai)
#pragma unroll
                for (int m = 0; m < 4; ++m) {
                    const float* rp = res + ((size_t)u.pm * 256 + lr0 + 128 * ai + 16 * m) * DM + c0;
#pragma unroll
                    for (int bj = 0; bj < 2; ++bj) { acc[ai][bj][m][0] = *(const f32x4*)(rp + bj * 128); acc[ai][bj][m][1] = *(const f32x4*)(rp + bj * 128 + 4); }
                }
        } else init_from_xn(acc, XN, gp, u, wr, wc, fr, fq);
    }
    __device__ __forceinline__ void operator()(EPI_ARGS) const {
        const int lr0 = wr * 64 + fr, c0 = u.pn * 256 + wc * 32 + 8 * fq;
        f32x4 gv[2][2];
#pragma unroll
        for (int bj = 0; bj < 2; ++bj)
#pragma unroll
            for (int n = 0; n < 2; ++n) gv[bj][n] = *(const f32x4*)(g + c0 + bj * 128 + 4 * n);
#pragma unroll
        for (int ai = 0; ai < 2; ++ai)
#pragma unroll
            for (int m = 0; m < 4; ++m) {
                const size_t grow = (size_t)u.pm * 256 + lr0 + 128 * ai + 16 * m; const size_t off = grow * DM + c0;
                float ss = 0.f;
#pragma unroll
                for (int bj = 0; bj < 2; ++bj) {
                    f32x4 x0 = acc[ai][bj][m][0], x1 = acc[ai][bj][m][1];
                    ss += (x0[0] * x0[0] + x0[1] * x0[1]) + (x0[2] * x0[2] + x0[3] * x0[3]) + (x1[0] * x1[0] + x1[1] * x1[1]) + (x1[2] * x1[2] + x1[3] * x1[3]);
                    x0 = x0 * gv[bj][0]; x1 = x1 * gv[bj][1];
                    u32x4 w; w.x = pkbf(x0[0], x0[1]); w.y = pkbf(x0[2], x0[3]); w.z = pkbf(x1[0], x1[1]); w.w = pkbf(x1[2], x1[3]);
                    *(u32x4*)(XN + off + bj * 128) = w;
                }
                ss += __shfl_xor(ss, 16); ss += __shfl_xor(ss, 32);
                if (fq == 0) SSQ[grow * 16 + u.pn * 4 + wc] = ss;
            }
    }
};
struct EpiFinal {
    const bf16_t* XN; const float* gp; float* Y; const float* g; float* slots; unsigned* cnt; LAS float* xl; int wave;
    __device__ __forceinline__ void init(f32x4 (&acc)[2][2][4][2], const Unit& u, int wr, int wc, int fr, int fq) const { init_from_xn(acc, XN, gp, u, wr, wc, fr, fq); }
    __device__ __forceinline__ void operator()(EPI_ARGS) const {
        const int lr0 = wr * 64 + fr, c0 = u.pn * 256 + wc * 32 + 8 * fq;
        const int lane = fr + 16 * fq;
#pragma unroll
        for (int ai = 0; ai < 2; ++ai)
#pragma unroll
            for (int m = 0; m < 4; ++m) {
                float ss = 0.f;
#pragma unroll
                for (int bj = 0; bj < 2; ++bj)
#pragma unroll
                    for (int n = 0; n < 2; ++n) { const f32x4 x = acc[ai][bj][m][n]; ss += (x[0] * x[0] + x[1] * x[1]) + (x[2] * x[2] + x[3] * x[3]); }
                ss += __shfl_xor(ss, 16); ss += __shfl_xor(ss, 32);
                if (fq == 0) xl[(lr0 + 128 * ai + 16 * m) * 4 + wc] = ss;
            }
        asm volatile("s_waitcnt lgkmcnt(0)" ::: "memory"); __builtin_amdgcn_s_barrier(); asm volatile("" ::: "memory");
        const int row = wave * 32 + (lane & 31);
        if (lane < 32) { const f32x4 q4 = *(const LAS f32x4*)(xl + row * 4);
            __hip_atomic_store(slots + ((size_t)u.pm * 256 + row) * 4 + u.pn, (q4[0] + q4[1]) + (q4[2] + q4[3]), __ATOMIC_RELAXED, __HIP_MEMORY_SCOPE_AGENT); }
        asm volatile("s_waitcnt vmcnt(0)" ::: "memory");
        if (lane == 0) __hip_atomic_fetch_add(cnt + 64 * u.pm, 1u, __ATOMIC_RELAXED, __HIP_MEMORY_SCOPE_AGENT);
        if (wave == 0) {
            unsigned sp = 0;
            while ((unsigned)__builtin_amdgcn_readfirstlane(__hip_atomic_load(cnt + 64 * u.pm, __ATOMIC_RELAXED, __HIP_MEMORY_SCOPE_AGENT)) < 32u) { __builtin_amdgcn_s_sleep(2); if (++sp > (1u << 21)) break; }
            __builtin_amdgcn_fence(__ATOMIC_ACQUIRE, "agent");
        }
        asm volatile("s_waitcnt vmcnt(0) lgkmcnt(0)" ::: "memory"); __builtin_amdgcn_s_barrier(); asm volatile("" ::: "memory");
        if (lane < 32) { const float* sl = slots + ((size_t)u.pm * 256 + row) * 4; float t = 0.f;
#pragma unroll
            for (int k = 0; k < 4; ++k) t += __hip_atomic_load(sl + k, __ATOMIC_RELAXED, __HIP_MEMORY_SCOPE_AGENT);
            xl[1024 + row] = 1.0f / sqrtf(t * (1.0f / DM) + EPS); }
        asm volatile("s_waitcnt vmcnt(0) lgkmcnt(0)" ::: "memory"); __builtin_amdgcn_s_barrier(); asm volatile("" ::: "memory");
#pragma unroll
        for (int ai = 0; ai < 2; ++ai)
#pragma unroll
            for (int m = 0; m < 4; ++m) {
                const int lr = lr0 + 128 * ai + 16 * m; const float rs = xl[1024 + lr]; float* yp = Y + ((size_t)u.pm * 256 + lr) * DM + c0;
#pragma unroll
                for (int bj = 0; bj < 2; ++bj) { const f32x4 g0 = *(const f32x4*)(g + c0 + bj * 128), g1 = *(const f32x4*)(g + c0 + bj * 128 + 4);
                    *(f32x4*)(yp + bj * 128) = acc[ai][bj][m][0] * rs * g0; *(f32x4*)(yp + bj * 128 + 4) = acc[ai][bj][m][1] * rs * g1; }
                asm volatile("" ::: "memory");
            }
        asm volatile("s_waitcnt lgkmcnt(0)" ::: "memory"); __builtin_amdgcn_s_barrier(); asm volatile("" ::: "memory");
    }
};
__device__ __forceinline__ float row_rstd(const float* SSQ, size_t grow) {
    const f32x4* p = (const f32x4*)(SSQ + grow * 16); const f32x4 a = p[0], b = p[1], c = p[2], d = p[3];
    const float s = ((a[0] + a[1]) + (a[2] + a[3])) + ((b[0] + b[1]) + (b[2] + b[3])) + ((c[0] + c[1]) + (c[2] + c[3])) + ((d[0] + d[1]) + (d[2] + d[3]));
    return 1.0f / sqrtf(s * (1.0f / DM) + EPS);
}
__device__ __forceinline__ void rows_rstd8(const float* SSQ, size_t row0, int fq, float (&rs)[2][4]) {
    f32x4 pre[2][4];
#pragma unroll
    for (int ai = 0; ai < 2; ++ai)
#pragma unroll
        for (int m = 0; m < 4; ++m) pre[ai][m] = *(const f32x4*)(SSQ + (row0 + 128 * ai + 16 * m) * 16 + fq * 4);
    __builtin_amdgcn_sched_barrier(0);
#pragma unroll
    for (int ai = 0; ai < 2; ++ai)
#pragma unroll
        for (int m = 0; m < 4; ++m) { float sq = (pre[ai][m][0] + pre[ai][m][1]) + (pre[ai][m][2] + pre[ai][m][3]); sq += __shfl_xor(sq, 16); sq += __shfl_xor(sq, 32);
            rs[ai][m] = 1.0f / sqrtf(sq * (1.0f / DM) + EPS); }
}
struct EpiScale {
    bf16_t* O; const float* SSQ; float sc;
    EPI_ZERO_INIT
    __device__ __forceinline__ void operator()(EPI_ARGS) const {
        const int lr0 = wr * 64 + fr, c0 = u.pn * 256 + wc * 32 + 8 * fq;
        float rsv[2][4]; rows_rstd8(SSQ, (size_t)u.pm * 256 + lr0, fq, rsv);
#pragma unroll
        for (int ai = 0; ai < 2; ++ai)
#pragma unroll
            for (int m = 0; m < 4; ++m) {
                const size_t grow = (size_t)u.pm * 256 + lr0 + 128 * ai + 16 * m; const float rs = rsv[ai][m] * sc;
#pragma unroll
                for (int bj = 0; bj < 2; ++bj) {
                    const f32x4 v0 = acc[ai][bj][m][0] * rs, v1 = acc[ai][bj][m][1] * rs;
                    u32x4 w; w.x = pkbf(v0[0], v0[1]); w.y = pkbf(v0[2], v0[3]); w.z = pkbf(v1[0], v1[1]); w.w = pkbf(v1[2], v1[3]);
                    *(u32x4*)(O + grow * DM + c0 + bj * 128) = w;
                }
            }
    }
};
struct EpiSwiGLU {
    bf16_t* H; const float* SSQ;
    EPI_ZERO_INIT
    __device__ __forceinline__ void operator()(EPI_ARGS) const {
        const int lr0 = wr * 64 + fr, c0 = u.pn * 128 + wc * 32 + 8 * fq;
        float rsv[2][4]; rows_rstd8(SSQ, (size_t)u.pm * 256 + lr0, fq, rsv);
#pragma unroll
        for (int ai = 0; ai < 2; ++ai)
#pragma unroll
            for (int m = 0; m < 4; ++m) {
                const size_t grow = (size_t)u.pm * 256 + lr0 + 128 * ai + 16 * m; const float rs = rsv[ai][m];
                float hv[8];
#pragma unroll
                for (int n = 0; n < 2; ++n)
#pragma unroll
                    for (int e = 0; e < 4; ++e) { const float gt = acc[ai][0][m][n][e] * rs, up = acc[ai][1][m][n][e] * rs; hv[4 * n + e] = gt * fast_rcp(1.f + fast_exp2(-gt * LOG2E)) * up; }
                u32x4 w; w.x = pkbf(hv[0], hv[1]); w.y = pkbf(hv[2], hv[3]); w.z = pkbf(hv[4], hv[5]); w.w = pkbf(hv[6], hv[7]);
                *(u32x4*)(H + grow * DFF + c0) = w;
            }
    }
};
struct EpiSoftmax {
    bf16_t* P; float* LSUM; LAS float* xch;
    EPI_ZERO_INIT
    __device__ __forceinline__ void operator()(EPI_ARGS) const {
        const int lr0 = wr * 64 + fr, c0 = u.pn * 256 + wc * 32 + 8 * fq;
#pragma unroll
        for (int ai = 0; ai < 2; ++ai)
#pragma unroll
            for (int m = 0; m < 4; ++m) {
                float v = -3.0e38f;
#pragma unroll
                for (int bj = 0; bj < 2; ++bj)
#pragma unroll
                    for (int n = 0; n < 2; ++n) { const f32x4 x = acc[ai][bj][m][n]; v = fmaxf(v, fmaxf(fmaxf(x[0], x[1]), fmaxf(x[2], x[3]))); }
                v = fmaxf(v, __shfl_xor(v, 16)); v = fmaxf(v, __shfl_xor(v, 32));
                if (fq == 0) xch[(lr0 + 128 * ai + 16 * m) * 4 + wc] = v;
            }
        asm volatile("s_waitcnt lgkmcnt(0)" ::: "memory"); __builtin_amdgcn_s_barrier(); asm volatile("" ::: "memory");
#pragma unroll
        for (int ai = 0; ai < 2; ++ai)
#pragma unroll
            for (int m = 0; m < 4; ++m) {
                const f32x4 q4 = *(const LAS f32x4*)(xch + (lr0 + 128 * ai + 16 * m) * 4); const float mx = fmaxf(fmaxf(q4[0], q4[1]), fmaxf(q4[2], q4[3]));
                const size_t grow = (size_t)u.pm * 256 + lr0 + 128 * ai + 16 * m; float ss = 0.f;
#pragma unroll
                for (int bj = 0; bj < 2; ++bj) {
                    f32x4 p0, p1;
#pragma unroll
                    for (int e = 0; e < 4; ++e) { p0[e] = fast_exp2(acc[ai][bj][m][0][e] - mx); p1[e] = fast_exp2(acc[ai][bj][m][1][e] - mx); }
                    ss += ((p0[0] + p0[1]) + (p0[2] + p0[3])) + ((p1[0] + p1[1]) + (p1[2] + p1[3]));
                    u32x4 w; w.x = pkbf(p0[0], p0[1]); w.y = pkbf(p0[2], p0[3]); w.z = pkbf(p1[0], p1[1]); w.w = pkbf(p1[2], p1[3]);
                    *(u32x4*)(P + grow * DM + c0 + bj * 128) = w;
                }
                ss += __shfl_xor(ss, 16); ss += __shfl_xor(ss, 32);
                if (fq == 0) LSUM[grow * 16 + u.pn * 4 + wc] = ss;
                asm volatile("" ::: "memory"); __builtin_amdgcn_sched_barrier(0);
            }
    }
};
struct EpiPV {
    bf16_t* O; const float* LSUM;
    EPI_ZERO_INIT
    __device__ __forceinline__ void operator()(EPI_ARGS) const {
        const int lr0 = wr * 64 + fr, c0 = u.pn * 256 + wc * 32 + 8 * fq;
        f32x4 pre[2][4];
#pragma unroll
        for (int ai = 0; ai < 2; ++ai)
#pragma unroll
            for (int m = 0; m < 4; ++m) pre[ai][m] = *(const f32x4*)(LSUM + ((size_t)u.pm * 256 + lr0 + 128 * ai + 16 * m) * 16 + u.pn * 4);
        __builtin_amdgcn_sched_barrier(0);
#pragma unroll
        for (int ai = 0; ai < 2; ++ai)
#pragma unroll
            for (int m = 0; m < 4; ++m) {
                const size_t grow = (size_t)u.pm * 256 + lr0 + 128 * ai + 16 * m;
                const f32x4 l4 = pre[ai][m]; const float rs = 1.0f / ((l4[0] + l4[1]) + (l4[2] + l4[3]));
#pragma unroll
                for (int bj = 0; bj < 2; ++bj) {
                    const f32x4 v0 = acc[ai][bj][m][0] * rs, v1 = acc[ai][bj][m][1] * rs;
                    u32x4 w; w.x = pkbf(v0[0], v0[1]); w.y = pkbf(v0[2], v0[3]); w.z = pkbf(v1[0], v1[1]); w.w = pkbf(v1[2], v1[3]);
                    *(u32x4*)(O + grow * DM + c0 + bj * 128) = w;
                }
            }
    }
};
}

#define XB_TMO      128
#define XB_XCNT(j)  (256  + 64 * (j))
#define XB_XSUB(j)  (1280 + 64 * (j))
#define XB_XGEN(j)  (2304 + 64 * (j))
#define XB_TOP      3328
#define XB_TOPGEN   3392
#define XCD_BAR_WORDS 3456
#define XB_SPIN_CAP (1u << 18)
__device__ __forceinline__ unsigned xb_ld(unsigned* p)              { return __hip_atomic_load(p, __ATOMIC_RELAXED, __HIP_MEMORY_SCOPE_AGENT); }
__device__ __forceinline__ unsigned xb_add(unsigned* p, unsigned v) { return __hip_atomic_fetch_add(p, v, __ATOMIC_RELAXED, __HIP_MEMORY_SCOPE_AGENT); }
__device__ __forceinline__ unsigned xb_xcc_id() { return (unsigned)__builtin_amdgcn_s_getreg((3 << 11) | 20) & 0xFu; }
#define XB_SPIN(cond, bar) do { unsigned _sp = 0; while (cond) { __builtin_amdgcn_s_sleep(1); \
    if ((++_sp & 255u) == 0u) { if (xb_ld(&(bar)[XB_TMO])) break; if (_sp > XB_SPIN_CAP) { atomicAdd(&(bar)[XB_TMO], 1u); break; } } } } while (0)
struct XcdBarrier { unsigned* bar; unsigned x; volatile LAS unsigned* st; };
__device__ __forceinline__ XcdBarrier xcd_barrier_post(unsigned* bar, volatile LAS unsigned* st) {
    XcdBarrier b; b.bar = bar; b.x = xb_xcc_id(); b.st = st;
    if (threadIdx.x == 0) st[3] = xb_add(&bar[XB_XCNT(b.x)], 1u);
    return b;
}
__device__ __forceinline__ void xcd_barrier_complete(unsigned* bar, unsigned x, unsigned& nloc, unsigned& nx, unsigned& xi) {
    const unsigned G = gridDim.x * gridDim.y * gridDim.z;
    unsigned sum, cnt, mine, sp = 0u;
    for (;;) {
        sum = 0u; cnt = 0u; mine = 0u; xi = 0u;
#pragma unroll
        for (unsigned j = 0; j < 16; ++j) { const unsigned c = xb_ld(&bar[XB_XCNT(j)]); sum += c; cnt += (c > 0u) ? 1u : 0u; mine = (j == x) ? c : mine; xi += (c > 0u && j < x) ? 1u : 0u; }
        if (sum == G) break;
        __builtin_amdgcn_s_sleep(1);
        if ((++sp & 255u) == 0u) { if (xb_ld(&bar[XB_TMO])) break; if (sp > XB_SPIN_CAP) { atomicAdd(&bar[XB_TMO], 1u); break; } }
    }
    nloc = mine > 0u ? mine : 1u; nx = cnt > 0u ? cnt : 1u;
}
__device__ __forceinline__ void xcd_barrier(const XcdBarrier& b) {
    asm volatile("s_waitcnt vmcnt(0)" ::: "memory");
    __syncthreads();
    if (threadIdx.x == 0) {
        unsigned* bar = b.bar;
        __builtin_amdgcn_s_waitcnt(0);
        unsigned nloc = b.st[0], nx = b.st[1];
        if (nloc == 0u) { unsigned xi; xcd_barrier_complete(bar, b.x, nloc, nx, xi); b.st[0] = nloc; b.st[1] = nx; b.st[2] = xi; }
        const unsigned old = xb_add(&bar[XB_XSUB(b.x)], 1u);
        const unsigned gen = old / nloc;
        if (old + 1u == (gen + 1u) * nloc) {
            __builtin_amdgcn_fence(__ATOMIC_RELEASE, "agent");
            asm volatile("s_waitcnt vmcnt(0)" ::: "memory");
            const unsigned og = xb_add(&bar[XB_TOP], 1u);
            const unsigned tg = og / nx;
            if (og + 1u == (tg + 1u) * nx) xb_add(&bar[XB_TOPGEN], 1u);
            else XB_SPIN(xb_ld(&bar[XB_TOPGEN]) == tg, bar);
            __builtin_amdgcn_fence(__ATOMIC_ACQUIRE, "agent");
            xb_add(&bar[XB_XGEN(b.x)], 1u);
            asm volatile("s_waitcnt vmcnt(0)" ::: "memory");
        } else {
            XB_SPIN(xb_ld(&bar[XB_XGEN(b.x)]) == gen, bar);
            __builtin_amdgcn_fence(__ATOMIC_ACQUIRE, "agent");
            asm volatile("s_waitcnt vmcnt(0)" ::: "memory");
        }
    }
    __syncthreads();
}

#define XL_SUB(j) (3584 + 64 * (j))
#define XL_GEN(j) (12416 + 64 * (j))
__device__ __forceinline__ void xl_barrier(const XcdBarrier& b) {
    asm volatile("s_waitcnt vmcnt(0)" ::: "memory");
    __syncthreads();
    if (threadIdx.x == 0) {
        unsigned* bar = b.bar; const unsigned nloc = b.st[0], xd = b.st[2] & 7u;
        const unsigned old = xb_add(&bar[XL_SUB(xd)], 1u), gen = old / nloc;
        if (old + 1u == (gen + 1u) * nloc) xb_add(&bar[XL_GEN(xd)], 1u);
        else XB_SPIN(xb_ld(&bar[XL_GEN(xd)]) == gen, bar);
        __builtin_amdgcn_fence(__ATOMIC_ACQUIRE, "agent");
        asm volatile("s_waitcnt vmcnt(0)" ::: "memory");
    }
    __syncthreads();
}

constexpr int RING_BYTES = 131072;
constexpr int XCH_OFF = RING_BYTES;
constexpr int MISC_OFF = RING_BYTES + 6144;
constexpr int LDS_BYTES = RING_BYTES + 8192;
constexpr int ATT_V_OFF = 0, ATT_WBUF = 12800, ATT_TAB_OFF = 8 * ATT_WBUF, ATT_CW_OFF = 65536;

struct Params {
    const float* in[27]; float* out; unsigned char* ws; int ph_lo, ph_hi, coop, pad;
};

__device__ __forceinline__ float wave_sum(float v) {
#pragma unroll
    for (int o = 1; o < 64; o <<= 1) v += __shfl_xor(v, o);
    return v;
}
__device__ __forceinline__ void transpose_item(const float* W, int K, int N, bf16_t* WT, int item, int mode, LAS float* scr, int lane) {
    const int nblk = N / 32, kb = item / nblk, nb = item % nblk, k0 = 64 * kb, n0 = 32 * nb;
    int r0 = n0;
    if (mode == 1) { if (n0 >= 2304) { const int isg = n0 >= 2560, cch = n0 - (isg ? 2560 : 2304); r0 = 2304 + (cch >> 7) * 256 + isg * 128 + (cch & 127); } }
    else if (mode == 2) r0 = (n0 >> 7) * 256 + (n0 & 127);
    else if (mode == 3) r0 = (n0 >> 7) * 256 + 128 + (n0 & 127);
    float wv[32];
#pragma unroll
    for (int i = 0; i < 32; ++i) wv[i] = W[(size_t)(k0 + 2 * i + (lane >> 5)) * N + n0 + (lane & 31)];
#pragma unroll
    for (int i = 0; i < 32; ++i) scr[(2 * i + (lane >> 5)) * 33 + (lane & 31)] = wv[i];
    asm volatile("s_waitcnt lgkmcnt(0)" ::: "memory");
    const int c = lane & 7;
#pragma unroll
    for (int j = 0; j < 4; ++j) { const int n = (lane >> 3) + 8 * j; const LAS float* s = scr + (8 * c) * 33 + n;
        u32x4 o; o.x = pkbf(s[0 * 33], s[1 * 33]); o.y = pkbf(s[2 * 33], s[3 * 33]); o.z = pkbf(s[4 * 33], s[5 * 33]); o.w = pkbf(s[6 * 33], s[7 * 33]);
        *(u32x4*)(WT + (size_t)(r0 + n) * K + k0 + 8 * c) = o; }
    asm volatile("s_waitcnt lgkmcnt(0)" ::: "memory");
}
template <int NR> __device__ __forceinline__ void rms_rows_bf16(const float* const (&xrow)[NR], const float* g, bf16_t* const (&orow)[NR], int lane) {
    f32x4 v[NR][4];
#pragma unroll
    for (int r = 0; r < NR; ++r)
#pragma unroll
        for (int j = 0; j < 4; ++j) v[r][j] = ((const f32x4*)xrow[r] + lane)[64 * j];
    const f32x4* gr = (const f32x4*)g + lane;
    f32x4 gg[4];
#pragma unroll
    for (int j = 0; j < 4; ++j) gg[j] = gr[64 * j];
#pragma unroll
    for (int r = 0; r < NR; ++r) {
        float s = 0.f;
#pragma unroll
        for (int j = 0; j < 4; ++j) s += (v[r][j][0] * v[r][j][0] + v[r][j][1] * v[r][j][1]) + (v[r][j][2] * v[r][j][2] + v[r][j][3] * v[r][j][3]);
        const float rstd = 1.0f / sqrtf(wave_sum(s) * (1.0f / DM) + EPS);
        u32x2* o8 = (u32x2*)orow[r] + lane;
#pragma unroll
        for (int j = 0; j < 4; ++j) { u32x2 w; w.x = pkbf(v[r][j][0] * rstd * gg[j][0], v[r][j][1] * rstd * gg[j][1]); w.y = pkbf(v[r][j][2] * rstd * gg[j][2], v[r][j][3] * rstd * gg[j][3]); o8[64 * j] = w; }
    }
}

namespace att {
__device__ __forceinline__ int crow(int r, int hi) { return (r & 3) + 8 * (r >> 2) + 4 * hi; }
struct Ctx {
    const bf16_t *QB, *KB, *VB; const float *CK, *CV;
    bf16_t* OP; float* LSE; bf16_t* ATT;
};
__device__ __forceinline__ bf16x8 ld8_bf16(const bf16_t* p) { return *(const bf16x8*)p; }
__device__ __forceinline__ bf16x8 ld8_f32(const float* p) {
    const f32x4 a = *(const f32x4*)p, b = *(const f32x4*)(p + 4); u32x4 w; w.x = pkbf(a[0], a[1]); w.y = pkbf(a[2], a[3]); w.z = pkbf(b[0], b[1]); w.w = pkbf(b[2], b[3]);
    return __builtin_bit_cast(bf16x8, w);
}
template <int MODE> __device__ __forceinline__ bf16x8 ld_kv(const bf16_t* B16, const float* C32, int bq, int h, int dil, int r, int idx, int doff, bool newrows) {
    if (MODE == 0) { const int ii = idx < 0 ? 0 : idx; return ld8_bf16(B16 + ((size_t)bq * SEQ + r + (size_t)dil * ii) * AW + h * HD + doff); }
    int p = r + dil * idx;
    if (!newrows) return ld8_f32(C32 + (((size_t)bq * WBUF + p) * NH + h) * HD + doff);
    p = p > (WBUF + TS - 1) ? (WBUF + TS - 1) : p;
    return ld8_bf16(B16 + ((size_t)MP + bq * TS + (p - WBUF)) * AW + h * HD + doff);
}
template <int MODE> __device__ __forceinline__ void ld_kv4(bf16x8 (&dst)[4], const bf16_t* B16, const float* C32, int bq, int h, int dil, int r, int idx0, int doff, bool newrows) {
    if (MODE == 1 && !newrows) {
        f32x4 raw[4][2];
#pragma unroll
        for (int i = 0; i < 4; ++i) { const float* p = C32 + (((size_t)bq * WBUF + (r + dil * (idx0 + 8 * i))) * NH + h) * HD + doff; raw[i][0] = *(const f32x4*)p; raw[i][1] = *(const f32x4*)(p + 4); }
        __builtin_amdgcn_sched_barrier(0);
#pragma unroll
        for (int i = 0; i < 4; ++i) { u32x4 w; w.x = pkbf(raw[i][0][0], raw[i][0][1]); w.y = pkbf(raw[i][0][2], raw[i][0][3]); w.z = pkbf(raw[i][1][0], raw[i][1][1]); w.w = pkbf(raw[i][1][2], raw[i][1][3]);
            dst[i] = __builtin_bit_cast(bf16x8, w); }
    } else {
#pragma unroll
        for (int i = 0; i < 4; ++i) dst[i] = ld_kv<MODE>(B16, C32, bq, h, dil, r, idx0 + 8 * i, doff, newrows);
    }
}
template <int MODE> __device__ __forceinline__ void wave_block(const Ctx& c, int bq, int h, int g, int dil, int r, int i0, int nq, const LAS float* tab, LAS unsigned char* wbuf) {
    const int lane = fresh_lane(), r32 = lane & 31, hi = lane >> 5;
    const int vkey = lane >> 3, vch = lane & 7;
    const bool qvalid = r32 < nq; const int qq = qvalid ? r32 : 0;
    size_t qtok;
    if (MODE == 0) qtok = (size_t)bq * SEQ + r + (size_t)dil * (i0 + qq);
    else qtok = (size_t)MP + bq * TS + (r + dil * (i0 + qq) - WBUF);
    LAS unsigned char* kb = wbuf; LAS unsigned char* vbuf = wbuf + 4608;
    bf16x8 qv[4];
#pragma unroll
    for (int i = 0; i < 4; ++i) { int qi = 8 * i + vkey; qi = qi < nq ? qi : 0;
        const size_t tk = (MODE == 0) ? (size_t)bq * SEQ + r + (size_t)dil * (i0 + qi) : (size_t)MP + bq * TS + (r + dil * (i0 + qi) - WBUF);
        qv[i] = ld8_bf16(c.QB + tk * AW + h * HD + vch * 8); }
    bf16x8 kr[5][4];
    constexpr int KA = (MODE == 0) ? 5 : 2;
#pragma unroll
    for (int s = 0; s < KA; ++s)
        ld_kv4<MODE>(kr[s], c.KB, c.CK, bq, h, dil, r, i0 - 128 + 32 * s + vkey, vch * 8, s == 4);
#pragma unroll
    for (int i = 0; i < 4; ++i) *(LAS bf16x8*)(kb + (8 * i + vkey) * 144 + vch * 16) = qv[i];
    bf16x8 qr[4];
#pragma unroll
    for (int d0 = 0; d0 < 4; ++d0) qr[d0] = *(const LAS bf16x8*)(kb + r32 * 144 + d0 * 32 + hi * 16);
    f32x16 S[5];
#pragma unroll
    for (int s = 0; s < 5; ++s) {
        if (MODE != 0 && s + KA < 5) {
            ld_kv4<MODE>(kr[s + KA], c.KB, c.CK, bq, h, dil, r, i0 - 128 + 32 * (s + KA) + vkey, vch * 8, s + KA == 4);
        }
#pragma unroll
        for (int i = 0; i < 4; ++i) *(LAS bf16x8*)(kb + (8 * i + vkey) * 144 + vch * 16) = kr[s][i];
        bf16x8 kf[4];
#pragma unroll
        for (int d0 = 0; d0 < 4; ++d0) kf[d0] = *(const LAS bf16x8*)(kb + r32 * 144 + d0 * 32 + hi * 16);
        f32x16 a = {};
#pragma unroll
        for (int d0 = 0; d0 < 4; ++d0) a = __builtin_amdgcn_mfma_f32_32x32x16_bf16(kf[d0], qr[d0], a, 0, 0, 0);
        S[s] = a;
        __builtin_amdgcn_sched_barrier(0);
    }
    bf16x8 vr[5][4];
#pragma unroll
    for (int s = 0; s < KA; ++s)
        ld_kv4<MODE>(vr[s], c.VB, c.CV, bq, h, dil, r, i0 - 128 + 32 * s + vkey, vch * 8, s == 4);
    __builtin_amdgcn_sched_barrier(0);
    const LAS float* tb = tab + 159 + r32 - 4 * hi;
#pragma unroll
    for (int s = 0; s < 5; ++s)
#pragma unroll
        for (int rr = 0; rr < 16; ++rr) S[s][rr] += tb[-(32 * s + (rr & 3) + 8 * (rr >> 2))];
    if (MODE == 0 && i0 < 128) {
#pragma unroll
        for (int s = 0; s < 5; ++s)
#pragma unroll
            for (int rr = 0; rr < 16; ++rr) if (i0 - 128 + 32 * s + crow(rr, hi) < 0) S[s][rr] = -1e30f;
    }
    float mx = -3.0e38f;
#pragma unroll
    for (int s = 0; s < 5; ++s)
#pragma unroll
        for (int rr = 0; rr < 16; ++rr) mx = fmaxf(mx, S[s][rr]);
    mx = fmaxf(mx, __shfl_xor(mx, 32));
    float l = 0.f;
#pragma unroll
    for (int s = 0; s < 5; ++s)
#pragma unroll
        for (int rr = 0; rr < 16; ++rr) { const float p = fast_exp2(S[s][rr] - mx); S[s][rr] = p; l += p; }
    l += __shfl_xor(l, 32);
    f32x16 o[2]; o[0] = (f32x16){}; o[1] = (f32x16){};
    const int vrd = (4 * hi + ((lane & 15) >> 2)) * 64 + ((lane >> 4) & 1) * 32 + (lane & 3) * 8;
    __builtin_amdgcn_sched_barrier(0);
#pragma unroll
    for (int s = 0; s < 5; ++s) {
        LAS unsigned char* vb = vbuf + (s & 1) * 4096;
#pragma unroll
        for (int i = 0; i < 4; ++i) *(LAS bf16x8*)(vb + (vch >> 2) * 2048 + (8 * i + vkey) * 64 + (vch & 3) * 16) = vr[s][i];
        if (MODE != 0 && s + KA < 5) {
            ld_kv4<MODE>(vr[s + KA], c.VB, c.CV, bq, h, dil, r, i0 - 128 + 32 * (s + KA) + vkey, vch * 8, s + KA == 4);
        }
#pragma unroll
        for (int sp = 0; sp < 2; ++sp) {
            u32x4 pw; pw.x = pkbf(S[s][8 * sp + 0], S[s][8 * sp + 1]); pw.y = pkbf(S[s][8 * sp + 2], S[s][8 * sp + 3]); pw.z = pkbf(S[s][8 * sp + 4], S[s][8 * sp + 5]); pw.w = pkbf(S[s][8 * sp + 6], S[s][8 * sp + 7]);
            const bf16x8 pf = __builtin_bit_cast(bf16x8, pw);
#pragma unroll
            for (int dt = 0; dt < 2; ++dt) {
                const s16x4 lo = __builtin_bit_cast(s16x4, __builtin_amdgcn_ds_read_tr16_b64_v4i16((LAS s16x4*)(vb + vrd + dt * 2048 + sp * 1024)));
                const s16x4 hh = __builtin_bit_cast(s16x4, __builtin_amdgcn_ds_read_tr16_b64_v4i16((LAS s16x4*)(vb + vrd + dt * 2048 + sp * 1024 + 512)));
                const bf16x8 vf = (bf16x8){lo[0], lo[1], lo[2], lo[3], hh[0], hh[1], hh[2], hh[3]};
                o[dt] = __builtin_amdgcn_mfma_f32_32x32x16_bf16(vf, pf, o[dt], 0, 0, 0);
            }
        }
        __builtin_amdgcn_sched_barrier(0);
    }
    {
        const float inv = 1.0f / l;
#pragma unroll
        for (int dt = 0; dt < 2; ++dt)
#pragma unroll
            for (int rg = 0; rg < 4; ++rg) { u32x2 w; w.x = pkbf(o[dt][4 * rg] * inv, o[dt][4 * rg + 1] * inv); w.y = pkbf(o[dt][4 * rg + 2] * inv, o[dt][4 * rg + 3] * inv);
                *(LAS u32x2*)(kb + r32 * 144 + (32 * dt + 8 * rg + 4 * hi) * 2) = w; }
        if (qvalid && hi == 0) c.LSE[(size_t)g * LSE_STRIDE + qtok * NH + h] = mx + __log2f(l);
#pragma unroll
        for (int i = 0; i < 4; ++i) { const int qi = 8 * i + vkey;
            if (qi < nq) {
                const size_t tk = (MODE == 0) ? (size_t)bq * SEQ + r + (size_t)dil * (i0 + qi) : (size_t)MP + bq * TS + (r + dil * (i0 + qi) - WBUF);
                *(u32x4*)(c.OP + (size_t)g * OP_STRIDE + tk * AW + h * HD + vch * 8) = *(const LAS u32x4*)(kb + qi * 144 + vch * 16);
            } }
    }
}
struct PDesc { int b, h, g, dil, r, i0; };
__device__ __forceinline__ unsigned ptok(const PDesc& d, int idx) { return (unsigned)(d.b * SEQ + d.r + d.dil * idx); }
__device__ __forceinline__ bf16x8 ld8_off(const bf16_t* base, unsigned byte_off) { return *(const bf16x8*)((const char*)base + byte_off); }
__device__ __forceinline__ void p_load_q(const Ctx& c, const PDesc& d, bf16x8 (&qv)[4], int vkey, int vch) {
    const unsigned o0 = (ptok(d, d.i0 + vkey) * AW + d.h * HD + vch * 8) * 2u, st = (unsigned)(8 * d.dil * AW * 2);
#pragma unroll
    for (int i = 0; i < 4; ++i) qv[i] = ld8_off(c.QB, o0 + i * st);
}
__device__ __forceinline__ void p_load_kv(const bf16_t* B, const PDesc& d, int s, bf16x8 (&x)[4], int vkey, int vch) {
    const unsigned cb = (unsigned)((d.b * SEQ + d.r) * AW + d.h * HD + vch * 8) * 2u, st = (unsigned)(d.dil * AW * 2);
#pragma unroll
    for (int i = 0; i < 4; ++i) { int idx = d.i0 - 128 + 32 * s + 8 * i + vkey; idx = idx < 0 ? 0 : idx; x[i] = ld8_off(B, cb + (unsigned)idx * st); }
}
__device__ __forceinline__ void pblock(const Ctx& c, const PDesc& cur, const PDesc& nxt, bool has_next, bf16x8 (&qv)[4], bf16x8 (&kr)[5][4], const LAS float* tabs, LAS unsigned char* wbuf) {
    const int lane = fresh_lane(), r32 = lane & 31, hi = lane >> 5, vkey = lane >> 3, vch = lane & 7;
    LAS unsigned char* vbuf = wbuf;
    LAS unsigned char* kb = wbuf + 8192;
    const int kwr = vkey * 128 + ((vch ^ (vkey & 7)) << 4);
    const int krd0 = r32 * 128, kx = r32 & 7;
    const int i0 = cur.i0;
#pragma unroll
    for (int i = 0; i < 4; ++i) *(LAS bf16x8*)(kb + (8 * i + vkey) * 144 + vch * 16) = qv[i];
    bf16x8 qr[4];
#pragma unroll
    for (int d0 = 0; d0 < 4; ++d0) qr[d0] = *(const LAS bf16x8*)(kb + r32 * 144 + d0 * 32 + hi * 16);
    f32x16 S[5];
    bf16x8 vr[5][4];
    p_load_kv(c.KB, cur, 2, kr[2], vkey, vch); p_load_kv(c.KB, cur, 3, kr[3], vkey, vch); p_load_kv(c.KB, cur, 4, kr[4], vkey, vch);
#pragma unroll
    for (int s = 0; s < 5; ++s) {
        LAS unsigned char* kp = vbuf + (s & 1) * 4096;
#pragma unroll
        for (int i = 0; i < 4; ++i) *(LAS bf16x8*)(kp + i * 1024 + kwr) = kr[s][i];
        if (s < 3) p_load_kv(c.VB, cur, s, vr[s], vkey, vch);
        bf16x8 kf[4];
#pragma unroll
        for (int d0 = 0; d0 < 4; ++d0) kf[d0] = *(const LAS bf16x8*)(kp + krd0 + (((2 * d0 + hi) ^ kx) << 4));
        f32x16 a = {};
#pragma unroll
        for (int d0 = 0; d0 < 4; ++d0) a = __builtin_amdgcn_mfma_f32_32x32x16_bf16(kf[d0], qr[d0], a, 0, 0, 0);
        S[s] = a;
    }
    __builtin_amdgcn_sched_barrier(0);
    const LAS float* tb = tabs + (cur.g * 12 + cur.h) * 192 + 159 + r32 - 4 * hi;
#pragma unroll
    for (int s = 0; s < 5; ++s)
#pragma unroll
        for (int rr = 0; rr < 16; ++rr) S[s][rr] += tb[-(32 * s + (rr & 3) + 8 * (rr >> 2))];
    if (i0 < 128) {
#pragma unroll
        for (int s = 0; s < 5; ++s)
#pragma unroll
            for (int rr = 0; rr < 16; ++rr) if (i0 - 128 + 32 * s + crow(rr, hi) < 0) S[s][rr] = -1e30f;
    }
    float mx = -3.0e38f;
#pragma unroll
    for (int s = 0; s < 5; ++s)
#pragma unroll
        for (int rr = 0; rr < 16; ++rr) mx = fmaxf(mx, S[s][rr]);
    mx = fmaxf(mx, __shfl_xor(mx, 32));
    float l = 0.f;
    bf16x8 pf[5][2];
#pragma unroll
    for (int s = 0; s < 5; ++s) {
#pragma unroll
        for (int rr = 0; rr < 16; ++rr) { const float p = fast_exp2(S[s][rr] - mx); S[s][rr] = p; l += p; }
#pragma unroll
        for (int sp = 0; sp < 2; ++sp) { u32x4 pw; pw.x = pkbf(S[s][8 * sp + 0], S[s][8 * sp + 1]); pw.y = pkbf(S[s][8 * sp + 2], S[s][8 * sp + 3]); pw.z = pkbf(S[s][8 * sp + 4], S[s][8 * sp + 5]); pw.w = pkbf(S[s][8 * sp + 6], S[s][8 * sp + 7]);
            pf[s][sp] = __builtin_bit_cast(bf16x8, pw); asm volatile("" : "+v"(pf[s][sp])); }
    }
    l += __shfl_xor(l, 32);
    __builtin_amdgcn_sched_barrier(0);
    p_load_kv(c.VB, cur, 3, vr[3], vkey, vch); p_load_kv(c.VB, cur, 4, vr[4], vkey, vch);
    f32x16 o[2]; o[0] = (f32x16){}; o[1] = (f32x16){};
    const int vrd = (4 * hi + ((lane & 15) >> 2)) * 64 + ((lane >> 4) & 1) * 32 + (lane & 3) * 8;
    __builtin_amdgcn_sched_barrier(0);
#pragma unroll
    for (int s = 0; s < 5; ++s) {
        LAS unsigned char* vb = vbuf + (s & 1) * 4096;
#pragma unroll
        for (int i = 0; i < 4; ++i) *(LAS bf16x8*)(vb + (vch >> 2) * 2048 + (8 * i + vkey) * 64 + (vch & 3) * 16) = vr[s][i];
        if (has_next && s < 2) p_load_kv(c.KB, nxt, s, kr[s], vkey, vch);
        if (has_next && s == 2) p_load_q(c, nxt, qv, vkey, vch);
#pragma unroll
        for (int sp = 0; sp < 2; ++sp)
#pragma unroll
            for (int dt = 0; dt < 2; ++dt) {
                const s16x4 lo = __builtin_bit_cast(s16x4, __builtin_amdgcn_ds_read_tr16_b64_v4i16((LAS s16x4*)(vb + vrd + dt * 2048 + sp * 1024)));
                const s16x4 hh = __builtin_bit_cast(s16x4, __builtin_amdgcn_ds_read_tr16_b64_v4i16((LAS s16x4*)(vb + vrd + dt * 2048 + sp * 1024 + 512)));
                const bf16x8 vf = (bf16x8){lo[0], lo[1], lo[2], lo[3], hh[0], hh[1], hh[2], hh[3]};
                o[dt] = __builtin_amdgcn_mfma_f32_32x32x16_bf16(vf, pf[s][sp], o[dt], 0, 0, 0);
            }
    }
    __builtin_amdgcn_sched_barrier(0);
    {
        const float inv = 1.0f / l;
#pragma unroll
        for (int dt = 0; dt < 2; ++dt)
#pragma unroll
            for (int rg = 0; rg < 4; ++rg) { u32x2 w; w.x = pkbf(o[dt][4 * rg] * inv, o[dt][4 * rg + 1] * inv); w.y = pkbf(o[dt][4 * rg + 2] * inv, o[dt][4 * rg + 3] * inv);
                *(LAS u32x2*)(kb + r32 * 144 + (32 * dt + 8 * rg + 4 * hi) * 2) = w; }
        if (hi == 0) c.LSE[(size_t)cur.g * LSE_STRIDE + (size_t)ptok(cur, i0 + r32) * NH + cur.h] = mx + __log2f(l);
#pragma unroll
        for (int i = 0; i < 4; ++i) { const int qi = 8 * i + vkey;
            *(u32x4*)(c.OP + (size_t)cur.g * OP_STRIDE + (size_t)ptok(cur, i0 + qi) * AW + cur.h * HD + vch * 8) = *(const LAS u32x4*)(kb + qi * 144 + vch * 16); }
    }
}
struct TDesc { int b, h, g, dil, r, j0; };
constexpr int TK_OFF = 0, TV_OFF = 49152, TB_OFF = 98304, TT_OFF = TB_OFF + 8 * 4608;
__device__ __forceinline__ void glds16(const void* sbase, unsigned voff, unsigned lds_dst) { unsigned keep;
    asm volatile("s_mov_b32 %0, m0\n\ts_mov_b32 m0, %3\n\ts_nop 4\n\tglobal_load_lds_dwordx4 %1, %2\n\ts_mov_b32 m0, %0" : "=&s"(keep) : "v"(voff), "s"(sbase), "s"(lds_dst) : "memory"); }
__device__ __forceinline__ void glds4(const void* sbase, unsigned voff, unsigned lds_dst) { unsigned keep;
    asm volatile("s_mov_b32 %0, m0\n\ts_mov_b32 m0, %3\n\ts_nop 4\n\tglobal_load_lds_dword %1, %2\n\ts_mov_b32 m0, %0" : "=&s"(keep) : "v"(voff), "s"(sbase), "s"(lds_dst) : "memory"); }
__device__ __forceinline__ void t_issue_tab(const float* tabg, const TDesc& d, LAS unsigned char* lds, int wave, int lane) {
    if (wave < 3) glds4(tabg, (unsigned)(((d.g * 12 + d.h) * 192 + wave * 64 + lane) * 4), (unsigned)__builtin_amdgcn_readfirstlane((int)((unsigned)(uintptr_t)lds + TT_OFF + wave * 256)));
}
__device__ __forceinline__ void t_issue_k(const Ctx& c, const TDesc& d, LAS unsigned char* lds, int wave, int lane) {
    const int rr = lane >> 3, ch = (lane & 7) ^ ((4 * (wave & 1) + (rr >> 1)) & 7);
    const unsigned cb = (unsigned)((d.b * SEQ + d.r) * AW + d.h * HD + ch * 8) * 2u, st = (unsigned)(d.dil * AW * 2);
    const unsigned l0 = (unsigned)(uintptr_t)lds + TK_OFF;
#pragma unroll
    for (int i = 0; i < 6; ++i) { const int e = wave + 8 * i; int idx = d.j0 - 128 + 8 * e + rr; idx = idx < 0 ? 0 : idx;
        glds16(c.KB, cb + (unsigned)idx * st, (unsigned)__builtin_amdgcn_readfirstlane((int)(l0 + e * 1024))); }
}
__device__ __forceinline__ void t_issue_v(const Ctx& c, const TDesc& d, LAS unsigned char* lds, int wave, int lane) {
    const int kq = lane >> 2, q4 = lane & 3;
    const unsigned cb = (unsigned)((d.b * SEQ + d.r) * AW + d.h * HD + q4 * 8) * 2u, st = (unsigned)(d.dil * AW * 2);
    const unsigned l0 = (unsigned)(uintptr_t)lds + TV_OFF;
#pragma unroll
    for (int i = 0; i < 6; ++i) { const int e = 6 * wave + i, hf = e / 24, e24 = e - hf * 24; int idx = d.j0 - 128 + 16 * e24 + kq; idx = idx < 0 ? 0 : idx;
        glds16(c.VB, cb + (unsigned)idx * st + (unsigned)hf * 64u, (unsigned)__builtin_amdgcn_readfirstlane((int)(l0 + e * 1024))); }
}
__device__ __forceinline__ void t_issue_q(const Ctx& c, const TDesc& d, LAS unsigned char* lds, int wave, int lane) {
    const int rr = lane >> 3, i0 = d.j0 + 32 * wave;
    const unsigned qo0 = ((unsigned)(d.b * SEQ + d.r + d.dil * (i0 + rr)) * AW + d.h * HD) * 2u, qst = (unsigned)(8 * d.dil * AW * 2);
    const unsigned l0 = (unsigned)(uintptr_t)lds + TB_OFF + wave * 4608;
#pragma unroll
    for (int i = 0; i < 4; ++i) { const int ch = (lane & 7) ^ ((4 * (i & 1) + (rr >> 1)) & 7);
        glds16(c.QB, qo0 + i * qst + ch * 16, (unsigned)__builtin_amdgcn_readfirstlane((int)(l0 + i * 1024))); }
}
struct TOut { f32x16 o[2]; float l, mx; };
__device__ __forceinline__ void* sgpr_ptr(const void* p) { const unsigned long long u = (unsigned long long)(uintptr_t)p;
    const unsigned lo = (unsigned)__builtin_amdgcn_readfirstlane((int)(unsigned)u), hi = (unsigned)__builtin_amdgcn_readfirstlane((int)(unsigned)(u >> 32));
    return (void*)(uintptr_t)(((unsigned long long)hi << 32) | lo); }
__device__ __forceinline__ void gst16(void* sbase, unsigned voff, u32x4 v) { asm volatile("s_nop 4\n\tglobal_store_dwordx4 %0, %1, %2\n\ts_nop 1" :: "v"(voff), "v"(v), "s"(sbase) : "memory"); }
__device__ __forceinline__ void gst4(void* sbase, unsigned voff, float v) { asm volatile("s_nop 4\n\tglobal_store_dword %0, %1, %2\n\ts_nop 1" :: "v"(voff), "v"(v), "s"(sbase) : "memory"); }
__device__ __forceinline__ void t_out1(const TOut& po, LAS unsigned char* kb, int r32, int hi) {
    const float inv = 1.0f / po.l;
#pragma unroll
    for (int dt = 0; dt < 2; ++dt)
#pragma unroll
        for (int rg = 0; rg < 4; ++rg) { u32x2 w; w.x = pkbf(po.o[dt][4 * rg] * inv, po.o[dt][4 * rg + 1] * inv); w.y = pkbf(po.o[dt][4 * rg + 2] * inv, po.o[dt][4 * rg + 3] * inv);
            *(LAS u32x2*)(kb + r32 * 144 + (32 * dt + 8 * rg + 4 * hi) * 2) = w; }
}
__device__ __forceinline__ void t_out2(const Ctx& c, const TDesc& d, const TOut& po, const LAS unsigned char* kb, int wave, int r32, int hi, int vkey, int vch, u32x4 (&ow)[4]) {
    const int i0 = d.j0 + 32 * wave;
#pragma unroll
    for (int i = 0; i < 4; ++i) ow[i] = *(const LAS u32x4*)(kb + (8 * i + vkey) * 144 + vch * 16);
    const unsigned tq = (unsigned)(d.b * SEQ + d.r + d.dil * (i0 + r32));
    if (hi == 0) gst4(sgpr_ptr(c.LSE + (size_t)d.g * LSE_STRIDE + d.h), tq * (unsigned)(NH * 4), po.mx + __log2f(po.l));
}
__device__ __forceinline__ void t_out3(const Ctx& c, const TDesc& d, int wave, int vkey, int vch, const u32x4 (&ow)[4]) {
    const int i0 = d.j0 + 32 * wave; void* ob = sgpr_ptr(c.OP + (size_t)d.g * OP_STRIDE + d.h * HD);
#pragma unroll
    for (int i = 0; i < 4; ++i) { const int qi = 8 * i + vkey; const unsigned tk = (unsigned)(d.b * SEQ + d.r + d.dil * (i0 + qi));
        gst16(ob, tk * (unsigned)(AW * 2) + (unsigned)(vch * 16), ow[i]); }
}
__device__ __forceinline__ void t_unit(const Ctx& c, const TDesc& prv, const TDesc& cur, const TDesc& nxt, bool has_next, const float* tabg, LAS unsigned char* lds, int wave, TOut& po) {
    const int lane = fresh_lane(), r32 = lane & 31, hi = lane >> 5, vkey = lane >> 3, vch = lane & 7;
    LAS unsigned char* qb = lds + TB_OFF + wave * 4608;
    const LAS float* tt = (const LAS float*)(lds + TT_OFF);
    const int i0 = cur.j0 + 32 * wave;
    asm volatile("s_waitcnt vmcnt(6) lgkmcnt(0)\n\ts_barrier" ::: "memory");
    const int kx = (r32 >> 1) & 7;
    bf16x8 qr[4];
#pragma unroll
    for (int d0 = 0; d0 < 4; ++d0) qr[d0] = *(const LAS bf16x8*)(qb + r32 * 128 + (((2 * d0 + hi) ^ kx) << 4));
    asm volatile("" ::: "memory");
    t_out1(po, qb, r32, hi);
    f32x16 S[5];
    const LAS float* tb = tt + 159 + r32 - 4 * hi;
    const LAS unsigned char* kt = lds + TK_OFF + (32 * wave + r32) * 128;
    float mx;
    {   bf16x8 kf[4];
#pragma unroll
        for (int d0 = 0; d0 < 4; ++d0) kf[d0] = *(const LAS bf16x8*)(kt + 4 * 4096 + (((2 * d0 + hi) ^ kx) << 4));
        f32x16 a = {};
#pragma unroll
        for (int d0 = 0; d0 < 4; ++d0) a = __builtin_amdgcn_mfma_f32_32x32x16_bf16(kf[d0], qr[d0], a, 0, 0, 0);
#pragma unroll
        for (int rr = 0; rr < 16; ++rr) a[rr] += tb[-(128 + (rr & 3) + 8 * (rr >> 2))];
        float m1 = fmaxf(fmaxf(a[0], a[1]), a[2]);
#pragma unroll
        for (int rr = 3; rr < 15; rr += 2) m1 = fmaxf(fmaxf(m1, a[rr]), a[rr + 1]);
        m1 = fmaxf(m1, a[15]);
        mx = fmaxf(m1, __shfl_xor(m1, 32));
        S[4] = a; }
    u32x4 ow[4];
    asm volatile("" ::: "memory");
    t_out2(c, prv, po, qb, wave, r32, hi, vkey, vch, ow);
#pragma unroll
    for (int s = 0; s < 4; s += 2) {
        bf16x8 kfa[4], kfb[4];
#pragma unroll
        for (int d0 = 0; d0 < 4; ++d0) { kfa[d0] = *(const LAS bf16x8*)(kt + s * 4096 + (((2 * d0 + hi) ^ kx) << 4)); kfb[d0] = *(const LAS bf16x8*)(kt + (s + 1) * 4096 + (((2 * d0 + hi) ^ kx) << 4)); }
        f32x16 a, b;
#pragma unroll
        for (int rr = 0; rr < 16; ++rr) { a[rr] = tb[-(32 * s + (rr & 3) + 8 * (rr >> 2))] - mx; b[rr] = tb[-(32 * (s + 1) + (rr & 3) + 8 * (rr >> 2))] - mx; }
#pragma unroll
        for (int d0 = 0; d0 < 4; ++d0) { a = __builtin_amdgcn_mfma_f32_32x32x16_bf16(kfa[d0], qr[d0], a, 0, 0, 0); b = __builtin_amdgcn_mfma_f32_32x32x16_bf16(kfb[d0], qr[d0], b, 0, 0, 0); }
        S[s] = a; S[s + 1] = b;
        if (s == 0) { asm volatile("" ::: "memory"); t_out3(c, prv, wave, vkey, vch, ow); }
    }
    asm volatile("s_waitcnt vmcnt(5) lgkmcnt(0)\n\ts_barrier" ::: "memory");
    if (has_next) { t_issue_tab(tabg, nxt, lds, wave, lane); t_issue_k(c, nxt, lds, wave, lane); t_issue_q(c, nxt, lds, wave, lane); }
    if (i0 < 128) {
#pragma unroll
        for (int s = 0; s < 5; ++s)
#pragma unroll
            for (int rr = 0; rr < 16; ++rr) if (i0 - 128 + 32 * s + crow(rr, hi) < 0) S[s][rr] = -1e30f;
    }
    bf16x8 pf[5][2];
#pragma unroll
    for (int s = 0; s < 5; ++s) {
#pragma unroll
        for (int rr = 0; rr < 16; ++rr) S[s][rr] = fast_exp2(s == 4 ? S[s][rr] - mx : S[s][rr]);
#pragma unroll
        for (int sp = 0; sp < 2; ++sp) { u32x4 pw; pw.x = pkbf(S[s][8 * sp + 0], S[s][8 * sp + 1]); pw.y = pkbf(S[s][8 * sp + 2], S[s][8 * sp + 3]); pw.z = pkbf(S[s][8 * sp + 4], S[s][8 * sp + 5]); pw.w = pkbf(S[s][8 * sp + 6], S[s][8 * sp + 7]);
            pf[s][sp] = __builtin_bit_cast(bf16x8, pw); asm volatile("" : "+v"(pf[s][sp])); }
    }
    f32x16 o[2]; o[0] = (f32x16){}; o[1] = (f32x16){};
    f32x16 ol = {};
    const bf16x8 ones = __builtin_bit_cast(bf16x8, (u32x4){0x3F803F80u, 0x3F803F80u, 0x3F803F80u, 0x3F803F80u});
    const LAS unsigned char* vt = lds + TV_OFF + (32 * wave + 4 * hi + ((lane & 15) >> 2)) * 64 + ((lane >> 4) & 1) * 32 + (lane & 3) * 8;
#pragma unroll
    for (int s = 0; s < 5; ++s)
#pragma unroll
        for (int sp = 0; sp < 2; ++sp)
#pragma unroll
            for (int dt = 0; dt < 2; ++dt) {
                const s16x4 lo = __builtin_bit_cast(s16x4, __builtin_amdgcn_ds_read_tr16_b64_v4i16((LAS s16x4*)(vt + dt * 24576 + s * 2048 + sp * 1024)));
                const s16x4 hh = __builtin_bit_cast(s16x4, __builtin_amdgcn_ds_read_tr16_b64_v4i16((LAS s16x4*)(vt + dt * 24576 + s * 2048 + sp * 1024 + 512)));
                const bf16x8 vf = (bf16x8){lo[0], lo[1], lo[2], lo[3], hh[0], hh[1], hh[2], hh[3]};
                o[dt] = __builtin_amdgcn_mfma_f32_32x32x16_bf16(vf, pf[s][sp], o[dt], 0, 0, 0);
                if (dt == 1) ol = __builtin_amdgcn_mfma_f32_32x32x16_bf16(ones, pf[s][sp], ol, 0, 0, 0);
            }
    const float l = ol[0];
    asm volatile("s_waitcnt lgkmcnt(0)\n\ts_barrier" ::: "memory");
    if (has_next) t_issue_v(c, nxt, lds, wave, lane);
    po.o[0] = o[0]; po.o[1] = o[1]; po.l = l; po.mx = mx;
}
__device__ __forceinline__ void t_flush(const Ctx& c, const TDesc& d, const TOut& po, LAS unsigned char* lds, int wave) {
    const int lane = fresh_lane(), r32 = lane & 31, hi = lane >> 5, vkey = lane >> 3, vch = lane & 7;
    LAS unsigned char* qb = lds + TB_OFF + wave * 4608;
    u32x4 ow[4];
    t_out1(po, qb, r32, hi); t_out2(c, d, po, qb, wave, r32, hi, vkey, vch, ow); t_out3(c, d, wave, vkey, vch, ow);
}
template <int NQ> __device__ __forceinline__ void sample_vblock(const Ctx& c, int n, int h, int g, int dil, int r, int i0, const LAS float* tab, LAS float* sbuf) {
    const int lane = fresh_lane(), sub = lane & 15, rgp = lane >> 4;
    constexpr int NT = (NQ + 3) / 4, NSA = 32 + NT;
    f32x4 q4[NQ];
#pragma unroll
    for (int qq = 0; qq < NQ; ++qq) { const size_t row = (size_t)MP + n * TS + (r + dil * (i0 + qq) - WBUF);
        const u32x2 w = *(const u32x2*)(c.QB + row * AW + h * HD + 4 * sub); q4[qq] = (f32x4){bf_lo(w.x), bf_hi(w.x), bf_lo(w.y), bf_hi(w.y)}; }
    const unsigned cbase = (unsigned)((((n * WBUF) + r + dil * (i0 - 128 + rgp)) * NH + h) * HD + 4 * sub) * 4u, cstep = (unsigned)(4 * dil * NH * HD * 4);
    auto new_row = [&](const bf16_t* B16, int tt) -> f32x4 { const int tc = tt < NQ ? tt : NQ - 1;
        const u32x2 w = *(const u32x2*)(B16 + ((size_t)MP + n * TS + (r + dil * (i0 + tc) - WBUF)) * AW + h * HD + 4 * sub);
        return (f32x4){bf_lo(w.x), bf_hi(w.x), bf_lo(w.y), bf_hi(w.y)}; };
    auto score = [&](const f32x4 kv, int kk) {
#pragma unroll
        for (int qq = 0; qq < NQ; ++qq) {
            float d = (kv[0] * q4[qq][0] + kv[1] * q4[qq][1]) + (kv[2] * q4[qq][2] + kv[3] * q4[qq][3]);
            d += __shfl_xor(d, 1); d += __shfl_xor(d, 2); d += __shfl_xor(d, 4); d += __shfl_xor(d, 8);
            if (sub == 0) sbuf[qq * 136 + kk] = (kk < 128 + NQ) ? d + tab[159 + qq - kk] : -1e30f;
        } };
    {   f32x4 nk[NT];
#pragma unroll
        for (int i = 0; i < NT; ++i) nk[i] = new_row(c.KB, 4 * i + rgp);
        {   f32x4 kv[32];
#pragma unroll
            for (int i = 0; i < 32; ++i) kv[i] = *(const f32x4*)((const char*)c.CK + cbase + (unsigned)i * cstep);
#pragma unroll
            for (int i = 0; i < 32; ++i) score(kv[i], 4 * i + rgp);
        }
#pragma unroll
        for (int i = 0; i < NT; ++i) score(nk[i], 128 + 4 * i + rgp);
    }
    asm volatile("s_waitcnt lgkmcnt(0)" ::: "memory");
    float lq[NQ], lse[NQ];
#pragma unroll
    for (int qq = 0; qq < NQ; ++qq) {
        float v[3]; float mx = -3.0e38f;
#pragma unroll
        for (int j = 0; j < 3; ++j) { const int kk = lane + 64 * j; v[j] = (kk < 4 * NSA) ? sbuf[qq * 136 + kk] : -1e30f; mx = fmaxf(mx, v[j]); }
#pragma unroll
        for (int o = 1; o < 64; o <<= 1) mx = fmaxf(mx, __shfl_xor(mx, o));
        float sm = 0.f;
#pragma unroll
        for (int j = 0; j < 3; ++j) { const int kk = lane + 64 * j; const float pv = fast_exp2(v[j] - mx); sm += pv; if (kk < 4 * NSA) sbuf[qq * 136 + kk] = pv; }
        sm = wave_sum(sm); lq[qq] = sm; lse[qq] = mx + __log2f(sm);
    }
    asm volatile("s_waitcnt lgkmcnt(0)" ::: "memory");
    f32x4 oa[NQ];
#pragma unroll
    for (int qq = 0; qq < NQ; ++qq) oa[qq] = (f32x4){0.f, 0.f, 0.f, 0.f};
    {   f32x4 nv[NT];
#pragma unroll
        for (int i = 0; i < NT; ++i) nv[i] = new_row(c.VB, 4 * i + rgp);
        {   f32x4 vv[32];
#pragma unroll
            for (int i = 0; i < 32; ++i) vv[i] = *(const f32x4*)((const char*)c.CV + cbase + (unsigned)i * cstep);
#pragma unroll
            for (int i = 0; i < 32; ++i) { const int kk = 4 * i + rgp;
#pragma unroll
                for (int qq = 0; qq < NQ; ++qq) { const float pv = sbuf[qq * 136 + kk]; oa[qq] += vv[i] * pv; } }
        }
#pragma unroll
        for (int i = 0; i < NT; ++i) { const int kk = 128 + 4 * i + rgp;
#pragma unroll
            for (int qq = 0; qq < NQ; ++qq) { const float pv = sbuf[qq * 136 + kk]; oa[qq] += nv[i] * pv; } }
    }
#pragma unroll
    for (int qq = 0; qq < NQ; ++qq) {
#pragma unroll
        for (int e = 0; e < 4; ++e) { float x = oa[qq][e]; x += __shfl_xor(x, 16); x += __shfl_xor(x, 32); oa[qq][e] = x; }
        const size_t tok = (size_t)MP + n * TS + (r + dil * (i0 + qq) - WBUF);
        if (rgp == 0) { const float inv = 1.0f / lq[qq]; u32x2 w; w.x = pkbf(oa[qq][0] * inv, oa[qq][1] * inv); w.y = pkbf(oa[qq][2] * inv, oa[qq][3] * inv);
            *(u32x2*)(c.OP + (size_t)g * OP_STRIDE + tok * AW + h * HD + 4 * sub) = w;
            if (sub == 0) c.LSE[(size_t)g * LSE_STRIDE + tok * NH + h] = lse[qq]; }
    }
    asm volatile("s_waitcnt lgkmcnt(0)" ::: "memory");
}
template <int NP> __device__ __forceinline__ void merge_pieces(const Ctx& c, size_t tok0, size_t tstride, int h, int piece) {
    float ls[NP][3]; u32x4 ov[NP][3];
#pragma unroll
    for (int q = 0; q < NP; ++q)
#pragma unroll
        for (int g = 0; g < 3; ++g) { const size_t tok = tok0 + q * tstride; ls[q][g] = c.LSE[(size_t)g * LSE_STRIDE + tok * NH + h]; ov[q][g] = *(const u32x4*)(c.OP + (size_t)g * OP_STRIDE + tok * AW + h * HD + piece * 8); }
#pragma unroll
    for (int q = 0; q < NP; ++q) {
        const float M = fmaxf(fmaxf(ls[q][0], ls[q][1]), ls[q][2]);
        float w0 = fast_exp2(ls[q][0] - M), w1 = fast_exp2(ls[q][1] - M), w2 = fast_exp2(ls[q][2] - M); const float inv = 1.0f / (w0 + w1 + w2); w0 *= inv; w1 *= inv; w2 *= inv;
        u32x4 o;
#pragma unroll
        for (int e = 0; e < 4; ++e) {
            const float lo = w0 * bf_lo(ov[q][0][e]) + w1 * bf_lo(ov[q][1][e]) + w2 * bf_lo(ov[q][2][e]);
            const float hi_ = w0 * bf_hi(ov[q][0][e]) + w1 * bf_hi(ov[q][1][e]) + w2 * bf_hi(ov[q][2][e]);
            o[e] = pkbf(lo, hi_);
        }
        *(u32x4*)(c.ATT + (tok0 + q * tstride) * DM + h * HD + piece * 8) = o;
    }
}
__device__ __forceinline__ void copy_slot(const float* ck, const float* cv, float* out, int sl, int lane) {
    const int sq = sl / 576, j0 = (sl - sq * 576) * 680, which = sq >> 5, n = sq & 31;
    const f32x4* src = (const f32x4*)((which ? cv : ck) + (size_t)n * WBUF * AW + (size_t)TS * AW) + j0 + lane;
    f32x4* dst = (f32x4*)(out + (which ? OFF_SWV : OFF_SWK) + (size_t)n * WBUF * AW) + j0 + lane;
    f32x4 v[11];
#pragma unroll
    for (int i = 0; i < 10; ++i) v[i] = __builtin_nontemporal_load(src + 64 * i);
    if (lane < 40) v[10] = __builtin_nontemporal_load(src + 640);
#pragma unroll
    for (int i = 0; i < 10; ++i) __builtin_nontemporal_store(v[i], dst + 64 * i);
    if (lane < 40) __builtin_nontemporal_store(v[10], dst + 640);
}
__device__ __forceinline__ void copy_range(const float* ck, const float* cv, float* out, unsigned first, unsigned count, int widx, int nw, int tid) {
    constexpr unsigned PER = (unsigned)(WBUF - TS) * AW / 4;
    const unsigned end = first + count;
    for (unsigned i0 = first + (unsigned)widx * 4096u + tid; i0 < end; i0 += (unsigned)nw * 4096u) {
        f32x4 v[8];
#pragma unroll
        for (int k = 0; k < 8; ++k) { const unsigned i = i0 + 512u * k; if (i < end) { const unsigned sq = i / PER, j = i - sq * PER, which = sq >> 5, n = sq & 31;
            v[k] = __builtin_nontemporal_load((const f32x4*)((which ? cv : ck) + (size_t)n * WBUF * AW + (size_t)TS * AW) + j); } }
#pragma unroll
        for (int k = 0; k < 8; ++k) { const unsigned i = i0 + 512u * k; if (i < end) { const unsigned sq = i / PER, j = i - sq * PER, which = sq >> 5, n = sq & 31;
            __builtin_nontemporal_store(v[k], (f32x4*)(out + (which ? OFF_SWV : OFF_SWK) + (size_t)n * WBUF * AW) + j); } }
    }
}
}

template <int NTW, bool SAMPLE> __device__ __forceinline__ void conv_unit(const float* U, const float* cache_conv, int seq, int t0, LAS float* tile, const LAS float* cw,
                                                                          const float* cb, const float* lg, const float* lb, bf16_t* ATT, int tid, int lane, int wave) {
    constexpr int NROW = 8 * NTW + 30;
    const size_t rowbase = SAMPLE ? (size_t)MP + (size_t)seq * TS : (size_t)seq * SEQ;
    for (int idx = tid; idx < NROW * 64; idx += 512) {
        const int rr = idx >> 6, c4 = idx & 63, tau = rr - 30; f32x4 v = (f32x4){0.f, 0.f, 0.f, 0.f};
        if (SAMPLE) { v = tau < 0 ? *(const f32x4*)(cache_conv + ((size_t)seq * 30 + (30 + tau)) * CWD + 4 * c4) : *(const f32x4*)(U + (rowbase + tau) * CWD + 4 * c4); }
        else if (t0 + tau >= 0) v = *(const f32x4*)(U + (rowbase + t0 + tau) * CWD + 4 * c4);
        *(LAS f32x4*)(tile + rr * CWD + 4 * c4) = v;
    }
    __syncthreads();
    f32x4 acc[NTW], uw[NTW];
    const LAS float* tw = tile + (NTW * wave) * CWD + 4 * lane;
#pragma unroll
    for (int i = 0; i < NTW; ++i) { acc[i] = (f32x4){0.f, 0.f, 0.f, 0.f}; uw[i] = *(const LAS f32x4*)(tw + i * CWD); }
#pragma unroll 1
    for (int j = 0; j < 31; ++j) {
        const f32x4 w = *(const LAS f32x4*)(cw + j * CWD + 4 * lane);
        const f32x4 nx = *(const LAS f32x4*)(tw + (NTW + j) * CWD);
#pragma unroll
        for (int i = 0; i < NTW; ++i) acc[i] += w * uw[i];
#pragma unroll
        for (int i = 0; i + 1 < NTW; ++i) uw[i] = uw[i + 1];
        uw[NTW - 1] = nx;
    }
    const f32x4 bv = *(const f32x4*)(cb + 4 * lane), gv = *(const f32x4*)(lg + 4 * lane), lv = *(const f32x4*)(lb + 4 * lane);
#pragma unroll
    for (int i = 0; i < NTW; ++i) {
        f32x4 y = acc[i] + bv;
        const float mean = wave_sum((y[0] + y[1]) + (y[2] + y[3])) * (1.0f / CWD);
        y = y - mean;
        const float var = wave_sum((y[0] * y[0] + y[1] * y[1]) + (y[2] * y[2] + y[3] * y[3])) * (1.0f / CWD);
        const float rstd = 1.0f / sqrtf(var + EPS);
        f32x4 z = y * rstd * gv + lv;
#pragma unroll
        for (int e = 0; e < 4; ++e) z[e] = z[e] * fast_rcp(1.f + fast_exp2(-z[e] * LOG2E));
        u32x2 w; w.x = pkbf(z[0], z[1]); w.y = pkbf(z[2], z[3]);
        *(u32x2*)(ATT + (rowbase + t0 + NTW * wave + i) * DM + AW + 4 * lane) = w;
    }
    __syncthreads();
}

__global__ void __launch_bounds__(512, 2) fwd_kernel(Params p) {
    extern __shared__ __attribute__((aligned(16))) unsigned char lds_raw[];
    LAS unsigned char* lds = (LAS unsigned char*)lds_raw;
    const int G = gridDim.x, bid = blockIdx.x;
    const int wave = __builtin_amdgcn_readfirstlane(threadIdx.x >> 6);
#define PHASE_IDS const int lane = fresh_lane(), tid = wave * 64 + lane; (void)tid
    unsigned char* ws = p.ws; float* out = p.out;
    bf16_t* WALL = (bf16_t*)(ws + WS_WALL); bf16_t* WOUT = (bf16_t*)(ws + WS_WOUT); bf16_t* WXQ = (bf16_t*)(ws + WS_WXQ); bf16_t* WXO = (bf16_t*)(ws + WS_WXO);
    bf16_t* WGU = (bf16_t*)(ws + WS_WGU); bf16_t* WDN = (bf16_t*)(ws + WS_WDN); bf16_t* XN = (bf16_t*)(ws + WS_XN);
    bf16_t* QB = (bf16_t*)(ws + WS_QB); bf16_t* KB = (bf16_t*)(ws + WS_KB); bf16_t* VB = (bf16_t*)(ws + WS_VB); float* U = (float*)(ws + WS_U);
    bf16_t* OP = (bf16_t*)(ws + WS_OP); float* LSE = (float*)(ws + WS_LSE); bf16_t* ATT = (bf16_t*)(ws + WS_ATT); float* X1 = (float*)(ws + WS_X1);
    float* SSQ = (float*)(ws + WS_SSQ); bf16_t* MKB = (bf16_t*)(ws + WS_MKB); bf16_t* MVT = (bf16_t*)(ws + WS_MVT); float* LSUM = (float*)(ws + WS_LSUM);
    bf16_t* XQ = (bf16_t*)(ws + WS_XQ); bf16_t* PB = (bf16_t*)(ws + WS_PB); bf16_t* XO = (bf16_t*)(ws + WS_XO); bf16_t* HB = (bf16_t*)(ws + WS_H);
    const int lo = p.ph_lo, hi = p.ph_hi;
    if (threadIdx.x < 4) ((volatile LAS unsigned*)(lds + MISC_OFF))[threadIdx.x] = 0u;
    __syncthreads();
    XcdBarrier xbar; xbar.bar = (unsigned*)(ws + WS_CTL); xbar.x = 0; xbar.st = nullptr;
    if (p.coop) xbar = xcd_barrier_post((unsigned*)(ws + WS_CTL), (volatile LAS unsigned*)(lds + MISC_OFF));
#ifndef PH_MASK
#define PH_MASK 0x7ff
#endif
#define IN(k) (((PH_MASK >> (k)) & 1) && lo <= (k) && (k) < hi)
#ifndef PROBE_DUP
#define PROBE_DUP 0
#endif
#define REP(k) for (int rep_ = 0; rep_ <= ((PROBE_DUP >> (k)) & 1); ++rep_)
#define REPSYNC if (rep_) xcd_barrier(xbar)
#define SEAM(k) do { if (IN(k) && IN((k) + 1)) { if (p.coop == 2) cg::this_grid().sync(); else xcd_barrier(xbar); } } while (0)

    if (IN(0)) REP(0) {
        REPSYNC;
        PHASE_IDS;
        LAS float* scr = (LAS float*)(lds + wave * 16384);
        const int gw = bid * 8 + wave, NGW = G * 8;
        constexpr int I_IN = 16 * 88, I_SQ = 16 * 32, I_FF = 16 * 88, I_DN = 44 * 32;
        constexpr int NITEMS = I_IN + 5 * I_SQ + 2 * I_FF + I_DN;
        for (int it = gw; it < NITEMS; it += NGW) {
            int r = it;
            if (r < I_IN) { transpose_item(p.in[10], DM, NIN, WALL, r, 1, scr, lane); continue; } r -= I_IN;
            if (r < I_SQ) { transpose_item(p.in[19], DM, DM, WALL + (size_t)2816 * DM, r, 0, scr, lane); continue; } r -= I_SQ;
            if (r < I_SQ) { transpose_item(p.in[20], DM, DM, WALL + (size_t)3840 * DM, r, 0, scr, lane); continue; } r -= I_SQ;
            if (r < I_SQ) { transpose_item(p.in[15], DM, DM, WOUT, r, 0, scr, lane); continue; } r -= I_SQ;
            if (r < I_SQ) { transpose_item(p.in[18], DM, DM, WXQ, r, 0, scr, lane); continue; } r -= I_SQ;
            if (r < I_SQ) { transpose_item(p.in[21], DM, DM, WXO, r, 0, scr, lane); continue; } r -= I_SQ;
            if (r < I_FF) { transpose_item(p.in[23], DM, DFF, WGU, r, 2, scr, lane); continue; } r -= I_FF;
            if (r < I_FF) { transpose_item(p.in[24], DM, DFF, WGU, r, 3, scr, lane); continue; } r -= I_FF;
            transpose_item(p.in[25], DFF, DM, WDN, r, 0, scr, lane);
        }
        for (int m0 = gw * 4; m0 < MALL; m0 += NGW * 4) {
            const float* base; const float* g;
            if (m0 < MP) { base = p.in[0] + (size_t)m0 * DM; g = p.in[9]; }
            else if (m0 < MTOK) { base = p.in[1] + (size_t)(m0 - MP) * DM; g = p.in[9]; }
            else { base = p.in[2] + (size_t)(m0 - MTOK) * DM; g = p.in[17]; }
            const float* const xr[4] = {base, base + DM, base + 2 * DM, base + 3 * DM};
            bf16_t* ob = XN + (size_t)m0 * DM; bf16_t* const orr[4] = {ob, ob + DM, ob + 2 * DM, ob + 3 * DM};
            rms_rows_bf16<4>(xr, g, orr, lane);
        }
        if (bid == 0) {
            float* tabg = (float*)(ws + WS_TABG);
            for (int i = tid; i < 36 * 192; i += 512) {
                const int gh = i / 192, e = i - gh * 192, g = gh / 12, h = gh - g * 12, dist = e - 31; float v = -1e30f;
                if (dist >= 0 && dist <= 128) { const int n = dist << (2 * g); int bk;
                    if (n < 16) bk = n; else { const float vv = logf((float)n / 16.0f) / 4.852030263919617f * 16.0f; bk = 16 + (int)vv; bk = bk > 31 ? 31 : bk; }
                    v = p.in[8][bk * NH + h] * LOG2E; }
                tabg[i] = v;
            }
        }
        {
            constexpr int CPER = (30 - TS) * CWD / 4;
            for (int i = bid * 512 + tid; i < NSEQ * CPER; i += G * 512) { const int n = i / CPER, j = i - n * CPER;
                ((f32x4*)(out + OFF_SCONV + (size_t)n * 30 * CWD))[j] = ((const f32x4*)(p.in[5] + (size_t)n * 30 * CWD + TS * CWD))[j]; }
        }
    }
    SEAM(0);
    if (IN(1)) REP(1) {
        REPSYNC;
#ifndef P1_NO_MAIN
        { pg8::SchedGrid S{129, 11, G, bid, (const char*)XN, (const char*)WALL, (size_t)256 * DM * 2, (size_t)256 * DM * 2};
          pg8::EpiIn E{ws, out};
          pg8::gemm_phase<pg8::EpiIn, pg8::SchedGrid, true>(lds, pg8::Cfg{DM, DM, DM}, S, E, wave); }
#endif
#ifndef P1_NO_MEM
        { const int cfirst = (129 * 11) % G;
          pg8::SchedMem S{(bid - cfirst + G) % G, (const char*)XN, (const char*)WALL};
          pg8::EpiMem E{ws, out};
          pg8::gemm_phase<pg8::EpiMem, pg8::SchedMem, true>(lds, pg8::Cfg{DM, DM, DM}, S, E, wave); }
        if (bid >= 187 && rep_ == 0) { PHASE_IDS; att::copy_range(p.in[3], p.in[4], out, 0u, 2000000u, bid - 187, G - 187, tid); }
#endif
    }
    SEAM(1);
    if (IN(2)) REP(2) {
        REPSYNC;
        PHASE_IDS;
        LAS float* tab = (LAS float*)(lds + ATT_TAB_OFF); LAS float* cw = (LAS float*)(lds + ATT_CW_OFF);
#ifndef MK_TILE_ATT
#define MK_TILE_ATT 1
#endif
        const float* tabg = (const float*)(ws + WS_TABG);
#if !MK_TILE_ATT
        for (int i = tid; i < 36 * 192; i += 512) tab[i] = tabg[i];
        __syncthreads();
#endif
        att::Ctx c{QB, KB, VB, p.in[3], p.in[4], OP, LSE, ATT};
        LAS unsigned char* vbuf = lds + ATT_V_OFF + wave * ATT_WBUF;
#ifndef PROBE_P2
#define PROBE_P2 0
#endif
#if MK_TILE_ATT
        {
            const int nl2 = __builtin_amdgcn_readfirstlane((int)((volatile LAS unsigned*)(lds + MISC_OFF))[0]), nx2 = __builtin_amdgcn_readfirstlane((int)((volatile LAS unsigned*)(lds + MISC_OFF))[1]);
            const int xi2 = __builtin_amdgcn_readfirstlane((int)((volatile LAS unsigned*)(lds + MISC_OFF))[2]), rk2 = __builtin_amdgcn_readfirstlane((int)((volatile LAS unsigned*)(lds + MISC_OFF))[3]);
            const int npair = (48 - xi2 + nx2 - 1) / nx2, nun = npair * 96;
            auto mk = [&](int Lx) -> att::TDesc { att::TDesc d; const int pair = Lx / 96, u = Lx - pair * 96, pp = xi2 + nx2 * pair; d.b = pp / 12; d.h = pp - d.b * 12; d.g = u >> 5; const int cj = u & 31;
                if (d.g == 0) { d.dil = 1; d.r = 0; d.j0 = 256 * cj; } else if (d.g == 1) { d.dil = 4; d.r = cj >> 3; d.j0 = 256 * (cj & 7); } else { d.dil = 16; d.r = cj >> 1; d.j0 = 256 * (cj & 1); }
                return d; };
            int Lx = rk2;
            att::TDesc cur = mk(Lx < nun ? Lx : 0), prv = cur;
            att::TOut po; po.o[0] = (f32x16){}; po.o[1] = (f32x16){}; po.l = 1.f; po.mx = 0.f;
            const bool any = Lx < nun;
            __builtin_amdgcn_s_waitcnt(0x0070);
            if (any) { att::t_issue_tab(tabg, cur, lds, wave, lane);
                att::t_issue_k(c, cur, lds, wave, lane); att::t_issue_q(c, cur, lds, wave, lane); att::t_issue_v(c, cur, lds, wave, lane); }
            while (Lx < nun) {
                const int Lx2 = Lx + nl2; const bool has_next = Lx2 < nun;
                const att::TDesc nxt = mk(has_next ? Lx2 : Lx);
                att::t_unit(c, prv, cur, nxt, has_next, tabg, lds, wave, po);
                prv = cur; cur = nxt; Lx = Lx2;
            }
            if (any) att::t_flush(c, prv, po, lds, wave);
            xl_barrier(xbar);
            for (int k = 0; k < npair; ++k) { const int pp = xi2 + nx2 * k, b = pp / 12, h = pp - b * 12;
                for (int ck = rk2; ck < 32; ck += nl2) att::merge_pieces<4>(c, (size_t)b * SEQ + ck * 256 + (tid >> 3), 64, h, tid & 7); }
            __syncthreads();
            for (int i = tid; i < 36 * 192; i += 512) tab[i] = tabg[i];
            __syncthreads();
        }
#endif
#if !defined(P2_NO_PROMPT) && !MK_TILE_ATT
        for (int rp_ = 0; rp_ <= (PROBE_P2 & 1) + ((PROBE_P2 >> 3) & 1); ++rp_) {
            auto mkdesc = [&](int un, int it) -> att::PDesc {
                att::PDesc d; d.b = un / 192; const int rem = un - d.b * 192; d.h = rem >> 4; const int ch = rem & 15; d.g = it >> 4; const int j = it & 15;
                if (d.g == 0) { d.dil = 1; d.r = 0; d.i0 = ch * 512 + 32 * j; } else if (d.g == 1) { d.dil = 4; d.r = j >> 2; d.i0 = ch * 128 + 32 * (j & 3); } else { d.dil = 16; d.r = j; d.i0 = ch * 32; }
                return d; };
            bf16x8 qv[4], kr[5][4];
            const int vkey_ = lane >> 3, vch_ = lane & 7;
            const int vcu = (G % 8 == 0) ? (bid & 7) * (G >> 3) + (bid >> 3) : bid;
            int un = vcu, it = wave;
            att::PDesc cur = mkdesc(un < 768 ? un : 0, it);
            if (un < 768) { att::p_load_q(c, cur, qv, vkey_, vch_);
#pragma unroll
                for (int s5 = 0; s5 < 2; ++s5) att::p_load_kv(c.KB, cur, s5, kr[s5], vkey_, vch_); }
            while (un < 768) {
                int un2 = un, it2 = it + 8; if (it2 >= 48) { it2 = wave; un2 = un + G; }
                const bool has_next = un2 < 768;
                const att::PDesc nxt = mkdesc(has_next ? un2 : un, has_next ? it2 : it);
                att::pblock(c, cur, nxt, has_next, qv, kr, tab, vbuf);
                if (un2 != un) {
                    __syncthreads();
                    const int b = un / 192, rem = un - b * 192, h = rem >> 4, ch = rem & 15;
#pragma unroll 1
                    for (int ps = 0; ps < 8; ps += 4) att::merge_pieces<4>(c, (size_t)b * SEQ + ch * 512 + ps * 64 + (tid >> 3), 64, h, tid & 7);
                }
                cur = nxt; un = un2; it = it2;
            }
        }
#endif
        {
            unsigned* cq = (unsigned*)(ws + WS_CTL) + 13200;
            volatile LAS unsigned* qw = (volatile LAS unsigned*)(lds + MISC_OFF) + 8;
            constexpr unsigned NSU = NSEQ * NH, NIT = NSU + 1024 + NSEQ;
            unsigned tk_ = 0;
            if (threadIdx.x == 0) { tk_ = xb_add(cq, 1u); qw[0] = tk_; }
            __syncthreads();
            unsigned q = (unsigned)__builtin_amdgcn_readfirstlane((int)qw[0]);
            bool conv_ready = false;
            while (q < NIT) {
                __syncthreads();
                if (threadIdx.x == 0) tk_ = xb_add(cq, 1u);
                if (q < NSU) {
                    const int n = (int)q / NH, h = (int)q - n * NH;
                    if (wave == 0) att::wave_block<1>(c, n, h, 0, 1, 0, 2048, 8, tab + (0 * 12 + h) * 192, vbuf);
                    else for (int it = wave; it < 13; it += 7) {
                        LAS float* sb = (LAS float*)vbuf;
                        if (it < 5) att::sample_vblock<2>(c, n, h, 1, 4, it - 1, 512, tab + (1 * 12 + h) * 192, sb);
                        else att::sample_vblock<1>(c, n, h, 2, 16, it - 5, 128, tab + (2 * 12 + h) * 192, sb);
                    }
                    __syncthreads();
                    if (tid < 64) att::merge_pieces<1>(c, (size_t)MP + n * TS + (tid >> 3), 0, h, tid & 7);
                } else {
                    if (!conv_ready) { __syncthreads(); for (int i = tid; i < 31 * CWD; i += 512) cw[i] = p.in[11][i]; conv_ready = true; }
                    const int un = (int)(q - NSU);
                    if (un < 1024) conv_unit<4, false>(U, p.in[5], un >> 8, (un & 255) * 32, (LAS float*)(lds + ATT_V_OFF), cw, p.in[12], p.in[13], p.in[14], ATT, tid, lane, wave);
                    else conv_unit<1, true>(U, p.in[5], un - 1024, 0, (LAS float*)(lds + ATT_V_OFF), cw, p.in[12], p.in[13], p.in[14], ATT, tid, lane, wave);
                }
                if (threadIdx.x == 0) qw[0] = tk_;
                __syncthreads();
                q = (unsigned)__builtin_amdgcn_readfirstlane((int)qw[0]);
            }
        }
    }
    SEAM(2);
    const int nl = __builtin_amdgcn_readfirstlane((int)((volatile LAS unsigned*)(lds + MISC_OFF))[0]), nx = __builtin_amdgcn_readfirstlane((int)((volatile LAS unsigned*)(lds + MISC_OFF))[1]);
    const int xi = __builtin_amdgcn_readfirstlane((int)((volatile LAS unsigned*)(lds + MISC_OFF))[2]), rk = __builtin_amdgcn_readfirstlane((int)((volatile LAS unsigned*)(lds + MISC_OFF))[3]);
    unsigned* xq_flag = (unsigned*)(ws + WS_CTL) + 3520; unsigned* xo_flag = (unsigned*)(ws + WS_CTL) + 13000;
    bool own128 = false;
    { for (int j = 0; j < 16; ++j) { const int Lx = j * nl + rk, pm = xi + nx * (Lx >> 2); if (pm >= 129) break; own128 |= (pm == 128); } }
    if (IN(3)) {
        pg8::SchedXL S{nl, rk, xi, nx, (const char*)ATT, (const char*)WOUT, (size_t)256 * DM * 2, (size_t)256 * DM * 2, 0};
        pg8::EpiRes<true> E{p.in[0], p.in[1], nullptr, XN, p.in[16], SSQ};
        pg8::gemm_phase<pg8::EpiRes<true>, pg8::SchedXL, true>(lds, pg8::Cfg{DM, DM, DM}, S, E, wave);
    }
    xl_barrier(xbar);
    if (IN(4)) {
        {   pg8::SchedXL S{nl, rk, xi, nx, (const char*)XN, (const char*)WXQ, (size_t)256 * DM * 2, (size_t)256 * DM * 2, 0};
            pg8::EpiScale E{XQ, SSQ, XQSCALE};
            pg8::gemm_phase<pg8::EpiScale, pg8::SchedXL, true>(lds, pg8::Cfg{DM, DM, DM}, S, E, wave); }
        if (own128 && threadIdx.x == 0) { __builtin_amdgcn_fence(__ATOMIC_RELEASE, "agent"); asm volatile("s_waitcnt vmcnt(0)" ::: "memory"); (void)xb_add(xq_flag, 1u); }
        {   pg8::SchedXLs S{nl, rk, xi, nx, (const char*)XQ, (const char*)MKB, 0};
            pg8::EpiSoftmax E{PB, LSUM, (LAS float*)(lds + XCH_OFF)};
            pg8::gemm_phase<pg8::EpiSoftmax, pg8::SchedXLs, true>(lds, pg8::Cfg{256, DM, DM}, S, E, wave); }
        {   pg8::SchedXLs S{nl, rk, xi, nx, (const char*)PB, (const char*)MVT, 1};
            pg8::EpiPV E{XO, LSUM};
            pg8::gemm_phase<pg8::EpiPV, pg8::SchedXLs, true>(lds, pg8::Cfg{256, DM, DM}, S, E, wave); }
        PHASE_IDS;
        if (threadIdx.x == 0) { unsigned sp = 0; while (xb_ld(xq_flag) < 4u) { __builtin_amdgcn_s_sleep(2); if (++sp > (1u << 22)) break; }
            __builtin_amdgcn_fence(__ATOMIC_ACQUIRE, "agent"); asm volatile("s_waitcnt vmcnt(0)" ::: "memory"); }
        LAS float* qs = (LAS float*)lds;
        LAS float* sc = (LAS float*)(lds + 4096);
        LAS float* red = (LAS float*)(lds + 8192);
        for (int un = bid; un < NSEQ * 4 * 2; un += G) {
            const int n = un >> 3, h = (un >> 1) & 3, half = un & 1;
            __syncthreads();
            for (int i = tid; i < 4 * 256; i += 512) { const int t = i >> 8, d = i & 255; qs[i] = __uint_as_float((unsigned)XQ[((size_t)MP + n * TS + 4 * half + t) * DM + h * 256 + d] << 16); }
            __syncthreads();
            const float* Kc = p.in[6] + ((size_t)n * NMEM * 4 + h) * 256; const float* Vc = p.in[7] + ((size_t)n * NMEM * 4 + h) * 256;
            f32x4 qv[4];
#pragma unroll
            for (int t = 0; t < 4; ++t) qv[t] = *(const LAS f32x4*)(qs + t * 256 + 4 * lane);
#pragma unroll 1
            for (int mb = 0; mb < 2; ++mb) {
                f32x4 kv[16];
#pragma unroll
                for (int k = 0; k < 16; ++k) kv[k] = *(const f32x4*)(Kc + (size_t)(wave * 32 + mb * 16 + k) * 1024 + 4 * lane);
#pragma unroll
                for (int k = 0; k < 16; ++k) {
                    float pt[4];
#pragma unroll
                    for (int t = 0; t < 4; ++t) pt[t] = wave_sum((kv[k][0] * qv[t][0] + kv[k][1] * qv[t][1]) + (kv[k][2] * qv[t][2] + kv[k][3] * qv[t][3]));
                    if (lane == 0) *(LAS f32x4*)(sc + (wave * 32 + mb * 16 + k) * 4) = (f32x4){pt[0], pt[1], pt[2], pt[3]};
                }
            }
            __syncthreads();
            if (wave < 4) {
                const int t = wave; float v[4]; float mx = -3.0e38f;
#pragma unroll
                for (int j = 0; j < 4; ++j) { v[j] = sc[(lane + 64 * j) * 4 + t]; mx = fmaxf(mx, v[j]); }
#pragma unroll
                for (int o = 1; o < 64; o <<= 1) mx = fmaxf(mx, __shfl_xor(mx, o));
                float sm = 0.f;
#pragma unroll
                for (int j = 0; j < 4; ++j) { v[j] = fast_exp2(v[j] - mx); sm += v[j]; }
                sm = wave_sum(sm); const float inv = 1.0f / sm;
#pragma unroll
                for (int j = 0; j < 4; ++j) sc[(lane + 64 * j) * 4 + t] = v[j] * inv;
            }
            __syncthreads();
            {
                const int d = tid & 255, mh = tid >> 8; f32x4 o = (f32x4){0.f, 0.f, 0.f, 0.f};
                const float* vp = Vc + (size_t)(mh * 128) * 1024 + d; const LAS float* pp = sc + (mh * 128) * 4;
#pragma unroll 1
                for (int m0 = 0; m0 < 128; m0 += 32) {
                    float vv[32];
#pragma unroll
                    for (int m = 0; m < 32; ++m) vv[m] = vp[(size_t)(m0 + m) * 1024];
#pragma unroll
                    for (int m = 0; m < 32; ++m) { const f32x4 pw = *(const LAS f32x4*)(pp + (m0 + m) * 4); o += pw * vv[m]; }
                }
                if (mh == 1) *(LAS f32x4*)(red + d * 4) = o;
                __syncthreads();
                if (mh == 0) { o += *(const LAS f32x4*)(red + d * 4);
#pragma unroll
                    for (int e = 0; e < 4; ++e) { const unsigned mine = pkbf(o[e], 0.f) & 0xffffu, nb = (unsigned)__shfl_down((int)mine, 1);
                        if (!(d & 1)) __hip_atomic_store((unsigned*)(XO + ((size_t)MP + n * TS + 4 * half + e) * DM + h * 256 + d), mine | (nb << 16), __ATOMIC_RELAXED, __HIP_MEMORY_SCOPE_AGENT); } }
            }
            asm volatile("s_waitcnt vmcnt(0)" ::: "memory"); __syncthreads();
            if (threadIdx.x == 0) (void)xb_add(xo_flag, 1u);
        }
        __syncthreads();
    }
    xl_barrier(xbar);
    if (IN(7)) {
        if (own128) {
            if (threadIdx.x == 0) { unsigned sp = 0; while (xb_ld(xo_flag) < (unsigned)(NSEQ * 8)) { __builtin_amdgcn_s_sleep(2); if (++sp > (1u << 22)) break; }
                __builtin_amdgcn_fence(__ATOMIC_ACQUIRE, "agent"); asm volatile("s_waitcnt vmcnt(0)" ::: "memory"); }
            __syncthreads();
        }
        pg8::SchedXL S{nl, rk, xi, nx, (const char*)XO, (const char*)WXO, (size_t)256 * DM * 2, (size_t)256 * DM * 2, 0};
        pg8::EpiRes<false> E{nullptr, nullptr, p.in[16], XN, p.in[22], SSQ + SSQ_STRIDE};
        pg8::gemm_phase<pg8::EpiRes<false>, pg8::SchedXL, true>(lds, pg8::Cfg{DM, DM, DM}, S, E, wave);
    }
    xl_barrier(xbar);
    const int xi0 = 128 % nx;
    const int xi9 = (nx > 1 && nl >= 4) ? (xi0 + 1) % nx : xi0;
    unsigned* h_flag = (unsigned*)(ws + WS_CTL) + 13064;
    if (IN(8)) {
        pg8::SchedXL22 S{nl, rk, xi, nx, (const char*)XN, (const char*)WGU, (size_t)256 * DM * 2, (size_t)256 * DM * 2};
        pg8::EpiSwiGLU E{HB, SSQ + SSQ_STRIDE};
        pg8::gemm_phase<pg8::EpiSwiGLU, pg8::SchedXL22, true>(lds, pg8::Cfg{DM, DM, DM}, S, E, wave);
        bool had = false;
        for (int j = 0; j < 16; ++j) { const int Lx = j * nl + rk, pm = xi + nx * (Lx / 22); if (pm >= 129) break; had |= (pm == 128); }
        if (had && threadIdx.x == 0) { __builtin_amdgcn_fence(__ATOMIC_RELEASE, "agent"); asm volatile("s_waitcnt vmcnt(0)" ::: "memory"); (void)xb_add(h_flag, 1u); }
    }
    xl_barrier(xbar);
    if (IN(9)) {
        pg8::EpiFinal E{XN, p.in[22], out + OFF_Y, p.in[26], (float*)(ws + WS_SLOT), (unsigned*)(ws + WS_CTL) + 4096, (LAS float*)(lds + XCH_OFF), wave};
        {   pg8::SchedXL S{nl, rk, xi, nx, (const char*)HB, (const char*)WDN, (size_t)256 * DFF * 2, (size_t)256 * DFF * 2, 1};
            pg8::gemm_phase<pg8::EpiFinal, pg8::SchedXL, true>(lds, pg8::Cfg{DFF, DFF, DFF}, S, E, wave); }
        if (xi == xi9 && rk < 4) {
            if (threadIdx.x == 0) { unsigned sp = 0; while (xb_ld(h_flag) < 22u) { __builtin_amdgcn_s_sleep(2); if (++sp > (1u << 22)) break; }
                __builtin_amdgcn_fence(__ATOMIC_ACQUIRE, "agent"); asm volatile("s_waitcnt vmcnt(0)" ::: "memory"); }
            __syncthreads();
            pg8::SchedOne S{128, rk, (const char*)HB, (const char*)WDN, (size_t)256 * DFF * 2, (size_t)256 * DFF * 2};
            pg8::gemm_phase<pg8::EpiFinal, pg8::SchedOne, true>(lds, pg8::Cfg{DFF, DFF, DFF}, S, E, wave);
        }
    }
    {   const bool all = (nx <= 1);
        int before = 0; for (int x = 0; x < xi; ++x) if (x != xi0) before += (x == xi9 && xi9 != xi0) ? nl - 4 : nl;
        const int mine = (xi == xi9 && xi9 != xi0) ? rk - 4 : rk;
        const int nwk = all ? nl : (nx - 1) * nl - (xi9 != xi0 ? 4 : 0), widx = all ? rk : before + mine;
        if (all || (xi != xi0 && mine >= 0)) { PHASE_IDS; att::copy_range(p.in[3], p.in[4], out, 2000000u, 23067520u, widx, nwk, tid); } }
#undef IN
#undef SEAM
}

extern "C" void kernel_launch(void* const* d_in, const int* in_sizes, int n_in, void* d_out, int out_size, void* d_ws, size_t ws_size, hipStream_t stream) {
    static int grid = 0;
    if (grid == 0) {
        if (n_in != 27 || (size_t)out_size != OUT_TOTAL || ws_size < WS_END) { fprintf(stderr, "kernel_launch: unexpected shapes: n_in %d out %d ws %zu\n", n_in, out_size, ws_size); grid = -1; return; }
        int dev = 0, cus = 0, per_cu = 0;
        (void)hipGetDevice(&dev); (void)hipDeviceGetAttribute(&cus, hipDeviceAttributeMultiprocessorCount, dev);
        if (hipFuncSetAttribute((const void*)fwd_kernel, hipFuncAttributeMaxDynamicSharedMemorySize, LDS_BYTES) != hipSuccess) { fprintf(stderr, "kernel_launch: hipFuncSetAttribute failed\n"); grid = -1; return; }
        if (hipOccupancyMaxActiveBlocksPerMultiprocessor(&per_cu, (const void*)fwd_kernel, 512, LDS_BYTES) != hipSuccess || per_cu < 1) { fprintf(stderr, "kernel_launch: occupancy query failed (%d)\n", per_cu); (void)hipGetLastError(); per_cu = 1; }
        grid = cus * 1;
        if (per_cu < 1) grid = -1;
    }
    if (grid < 0) return;
    Params p{};
    for (int i = 0; i < 27; ++i) p.in[i] = (const float*)d_in[i];
    p.out = (float*)d_out; p.ws = (unsigned char*)d_ws;
#if MK_COOP
    if (hipMemsetAsync((char*)d_ws + WS_CTL, 0, CTL_ZERO_BYTES, stream) != hipSuccess) { fprintf(stderr, "kernel_launch: memset of the barrier words failed\n"); return; }
    p.ph_lo = 0; p.ph_hi = 11; p.coop = 1;
    void* args[] = {&p};
    hipError_t e = hipLaunchCooperativeKernel((const void*)fwd_kernel, dim3(grid), dim3(512), args, LDS_BYTES, stream);
    if (e != hipSuccess) fprintf(stderr, "cooperative launch failed: %s (grid %d)\n", hipGetErrorString(e), grid);
#else
    for (int ph = 0; ph < 11; ++ph) {
        p.ph_lo = ph; p.ph_hi = ph + 1; p.coop = 0;
        hipLaunchKernelGGL(fwd_kernel, dim3(grid), dim3(512), LDS_BYTES, stream, p);
    }
#endif
}
```

```cpp
#include <hip/hip_runtime.h>
#include <hip/hip_cooperative_groups.h>
#include <cstdio>
#include <cstdint>
namespace cg = cooperative_groups;

#ifndef MK_COOP
#define MK_COOP 1
#endif

#define LAS __attribute__((address_space(3)))
typedef unsigned short bf16_t;
typedef short bf16x8 __attribute__((ext_vector_type(8)));
typedef short s16x4 __attribute__((ext_vector_type(4)));
typedef float f32x2 __attribute__((ext_vector_type(2)));
typedef float f32x4 __attribute__((ext_vector_type(4)));
typedef float f32x16 __attribute__((ext_vector_type(16)));
typedef unsigned u32x2 __attribute__((ext_vector_type(2)));
typedef unsigned u32x4 __attribute__((ext_vector_type(4)));
typedef __bf16 bf16x2_t __attribute__((ext_vector_type(2)));

__device__ __forceinline__ unsigned pkbf(float lo, float hi) { f32x2 v = {lo, hi}; bf16x2_t b = __builtin_convertvector(v, bf16x2_t); return __builtin_bit_cast(unsigned, b); }
__device__ __forceinline__ float bf_lo(unsigned w) { return __uint_as_float(w << 16); }
__device__ __forceinline__ float bf_hi(unsigned w) { return __uint_as_float(w & 0xffff0000u); }
__device__ __forceinline__ int fresh_lane() { int t = __builtin_amdgcn_mbcnt_hi(~0u, __builtin_amdgcn_mbcnt_lo(~0u, 0u)); asm volatile("" : "+v"(t)); return t; }
__device__ __forceinline__ float fast_exp2(float x) { return __builtin_amdgcn_exp2f(x); }
__device__ __forceinline__ float fast_rcp(float x) { return __builtin_amdgcn_rcpf(x); }

constexpr int DM = 1024, NBATCH = 4, SEQ = 8192, MP = NBATCH * SEQ;
constexpr int NSEQ = 32, TS = 8, MSMP = NSEQ * TS;
constexpr int MTOK = MP + MSMP;
constexpr int NMEM = 256, MMEM = NBATCH * NMEM;
constexpr int MALL = MTOK + MMEM;
constexpr int AW = 768, CWD = 256, NIN = 2816, DFF = 2816, NH = 12, HD = 64;
constexpr int WBUF = 2048;
constexpr float EPS = 1e-6f;
constexpr float LOG2E = 1.4426950408889634f;
constexpr float QSCALE = 0.125f * LOG2E;
constexpr float XQSCALE = 0.0625f * LOG2E;

constexpr size_t OFF_Y = 0;
constexpr size_t OFF_PWK = 33816576, OFF_PWV = 40108032, OFF_PCONV = 46399488, OFF_PMK = 46430208, OFF_PMV = 47478784;
constexpr size_t OFF_SWK = 48527360, OFF_SWV = 98859008, OFF_SCONV = 149190656, OUT_TOTAL = 149436416;

constexpr size_t MiB = 1u << 20;
constexpr size_t WS_CTL = 0, CTL_ZERO_BYTES = 65536;
constexpr size_t WS_WALL = 2 * MiB;
constexpr size_t WS_WOUT = 12 * MiB, WS_WXQ = 14 * MiB, WS_WXO = 16 * MiB;
constexpr size_t WS_WGU = 18 * MiB;
constexpr size_t WS_WDN = 30 * MiB;
constexpr size_t WS_XN = 36 * MiB;
constexpr size_t WS_QB = 104 * MiB, WS_KB = 154 * MiB, WS_VB = 204 * MiB;
constexpr size_t WS_U = 254 * MiB;
constexpr size_t WS_OP = 288 * MiB;
constexpr size_t OP_STRIDE = (size_t)MTOK * AW;
constexpr size_t WS_LSE = 434 * MiB;
constexpr size_t LSE_STRIDE = (size_t)MTOK * NH;
constexpr size_t WS_ATT = 440 * MiB;
constexpr size_t WS_X1 = 506 * MiB;
constexpr size_t WS_SSQ = 636 * MiB;
constexpr size_t SSQ_STRIDE = (size_t)MTOK * 16;
constexpr size_t WS_MKB = 644 * MiB, WS_MVT = 646 * MiB;
constexpr size_t WS_LSUM = 648 * MiB;
constexpr size_t WS_XQ = 353 * MiB;
constexpr size_t WS_PB = 652 * MiB;
constexpr size_t WS_XO = 288 * MiB;
constexpr size_t WS_H = 104 * MiB;
constexpr size_t WS_TABG = 651 * MiB;
constexpr size_t WS_SLOT = 650 * MiB;
constexpr size_t WS_END = 716 * MiB;

namespace pg8 {
constexpr int BM = 256, BK = 64, HALF = 128, HTB = HALF * BK * 2, STAGE_BYTES = 8 * HTB, NXCD = 8, WGM = 8;
__host__ __device__ __forceinline__ int lds_byte(int r, int c) { const int st = (r >> 4) * 2 + (c >> 5), rr = r & 15, cc = c & 31, ob = rr * 64 + cc * 2; return st * 1024 + (ob ^ (((ob >> 9) & 1) << 5)); }
__host__ __device__ __forceinline__ void stage_rc(int b, int& R, int& C) { const int st = b / 1024, sb = b % 1024, swz = sb ^ (((sb >> 9) & 1) << 5); R = (st >> 1) * 16 + swz / 64; C = (st & 1) * 32 + (swz % 64) / 2; }
__host__ __device__ __forceinline__ int perm32(int rho) { const int n = rho >> 4, i = rho & 15; return 8 * (i >> 2) + 4 * n + (i & 3); }

struct Unit { int pm, pn, kind; };
struct Cfg { int K, lda, ldb; };

template <class Epi, class Sched, bool ALIGN_EPI>
__device__ __forceinline__ void gemm_phase(LAS unsigned char* lds, const Cfg g, const Sched& S, const Epi& E, const int wid) {
    const int lane = fresh_lane(), tid = wid * 64 + lane, wr = wid >> 2, wc = wid & 3, fr = lane & 15, fq = lane >> 4;
    const int K = g.K, nt = K / BK;
    unsigned voffA[2], voffB[2];
#pragma unroll
    for (int i = 0; i < 2; ++i) { int R, C; stage_rc(tid * 16 + i * 8192, R, C); const int Rb = (R & ~31) + perm32(R & 31);
        voffA[i] = (unsigned)(R * g.lda + C) * 2u; voffB[i] = (unsigned)(Rb * g.ldb + C) * 2u; }
    const size_t kstep = (size_t)(BK * 2);
    const size_t hA = (size_t)HALF * g.lda * 2, hB = (size_t)HALF * g.ldb * 2;
    const unsigned ldsw = (unsigned)wid * 1024u;
    const int aoff = lds_byte(wr * 64 + fr, fq * 8), boff = lds_byte(wc * 32 + fr, fq * 8);
#define PG8_SA(b, h) (((b) * 2 + (h)) * HTB)
#define PG8_SB(b, h) ((4 + (b) * 2 + (h)) * HTB)
#define PG8_STAGE(bufoff, gbase, voff) do { _Pragma("unroll") for (int _i = 0; _i < 2; ++_i) \
        __builtin_amdgcn_global_load_lds((const unsigned*)((const char*)(gbase) + (voff)[_i]), (LAS unsigned*)(lds + (bufoff) + ldsw + _i * 8192), 16, 0, 0); } while (0)
#define PG8_LDA(dst, b, h) do { _Pragma("unroll") for (int m = 0; m < 4; ++m) _Pragma("unroll") for (int k = 0; k < 2; ++k) dst[m][k] = *(const LAS bf16x8*)(lds + PG8_SA(b, h) + aoff + m * 2048 + k * 1024); } while (0)
#define PG8_LDB(dst, b, h) do { _Pragma("unroll") for (int n = 0; n < 2; ++n) _Pragma("unroll") for (int k = 0; k < 2; ++k) dst[n][k] = *(const LAS bf16x8*)(lds + PG8_SB(b, h) + boff + n * 2048 + k * 1024); } while (0)
#define PG8_MMA(ai, bj, At, Bt) do { __builtin_amdgcn_s_setprio(1); _Pragma("unroll") for (int m = 0; m < 4; ++m) _Pragma("unroll") for (int n = 0; n < 2; ++n) _Pragma("unroll") for (int k = 0; k < 2; ++k) \
        acc[ai][bj][m][n] = __builtin_amdgcn_mfma_f32_16x16x32_bf16(Bt[n][k], At[m][k], acc[ai][bj][m][n], 0, 0, 0); __builtin_amdgcn_s_setprio(0); } while (0)
#define PG8_WAIT_V(n) asm volatile("s_waitcnt vmcnt(" #n ")" ::: "memory")
#define PG8_WAIT_L(n) asm volatile("s_waitcnt lgkmcnt(" #n ")" ::: "memory")
#define PG8_BAR __builtin_amdgcn_s_barrier()
#define PG8_SCHED __builtin_amdgcn_sched_barrier(0)
    Unit cur, nxt; int ui = 0;
    if (!S.next(0, cur)) return;
    f32x4 acc[2][2][4][2];
    E.init(acc, cur, wr, wc, fr, fq);
    bf16x8 At[4][2], B0[2][2], B1[2][2];
    const char* cA = S.aptr(cur); const char* cB = S.bptr(cur);
    PG8_STAGE(PG8_SB(0, 0), cB, voffB); PG8_STAGE(PG8_SB(0, 1), cB + hB, voffB); PG8_STAGE(PG8_SA(0, 0), cA, voffA); PG8_STAGE(PG8_SA(0, 1), cA + hA, voffA);
    if (wr == 1) PG8_BAR;
    PG8_WAIT_V(2); PG8_BAR;
    PG8_STAGE(PG8_SB(1, 0), cB + kstep, voffB); PG8_STAGE(PG8_SA(1, 0), cA + kstep, voffA); PG8_STAGE(PG8_SB(1, 1), cB + hB + kstep, voffB);
    PG8_WAIT_V(6); PG8_BAR;
    for (;;) {
        const bool has_next = S.next(ui + 1, nxt);
        const char* nA = has_next ? S.aptr(nxt) : cA; const char* nB = has_next ? S.bptr(nxt) : cB;
#pragma unroll 1
        for (int t = 0; t < nt; t += 2) {
            const bool last = (t == nt - 2);
            const char* a1 = cA + (size_t)(t + 1) * kstep;
            const char* a2 = last ? nA : cA + (size_t)(t + 2) * kstep; const char* b2 = last ? nB : cB + (size_t)(t + 2) * kstep;
            const char* a3 = a2 + kstep; const char* b3 = b2 + kstep;
            PG8_LDB(B0, 0, 0); PG8_LDB(B1, 0, 1); PG8_SCHED; PG8_LDA(At, 0, 0); PG8_STAGE(PG8_SA(1, 1), a1 + hA, voffA);
            PG8_WAIT_V(8); PG8_WAIT_L(0); PG8_BAR; PG8_MMA(0, 0, At, B0); PG8_MMA(0, 1, At, B1); PG8_BAR; PG8_SCHED;
            PG8_LDA(At, 0, 1); PG8_STAGE(PG8_SB(0, 0), b2, voffB); PG8_STAGE(PG8_SB(0, 1), b2 + hB, voffB); PG8_STAGE(PG8_SA(0, 0), a2, voffA);
            PG8_WAIT_V(8); PG8_WAIT_L(0); PG8_BAR; PG8_MMA(1, 0, At, B0); PG8_MMA(1, 1, At, B1); PG8_BAR; PG8_SCHED;
            PG8_LDB(B0, 1, 0); PG8_LDB(B1, 1, 1); PG8_SCHED; PG8_LDA(At, 1, 0); PG8_STAGE(PG8_SA(0, 1), a2 + hA, voffA);
            PG8_WAIT_V(8); PG8_WAIT_L(0); PG8_BAR; PG8_MMA(0, 0, At, B0); PG8_MMA(0, 1, At, B1); PG8_BAR; PG8_SCHED;
            PG8_LDA(At, 1, 1); PG8_STAGE(PG8_SB(1, 0), b3, voffB); PG8_STAGE(PG8_SB(1, 1), b3 + hB, voffB); PG8_STAGE(PG8_SA(1, 0), a3, voffA);
            PG8_WAIT_V(8); PG8_WAIT_L(0); PG8_BAR; PG8_MMA(1, 0, At, B0); PG8_MMA(1, 1, At, B1); PG8_BAR; PG8_SCHED;
        }
        if constexpr (ALIGN_EPI) { if (wr == 0) PG8_BAR; }
        E(acc, cur, wr, wc, fr, fq);
        if (!has_next) break;
        E.init(acc, nxt, wr, wc, fr, fq);
        cur = nxt; cA = nA; cB = nB; ++ui;
        if constexpr (ALIGN_EPI) { if (wr == 1) PG8_BAR; }
    }
    PG8_WAIT_V(0);
    if constexpr (!ALIGN_EPI) { if (wr == 0) PG8_BAR; }
    PG8_BAR;
#undef PG8_SA
#undef PG8_SB
#undef PG8_STAGE
#undef PG8_LDA
#undef PG8_LDB
#undef PG8_MMA
#undef PG8_WAIT_V
#undef PG8_WAIT_L
#undef PG8_BAR
#undef PG8_SCHED
}

__device__ __forceinline__ void swz_tile(int L, int nM, int nN, int& pm, int& pn) {
    const int nwg = nM * nN; int wgid = L;
    { const int q = nwg / NXCD, r = nwg % NXCD, xcd = wgid % NXCD, off = wgid / NXCD; wgid = (xcd < r ? xcd * (q + 1) : r * (q + 1) + (xcd - r) * q) + off; }
    const int nig = WGM * nN, gid = wgid / nig, fm = gid * WGM, gsz = (nM - fm) < WGM ? (nM - fm) : WGM;
    pm = fm + ((wgid % nig) % gsz); pn = (wgid % nig) / gsz;
}
struct SchedGrid {
    int nM, nN, G, c; const char* A; const char* B; size_t tA, tB;
    __device__ __forceinline__ bool next(int i, Unit& u) const { const long L = (long)i * G + c; if (L >= (long)nM * nN) return false; swz_tile((int)L, nM, nN, u.pm, u.pn); u.kind = 0; return true; }
    __device__ __forceinline__ const char* aptr(const Unit& u) const { return A + (size_t)u.pm * tA; }
    __device__ __forceinline__ const char* bptr(const Unit& u) const { return B + (size_t)u.pn * tB; }
};
struct SchedMem {
    int c; const char* XN; const char* W;
    static constexpr size_t TS_ = (size_t)256 * 1024 * 2;
    __device__ __forceinline__ bool next(int i, Unit& u) const {
        if (i > 0 || c < 0 || c >= 48) return false;
        if (c < 32) { u.pm = 129 + (c >> 3); u.pn = 11 + (c & 7); u.kind = 1; } else { const int f = c - 32; u.pm = f >> 2; u.pn = f & 3; u.kind = 2; }
        return true;
    }
    __device__ __forceinline__ const char* aptr(const Unit& u) const { return u.kind == 2 ? W + (size_t)(15 + u.pm) * TS_ : XN + (size_t)u.pm * TS_; }
    __device__ __forceinline__ const char* bptr(const Unit& u) const { return u.kind == 2 ? XN + (size_t)(129 + u.pn) * TS_ : W + (size_t)u.pn * TS_; }
};
struct SchedX {
    int G, c; const char* A; const char* B; int bmode;
    __device__ __forceinline__ bool next(int i, Unit& u) const { const long L = (long)i * G + c; if (L >= 512) return false; u.pm = (int)L >> 2; u.pn = (int)L & 3; u.kind = 0; return true; }
    __device__ __forceinline__ const char* aptr(const Unit& u) const { return A + ((size_t)u.pm * 256 * 1024 + (size_t)u.pn * 256) * 2; }
    __device__ __forceinline__ const char* bptr(const Unit& u) const { const int b = u.pm >> 5; return bmode == 0 ? B + ((size_t)b * 256 * 1024 + (size_t)u.pn * 256) * 2 : B + ((size_t)u.pn * 256 * 1024 + (size_t)b * 256) * 2; }
};

struct SchedPanel {
    int G, vcu; const char* A; const char* B; size_t tA, tB;
    __device__ __forceinline__ bool next(int i, Unit& u) const { const int L = i * G + vcu; if (L >= 516) return false; u.pm = L >> 2; u.pn = L & 3; u.kind = 0; return true; }
    __device__ __forceinline__ const char* aptr(const Unit& u) const { return A + (size_t)u.pm * tA; }
    __device__ __forceinline__ const char* bptr(const Unit& u) const { return B + (size_t)u.pn * tB; }
};
struct SchedXL {
    int nl, rk, xi, nx; const char* A; const char* B; size_t tA, tB; int skip128;
    __device__ __forceinline__ bool next(int i, Unit& u) const { const int Lx = i * nl + rk, pm = xi + nx * (Lx >> 2); if (pm >= 129 || (skip128 && pm == 128)) return false; u.pm = pm; u.pn = Lx & 3; u.kind = 0; return true; }
    __device__ __forceinline__ const char* aptr(const Unit& u) const { return A + (size_t)u.pm * tA; }
    __device__ __forceinline__ const char* bptr(const Unit& u) const { return B + (size_t)u.pn * tB; }
};
struct SchedOne {
    int pm, pn; const char* A; const char* B; size_t tA, tB;
    __device__ __forceinline__ bool next(int i, Unit& u) const { if (i > 0) return false; u.pm = pm; u.pn = pn; u.kind = 0; return true; }
    __device__ __forceinline__ const char* aptr(const Unit& u) const { return A + (size_t)u.pm * tA; }
    __device__ __forceinline__ const char* bptr(const Unit& u) const { return B + (size_t)u.pn * tB; }
};
struct SchedXL22 {
    int nl, rk, xi, nx; const char* A; const char* B; size_t tA, tB;
    __device__ __forceinline__ bool next(int i, Unit& u) const { const int Lx = i * nl + rk, q = Lx / 22, pm = xi + nx * q; if (pm >= 129) return false; u.pm = pm; u.pn = Lx - q * 22; u.kind = 0; return true; }
    __device__ __forceinline__ const char* aptr(const Unit& u) const { return A + (size_t)u.pm * tA; }
    __device__ __forceinline__ const char* bptr(const Unit& u) const { return B + (size_t)u.pn * tB; }
};
struct SchedXLs {
    int nl, rk, xi, nx; const char* A; const char* B; int bmode;
    __device__ __forceinline__ bool next(int i, Unit& u) const {
        int idx = 0;
#pragma unroll 1
        for (int j = 0; j < 16; ++j) { const int Lx = j * nl + rk, pm = xi + nx * (Lx >> 2); if (pm >= 129) break; if (pm == 128) continue;
            if (idx == i) { u.pm = pm; u.pn = Lx & 3; u.kind = 0; return true; } ++idx; }
        return false;
    }
    __device__ __forceinline__ const char* aptr(const Unit& u) const { return A + ((size_t)u.pm * 256 * 1024 + (size_t)u.pn * 256) * 2; }
    __device__ __forceinline__ const char* bptr(const Unit& u) const { const int b = u.pm >> 5; return bmode == 0 ? B + ((size_t)b * 256 * 1024 + (size_t)u.pn * 256) * 2 : B + ((size_t)u.pn * 256 * 1024 + (size_t)b * 256) * 2; }
};
struct SchedXs {
    int G, c; const char* A; const char* B; int bmode;
    __device__ __forceinline__ bool next(int i, Unit& u) const {
        int idx = 0;
#pragma unroll
        for (int j = 0; j < 3; ++j) { const int L = j * G + c; if (L >= 516) break; int pm, pn; swz_tile(L, 129, 4, pm, pn); if (pm == 128) continue;
            if (idx == i) { u.pm = pm; u.pn = pn; u.kind = 0; return true; } ++idx; }
        return false;
    }
    __device__ __forceinline__ const char* aptr(const Unit& u) const { return A + ((size_t)u.pm * 256 * 1024 + (size_t)u.pn * 256) * 2; }
    __device__ __forceinline__ const char* bptr(const Unit& u) const { const int b = u.pm >> 5; return bmode == 0 ? B + ((size_t)b * 256 * 1024 + (size_t)u.pn * 256) * 2 : B + ((size_t)u.pn * 256 * 1024 + (size_t)b * 256) * 2; }
};

#define EPI_ARGS const f32x4 (&acc)[2][2][4][2], const Unit& u, int wr, int wc, int fr, int fq
#define EPI_ZERO_INIT __device__ __forceinline__ void init(f32x4 (&acc)[2][2][4][2], const Unit&, int, int, int, int) const { \
    _Pragma("unroll") for (int a = 0; a < 2; ++a) _Pragma("unroll") for (int b = 0; b < 2; ++b) _Pragma("unroll") for (int m = 0; m < 4; ++m) _Pragma("unroll") for (int n = 0; n < 2; ++n) acc[a][b][m][n] = (f32x4){0.f, 0.f, 0.f, 0.f}; }
struct EpiIn {
    unsigned char* ws; float* out;
    EPI_ZERO_INIT
    __device__ __forceinline__ void operator()(EPI_ARGS) const {
        const int lr0 = wr * 64 + fr, lc0 = wc * 32 + 8 * fq;
        const int pm = u.pm, pn = u.pn;
        const bool smp = (pm == 128);
#ifdef P1_NO_QKV
        if (false) {
#else
        if (pn < 9) {
#endif
            const int sec = pn / 3, cb = (pn - sec * 3) * 256 + lc0;
            bf16_t* dst = (bf16_t*)(ws + (sec == 0 ? WS_QB : (sec == 1 ? WS_KB : WS_VB)));
            const float sc = sec == 0 ? QSCALE : 1.f;
#pragma unroll
            for (int ai = 0; ai < 2; ++ai)
#pragma unroll
                for (int m = 0; m < 4; ++m) {
                    bf16_t* rowp = dst + ((size_t)pm * 256 + lr0 + 128 * ai + 16 * m) * AW + cb;
#pragma unroll
                    for (int bj = 0; bj < 2; ++bj) {
                        const f32x4 v0 = acc[ai][bj][m][0] * sc, v1 = acc[ai][bj][m][1] * sc;
                        u32x4 w; w.x = pkbf(v0[0], v0[1]); w.y = pkbf(v0[2], v0[3]); w.z = pkbf(v1[0], v1[1]); w.w = pkbf(v1[2], v1[3]);
                        *(u32x4*)(rowp + bj * 128) = w;
                    }
                }
            if (sec > 0 && (smp || (pm & 31) >= 24)) {
                float* fb; size_t sa, sm;
                if (smp) { fb = out + (sec == 1 ? OFF_SWK : OFF_SWV) + ((size_t)(8 * wr + (fr >> 3)) * WBUF + (WBUF - TS) + (fr & 7)) * AW + cb; sa = (size_t)16 * WBUF * AW; sm = (size_t)2 * WBUF * AW; }
                else { fb = out + (sec == 1 ? OFF_PWK : OFF_PWV) + ((size_t)(pm >> 5) * WBUF + ((pm & 31) - 24) * 256 + lr0) * AW + cb; sa = (size_t)128 * AW; sm = (size_t)16 * AW; }
#pragma unroll
                for (int ai = 0; ai < 2; ++ai)
#pragma unroll
                    for (int m = 0; m < 4; ++m)
#pragma unroll
                        for (int bj = 0; bj < 2; ++bj) { float* fp = fb + ai * sa + m * sm + bj * 128; *(f32x4*)fp = acc[ai][bj][m][0]; *(f32x4*)(fp + 4) = acc[ai][bj][m][1]; }
            }
#ifdef P1_NO_GLU
        } else if (false) {
#else
        } else {
#endif
            const int c0 = (pn - 9) * 128 + lc0;
            float* U = (float*)(ws + WS_U);
#pragma unroll
            for (int ai = 0; ai < 2; ++ai)
#pragma unroll
                for (int m = 0; m < 4; ++m) {
                    const size_t grow = (size_t)pm * 256 + lr0 + 128 * ai + 16 * m;
#pragma unroll
                    for (int n = 0; n < 2; ++n) {
                        const f32x4 a = acc[ai][0][m][n], gg = acc[ai][1][m][n]; f32x4 uu;
#pragma unroll
                        for (int e = 0; e < 4; ++e) uu[e] = a[e] * fast_rcp(1.f + fast_exp2(-gg[e] * LOG2E));
                        *(f32x4*)(U + grow * CWD + c0 + 4 * n) = uu;
                    }
                }
            if (smp) {
                float* fb = out + OFF_SCONV + ((size_t)(8 * wr + (fr >> 3)) * 30 + 22 + (fr & 7)) * CWD + c0;
#pragma unroll
                for (int ai = 0; ai < 2; ++ai)
#pragma unroll
                    for (int m = 0; m < 4; ++m)
#pragma unroll
                        for (int n = 0; n < 2; ++n) {
                            const f32x4 a = acc[ai][0][m][n], gg = acc[ai][1][m][n]; f32x4 uu;
#pragma unroll
                            for (int e = 0; e < 4; ++e) uu[e] = a[e] * fast_rcp(1.f + fast_exp2(-gg[e] * LOG2E));
                            *(f32x4*)(fb + (size_t)(16 * ai + 2 * m) * 30 * CWD + 4 * n) = uu;
                        }
            } else if ((pm & 31) == 31 && wr == 1) {
#pragma unroll
                for (int m = 2; m < 4; ++m) {
                    const int lr = lr0 + 128 + 16 * m;
                    if (lr >= 226) {
                        float* fb = out + OFF_PCONV + ((size_t)(pm >> 5) * 30 + (lr - 226)) * CWD + c0;
#pragma unroll
                        for (int n = 0; n < 2; ++n) {
                            const f32x4 a = acc[1][0][m][n], gg = acc[1][1][m][n]; f32x4 uu;
#pragma unroll
                            for (int e = 0; e < 4; ++e) uu[e] = a[e] * fast_rcp(1.f + fast_exp2(-gg[e] * LOG2E));
                            *(f32x4*)(fb + 4 * n) = uu;
                        }
                    }
                }
            }
        }
    }
};
struct EpiMem {
    unsigned char* ws; float* out;
    EPI_ZERO_INIT
    __device__ __forceinline__ void operator()(EPI_ARGS) const {
        const int lr0 = wr * 64 + fr, lc0 = wc * 32 + 8 * fq;
        if (u.kind == 1) {
            const int sec = (u.pn - 11) >> 2, cb = ((u.pn - 11) & 3) * 256 + lc0;
            float* fo = out + (sec ? OFF_PMV : OFF_PMK); bf16_t* MKB = (bf16_t*)(ws + WS_MKB);
#pragma unroll
            for (int ai = 0; ai < 2; ++ai)
#pragma unroll
                for (int m = 0; m < 4; ++m) {
                    const size_t mr = (size_t)(u.pm - 129) * 256 + lr0 + 128 * ai + 16 * m;
#pragma unroll
                    for (int bj = 0; bj < 2; ++bj) {
                        const f32x4 v0 = acc[ai][bj][m][0], v1 = acc[ai][bj][m][1];
                        float* fp = fo + mr * 1024 + cb + bj * 128; *(f32x4*)fp = v0; *(f32x4*)(fp + 4) = v1;
                        if (sec == 0) { u32x4 w; w.x = pkbf(v0[0], v0[1]); w.y = pkbf(v0[2], v0[3]); w.z = pkbf(v1[0], v1[1]); w.w = pkbf(v1[2], v1[3]); *(u32x4*)(MKB + mr * 1024 + cb + bj * 128) = w; }
                    }
                }
        } else {
            bf16_t* MVT = (bf16_t*)(ws + WS_MVT);
#pragma unroll
            for (int ai = 0; ai < 2; ++ai)
#pragma unroll
                for (int m = 0; m < 4; ++m) {
                    const size_t nr = (size_t)u.pm * 256 + lr0 + 128 * ai + 16 * m;
#pragma unroll
                    for (int bj = 0; bj < 2; ++bj) {
                        const f32x4 v0 = acc[ai][bj][m][0], v1 = acc[ai][bj][m][1];
                        u32x4 w; w.x = pkbf(v0[0], v0[1]); w.y = pkbf(v0[2], v0[3]); w.z = pkbf(v1[0], v1[1]); w.w = pkbf(v1[2], v1[3]);
                        *(u32x4*)(MVT + nr * 1024 + u.pn * 256 + lc0 + bj * 128) = w;
                    }
                }
        }
    }
};
__device__ __forceinline__ void init_from_xn(f32x4 (&acc)[2][2][4][2], const bf16_t* XN, const float* g, const Unit& u, int wr, int wc, int fr, int fq) {
    const int lr0 = wr * 64 + fr, c0 = u.pn * 256 + wc * 32 + 8 * fq;
    f32x4 rg[2][2];
#pragma unroll
    for (int bj = 0; bj < 2; ++bj)
#pragma unroll
        for (int n = 0; n < 2; ++n) { const f32x4 gg = *(const f32x4*)(g + c0 + bj * 128 + 4 * n); rg[bj][n] = (f32x4){fast_rcp(gg[0]), fast_rcp(gg[1]), fast_rcp(gg[2]), fast_rcp(gg[3])}; }
#pragma unroll
    for (int ai = 0; ai < 2; ++ai)
#pragma unroll
        for (int m = 0; m < 4; ++m) {
            const unsigned ro = (unsigned)((u.pm * 256 + lr0 + 128 * ai + 16 * m) * DM + c0) * 2u;
#pragma unroll
            for (int bj = 0; bj < 2; ++bj) { const u32x4 w = *(const u32x4*)((const char*)XN + ro + bj * 256);
                acc[ai][bj][m][0] = (f32x4){bf_lo(w.x), bf_hi(w.x), bf_lo(w.y), bf_hi(w.y)} * rg[bj][0];
                acc[ai][bj][m][1] = (f32x4){bf_lo(w.z), bf_hi(w.z), bf_lo(w.w), bf_hi(w.w)} * rg[bj][1]; }
        }
}
template <bool RESX> struct EpiRes {
    const float* resP; const float* resS; const float* gp; bf16_t* XN; const float* g; float* SSQ;
    __device__ __forceinline__ void init(f32x4 (&acc)[2][2][4][2], const Unit& u, int wr, int wc, int fr, int fq) const {
        if (RESX) {
            const int lr0 = wr * 64 + fr, c0 = u.pn * 256 + wc * 32 + 8 * fq;
            const float* res = (u.pm == 128) ? resS - (size_t)MP * DM : resP;
#pragma unroll
            for (int ai = 0; ai < 2; ++ai)
#pragma unroll
                for (int m = 0; m < 4; ++m) {
                    const float* rp = res + ((size_t)u.pm * 256 + lr0 + 128 * ai + 16 * m) * DM + c0;
#pragma unroll
                    for (int bj = 0; bj < 2; ++bj) { acc[ai][bj][m][0] = *(const f32x4*)(rp + bj * 128); acc[ai][bj][m][1] = *(const f32x4*)(rp + bj * 128 + 4); }
                }
        } else init_from_xn(acc, XN, gp, u, wr, wc, fr, fq);
    }
    __device__ __forceinline__ void operator()(EPI_ARGS) const {
        const int lr0 = wr * 64 + fr, c0 = u.pn * 256 + wc * 32 + 8 * fq;
        f32x4 gv[2][2];
#pragma unroll
        for (int bj = 0; bj < 2; ++bj)
#pragma unroll
            for (int n = 0; n < 2; ++n) gv[bj][n] = *(const f32x4*)(g + c0 + bj * 128 + 4 * n);
#pragma unroll
        for (int ai = 0; ai < 2; ++ai)
#pragma unroll
            for (int m = 0; m < 4; ++m) {
                const size_t grow = (size_t)u.pm * 256 + lr0 + 128 * ai + 16 * m; const size_t off = grow * DM + c0;
                float ss = 0.f;
#pragma unroll
                for (int bj = 0; bj < 2; ++bj) {
                    f32x4 x0 = acc[ai][bj][m][0], x1 = acc[ai][bj][m][1];
                    ss += (x0[0] * x0[0] + x0[1] * x0[1]) + (x0[2] * x0[2] + x0[3] * x0[3]) + (x1[0] * x1[0] + x1[1] * x1[1]) + (x1[2] * x1[2] + x1[3] * x1[3]);
                    x0 = x0 * gv[bj][0]; x1 = x1 * gv[bj][1];
                    u32x4 w; w.x = pkbf(x0[0], x0[1]); w.y = pkbf(x0[2], x0[3]); w.z = pkbf(x1[0], x1[1]); w.w = pkbf(x1[2], x1[3]);
                    *(u32x4*)(XN + off + bj * 128) = w;
                }
                ss += __shfl_xor(ss, 16); ss += __shfl_xor(ss, 32);
                if (fq == 0) SSQ[grow * 16 + u.pn * 4 + wc] = ss;
            }
    }
};
struct EpiFinal {
    const bf16_t* XN; const float* gp; float* Y; const float* g; float* slots; unsigned* cnt; LAS float* xl; int wave;
    __device__ __forceinline__ void init(f32x4 (&acc)[2][2][4][2], const Unit& u, int wr, int wc, int fr, int fq) const { init_from_xn(acc, XN, gp, u, wr, wc, fr, fq); }
    __device__ __forceinline__ void operator()(EPI_ARGS) const {
        const int lr0 = wr * 64 + fr, c0 = u.pn * 256 + wc * 32 + 8 * fq;
        const int lane = fr + 16 * fq;
#pragma unroll
        for (int ai = 0; ai < 2; ++ai)
#pragma unroll
            for (int m = 0; m < 4; ++m) {
                float ss = 0.f;
#pragma unroll
                for (int bj = 0; bj < 2; ++bj)
#pragma unroll
                    for (int n = 0; n < 2; ++n) { const f32x4 x = acc[ai][bj][m][n]; ss += (x[0] * x[0] + x[1] * x[1]) + (x[2] * x[2] + x[3] * x[3]); }
                ss += __shfl_xor(ss, 16); ss += __shfl_xor(ss, 32);
                if (fq == 0) xl[(lr0 + 128 * ai + 16 * m) * 4 + wc] = ss;
            }
        asm volatile("s_waitcnt lgkmcnt(0)" ::: "memory"); __builtin_amdgcn_s_barrier(); asm volatile("" ::: "memory");
        const int row = wave * 32 + (lane & 31);
        if (lane < 32) { const f32x4 q4 = *(const LAS f32x4*)(xl + row * 4);
            __hip_atomic_store(slots + ((size_t)u.pm * 256 + row) * 4 + u.pn, (q4[0] + q4[1]) + (q4[2] + q4[3]), __ATOMIC_RELAXED, __HIP_MEMORY_SCOPE_AGENT); }
        asm volatile("s_waitcnt vmcnt(0)" ::: "memory");
        if (lane == 0) __hip_atomic_fetch_add(cnt + 64 * u.pm, 1u, __ATOMIC_RELAXED, __HIP_MEMORY_SCOPE_AGENT);
        if (wave == 0) {
            unsigned sp = 0;
            while ((unsigned)__builtin_amdgcn_readfirstlane(__hip_atomic_load(cnt + 64 * u.pm, __ATOMIC_RELAXED, __HIP_MEMORY_SCOPE_AGENT)) < 32u) { __builtin_amdgcn_s_sleep(2); if (++sp > (1u << 21)) break; }
            __builtin_amdgcn_fence(__ATOMIC_ACQUIRE, "agent");
        }
        asm volatile("s_waitcnt vmcnt(0) lgkmcnt(0)" ::: "memory"); __builtin_amdgcn_s_barrier(); asm volatile("" ::: "memory");
        if (lane < 32) { const float* sl = slots + ((size_t)u.pm * 256 + row) * 4; float t = 0.f;
#pragma unroll
            for (int k = 0; k < 4; ++k) t += __hip_atomic_load(sl + k, __ATOMIC_RELAXED, __HIP_MEMORY_SCOPE_AGENT);
            xl[1024 + row] = 1.0f / sqrtf(t * (1.0f / DM) + EPS); }
        asm volatile("s_waitcnt vmcnt(0) lgkmcnt(0)" ::: "memory"); __builtin_amdgcn_s_barrier(); asm volatile("" ::: "memory");
#pragma unroll
        for (int ai = 0; ai < 2; ++ai)
#pragma unroll
            for (int m = 0; m < 4; ++m) {
                const int lr = lr0 + 128 * ai + 16 * m; const float rs = xl[1024 + lr]; float* yp = Y + ((size_t)u.pm * 256 + lr) * DM + c0;
#pragma unroll
                for (int bj = 0; bj < 2; ++bj) { const f32x4 g0 = *(const f32x4*)(g + c0 + bj * 128), g1 = *(const f32x4*)(g + c0 + bj * 128 + 4);
                    *(f32x4*)(yp + bj * 128) = acc[ai][bj][m][0] * rs * g0; *(f32x4*)(yp + bj * 128 + 4) = acc[ai][bj][m][1] * rs * g1; }
                asm volatile("" ::: "memory");
            }
        asm volatile("s_waitcnt lgkmcnt(0)" ::: "memory"); __builtin_amdgcn_s_barrier(); asm volatile("" ::: "memory");
    }
};
__device__ __forceinline__ float row_rstd(const float* SSQ, size_t grow) {
    const f32x4* p = (const f32x4*)(SSQ + grow * 16); const f32x4 a = p[0], b = p[1], c = p[2], d = p[3];
    const float s = ((a[0] + a[1]) + (a[2] + a[3])) + ((b[0] + b[1]) + (b[2] + b[3])) + ((c[0] + c[1]) + (c[2] + c[3])) + ((d[0] + d[1]) + (d[2] + d[3]));
    return 1.0f / sqrtf(s * (1.0f / DM) + EPS);
}
__device__ __forceinline__ void rows_rstd8(const float* SSQ, size_t row0, int fq, float (&rs)[2][4]) {
    f32x4 pre[2][4];
#pragma unroll
    for (int ai = 0; ai < 2; ++ai)
#pragma unroll
        for (int m = 0; m < 4; ++m) pre[ai][m] = *(const f32x4*)(SSQ + (row0 + 128 * ai + 16 * m) * 16 + fq * 4);
    __builtin_amdgcn_sched_barrier(0);
#pragma unroll
    for (int ai = 0; ai < 2; ++ai)
#pragma unroll
        for (int m = 0; m < 4; ++m) { float sq = (pre[ai][m][0] + pre[ai][m][1]) + (pre[ai][m][2] + pre[ai][m][3]); sq += __shfl_xor(sq, 16); sq += __shfl_xor(sq, 32);
            rs[ai][m] = 1.0f / sqrtf(sq * (1.0f / DM) + EPS); }
}
struct EpiScale {
    bf16_t* O; const float* SSQ; float sc;
    EPI_ZERO_INIT
    __device__ __forceinline__ void operator()(EPI_ARGS) const {
        const int lr0 = wr * 64 + fr, c0 = u.pn * 256 + wc * 32 + 8 * fq;
        float rsv[2][4]; rows_rstd8(SSQ, (size_t)u.pm * 256 + lr0, fq, rsv);
#pragma unroll
        for (int ai = 0; ai < 2; ++ai)
#pragma unroll
            for (int m = 0; m < 4; ++m) {
                const size_t grow = (size_t)u.pm * 256 + lr0 + 128 * ai + 16 * m; const float rs = rsv[ai][m] * sc;
#pragma unroll
                for (int bj = 0; bj < 2; ++bj) {
                    const f32x4 v0 = acc[ai][bj][m][0] * rs, v1 = acc[ai][bj][m][1] * rs;
                    u32x4 w; w.x = pkbf(v0[0], v0[1]); w.y = pkbf(v0[2], v0[3]); w.z = pkbf(v1[0], v1[1]); w.w = pkbf(v1[2], v1[3]);
                    *(u32x4*)(O + grow * DM + c0 + bj * 128) = w;
                }
            }
    }
};
struct EpiSwiGLU {
    bf16_t* H; const float* SSQ;
    EPI_ZERO_INIT
    __device__ __forceinline__ void operator()(EPI_ARGS) const {
        const int lr0 = wr * 64 + fr, c0 = u.pn * 128 + wc * 32 + 8 * fq;
        float rsv[2][4]; rows_rstd8(SSQ, (size_t)u.pm * 256 + lr0, fq, rsv);
#pragma unroll
        for (int ai = 0; ai < 2; ++ai)
#pragma unroll
            for (int m = 0; m < 4; ++m) {
                const size_t grow = (size_t)u.pm * 256 + lr0 + 128 * ai + 16 * m; const float rs = rsv[ai][m];
                float hv[8];
#pragma unroll
                for (int n = 0; n < 2; ++n)
#pragma unroll
                    for (int e = 0; e < 4; ++e) { const float gt = acc[ai][0][m][n][e] * rs, up = acc[ai][1][m][n][e] * rs; hv[4 * n + e] = gt * fast_rcp(1.f + fast_exp2(-gt * LOG2E)) * up; }
                u32x4 w; w.x = pkbf(hv[0], hv[1]); w.y = pkbf(hv[2], hv[3]); w.z = pkbf(hv[4], hv[5]); w.w = pkbf(hv[6], hv[7]);
                *(u32x4*)(H + grow * DFF + c0) = w;
            }
    }
};
struct EpiSoftmax {
    bf16_t* P; float* LSUM; LAS float* xch;
    EPI_ZERO_INIT
    __device__ __forceinline__ void operator()(EPI_ARGS) const {
        const int lr0 = wr * 64 + fr, c0 = u.pn * 256 + wc * 32 + 8 * fq;
#pragma unroll
        for (int ai = 0; ai < 2; ++ai)
#pragma unroll
            for (int m = 0; m < 4; ++m) {
                float v = -3.0e38f;
#pragma unroll
                for (int bj = 0; bj < 2; ++bj)
#pragma unroll
                    for (int n = 0; n < 2; ++n) { const f32x4 x = acc[ai][bj][m][n]; v = fmaxf(v, fmaxf(fmaxf(x[0], x[1]), fmaxf(x[2], x[3]))); }
                v = fmaxf(v, __shfl_xor(v, 16)); v = fmaxf(v, __shfl_xor(v, 32));
                if (fq == 0) xch[(lr0 + 128 * ai + 16 * m) * 4 + wc] = v;
            }
        asm volatile("s_waitcnt lgkmcnt(0)" ::: "memory"); __builtin_amdgcn_s_barrier(); asm volatile("" ::: "memory");
#pragma unroll
        for (int ai = 0; ai < 2; ++ai)
#pragma unroll
            for (int m = 0; m < 4; ++m) {
                const f32x4 q4 = *(const LAS f32x4*)(xch + (lr0 + 128 * ai + 16 * m) * 4); const float mx = fmaxf(fmaxf(q4[0], q4[1]), fmaxf(q4[2], q4[3]));
                const size_t grow = (size_t)u.pm * 256 + lr0 + 128 * ai + 16 * m; float ss = 0.f;
#pragma unroll
                for (int bj = 0; bj < 2; ++bj) {
                    f32x4 p0, p1;
#pragma unroll
                    for (int e = 0; e < 4; ++e) { p0[e] = fast_exp2(acc[ai][bj][m][0][e] - mx); p1[e] = fast_exp2(acc[ai][bj][m][1][e] - mx); }
                    ss += ((p0[0] + p0[1]) + (p0[2] + p0[3])) + ((p1[0] + p1[1]) + (p1[2] + p1[3]));
                    u32x4 w; w.x = pkbf(p0[0], p0[1]); w.y = pkbf(p0[2], p0[3]); w.z = pkbf(p1[0], p1[1]); w.w = pkbf(p1[2], p1[3]);
                    *(u32x4*)(P + grow * DM + c0 + bj * 128) = w;
                }
                ss += __shfl_xor(ss, 16); ss += __shfl_xor(ss, 32);
                if (fq == 0) LSUM[grow * 16 + u.pn * 4 + wc] = ss;
                asm volatile("" ::: "memory"); __builtin_amdgcn_sched_barrier(0);
            }
    }
};
struct EpiPV {
    bf16_t* O; const float* LSUM;
    EPI_ZERO_INIT
    __device__ __forceinline__ void operator()(EPI_ARGS) const {
        const int lr0 = wr * 64 + fr, c0 = u.pn * 256 + wc * 32 + 8 * fq;
        f32x4 pre[2][4];
#pragma unroll
        for (int ai = 0; ai < 2; ++ai)
#pragma unroll
            for (int m = 0; m < 4; ++m) pre[ai][m] = *(const f32x4*)(LSUM + ((size_t)u.pm * 256 + lr0 + 128 * ai + 16 * m) * 16 + u.pn * 4);
        __builtin_amdgcn_sched_barrier(0);
#pragma unroll
        for (int ai = 0; ai < 2; ++ai)
#pragma unroll
            for (int m = 0; m < 4; ++m) {
                const size_t grow = (size_t)u.pm * 256 + lr0 + 128 * ai + 16 * m;
                const f32x4 l4 = pre[ai][m]; const float rs = 1.0f / ((l4[0] + l4[1]) + (l4[2] + l4[3]));
#pragma unroll
                for (int bj = 0; bj < 2; ++bj) {
                    const f32x4 v0 = acc[ai][bj][m][0] * rs, v1 = acc[ai][bj][m][1] * rs;
                    u32x4 w; w.x = pkbf(v0[0], v0[1]); w.y = pkbf(v0[2], v0[3]); w.z = pkbf(v1[0], v1[1]); w.w = pkbf(v1[2], v1[3]);
                    *(u32x4*)(O + grow * DM + c0 + bj * 128) = w;
                }
            }
    }
};
}

#define XB_TMO      128
#define XB_XCNT(j)  (256  + 64 * (j))
#define XB_XSUB(j)  (1280 + 64 * (j))
#define XB_XGEN(j)  (2304 + 64 * (j))
#define XB_TOP      3328
#define XB_TOPGEN   3392
#define XCD_BAR_WORDS 3456
#define XB_SPIN_CAP (1u << 18)
__device__ __forceinline__ unsigned xb_ld(unsigned* p)              { return __hip_atomic_load(p, __ATOMIC_RELAXED, __HIP_MEMORY_SCOPE_AGENT); }
__device__ __forceinline__ unsigned xb_add(unsigned* p, unsigned v) { return __hip_atomic_fetch_add(p, v, __ATOMIC_RELAXED, __HIP_MEMORY_SCOPE_AGENT); }
__device__ __forceinline__ unsigned xb_xcc_id() { return (unsigned)__builtin_amdgcn_s_getreg((3 << 11) | 20) & 0xFu; }
#define XB_SPIN(cond, bar) do { unsigned _sp = 0; while (cond) { __builtin_amdgcn_s_sleep(1); \
    if ((++_sp & 255u) == 0u) { if (xb_ld(&(bar)[XB_TMO])) break; if (_sp > XB_SPIN_CAP) { atomicAdd(&(bar)[XB_TMO], 1u); break; } } } } while (0)
struct XcdBarrier { unsigned* bar; unsigned x; volatile LAS unsigned* st; };
__device__ __forceinline__ XcdBarrier xcd_barrier_post(unsigned* bar, volatile LAS unsigned* st) {
    XcdBarrier b; b.bar = bar; b.x = xb_xcc_id(); b.st = st;
    if (threadIdx.x == 0) st[3] = xb_add(&bar[XB_XCNT(b.x)], 1u);
    return b;
}
__device__ __forceinline__ void xcd_barrier_complete(unsigned* bar, unsigned x, unsigned& nloc, unsigned& nx, unsigned& xi) {
    const unsigned G = gridDim.x * gridDim.y * gridDim.z;
    unsigned sum, cnt, mine, sp = 0u;
    for (;;) {
        sum = 0u; cnt = 0u; mine = 0u; xi = 0u;
#pragma unroll
        for (unsigned j = 0; j < 16; ++j) { const unsigned c = xb_ld(&bar[XB_XCNT(j)]); sum += c; cnt += (c > 0u) ? 1u : 0u; mine = (j == x) ? c : mine; xi += (c > 0u && j < x) ? 1u : 0u; }
        if (sum == G) break;
        __builtin_amdgcn_s_sleep(1);
        if ((++sp & 255u) == 0u) { if (xb_ld(&bar[XB_TMO])) break; if (sp > XB_SPIN_CAP) { atomicAdd(&bar[XB_TMO], 1u); break; } }
    }
    nloc = mine > 0u ? mine : 1u; nx = cnt > 0u ? cnt : 1u;
}
__device__ __forceinline__ void xcd_barrier(const XcdBarrier& b) {
    asm volatile("s_waitcnt vmcnt(0)" ::: "memory");
    __syncthreads();
    if (threadIdx.x == 0) {
        unsigned* bar = b.bar;
        __builtin_amdgcn_s_waitcnt(0);
        unsigned nloc = b.st[0], nx = b.st[1];
        if (nloc == 0u) { unsigned xi; xcd_barrier_complete(bar, b.x, nloc, nx, xi); b.st[0] = nloc; b.st[1] = nx; b.st[2] = xi; }
        const unsigned old = xb_add(&bar[XB_XSUB(b.x)], 1u);
        const unsigned gen = old / nloc;
        if (old + 1u == (gen + 1u) * nloc) {
            __builtin_amdgcn_fence(__ATOMIC_RELEASE, "agent");
            asm volatile("s_waitcnt vmcnt(0)" ::: "memory");
            const unsigned og = xb_add(&bar[XB_TOP], 1u);
            const unsigned tg = og / nx;
            if (og + 1u == (tg + 1u) * nx) xb_add(&bar[XB_TOPGEN], 1u);
            else XB_SPIN(xb_ld(&bar[XB_TOPGEN]) == tg, bar);
            __builtin_amdgcn_fence(__ATOMIC_ACQUIRE, "agent");
            xb_add(&bar[XB_XGEN(b.x)], 1u);
            asm volatile("s_waitcnt vmcnt(0)" ::: "memory");
        } else {
            XB_SPIN(xb_ld(&bar[XB_XGEN(b.x)]) == gen, bar);
            __builtin_amdgcn_fence(__ATOMIC_ACQUIRE, "agent");
            asm volatile("s_waitcnt vmcnt(0)" ::: "memory");
        }
    }
    __syncthreads();
}

#define XL_SUB(j) (3584 + 64 * (j))
#define XL_GEN(j) (12416 + 64 * (j))
__device__ __forceinline__ void xl_barrier(const XcdBarrier& b) {
    asm volatile("s_waitcnt vmcnt(0)" ::: "memory");
    __syncthreads();
    if (threadIdx.x == 0) {
        unsigned* bar = b.bar; const unsigned nloc = b.st[0], xd = b.st[2] & 7u;
        const unsigned old = xb_add(&bar[XL_SUB(xd)], 1u), gen = old / nloc;
        if (old + 1u == (gen + 1u) * nloc) xb_add(&bar[XL_GEN(xd)], 1u);
        else XB_SPIN(xb_ld(&bar[XL_GEN(xd)]) == gen, bar);
        __builtin_amdgcn_fence(__ATOMIC_ACQUIRE, "agent");
        asm volatile("s_waitcnt vmcnt(0)" ::: "memory");
    }
    __syncthreads();
}

constexpr int RING_BYTES = 131072;
constexpr int XCH_OFF = RING_BYTES;
constexpr int MISC_OFF = RING_BYTES + 6144;
constexpr int LDS_BYTES = RING_BYTES + 8192;
constexpr int ATT_V_OFF = 0, ATT_WBUF = 12800, ATT_TAB_OFF = 8 * ATT_WBUF, ATT_CW_OFF = 65536;

struct Params {
    const float* in[27]; float* out; unsigned char* ws; int ph_lo, ph_hi, coop, pad;
};

__device__ __forceinline__ float wave_sum(float v) {
#pragma unroll
    for (int o = 1; o < 64; o <<= 1) v += __shfl_xor(v, o);
    return v;
}
__device__ __forceinline__ void transpose_item(const float* W, int K, int N, bf16_t* WT, int item, int mode, LAS float* scr, int lane) {
    const int nblk = N / 32, kb = item / nblk, nb = item % nblk, k0 = 64 * kb, n0 = 32 * nb;
    int r0 = n0;
    if (mode == 1) { if (n0 >= 2304) { const int isg = n0 >= 2560, cch = n0 - (isg ? 2560 : 2304); r0 = 2304 + (cch >> 7) * 256 + isg * 128 + (cch & 127); } }
    else if (mode == 2) r0 = (n0 >> 7) * 256 + (n0 & 127);
    else if (mode == 3) r0 = (n0 >> 7) * 256 + 128 + (n0 & 127);
    float wv[32];
#pragma unroll
    for (int i = 0; i < 32; ++i) wv[i] = W[(size_t)(k0 + 2 * i + (lane >> 5)) * N + n0 + (lane & 31)];
#pragma unroll
    for (int i = 0; i < 32; ++i) scr[(2 * i + (lane >> 5)) * 33 + (lane & 31)] = wv[i];
    asm volatile("s_waitcnt lgkmcnt(0)" ::: "memory");
    const int c = lane & 7;
#pragma unroll
    for (int j = 0; j < 4; ++j) { const int n = (lane >> 3) + 8 * j; const LAS float* s = scr + (8 * c) * 33 + n;
        u32x4 o; o.x = pkbf(s[0 * 33], s[1 * 33]); o.y = pkbf(s[2 * 33], s[3 * 33]); o.z = pkbf(s[4 * 33], s[5 * 33]); o.w = pkbf(s[6 * 33], s[7 * 33]);
        *(u32x4*)(WT + (size_t)(r0 + n) * K + k0 + 8 * c) = o; }
    asm volatile("s_waitcnt lgkmcnt(0)" ::: "memory");
}
template <int NR> __device__ __forceinline__ void rms_rows_bf16(const float* const (&xrow)[NR], const float* g, bf16_t* const (&orow)[NR], int lane) {
    f32x4 v[NR][4];
#pragma unroll
    for (int r = 0; r < NR; ++r)
#pragma unroll
        for (int j = 0; j < 4; ++j) v[r][j] = ((const f32x4*)xrow[r] + lane)[64 * j];
    const f32x4* gr = (const f32x4*)g + lane;
    f32x4 gg[4];
#pragma unroll
    for (int j = 0; j < 4; ++j) gg[j] = gr[64 * j];
#pragma unroll
    for (int r = 0; r < NR; ++r) {
        float s = 0.f;
#pragma unroll
        for (int j = 0; j < 4; ++j) s += (v[r][j][0] * v[r][j][0] + v[r][j][1] * v[r][j][1]) + (v[r][j][2] * v[r][j][2] + v[r][j][3] * v[r][j][3]);
        const float rstd = 1.0f / sqrtf(wave_sum(s) * (1.0f / DM) + EPS);
        u32x2* o8 = (u32x2*)orow[r] + lane;
#pragma unroll
        for (int j = 0; j < 4; ++j) { u32x2 w; w.x = pkbf(v[r][j][0] * rstd * gg[j][0], v[r][j][1] * rstd * gg[j][1]); w.y = pkbf(v[r][j][2] * rstd * gg[j][2], v[r][j][3] * rstd * gg[j][3]); o8[64 * j] = w; }
    }
}

namespace att {
__device__ __forceinline__ int crow(int r, int hi) { return (r & 3) + 8 * (r >> 2) + 4 * hi; }
struct Ctx {
    const bf16_t *QB, *KB, *VB; const float *CK, *CV;
    bf16_t* OP; float* LSE; bf16_t* ATT;
};
__device__ __forceinline__ bf16x8 ld8_bf16(const bf16_t* p) { return *(const bf16x8*)p; }
__device__ __forceinline__ bf16x8 ld8_f32(const float* p) {
    const f32x4 a = *(const f32x4*)p, b = *(const f32x4*)(p + 4); u32x4 w; w.x = pkbf(a[0], a[1]); w.y = pkbf(a[2], a[3]); w.z = pkbf(b[0], b[1]); w.w = pkbf(b[2], b[3]);
    return __builtin_bit_cast(bf16x8, w);
}
template <int MODE> __device__ __forceinline__ bf16x8 ld_kv(const bf16_t* B16, const float* C32, int bq, int h, int dil, int r, int idx, int doff, bool newrows) {
    if (MODE == 0) { const int ii = idx < 0 ? 0 : idx; return ld8_bf16(B16 + ((size_t)bq * SEQ + r + (size_t)dil * ii) * AW + h * HD + doff); }
    int p = r + dil * idx;
    if (!newrows) return ld8_f32(C32 + (((size_t)bq * WBUF + p) * NH + h) * HD + doff);
    p = p > (WBUF + TS - 1) ? (WBUF + TS - 1) : p;
    return ld8_bf16(B16 + ((size_t)MP + bq * TS + (p - WBUF)) * AW + h * HD + doff);
}
template <int MODE> __device__ __forceinline__ void ld_kv4(bf16x8 (&dst)[4], const bf16_t* B16, const float* C32, int bq, int h, int dil, int r, int idx0, int doff, bool newrows) {
    if (MODE == 1 && !newrows) {
        f32x4 raw[4][2];
#pragma unroll
        for (int i = 0; i < 4; ++i) { const float* p = C32 + (((size_t)bq * WBUF + (r + dil * (idx0 + 8 * i))) * NH + h) * HD + doff; raw[i][0] = *(const f32x4*)p; raw[i][1] = *(const f32x4*)(p + 4); }
        __builtin_amdgcn_sched_barrier(0);
#pragma unroll
        for (int i = 0; i < 4; ++i) { u32x4 w; w.x = pkbf(raw[i][0][0], raw[i][0][1]); w.y = pkbf(raw[i][0][2], raw[i][0][3]); w.z = pkbf(raw[i][1][0], raw[i][1][1]); w.w = pkbf(raw[i][1][2], raw[i][1][3]);
            dst[i] = __builtin_bit_cast(bf16x8, w); }
    } else {
#pragma unroll
        for (int i = 0; i < 4; ++i) dst[i] = ld_kv<MODE>(B16, C32, bq, h, dil, r, idx0 + 8 * i, doff, newrows);
    }
}
template <int MODE> __device__ __forceinline__ void wave_block(const Ctx& c, int bq, int h, int g, int dil, int r, int i0, int nq, const LAS float* tab, LAS unsigned char* wbuf) {
    const int lane = fresh_lane(), r32 = lane & 31, hi = lane >> 5;
    const int vkey = lane >> 3, vch = lane & 7;
    const bool qvalid = r32 < nq; const int qq = qvalid ? r32 : 0;
    size_t qtok;
    if (MODE == 0) qtok = (size_t)bq * SEQ + r + (size_t)dil * (i0 + qq);
    else qtok = (size_t)MP + bq * TS + (r + dil * (i0 + qq) - WBUF);
    LAS unsigned char* kb = wbuf; LAS unsigned char* vbuf = wbuf + 4608;
    bf16x8 qv[4];
#pragma unroll
    for (int i = 0; i < 4; ++i) { int qi = 8 * i + vkey; qi = qi < nq ? qi : 0;
        const size_t tk = (MODE == 0) ? (size_t)bq * SEQ + r + (size_t)dil * (i0 + qi) : (size_t)MP + bq * TS + (r + dil * (i0 + qi) - WBUF);
        qv[i] = ld8_bf16(c.QB + tk * AW + h * HD + vch * 8); }
    bf16x8 kr[5][4];
    constexpr int KA = (MODE == 0) ? 5 : 2;
#pragma unroll
    for (int s = 0; s < KA; ++s)
        ld_kv4<MODE>(kr[s], c.KB, c.CK, bq, h, dil, r, i0 - 128 + 32 * s + vkey, vch * 8, s == 4);
#pragma unroll
    for (int i = 0; i < 4; ++i) *(LAS bf16x8*)(kb + (8 * i + vkey) * 144 + vch * 16) = qv[i];
    bf16x8 qr[4];
#pragma unroll
    for (int d0 = 0; d0 < 4; ++d0) qr[d0] = *(const LAS bf16x8*)(kb + r32 * 144 + d0 * 32 + hi * 16);
    f32x16 S[5];
#pragma unroll
    for (int s = 0; s < 5; ++s) {
        if (MODE != 0 && s + KA < 5) {
            ld_kv4<MODE>(kr[s + KA], c.KB, c.CK, bq, h, dil, r, i0 - 128 + 32 * (s + KA) + vkey, vch * 8, s + KA == 4);
        }
#pragma unroll
        for (int i = 0; i < 4; ++i) *(LAS bf16x8*)(kb + (8 * i + vkey) * 144 + vch * 16) = kr[s][i];
        bf16x8 kf[4];
#pragma unroll
        for (int d0 = 0; d0 < 4; ++d0) kf[d0] = *(const LAS bf16x8*)(kb + r32 * 144 + d0 * 32 + hi * 16);
        f32x16 a = {};
#pragma unroll
        for (int d0 = 0; d0 < 4; ++d0) a = __builtin_amdgcn_mfma_f32_32x32x16_bf16(kf[d0], qr[d0], a, 0, 0, 0);
        S[s] = a;
        __builtin_amdgcn_sched_barrier(0);
    }
    bf16x8 vr[5][4];
#pragma unroll
    for (int s = 0; s < KA; ++s)
        ld_kv4<MODE>(vr[s], c.VB, c.CV, bq, h, dil, r, i0 - 128 + 32 * s + vkey, vch * 8, s == 4);
    __builtin_amdgcn_sched_barrier(0);
    const LAS float* tb = tab + 159 + r32 - 4 * hi;
#pragma unroll
    for (int s = 0; s < 5; ++s)
#pragma unroll
        for (int rr = 0; rr < 16; ++rr) S[s][rr] += tb[-(32 * s + (rr & 3) + 8 * (rr >> 2))];
    if (MODE == 0 && i0 < 128) {
#pragma unroll
        for (int s = 0; s < 5; ++s)
#pragma unroll
            for (int rr = 0; rr < 16; ++rr) if (i0 - 128 + 32 * s + crow(rr, hi) < 0) S[s][rr] = -1e30f;
    }
    float mx = -3.0e38f;
#pragma unroll
    for (int s = 0; s < 5; ++s)
#pragma unroll
        for (int rr = 0; rr < 16; ++rr) mx = fmaxf(mx, S[s][rr]);
    mx = fmaxf(mx, __shfl_xor(mx, 32));
    float l = 0.f;
#pragma unroll
    for (int s = 0; s < 5; ++s)
#pragma unroll
        for (int rr = 0; rr < 16; ++rr) { const float p = fast_exp2(S[s][rr] - mx); S[s][rr] = p; l += p; }
    l += __shfl_xor(l, 32);
    f32x16 o[2]; o[0] = (f32x16){}; o[1] = (f32x16){};
    const int vrd = (4 * hi + ((lane & 15) >> 2)) * 64 + ((lane >> 4) & 1) * 32 + (lane & 3) * 8;
    __builtin_amdgcn_sched_barrier(0);
#pragma unroll
    for (int s = 0; s < 5; ++s) {
        LAS unsigned char* vb = vbuf + (s & 1) * 4096;
#pragma unroll
        for (int i = 0; i < 4; ++i) *(LAS bf16x8*)(vb + (vch >> 2) * 2048 + (8 * i + vkey) * 64 + (vch & 3) * 16) = vr[s][i];
        if (MODE != 0 && s + KA < 5) {
            ld_kv4<MODE>(vr[s + KA], c.VB, c.CV, bq, h, dil, r, i0 - 128 + 32 * (s + KA) + vkey, vch * 8, s + KA == 4);
        }
#pragma unroll
        for (int sp = 0; sp < 2; ++sp) {
            u32x4 pw; pw.x = pkbf(S[s][8 * sp + 0], S[s][8 * sp + 1]); pw.y = pkbf(S[s][8 * sp + 2], S[s][8 * sp + 3]); pw.z = pkbf(S[s][8 * sp + 4], S[s][8 * sp + 5]); pw.w = pkbf(S[s][8 * sp + 6], S[s][8 * sp + 7]);
            const bf16x8 pf = __builtin_bit_cast(bf16x8, pw);
#pragma unroll
            for (int dt = 0; dt < 2; ++dt) {
                const s16x4 lo = __builtin_bit_cast(s16x4, __builtin_amdgcn_ds_read_tr16_b64_v4i16((LAS s16x4*)(vb + vrd + dt * 2048 + sp * 1024)));
                const s16x4 hh = __builtin_bit_cast(s16x4, __builtin_amdgcn_ds_read_tr16_b64_v4i16((LAS s16x4*)(vb + vrd + dt * 2048 + sp * 1024 + 512)));
                const bf16x8 vf = (bf16x8){lo[0], lo[1], lo[2], lo[3], hh[0], hh[1], hh[2], hh[3]};
                o[dt] = __builtin_amdgcn_mfma_f32_32x32x16_bf16(vf, pf, o[dt], 0, 0, 0);
            }
        }
        __builtin_amdgcn_sched_barrier(0);
    }
    {
        const float inv = 1.0f / l;
#pragma unroll
        for (int dt = 0; dt < 2; ++dt)
#pragma unroll
            for (int rg = 0; rg < 4; ++rg) { u32x2 w; w.x = pkbf(o[dt][4 * rg] * inv, o[dt][4 * rg + 1] * inv); w.y = pkbf(o[dt][4 * rg + 2] * inv, o[dt][4 * rg + 3] * inv);
                *(LAS u32x2*)(kb + r32 * 144 + (32 * dt + 8 * rg + 4 * hi) * 2) = w; }
        if (qvalid && hi == 0) c.LSE[(size_t)g * LSE_STRIDE + qtok * NH + h] = mx + __log2f(l);
#pragma unroll
        for (int i = 0; i < 4; ++i) { const int qi = 8 * i + vkey;
            if (qi < nq) {
                const size_t tk = (MODE == 0) ? (size_t)bq * SEQ + r + (size_t)dil * (i0 + qi) : (size_t)MP + bq * TS + (r + dil * (i0 + qi) - WBUF);
                *(u32x4*)(c.OP + (size_t)g * OP_STRIDE + tk * AW + h * HD + vch * 8) = *(const LAS u32x4*)(kb + qi * 144 + vch * 16);
            } }
    }
}
struct PDesc { int b, h, g, dil, r, i0; };
__device__ __forceinline__ unsigned ptok(const PDesc& d, int idx) { return (unsigned)(d.b * SEQ + d.r + d.dil * idx); }
__device__ __forceinline__ bf16x8 ld8_off(const bf16_t* base, unsigned byte_off) { return *(const bf16x8*)((const char*)base + byte_off); }
__device__ __forceinline__ void p_load_q(const Ctx& c, const PDesc& d, bf16x8 (&qv)[4], int vkey, int vch) {
    const unsigned o0 = (ptok(d, d.i0 + vkey) * AW + d.h * HD + vch * 8) * 2u, st = (unsigned)(8 * d.dil * AW * 2);
#pragma unroll
    for (int i = 0; i < 4; ++i) qv[i] = ld8_off(c.QB, o0 + i * st);
}
__device__ __forceinline__ void p_load_kv(const bf16_t* B, const PDesc& d, int s, bf16x8 (&x)[4], int vkey, int vch) {
    const unsigned cb = (unsigned)((d.b * SEQ + d.r) * AW + d.h * HD + vch * 8) * 2u, st = (unsigned)(d.dil * AW * 2);
#pragma unroll
    for (int i = 0; i < 4; ++i) { int idx = d.i0 - 128 + 32 * s + 8 * i + vkey; idx = idx < 0 ? 0 : idx; x[i] = ld8_off(B, cb + (unsigned)idx * st); }
}
__device__ __forceinline__ void pblock(const Ctx& c, const PDesc& cur, const PDesc& nxt, bool has_next, bf16x8 (&qv)[4], bf16x8 (&kr)[5][4], const LAS float* tabs, LAS unsigned char* wbuf) {
    const int lane = fresh_lane(), r32 = lane & 31, hi = lane >> 5, vkey = lane >> 3, vch = lane & 7;
    LAS unsigned char* vbuf = wbuf;
    LAS unsigned char* kb = wbuf + 8192;
    const int kwr = vkey * 128 + ((vch ^ (vkey & 7)) << 4);
    const int krd0 = r32 * 128, kx = r32 & 7;
    const int i0 = cur.i0;
#pragma unroll
    for (int i = 0; i < 4; ++i) *(LAS bf16x8*)(kb + (8 * i + vkey) * 144 + vch * 16) = qv[i];
    bf16x8 qr[4];
#pragma unroll
    for (int d0 = 0; d0 < 4; ++d0) qr[d0] = *(const LAS bf16x8*)(kb + r32 * 144 + d0 * 32 + hi * 16);
    f32x16 S[5];
    bf16x8 vr[5][4];
    p_load_kv(c.KB, cur, 2, kr[2], vkey, vch); p_load_kv(c.KB, cur, 3, kr[3], vkey, vch); p_load_kv(c.KB, cur, 4, kr[4], vkey, vch);
#pragma unroll
    for (int s = 0; s < 5; ++s) {
        LAS unsigned char* kp = vbuf + (s & 1) * 4096;
#pragma unroll
        for (int i = 0; i < 4; ++i) *(LAS bf16x8*)(kp + i * 1024 + kwr) = kr[s][i];
        if (s < 3) p_load_kv(c.VB, cur, s, vr[s], vkey, vch);
        bf16x8 kf[4];
#pragma unroll
        for (int d0 = 0; d0 < 4; ++d0) kf[d0] = *(const LAS bf16x8*)(kp + krd0 + (((2 * d0 + hi) ^ kx) << 4));
        f32x16 a = {};
#pragma unroll
        for (int d0 = 0; d0 < 4; ++d0) a = __builtin_amdgcn_mfma_f32_32x32x16_bf16(kf[d0], qr[d0], a, 0, 0, 0);
        S[s] = a;
    }
    __builtin_amdgcn_sched_barrier(0);
    const LAS float* tb = tabs + (cur.g * 12 + cur.h) * 192 + 159 + r32 - 4 * hi;
#pragma unroll
    for (int s = 0; s < 5; ++s)
#pragma unroll
        for (int rr = 0; rr < 16; ++rr) S[s][rr] += tb[-(32 * s + (rr & 3) + 8 * (rr >> 2))];
    if (i0 < 128) {
#pragma unroll
        for (int s = 0; s < 5; ++s)
#pragma unroll
            for (int rr = 0; rr < 16; ++rr) if (i0 - 128 + 32 * s + crow(rr, hi) < 0) S[s][rr] = -1e30f;
    }
    float mx = -3.0e38f;
#pragma unroll
    for (int s = 0; s < 5; ++s)
#pragma unroll
        for (int rr = 0; rr < 16; ++rr) mx = fmaxf(mx, S[s][rr]);
    mx = fmaxf(mx, __shfl_xor(mx, 32));
    float l = 0.f;
    bf16x8 pf[5][2];
#pragma unroll
    for (int s = 0; s < 5; ++s) {
#pragma unroll
        for (int rr = 0; rr < 16; ++rr) { const float p = fast_exp2(S[s][rr] - mx); S[s][rr] = p; l += p; }
#pragma unroll
        for (int sp = 0; sp < 2; ++sp) { u32x4 pw; pw.x = pkbf(S[s][8 * sp + 0], S[s][8 * sp + 1]); pw.y = pkbf(S[s][8 * sp + 2], S[s][8 * sp + 3]); pw.z = pkbf(S[s][8 * sp + 4], S[s][8 * sp + 5]); pw.w = pkbf(S[s][8 * sp + 6], S[s][8 * sp + 7]);
            pf[s][sp] = __builtin_bit_cast(bf16x8, pw); asm volatile("" : "+v"(pf[s][sp])); }
    }
    l += __shfl_xor(l, 32);
    __builtin_amdgcn_sched_barrier(0);
    p_load_kv(c.VB, cur, 3, vr[3], vkey, vch); p_load_kv(c.VB, cur, 4, vr[4], vkey, vch);
    f32x16 o[2]; o[0] = (f32x16){}; o[1] = (f32x16){};
    const int vrd = (4 * hi + ((lane & 15) >> 2)) * 64 + ((lane >> 4) & 1) * 32 + (lane & 3) * 8;
    __builtin_amdgcn_sched_barrier(0);
#pragma unroll
    for (int s = 0; s < 5; ++s) {
        LAS unsigned char* vb = vbuf + (s & 1) * 4096;
#pragma unroll
        for (int i = 0; i < 4; ++i) *(LAS bf16x8*)(vb + (vch >> 2) * 2048 + (8 * i + vkey) * 64 + (vch & 3) * 16) = vr[s][i];
        if (has_next && s < 2) p_load_kv(c.KB, nxt, s, kr[s], vkey, vch);
        if (has_next && s == 2) p_load_q(c, nxt, qv, vkey, vch);
#pragma unroll
        for (int sp = 0; sp < 2; ++sp)
#pragma unroll
            for (int dt = 0; dt < 2; ++dt) {
                const s16x4 lo = __builtin_bit_cast(s16x4, __builtin_amdgcn_ds_read_tr16_b64_v4i16((LAS s16x4*)(vb + vrd + dt * 2048 + sp * 1024)));
                const s16x4 hh = __builtin_bit_cast(s16x4, __builtin_amdgcn_ds_read_tr16_b64_v4i16((LAS s16x4*)(vb + vrd + dt * 2048 + sp * 1024 + 512)));
                const bf16x8 vf = (bf16x8){lo[0], lo[1], lo[2], lo[3], hh[0], hh[1], hh[2], hh[3]};
                o[dt] = __builtin_amdgcn_mfma_f32_32x32x16_bf16(vf, pf[s][sp], o[dt], 0, 0, 0);
            }
    }
    __builtin_amdgcn_sched_barrier(0);
    {
        const float inv = 1.0f / l;
#pragma unroll
        for (int dt = 0; dt < 2; ++dt)
#pragma unroll
            for (int rg = 0; rg < 4; ++rg) { u32x2 w; w.x = pkbf(o[dt][4 * rg] * inv, o[dt][4 * rg + 1] * inv); w.y = pkbf(o[dt][4 * rg + 2] * inv, o[dt][4 * rg + 3] * inv);
                *(LAS u32x2*)(kb + r32 * 144 + (32 * dt + 8 * rg + 4 * hi) * 2) = w; }
        if (hi == 0) c.LSE[(size_t)cur.g * LSE_STRIDE + (size_t)ptok(cur, i0 + r32) * NH + cur.h] = mx + __log2f(l);
#pragma unroll
        for (int i = 0; i < 4; ++i) { const int qi = 8 * i + vkey;
            *(u32x4*)(c.OP + (size_t)cur.g * OP_STRIDE + (size_t)ptok(cur, i0 + qi) * AW + cur.h * HD + vch * 8) = *(const LAS u32x4*)(kb + qi * 144 + vch * 16); }
    }
}
struct TDesc { int b, h, g, dil, r, j0; };
constexpr int TK_OFF = 0, TV_OFF = 49152, TB_OFF = 98304, TT_OFF = TB_OFF + 8 * 4608;
__device__ __forceinline__ void glds16(const void* sbase, unsigned voff, unsigned lds_dst) { unsigned keep;
    asm volatile("s_mov_b32 %0, m0\n\ts_mov_b32 m0, %3\n\ts_nop 4\n\tglobal_load_lds_dwordx4 %1, %2\n\ts_mov_b32 m0, %0" : "=&s"(keep) : "v"(voff), "s"(sbase), "s"(lds_dst) : "memory"); }
__device__ __forceinline__ void glds4(const void* sbase, unsigned voff, unsigned lds_dst) { unsigned keep;
    asm volatile("s_mov_b32 %0, m0\n\ts_mov_b32 m0, %3\n\ts_nop 4\n\tglobal_load_lds_dword %1, %2\n\ts_mov_b32 m0, %0" : "=&s"(keep) : "v"(voff), "s"(sbase), "s"(lds_dst) : "memory"); }
__device__ __forceinline__ void t_issue_tab(const float* tabg, const TDesc& d, LAS unsigned char* lds, int wave, int lane) {
    if (wave < 3) glds4(tabg, (unsigned)(((d.g * 12 + d.h) * 192 + wave * 64 + lane) * 4), (unsigned)__builtin_amdgcn_readfirstlane((int)((unsigned)(uintptr_t)lds + TT_OFF + wave * 256)));
}
__device__ __forceinline__ void t_issue_k(const Ctx& c, const TDesc& d, LAS unsigned char* lds, int wave, int lane) {
    const int rr = lane >> 3, ch = (lane & 7) ^ ((4 * (wave & 1) + (rr >> 1)) & 7);
    const unsigned cb = (unsigned)((d.b * SEQ + d.r) * AW + d.h * HD + ch * 8) * 2u, st = (unsigned)(d.dil * AW * 2);
    const unsigned l0 = (unsigned)(uintptr_t)lds + TK_OFF;
#pragma unroll
    for (int i = 0; i < 6; ++i) { const int e = wave + 8 * i; int idx = d.j0 - 128 + 8 * e + rr; idx = idx < 0 ? 0 : idx;
        glds16(c.KB, cb + (unsigned)idx * st, (unsigned)__builtin_amdgcn_readfirstlane((int)(l0 + e * 1024))); }
}
__device__ __forceinline__ void t_issue_v(const Ctx& c, const TDesc& d, LAS unsigned char* lds, int wave, int lane) {
    const int kq = lane >> 2, q4 = lane & 3;
    const unsigned cb = (unsigned)((d.b * SEQ + d.r) * AW + d.h * HD + q4 * 8) * 2u, st = (unsigned)(d.dil * AW * 2);
    const unsigned l0 = (unsigned)(uintptr_t)lds + TV_OFF;
#pragma unroll
    for (int i = 0; i < 6; ++i) { const int e = 6 * wave + i, hf = e / 24, e24 = e - hf * 24; int idx = d.j0 - 128 + 16 * e24 + kq; idx = idx < 0 ? 0 : idx;
        glds16(c.VB, cb + (unsigned)idx * st + (unsigned)hf * 64u, (unsigned)__builtin_amdgcn_readfirstlane((int)(l0 + e * 1024))); }
}
__device__ __forceinline__ void t_issue_q(const Ctx& c, const TDesc& d, LAS unsigned char* lds, int wave, int lane) {
    const int rr = lane >> 3, i0 = d.j0 + 32 * wave;
    const unsigned qo0 = ((unsigned)(d.b * SEQ + d.r + d.dil * (i0 + rr)) * AW + d.h * HD) * 2u, qst = (unsigned)(8 * d.dil * AW * 2);
    const unsigned l0 = (unsigned)(uintptr_t)lds + TB_OFF + wave * 4608;
#pragma unroll
    for (int i = 0; i < 4; ++i) { const int ch = (lane & 7) ^ ((4 * (i & 1) + (rr >> 1)) & 7);
        glds16(c.QB, qo0 + i * qst + ch * 16, (unsigned)__builtin_amdgcn_readfirstlane((int)(l0 + i * 1024))); }
}
struct TOut { f32x16 o[2]; float l, mx; };
__device__ __forceinline__ void* sgpr_ptr(const void* p) { const unsigned long long u = (unsigned long long)(uintptr_t)p;
    const unsigned lo = (unsigned)__builtin_amdgcn_readfirstlane((int)(unsigned)u), hi = (unsigned)__builtin_amdgcn_readfirstlane((int)(unsigned)(u >> 32));
    return (void*)(uintptr_t)(((unsigned long long)hi << 32) | lo); }
__device__ __forceinline__ void gst16(void* sbase, unsigned voff, u32x4 v) { asm volatile("s_nop 4\n\tglobal_store_dwordx4 %0, %1, %2\n\ts_nop 1" :: "v"(voff), "v"(v), "s"(sbase) : "memory"); }
__device__ __forceinline__ void gst4(void* sbase, unsigned voff, float v) { asm volatile("s_nop 4\n\tglobal_store_dword %0, %1, %2\n\ts_nop 1" :: "v"(voff), "v"(v), "s"(sbase) : "memory"); }
__device__ __forceinline__ void t_out1(const TOut& po, LAS unsigned char* kb, int r32, int hi) {
    const float inv = 1.0f / po.l;
#pragma unroll
    for (int dt = 0; dt < 2; ++dt)
#pragma unroll
        for (int rg = 0; rg < 4; ++rg) { u32x2 w; w.x = pkbf(po.o[dt][4 * rg] * inv, po.o[dt][4 * rg + 1] * inv); w.y = pkbf(po.o[dt][4 * rg + 2] * inv, po.o[dt][4 * rg + 3] * inv);
            *(LAS u32x2*)(kb + r32 * 144 + (32 * dt + 8 * rg + 4 * hi) * 2) = w; }
}
__device__ __forceinline__ void t_out2(const Ctx& c, const TDesc& d, const TOut& po, const LAS unsigned char* kb, int wave, int r32, int hi, int vkey, int vch, u32x4 (&ow)[4]) {
    const int i0 = d.j0 + 32 * wave;
#pragma unroll
    for (int i = 0; i < 4; ++i) ow[i] = *(const LAS u32x4*)(kb + (8 * i + vkey) * 144 + vch * 16);
    const unsigned tq = (unsigned)(d.b * SEQ + d.r + d.dil * (i0 + r32));
    if (hi == 0) gst4(sgpr_ptr(c.LSE + (size_t)d.g * LSE_STRIDE + d.h), tq * (unsigned)(NH * 4), po.mx + __log2f(po.l));
}
__device__ __forceinline__ void t_out3(const Ctx& c, const TDesc& d, int wave, int vkey, int vch, const u32x4 (&ow)[4]) {
    const int i0 = d.j0 + 32 * wave; void* ob = sgpr_ptr(c.OP + (size_t)d.g * OP_STRIDE + d.h * HD);
#pragma unroll
    for (int i = 0; i < 4; ++i) { const int qi = 8 * i + vkey; const unsigned tk = (unsigned)(d.b * SEQ + d.r + d.dil * (i0 + qi));
        gst16(ob, tk * (unsigned)(AW * 2) + (unsigned)(vch * 16), ow[i]); }
}
__device__ __forceinline__ void t_unit(const Ctx& c, const TDesc& prv, const TDesc& cur, const TDesc& nxt, bool has_next, const float* tabg, LAS unsigned char* lds, int wave, TOut& po) {
    const int lane = fresh_lane(), r32 = lane & 31, hi = lane >> 5, vkey = lane >> 3, vch = lane & 7;
    LAS unsigned char* qb = lds + TB_OFF + wave * 4608;
    const LAS float* tt = (const LAS float*)(lds + TT_OFF);
    const int i0 = cur.j0 + 32 * wave;
    asm volatile("s_waitcnt vmcnt(6) lgkmcnt(0)\n\ts_barrier" ::: "memory");
    const int kx = (r32 >> 1) & 7;
    bf16x8 qr[4];
#pragma unroll
    for (int d0 = 0; d0 < 4; ++d0) qr[d0] = *(const LAS bf16x8*)(qb + r32 * 128 + (((2 * d0 + hi) ^ kx) << 4));
    asm volatile("" ::: "memory");
    t_out1(po, qb, r32, hi);
    f32x16 S[5];
    const LAS float* tb = tt + 159 + r32 - 4 * hi;
    const LAS unsigned char* kt = lds + TK_OFF + (32 * wave + r32) * 128;
    float mx;
    {   bf16x8 kf[4];
#pragma unroll
        for (int d0 = 0; d0 < 4; ++d0) kf[d0] = *(const LAS bf16x8*)(kt + 4 * 4096 + (((2 * d0 + hi) ^ kx) << 4));
        f32x16 a = {};
#pragma unroll
        for (int d0 = 0; d0 < 4; ++d0) a = __builtin_amdgcn_mfma_f32_32x32x16_bf16(kf[d0], qr[d0], a, 0, 0, 0);
#pragma unroll
        for (int rr = 0; rr < 16; ++rr) a[rr] += tb[-(128 + (rr & 3) + 8 * (rr >> 2))];
        float m1 = fmaxf(fmaxf(a[0], a[1]), a[2]);
#pragma unroll
        for (int rr = 3; rr < 15; rr += 2) m1 = fmaxf(fmaxf(m1, a[rr]), a[rr + 1]);
        m1 = fmaxf(m1, a[15]);
        mx = fmaxf(m1, __shfl_xor(m1, 32));
        S[4] = a; }
    u32x4 ow[4];
    asm volatile("" ::: "memory");
    t_out2(c, prv, po, qb, wave, r32, hi, vkey, vch, ow);
#pragma unroll
    for (int s = 0; s < 4; s += 2) {
        bf16x8 kfa[4], kfb[4];
#pragma unroll
        for (int d0 = 0; d0 < 4; ++d0) { kfa[d0] = *(const LAS bf16x8*)(kt + s * 4096 + (((2 * d0 + hi) ^ kx) << 4)); kfb[d0] = *(const LAS bf16x8*)(kt + (s + 1) * 4096 + (((2 * d0 + hi) ^ kx) << 4)); }
        f32x16 a, b;
#pragma unroll
        for (int rr = 0; rr < 16; ++rr) { a[rr] = tb[-(32 * s + (rr & 3) + 8 * (rr >> 2))] - mx; b[rr] = tb[-(32 * (s + 1) + (rr & 3) + 8 * (rr >> 2))] - mx; }
#pragma unroll
        for (int d0 = 0; d0 < 4; ++d0) { a = __builtin_amdgcn_mfma_f32_32x32x16_bf16(kfa[d0], qr[d0], a, 0, 0, 0); b = __builtin_amdgcn_mfma_f32_32x32x16_bf16(kfb[d0], qr[d0], b, 0, 0, 0); }
        S[s] = a; S[s + 1] = b;
        if (s == 0) { asm volatile("" ::: "memory"); t_out3(c, prv, wave, vkey, vch, ow); }
    }
    asm volatile("s_waitcnt vmcnt(5) lgkmcnt(0)\n\ts_barrier" ::: "memory");
    if (has_next) { t_issue_tab(tabg, nxt, lds, wave, lane); t_issue_k(c, nxt, lds, wave, lane); t_issue_q(c, nxt, lds, wave, lane); }
    if (i0 < 128) {
#pragma unroll
        for (int s = 0; s < 5; ++s)
#pragma unroll
            for (int rr = 0; rr < 16; ++rr) if (i0 - 128 + 32 * s + crow(rr, hi) < 0) S[s][rr] = -1e30f;
    }
    bf16x8 pf[5][2];
#pragma unroll
    for (int s = 0; s < 5; ++s) {
#pragma unroll
        for (int rr = 0; rr < 16; ++rr) S[s][rr] = fast_exp2(s == 4 ? S[s][rr] - mx : S[s][rr]);
#pragma unroll
        for (int sp = 0; sp < 2; ++sp) { u32x4 pw; pw.x = pkbf(S[s][8 * sp + 0], S[s][8 * sp + 1]); pw.y = pkbf(S[s][8 * sp + 2], S[s][8 * sp + 3]); pw.z = pkbf(S[s][8 * sp + 4], S[s][8 * sp + 5]); pw.w = pkbf(S[s][8 * sp + 6], S[s][8 * sp + 7]);
            pf[s][sp] = __builtin_bit_cast(bf16x8, pw); asm volatile("" : "+v"(pf[s][sp])); }
    }
    f32x16 o[2]; o[0] = (f32x16){}; o[1] = (f32x16){};
    f32x16 ol = {};
    const bf16x8 ones = __builtin_bit_cast(bf16x8, (u32x4){0x3F803F80u, 0x3F803F80u, 0x3F803F80u, 0x3F803F80u});
    const LAS unsigned char* vt = lds + TV_OFF + (32 * wave + 4 * hi + ((lane & 15) >> 2)) * 64 + ((lane >> 4) & 1) * 32 + (lane & 3) * 8;
#pragma unroll
    for (int s = 0; s < 5; ++s)
#pragma unroll
        for (int sp = 0; sp < 2; ++sp)
#pragma unroll
            for (int dt = 0; dt < 2; ++dt) {
                const s16x4 lo = __builtin_bit_cast(s16x4, __builtin_amdgcn_ds_read_tr16_b64_v4i16((LAS s16x4*)(vt + dt * 24576 + s * 2048 + sp * 1024)));
                const s16x4 hh = __builtin_bit_cast(s16x4, __builtin_amdgcn_ds_read_tr16_b64_v4i16((LAS s16x4*)(vt + dt * 24576 + s * 2048 + sp * 1024 + 512)));
                const bf16x8 vf = (bf16x8){lo[0], lo[1], lo[2], lo[3], hh[0], hh[1], hh[2], hh[3]};
                o[dt] = __builtin_amdgcn_mfma_f32_32x32x16_bf16(vf, pf[s][sp], o[dt], 0, 0, 0);
                if (dt == 1) ol = __builtin_amdgcn_mfma_f32_32x32x16_bf16(ones, pf[s][sp], ol, 0, 0, 0);
            }
    const float l = ol[0];
    asm volatile("s_waitcnt lgkmcnt(0)\n\ts_barrier" ::: "memory");
    if (has_next) t_issue_v(c, nxt, lds, wave, lane);
    po.o[0] = o[0]; po.o[1] = o[1]; po.l = l; po.mx = mx;
}
__device__ __forceinline__ void t_flush(const Ctx& c, const TDesc& d, const TOut& po, LAS unsigned char* lds, int wave) {
    const int lane = fresh_lane(), r32 = lane & 31, hi = lane >> 5, vkey = lane >> 3, vch = lane & 7;
    LAS unsigned char* qb = lds + TB_OFF + wave * 4608;
    u32x4 ow[4];
    t_out1(po, qb, r32, hi); t_out2(c, d, po, qb, wave, r32, hi, vkey, vch, ow); t_out3(c, d, wave, vkey, vch, ow);
}
template <int NQ> __device__ __forceinline__ void sample_vblock(const Ctx& c, int n, int h, int g, int dil, int r, int i0, const LAS float* tab, LAS float* sbuf) {
    const int lane = fresh_lane(), sub = lane & 15, rgp = lane >> 4;
    constexpr int NT = (NQ + 3) / 4, NSA = 32 + NT;
    f32x4 q4[NQ];
#pragma unroll
    for (int qq = 0; qq < NQ; ++qq) { const size_t row = (size_t)MP + n * TS + (r + dil * (i0 + qq) - WBUF);
        const u32x2 w = *(const u32x2*)(c.QB + row * AW + h * HD + 4 * sub); q4[qq] = (f32x4){bf_lo(w.x), bf_hi(w.x), bf_lo(w.y), bf_hi(w.y)}; }
    const unsigned cbase = (unsigned)((((n * WBUF) + r + dil * (i0 - 128 + rgp)) * NH + h) * HD + 4 * sub) * 4u, cstep = (unsigned)(4 * dil * NH * HD * 4);
    auto new_row = [&](const bf16_t* B16, int tt) -> f32x4 { const int tc = tt < NQ ? tt : NQ - 1;
        const u32x2 w = *(const u32x2*)(B16 + ((size_t)MP + n * TS + (r + dil * (i0 + tc) - WBUF)) * AW + h * HD + 4 * sub);
        return (f32x4){bf_lo(w.x), bf_hi(w.x), bf_lo(w.y), bf_hi(w.y)}; };
    auto score = [&](const f32x4 kv, int kk) {
#pragma unroll
        for (int qq = 0; qq < NQ; ++qq) {
            float d = (kv[0] * q4[qq][0] + kv[1] * q4[qq][1]) + (kv[2] * q4[qq][2] + kv[3] * q4[qq][3]);
            d += __shfl_xor(d, 1); d += __shfl_xor(d, 2); d += __shfl_xor(d, 4); d += __shfl_xor(d, 8);
            if (sub == 0) sbuf[qq * 136 + kk] = (kk < 128 + NQ) ? d + tab[159 + qq - kk] : -1e30f;
        } };
    {   f32x4 nk[NT];
#pragma unroll
        for (int i = 0; i < NT; ++i) nk[i] = new_row(c.KB, 4 * i + rgp);
        {   f32x4 kv[32];
#pragma unroll
            for (int i = 0; i < 32; ++i) kv[i] = *(const f32x4*)((const char*)c.CK + cbase + (unsigned)i * cstep);
#pragma unroll
            for (int i = 0; i < 32; ++i) score(kv[i], 4 * i + rgp);
        }
#pragma unroll
        for (int i = 0; i < NT; ++i) score(nk[i], 128 + 4 * i + rgp);
    }
    asm volatile("s_waitcnt lgkmcnt(0)" ::: "memory");
    float lq[NQ], lse[NQ];
#pragma unroll
    for (int qq = 0; qq < NQ; ++qq) {
        float v[3]; float mx = -3.0e38f;
#pragma unroll
        for (int j = 0; j < 3; ++j) { const int kk = lane + 64 * j; v[j] = (kk < 4 * NSA) ? sbuf[qq * 136 + kk] : -1e30f; mx = fmaxf(mx, v[j]); }
#pragma unroll
        for (int o = 1; o < 64; o <<= 1) mx = fmaxf(mx, __shfl_xor(mx, o));
        float sm = 0.f;
#pragma unroll
        for (int j = 0; j < 3; ++j) { const int kk = lane + 64 * j; const float pv = fast_exp2(v[j] - mx); sm += pv; if (kk < 4 * NSA) sbuf[qq * 136 + kk] = pv; }
        sm = wave_sum(sm); lq[qq] = sm; lse[qq] = mx + __log2f(sm);
    }
    asm volatile("s_waitcnt lgkmcnt(0)" ::: "memory");
    f32x4 oa[NQ];
#pragma unroll
    for (int qq = 0; qq < NQ; ++qq) oa[qq] = (f32x4){0.f, 0.f, 0.f, 0.f};
    {   f32x4 nv[NT];
#pragma unroll
        for (int i = 0; i < NT; ++i) nv[i] = new_row(c.VB, 4 * i + rgp);
        {   f32x4 vv[32];
#pragma unroll
            for (int i = 0; i < 32; ++i) vv[i] = *(const f32x4*)((const char*)c.CV + cbase + (unsigned)i * cstep);
#pragma unroll
            for (int i = 0; i < 32; ++i) { const int kk = 4 * i + rgp;
#pragma unroll
                for (int qq = 0; qq < NQ; ++qq) { const float pv = sbuf[qq * 136 + kk]; oa[qq] += vv[i] * pv; } }
        }
#pragma unroll
        for (int i = 0; i < NT; ++i) { const int kk = 128 + 4 * i + rgp;
#pragma unroll
            for (int qq = 0; qq < NQ; ++qq) { const float pv = sbuf[qq * 136 + kk]; oa[qq] += nv[i] * pv; } }
    }
#pragma unroll
    for (int qq = 0; qq < NQ; ++qq) {
#pragma unroll
        for (int e = 0; e < 4; ++e) { float x = oa[qq][e]; x += __shfl_xor(x, 16); x += __shfl_xor(x, 32); oa[qq][e] = x; }
        const size_t tok = (size_t)MP + n * TS + (r + dil * (i0 + qq) - WBUF);
        if (rgp == 0) { const float inv = 1.0f / lq[qq]; u32x2 w; w.x = pkbf(oa[qq][0] * inv, oa[qq][1] * inv); w.y = pkbf(oa[qq][2] * inv, oa[qq][3] * inv);
            *(u32x2*)(c.OP + (size_t)g * OP_STRIDE + tok * AW + h * HD + 4 * sub) = w;
            if (sub == 0) c.LSE[(size_t)g * LSE_STRIDE + tok * NH + h] = lse[qq]; }
    }
    asm volatile("s_waitcnt lgkmcnt(0)" ::: "memory");
}
template <int NP> __device__ __forceinline__ void merge_pieces(const Ctx& c, size_t tok0, size_t tstride, int h, int piece) {
    float ls[NP][3]; u32x4 ov[NP][3];
#pragma unroll
    for (int q = 0; q < NP; ++q)
#pragma unroll
        for (int g = 0; g < 3; ++g) { const size_t tok = tok0 + q * tstride; ls[q][g] = c.LSE[(size_t)g * LSE_STRIDE + tok * NH + h]; ov[q][g] = *(const u32x4*)(c.OP + (size_t)g * OP_STRIDE + tok * AW + h * HD + piece * 8); }
#pragma unroll
    for (int q = 0; q < NP; ++q) {
        const float M = fmaxf(fmaxf(ls[q][0], ls[q][1]), ls[q][2]);
        float w0 = fast_exp2(ls[q][0] - M), w1 = fast_exp2(ls[q][1] - M), w2 = fast_exp2(ls[q][2] - M); const float inv = 1.0f / (w0 + w1 + w2); w0 *= inv; w1 *= inv; w2 *= inv;
        u32x4 o;
#pragma unroll
        for (int e = 0; e < 4; ++e) {
            const float lo = w0 * bf_lo(ov[q][0][e]) + w1 * bf_lo(ov[q][1][e]) + w2 * bf_lo(ov[q][2][e]);
            const float hi_ = w0 * bf_hi(ov[q][0][e]) + w1 * bf_hi(ov[q][1][e]) + w2 * bf_hi(ov[q][2][e]);
            o[e] = pkbf(lo, hi_);
        }
        *(u32x4*)(c.ATT + (tok0 + q * tstride) * DM + h * HD + piece * 8) = o;
    }
}
__device__ __forceinline__ void copy_slot(const float* ck, const float* cv, float* out, int sl, int lane) {
    const int sq = sl / 576, j0 = (sl - sq * 576) * 680, which = sq >> 5, n = sq & 31;
    const f32x4* src = (const f32x4*)((which ? cv : ck) + (size_t)n * WBUF * AW + (size_t)TS * AW) + j0 + lane;
    f32x4* dst = (f32x4*)(out + (which ? OFF_SWV : OFF_SWK) + (size_t)n * WBUF * AW) + j0 + lane;
    f32x4 v[11];
#pragma unroll
    for (int i = 0; i < 10; ++i) v[i] = __builtin_nontemporal_load(src + 64 * i);
    if (lane < 40) v[10] = __builtin_nontemporal_load(src + 640);
#pragma unroll
    for (int i = 0; i < 10; ++i) __builtin_nontemporal_store(v[i], dst + 64 * i);
    if (lane < 40) __builtin_nontemporal_store(v[10], dst + 640);
}
__device__ __forceinline__ void copy_range(const float* ck, const float* cv, float* out, unsigned first, unsigned count, int widx, int nw, int tid) {
    constexpr unsigned PER = (unsigned)(WBUF - TS) * AW / 4;
    const unsigned end = first + count;
    for (unsigned i0 = first + (unsigned)widx * 4096u + tid; i0 < end; i0 += (unsigned)nw * 4096u) {
        f32x4 v[8];
#pragma unroll
        for (int k = 0; k < 8; ++k) { const unsigned i = i0 + 512u * k; if (i < end) { const unsigned sq = i / PER, j = i - sq * PER, which = sq >> 5, n = sq & 31;
            v[k] = __builtin_nontemporal_load((const f32x4*)((which ? cv : ck) + (size_t)n * WBUF * AW + (size_t)TS * AW) + j); } }
#pragma unroll
        for (int k = 0; k < 8; ++k) { const unsigned i = i0 + 512u * k; if (i < end) { const unsigned sq = i / PER, j = i - sq * PER, which = sq >> 5, n = sq & 31;
            __builtin_nontemporal_store(v[k], (f32x4*)(out + (which ? OFF_SWV : OFF_SWK) + (size_t)n * WBUF * AW) + j); } }
    }
}
}

template <int NTW, bool SAMPLE> __device__ __forceinline__ void conv_unit(const float* U, const float* cache_conv, int seq, int t0, LAS float* tile, const LAS float* cw,
                                                                          const float* cb, const float* lg, const float* lb, bf16_t* ATT, int tid, int lane, int wave) {
    constexpr int NROW = 8 * NTW + 30;
    const size_t rowbase = SAMPLE ? (size_t)MP + (size_t)seq * TS : (size_t)seq * SEQ;
    for (int idx = tid; idx < NROW * 64; idx += 512) {
        const int rr = idx >> 6, c4 = idx & 63, tau = rr - 30; f32x4 v = (f32x4){0.f, 0.f, 0.f, 0.f};
        if (SAMPLE) { v = tau < 0 ? *(const f32x4*)(cache_conv + ((size_t)seq * 30 + (30 + tau)) * CWD + 4 * c4) : *(const f32x4*)(U + (rowbase + tau) * CWD + 4 * c4); }
        else if (t0 + tau >= 0) v = *(const f32x4*)(U + (rowbase + t0 + tau) * CWD + 4 * c4);
        *(LAS f32x4*)(tile + rr * CWD + 4 * c4) = v;
    }
    __syncthreads();
    f32x4 acc[NTW], uw[NTW];
    const LAS float* tw = tile + (NTW * wave) * CWD + 4 * lane;
#pragma unroll
    for (int i = 0; i < NTW; ++i) { acc[i] = (f32x4){0.f, 0.f, 0.f, 0.f}; uw[i] = *(const LAS f32x4*)(tw + i * CWD); }
#pragma unroll 1
    for (int j = 0; j < 31; ++j) {
        const f32x4 w = *(const LAS f32x4*)(cw + j * CWD + 4 * lane);
        const f32x4 nx = *(const LAS f32x4*)(tw + (NTW + j) * CWD);
#pragma unroll
        for (int i = 0; i < NTW; ++i) acc[i] += w * uw[i];
#pragma unroll
        for (int i = 0; i + 1 < NTW; ++i) uw[i] = uw[i + 1];
        uw[NTW - 1] = nx;
    }
    const f32x4 bv = *(const f32x4*)(cb + 4 * lane), gv = *(const f32x4*)(lg + 4 * lane), lv = *(const f32x4*)(lb + 4 * lane);
#pragma unroll
    for (int i = 0; i < NTW; ++i) {
        f32x4 y = acc[i] + bv;
        const float mean = wave_sum((y[0] + y[1]) + (y[2] + y[3])) * (1.0f / CWD);
        y = y - mean;
        const float var = wave_sum((y[0] * y[0] + y[1] * y[1]) + (y[2] * y[2] + y[3] * y[3])) * (1.0f / CWD);
        const float rstd = 1.0f / sqrtf(var + EPS);
        f32x4 z = y * rstd * gv + lv;
#pragma unroll
        for (int e = 0; e < 4; ++e) z[e] = z[e] * fast_rcp(1.f + fast_exp2(-z[e] * LOG2E));
        u32x2 w; w.x = pkbf(z[0], z[1]); w.y = pkbf(z[2], z[3]);
        *(u32x2*)(ATT + (rowbase + t0 + NTW * wave + i) * DM + AW + 4 * lane) = w;
    }
    __syncthreads();
}

__global__ void __launch_bounds__(512, 2) fwd_kernel(Params p) {
    extern __shared__ __attribute__((aligned(16))) unsigned char lds_raw[];
    LAS unsigned char* lds = (LAS unsigned char*)lds_raw;
    const int G = gridDim.x, bid = blockIdx.x;
    const int wave = __builtin_amdgcn_readfirstlane(threadIdx.x >> 6);
#define PHASE_IDS const int lane = fresh_lane(), tid = wave * 64 + lane; (void)tid
    unsigned char* ws = p.ws; float* out = p.out;
    bf16_t* WALL = (bf16_t*)(ws + WS_WALL); bf16_t* WOUT = (bf16_t*)(ws + WS_WOUT); bf16_t* WXQ = (bf16_t*)(ws + WS_WXQ); bf16_t* WXO = (bf16_t*)(ws + WS_WXO);
    bf16_t* WGU = (bf16_t*)(ws + WS_WGU); bf16_t* WDN = (bf16_t*)(ws + WS_WDN); bf16_t* XN = (bf16_t*)(ws + WS_XN);
    bf16_t* QB = (bf16_t*)(ws + WS_QB); bf16_t* KB = (bf16_t*)(ws + WS_KB); bf16_t* VB = (bf16_t*)(ws + WS_VB); float* U = (float*)(ws + WS_U);
    bf16_t* OP = (bf16_t*)(ws + WS_OP); float* LSE = (float*)(ws + WS_LSE); bf16_t* ATT = (bf16_t*)(ws + WS_ATT); float* X1 = (float*)(ws + WS_X1);
    float* SSQ = (float*)(ws + WS_SSQ); bf16_t* MKB = (bf16_t*)(ws + WS_MKB); bf16_t* MVT = (bf16_t*)(ws + WS_MVT); float* LSUM = (float*)(ws + WS_LSUM);
    bf16_t* XQ = (bf16_t*)(ws + WS_XQ); bf16_t* PB = (bf16_t*)(ws + WS_PB); bf16_t* XO = (bf16_t*)(ws + WS_XO); bf16_t* HB = (bf16_t*)(ws + WS_H);
    const int lo = p.ph_lo, hi = p.ph_hi;
    if (threadIdx.x < 4) ((volatile LAS unsigned*)(lds + MISC_OFF))[threadIdx.x] = 0u;
    __syncthreads();
    XcdBarrier xbar; xbar.bar = (unsigned*)(ws + WS_CTL); xbar.x = 0; xbar.st = nullptr;
    if (p.coop) xbar = xcd_barrier_post((unsigned*)(ws + WS_CTL), (volatile LAS unsigned*)(lds + MISC_OFF));
#ifndef PH_MASK
#define PH_MASK 0x7ff
#endif
#define IN(k) (((PH_MASK >> (k)) & 1) && lo <= (k) && (k) < hi)
#ifndef PROBE_DUP
#define PROBE_DUP 0
#endif
#define REP(k) for (int rep_ = 0; rep_ <= ((PROBE_DUP >> (k)) & 1); ++rep_)
#define REPSYNC if (rep_) xcd_barrier(xbar)
#define SEAM(k) do { if (IN(k) && IN((k) + 1)) { if (p.coop == 2) cg::this_grid().sync(); else xcd_barrier(xbar); } } while (0)

    if (IN(0)) REP(0) {
        REPSYNC;
        PHASE_IDS;
        LAS float* scr = (LAS float*)(lds + wave * 16384);
        const int gw = bid * 8 + wave, NGW = G * 8;
        constexpr int I_IN = 16 * 88, I_SQ = 16 * 32, I_FF = 16 * 88, I_DN = 44 * 32;
        constexpr int NITEMS = I_IN + 5 * I_SQ + 2 * I_FF + I_DN;
        for (int it = gw; it < NITEMS; it += NGW) {
            int r = it;
            if (r < I_IN) { transpose_item(p.in[10], DM, NIN, WALL, r, 1, scr, lane); continue; } r -= I_IN;
            if (r < I_SQ) { transpose_item(p.in[19], DM, DM, WALL + (size_t)2816 * DM, r, 0, scr, lane); continue; } r -= I_SQ;
            if (r < I_SQ) { transpose_item(p.in[20], DM, DM, WALL + (size_t)3840 * DM, r, 0, scr, lane); continue; } r -= I_SQ;
            if (r < I_SQ) { transpose_item(p.in[15], DM, DM, WOUT, r, 0, scr, lane); continue; } r -= I_SQ;
            if (r < I_SQ) { transpose_item(p.in[18], DM, DM, WXQ, r, 0, scr, lane); continue; } r -= I_SQ;
            if (r < I_SQ) { transpose_item(p.in[21], DM, DM, WXO, r, 0, scr, lane); continue; } r -= I_SQ;
            if (r < I_FF) { transpose_item(p.in[23], DM, DFF, WGU, r, 2, scr, lane); continue; } r -= I_FF;
            if (r < I_FF) { transpose_item(p.in[24], DM, DFF, WGU, r, 3, scr, lane); continue; } r -= I_FF;
            transpose_item(p.in[25], DFF, DM, WDN, r, 0, scr, lane);
        }
        for (int m0 = gw * 4; m0 < MALL; m0 += NGW * 4) {
            const float* base; const float* g;
            if (m0 < MP) { base = p.in[0] + (size_t)m0 * DM; g = p.in[9]; }
            else if (m0 < MTOK) { base = p.in[1] + (size_t)(m0 - MP) * DM; g = p.in[9]; }
            else { base = p.in[2] + (size_t)(m0 - MTOK) * DM; g = p.in[17]; }
            const float* const xr[4] = {base, base + DM, base + 2 * DM, base + 3 * DM};
            bf16_t* ob = XN + (size_t)m0 * DM; bf16_t* const orr[4] = {ob, ob + DM, ob + 2 * DM, ob + 3 * DM};
            rms_rows_bf16<4>(xr, g, orr, lane);
        }
        if (bid == 0) {
            float* tabg = (float*)(ws + WS_TABG);
            for (int i = tid; i < 36 * 192; i += 512) {
                const int gh = i / 192, e = i - gh * 192, g = gh / 12, h = gh - g * 12, dist = e - 31; float v = -1e30f;
                if (dist >= 0 && dist <= 128) { const int n = dist << (2 * g); int bk;
                    if (n < 16) bk = n; else { const float vv = logf((float)n / 16.0f) / 4.852030263919617f * 16.0f; bk = 16 + (int)vv; bk = bk > 31 ? 31 : bk; }
                    v = p.in[8][bk * NH + h] * LOG2E; }
                tabg[i] = v;
            }
        }
        {
            constexpr int CPER = (30 - TS) * CWD / 4;
            for (int i = bid * 512 + tid; i < NSEQ * CPER; i += G * 512) { const int n = i / CPER, j = i - n * CPER;
                ((f32x4*)(out + OFF_SCONV + (size_t)n * 30 * CWD))[j] = ((const f32x4*)(p.in[5] + (size_t)n * 30 * CWD + TS * CWD))[j]; }
        }
    }
    SEAM(0);
    if (IN(1)) REP(1) {
        REPSYNC;
#ifndef P1_NO_MAIN
        { pg8::SchedGrid S{129, 11, G, bid, (const char*)XN, (const char*)WALL, (size_t)256 * DM * 2, (size_t)256 * DM * 2};
          pg8::EpiIn E{ws, out};
          pg8::gemm_phase<pg8::EpiIn, pg8::SchedGrid, true>(lds, pg8::Cfg{DM, DM, DM}, S, E, wave); }
#endif
#ifndef P1_NO_MEM
        { const int cfirst = (129 * 11) % G;
          pg8::SchedMem S{(bid - cfirst + G) % G, (const char*)XN, (const char*)WALL};
          pg8::EpiMem E{ws, out};
          pg8::gemm_phase<pg8::EpiMem, pg8::SchedMem, true>(lds, pg8::Cfg{DM, DM, DM}, S, E, wave); }
        if (bid >= 187 && rep_ == 0) { PHASE_IDS; att::copy_range(p.in[3], p.in[4], out, 0u, 2000000u, bid - 187, G - 187, tid); }
#endif
    }
    SEAM(1);
    if (IN(2)) REP(2) {
        REPSYNC;
        PHASE_IDS;
        LAS float* tab = (LAS float*)(lds + ATT_TAB_OFF); LAS float* cw = (LAS float*)(lds + ATT_CW_OFF);
#ifndef MK_TILE_ATT
#define MK_TILE_ATT 1
#endif
        const float* tabg = (const float*)(ws + WS_TABG);
#if !MK_TILE_ATT
        for (int i = tid; i < 36 * 192; i += 512) tab[i] = tabg[i];
        __syncthreads();
#endif
        att::Ctx c{QB, KB, VB, p.in[3], p.in[4], OP, LSE, ATT};
        LAS unsigned char* vbuf = lds + ATT_V_OFF + wave * ATT_WBUF;
#ifndef PROBE_P2
#define PROBE_P2 0
#endif
#if MK_TILE_ATT
        {
            const int nl2 = __builtin_amdgcn_readfirstlane((int)((volatile LAS unsigned*)(lds + MISC_OFF))[0]), nx2 = __builtin_amdgcn_readfirstlane((int)((volatile LAS unsigned*)(lds + MISC_OFF))[1]);
            const int xi2 = __builtin_amdgcn_readfirstlane((int)((volatile LAS unsigned*)(lds + MISC_OFF))[2]), rk2 = __builtin_amdgcn_readfirstlane((int)((volatile LAS unsigned*)(lds + MISC_OFF))[3]);
            const int npair = (48 - xi2 + nx2 - 1) / nx2, nun = npair * 96;
            auto mk = [&](int Lx) -> att::TDesc { att::TDesc d; const int pair = Lx / 96, u = Lx - pair * 96, pp = xi2 + nx2 * pair; d.b = pp / 12; d.h = pp - d.b * 12; d.g = u >> 5; const int cj = u & 31;
                if (d.g == 0) { d.dil = 1; d.r = 0; d.j0 = 256 * cj; } else if (d.g == 1) { d.dil = 4; d.r = cj >> 3; d.j0 = 256 * (cj & 7); } else { d.dil = 16; d.r = cj >> 1; d.j0 = 256 * (cj & 1); }
                return d; };
            int Lx = rk2;
            att::TDesc cur = mk(Lx < nun ? Lx : 0), prv = cur;
            att::TOut po; po.o[0] = (f32x16){}; po.o[1] = (f32x16){}; po.l = 1.f; po.mx = 0.f;
            const bool any = Lx < nun;
            __builtin_amdgcn_s_waitcnt(0x0070);
            if (any) { att::t_issue_tab(tabg, cur, lds, wave, lane);
                att::t_issue_k(c, cur, lds, wave, lane); att::t_issue_q(c, cur, lds, wave, lane); att::t_issue_v(c, cur, lds, wave, lane); }
            while (Lx < nun) {
                const int Lx2 = Lx + nl2; const bool has_next = Lx2 < nun;
                const att::TDesc nxt = mk(has_next ? Lx2 : Lx);
                att::t_unit(c, prv, cur, nxt, has_next, tabg, lds, wave, po);
                prv = cur; cur = nxt; Lx = Lx2;
            }
            if (any) att::t_flush(c, prv, po, lds, wave);
            xl_barrier(xbar);
            for (int k = 0; k < npair; ++k) { const int pp = xi2 + nx2 * k, b = pp / 12, h = pp - b * 12;
                for (int ck = rk2; ck < 32; ck += nl2) att::merge_pieces<4>(c, (size_t)b * SEQ + ck * 256 + (tid >> 3), 64, h, tid & 7); }
            __syncthreads();
            for (int i = tid; i < 36 * 192; i += 512) tab[i] = tabg[i];
            __syncthreads();
        }
#endif
#if !defined(P2_NO_PROMPT) && !MK_TILE_ATT
        for (int rp_ = 0; rp_ <= (PROBE_P2 & 1) + ((PROBE_P2 >> 3) & 1); ++rp_) {
            auto mkdesc = [&](int un, int it) -> att::PDesc {
                att::PDesc d; d.b = un / 192; const int rem = un - d.b * 192; d.h = rem >> 4; const int ch = rem & 15; d.g = it >> 4; const int j = it & 15;
                if (d.g == 0) { d.dil = 1; d.r = 0; d.i0 = ch * 512 + 32 * j; } else if (d.g == 1) { d.dil = 4; d.r = j >> 2; d.i0 = ch * 128 + 32 * (j & 3); } else { d.dil = 16; d.r = j; d.i0 = ch * 32; }
                return d; };
            bf16x8 qv[4], kr[5][4];
            const int vkey_ = lane >> 3, vch_ = lane & 7;
            const int vcu = (G % 8 == 0) ? (bid & 7) * (G >> 3) + (bid >> 3) : bid;
            int un = vcu, it = wave;
            att::PDesc cur = mkdesc(un < 768 ? un : 0, it);
            if (un < 768) { att::p_load_q(c, cur, qv, vkey_, vch_);
#pragma unroll
                for (int s5 = 0; s5 < 2; ++s5) att::p_load_kv(c.KB, cur, s5, kr[s5], vkey_, vch_); }
            while (un < 768) {
                int un2 = un, it2 = it + 8; if (it2 >= 48) { it2 = wave; un2 = un + G; }
                const bool has_next = un2 < 768;
                const att::PDesc nxt = mkdesc(has_next ? un2 : un, has_next ? it2 : it);
                att::pblock(c, cur, nxt, has_next, qv, kr, tab, vbuf);
                if (un2 != un) {
                    __syncthreads();
                    const int b = un / 192, rem = un - b * 192, h = rem >> 4, ch = rem & 15;
#pragma unroll 1
                    for (int ps = 0; ps < 8; ps += 4) att::merge_pieces<4>(c, (size_t)b * SEQ + ch * 512 + ps * 64 + (tid >> 3), 64, h, tid & 7);
                }
                cur = nxt; un = un2; it = it2;
            }
        }
#endif
        {
            unsigned* cq = (unsigned*)(ws + WS_CTL) + 13200;
            volatile LAS unsigned* qw = (volatile LAS unsigned*)(lds + MISC_OFF) + 8;
            constexpr unsigned NSU = NSEQ * NH, NCP = (unsigned)(MP / 64), NIT = NSU + NCP + NSEQ;
            LAS float* cw8 = (LAS float*)(lds + 98304);
            unsigned tk_ = 0;
            if (threadIdx.x == 0) { tk_ = xb_add(cq, 1u); qw[0] = tk_; }
            __syncthreads();
            unsigned q = (unsigned)__builtin_amdgcn_readfirstlane((int)qw[0]);
            bool conv_ready = false;
            while (q < NIT) {
                __syncthreads();
                if (threadIdx.x == 0) tk_ = xb_add(cq, 1u);
                if (q < NSU) {
                    const int n = (int)q / NH, h = (int)q - n * NH;
                    if (wave == 0) att::wave_block<1>(c, n, h, 0, 1, 0, 2048, 8, tab + (0 * 12 + h) * 192, vbuf);
                    else for (int it = wave; it < 13; it += 7) {
                        LAS float* sb = (LAS float*)vbuf;
                        if (it < 5) att::sample_vblock<2>(c, n, h, 1, 4, it - 1, 512, tab + (1 * 12 + h) * 192, sb);
                        else att::sample_vblock<1>(c, n, h, 2, 16, it - 5, 128, tab + (2 * 12 + h) * 192, sb);
                    }
                    __syncthreads();
                    if (tid < 64) att::merge_pieces<1>(c, (size_t)MP + n * TS + (tid >> 3), 0, h, tid & 7);
                } else {
                    if (!conv_ready) { __syncthreads(); for (int i = tid; i < 31 * CWD; i += 512) cw8[i] = p.in[11][i]; conv_ready = true; }
                    const int un = (int)(q - NSU);
                    if (un < (int)NCP) conv_unit<8, false>(U, p.in[5], un >> 7, (un & 127) * 64, (LAS float*)(lds + ATT_V_OFF), cw8, p.in[12], p.in[13], p.in[14], ATT, tid, lane, wave);
                    else conv_unit<1, true>(U, p.in[5], un - (int)NCP, 0, (LAS float*)(lds + ATT_V_OFF), cw8, p.in[12], p.in[13], p.in[14], ATT, tid, lane, wave);
                }
                if (threadIdx.x == 0) qw[0] = tk_;
                __syncthreads();
                q = (unsigned)__builtin_amdgcn_readfirstlane((int)qw[0]);
            }
        }
    }
    SEAM(2);
    const int nl = __builtin_amdgcn_readfirstlane((int)((volatile LAS unsigned*)(lds + MISC_OFF))[0]), nx = __builtin_amdgcn_readfirstlane((int)((volatile LAS unsigned*)(lds + MISC_OFF))[1]);
    const int xi = __builtin_amdgcn_readfirstlane((int)((volatile LAS unsigned*)(lds + MISC_OFF))[2]), rk = __builtin_amdgcn_readfirstlane((int)((volatile LAS unsigned*)(lds + MISC_OFF))[3]);
    unsigned* xq_flag = (unsigned*)(ws + WS_CTL) + 3520; unsigned* xo_flag = (unsigned*)(ws + WS_CTL) + 13000;
    bool own128 = false;
    { for (int j = 0; j < 16; ++j) { const int Lx = j * nl + rk, pm = xi + nx * (Lx >> 2); if (pm >= 129) break; own128 |= (pm == 128); } }
    if (IN(3)) {
        pg8::SchedXL S{nl, rk, xi, nx, (const char*)ATT, (const char*)WOUT, (size_t)256 * DM * 2, (size_t)256 * DM * 2, 0};
        pg8::EpiRes<true> E{p.in[0], p.in[1], nullptr, XN, p.in[16], SSQ};
        pg8::gemm_phase<pg8::EpiRes<true>, pg8::SchedXL, true>(lds, pg8::Cfg{DM, DM, DM}, S, E, wave);
    }
    xl_barrier(xbar);
    if (IN(4)) {
        {   pg8::SchedXL S{nl, rk, xi, nx, (const char*)XN, (const char*)WXQ, (size_t)256 * DM * 2, (size_t)256 * DM * 2, 0};
            pg8::EpiScale E{XQ, SSQ, XQSCALE};
            pg8::gemm_phase<pg8::EpiScale, pg8::SchedXL, true>(lds, pg8::Cfg{DM, DM, DM}, S, E, wave); }
        if (own128 && threadIdx.x == 0) { __builtin_amdgcn_fence(__ATOMIC_RELEASE, "agent"); asm volatile("s_waitcnt vmcnt(0)" ::: "memory"); (void)xb_add(xq_flag, 1u); }
        {   pg8::SchedXLs S{nl, rk, xi, nx, (const char*)XQ, (const char*)MKB, 0};
            pg8::EpiSoftmax E{PB, LSUM, (LAS float*)(lds + XCH_OFF)};
            pg8::gemm_phase<pg8::EpiSoftmax, pg8::SchedXLs, true>(lds, pg8::Cfg{256, DM, DM}, S, E, wave); }
        {   pg8::SchedXLs S{nl, rk, xi, nx, (const char*)PB, (const char*)MVT, 1};
            pg8::EpiPV E{XO, LSUM};
            pg8::gemm_phase<pg8::EpiPV, pg8::SchedXLs, true>(lds, pg8::Cfg{256, DM, DM}, S, E, wave); }
        PHASE_IDS;
        if (threadIdx.x == 0) { unsigned sp = 0; while (xb_ld(xq_flag) < 4u) { __builtin_amdgcn_s_sleep(2); if (++sp > (1u << 22)) break; }
            __builtin_amdgcn_fence(__ATOMIC_ACQUIRE, "agent"); asm volatile("s_waitcnt vmcnt(0)" ::: "memory"); }
        LAS float* qs = (LAS float*)lds;
        LAS float* sc = (LAS float*)(lds + 4096);
        LAS float* red = (LAS float*)(lds + 8192);
        for (int un = bid; un < NSEQ * 4 * 2; un += G) {
            const int n = un >> 3, h = (un >> 1) & 3, half = un & 1;
            __syncthreads();
            for (int i = tid; i < 4 * 256; i += 512) { const int t = i >> 8, d = i & 255; qs[i] = __uint_as_float((unsigned)XQ[((size_t)MP + n * TS + 4 * half + t) * DM + h * 256 + d] << 16); }
            __syncthreads();
            const float* Kc = p.in[6] + ((size_t)n * NMEM * 4 + h) * 256; const float* Vc = p.in[7] + ((size_t)n * NMEM * 4 + h) * 256;
            f32x4 qv[4];
#pragma unroll
            for (int t = 0; t < 4; ++t) qv[t] = *(const LAS f32x4*)(qs + t * 256 + 4 * lane);
#pragma unroll 1
            for (int mb = 0; mb < 2; ++mb) {
                f32x4 kv[16];
#pragma unroll
                for (int k = 0; k < 16; ++k) kv[k] = *(const f32x4*)(Kc + (size_t)(wave * 32 + mb * 16 + k) * 1024 + 4 * lane);
#pragma unroll
                for (int k = 0; k < 16; ++k) {
                    float pt[4];
#pragma unroll
                    for (int t = 0; t < 4; ++t) pt[t] = wave_sum((kv[k][0] * qv[t][0] + kv[k][1] * qv[t][1]) + (kv[k][2] * qv[t][2] + kv[k][3] * qv[t][3]));
                    if (lane == 0) *(LAS f32x4*)(sc + (wave * 32 + mb * 16 + k) * 4) = (f32x4){pt[0], pt[1], pt[2], pt[3]};
                }
            }
            __syncthreads();
            if (wave < 4) {
                const int t = wave; float v[4]; float mx = -3.0e38f;
#pragma unroll
                for (int j = 0; j < 4; ++j) { v[j] = sc[(lane + 64 * j) * 4 + t]; mx = fmaxf(mx, v[j]); }
#pragma unroll
                for (int o = 1; o < 64; o <<= 1) mx = fmaxf(mx, __shfl_xor(mx, o));
                float sm = 0.f;
#pragma unroll
                for (int j = 0; j < 4; ++j) { v[j] = fast_exp2(v[j] - mx); sm += v[j]; }
                sm = wave_sum(sm); const float inv = 1.0f / sm;
#pragma unroll
                for (int j = 0; j < 4; ++j) sc[(lane + 64 * j) * 4 + t] = v[j] * inv;
            }
            __syncthreads();
            {
                const int d = tid & 255, mh = tid >> 8; f32x4 o = (f32x4){0.f, 0.f, 0.f, 0.f};
                const float* vp = Vc + (size_t)(mh * 128) * 1024 + d; const LAS float* pp = sc + (mh * 128) * 4;
#pragma unroll 1
                for (int m0 = 0; m0 < 128; m0 += 32) {
                    float vv[32];
#pragma unroll
                    for (int m = 0; m < 32; ++m) vv[m] = vp[(size_t)(m0 + m) * 1024];
#pragma unroll
                    for (int m = 0; m < 32; ++m) { const f32x4 pw = *(const LAS f32x4*)(pp + (m0 + m) * 4); o += pw * vv[m]; }
                }
                if (mh == 1) *(LAS f32x4*)(red + d * 4) = o;
                __syncthreads();
                if (mh == 0) { o += *(const LAS f32x4*)(red + d * 4);
#pragma unroll
                    for (int e = 0; e < 4; ++e) { const unsigned mine = pkbf(o[e], 0.f) & 0xffffu, nb = (unsigned)__shfl_down((int)mine, 1);
                        if (!(d & 1)) __hip_atomic_store((unsigned*)(XO + ((size_t)MP + n * TS + 4 * half + e) * DM + h * 256 + d), mine | (nb << 16), __ATOMIC_RELAXED, __HIP_MEMORY_SCOPE_AGENT); } }
            }
            asm volatile("s_waitcnt vmcnt(0)" ::: "memory"); __syncthreads();
            if (threadIdx.x == 0) (void)xb_add(xo_flag, 1u);
        }
        __syncthreads();
    }
    xl_barrier(xbar);
    if (IN(7)) {
        if (own128) {
            if (threadIdx.x == 0) { unsigned sp = 0; while (xb_ld(xo_flag) < (unsigned)(NSEQ * 8)) { __builtin_amdgcn_s_sleep(2); if (++sp > (1u << 22)) break; }
                __builtin_amdgcn_fence(__ATOMIC_ACQUIRE, "agent"); asm volatile("s_waitcnt vmcnt(0)" ::: "memory"); }
            __syncthreads();
        }
        pg8::SchedXL S{nl, rk, xi, nx, (const char*)XO, (const char*)WXO, (size_t)256 * DM * 2, (size_t)256 * DM * 2, 0};
        pg8::EpiRes<false> E{nullptr, nullptr, p.in[16], XN, p.in[22], SSQ + SSQ_STRIDE};
        pg8::gemm_phase<pg8::EpiRes<false>, pg8::SchedXL, true>(lds, pg8::Cfg{DM, DM, DM}, S, E, wave);
    }
    xl_barrier(xbar);
    const int xi0 = 128 % nx;
    const int xi9 = (nx > 1 && nl >= 4) ? (xi0 + 1) % nx : xi0;
    unsigned* h_flag = (unsigned*)(ws + WS_CTL) + 13064;
    if (IN(8)) {
        pg8::SchedXL22 S{nl, rk, xi, nx, (const char*)XN, (const char*)WGU, (size_t)256 * DM * 2, (size_t)256 * DM * 2};
        pg8::EpiSwiGLU E{HB, SSQ + SSQ_STRIDE};
        pg8::gemm_phase<pg8::EpiSwiGLU, pg8::SchedXL22, true>(lds, pg8::Cfg{DM, DM, DM}, S, E, wave);
        bool had = false;
        for (int j = 0; j < 16; ++j) { const int Lx = j * nl + rk, pm = xi + nx * (Lx / 22); if (pm >= 129) break; had |= (pm == 128); }
        if (had && threadIdx.x == 0) { __builtin_amdgcn_fence(__ATOMIC_RELEASE, "agent"); asm volatile("s_waitcnt vmcnt(0)" ::: "memory"); (void)xb_add(h_flag, 1u); }
    }
    xl_barrier(xbar);
    if (IN(9)) {
        pg8::EpiFinal E{XN, p.in[22], out + OFF_Y, p.in[26], (float*)(ws + WS_SLOT), (unsigned*)(ws + WS_CTL) + 4096, (LAS float*)(lds + XCH_OFF), wave};
        {   pg8::SchedXL S{nl, rk, xi, nx, (const char*)HB, (const char*)WDN, (size_t)256 * DFF * 2, (size_t)256 * DFF * 2, 1};
            pg8::gemm_phase<pg8::EpiFinal, pg8::SchedXL, true>(lds, pg8::Cfg{DFF, DFF, DFF}, S, E, wave); }
        if (xi == xi9 && rk < 4) {
            if (threadIdx.x == 0) { unsigned sp = 0; while (xb_ld(h_flag) < 22u) { __builtin_amdgcn_s_sleep(2); if (++sp > (1u << 22)) break; }
                __builtin_amdgcn_fence(__ATOMIC_ACQUIRE, "agent"); asm volatile("s_waitcnt vmcnt(0)" ::: "memory"); }
            __syncthreads();
            pg8::SchedOne S{128, rk, (const char*)HB, (const char*)WDN, (size_t)256 * DFF * 2, (size_t)256 * DFF * 2};
            pg8::gemm_phase<pg8::EpiFinal, pg8::SchedOne, true>(lds, pg8::Cfg{DFF, DFF, DFF}, S, E, wave);
        }
    }
    {   const bool all = (nx <= 1);
        int before = 0; for (int x = 0; x < xi; ++x) if (x != xi0) before += (x == xi9 && xi9 != xi0) ? nl - 4 : nl;
        const int mine = (xi == xi9 && xi9 != xi0) ? rk - 4 : rk;
        const int nwk = all ? nl : (nx - 1) * nl - (xi9 != xi0 ? 4 : 0), widx = all ? rk : before + mine;
        if (all || (xi != xi0 && mine >= 0)) { PHASE_IDS; att::copy_range(p.in[3], p.in[4], out, 2000000u, 23067520u, widx, nwk, tid); } }
#undef IN
#undef SEAM
}

extern "C" void kernel_launch(void* const* d_in, const int* in_sizes, int n_in, void* d_out, int out_size, void* d_ws, size_t ws_size, hipStream_t stream) {
    static int grid = 0;
    if (grid == 0) {
        if (n_in != 27 || (size_t)out_size != OUT_TOTAL || ws_size < WS_END) { fprintf(stderr, "kernel_launch: unexpected shapes: n_in %d out %d ws %zu\n", n_in, out_size, ws_size); grid = -1; return; }
        int dev = 0, cus = 0, per_cu = 0;
        (void)hipGetDevice(&dev); (void)hipDeviceGetAttribute(&cus, hipDeviceAttributeMultiprocessorCount, dev);
        if (hipFuncSetAttribute((const void*)fwd_kernel, hipFuncAttributeMaxDynamicSharedMemorySize, LDS_BYTES) != hipSuccess) { fprintf(stderr, "kernel_launch: hipFuncSetAttribute failed\n"); grid = -1; return; }
        if (hipOccupancyMaxActiveBlocksPerMultiprocessor(&per_cu, (const void*)fwd_kernel, 512, LDS_BYTES) != hipSuccess || per_cu < 1) { fprintf(stderr, "kernel_launch: occupancy query failed (%d)\n", per_cu); (void)hipGetLastError(); per_cu = 1; }
        grid = cus * 1;
        if (per_cu < 1) grid = -1;
    }
    if (grid < 0) return;
    Params p{};
    for (int i = 0; i < 27; ++i) p.in[i] = (const float*)d_in[i];
    p.out = (float*)d_out; p.ws = (unsigned char*)d_ws;
#if MK_COOP
    if (hipMemsetAsync((char*)d_ws + WS_CTL, 0, CTL_ZERO_BYTES, stream) != hipSuccess) { fprintf(stderr, "kernel_launch: memset of the barrier words failed\n"); return; }
    p.ph_lo = 0; p.ph_hi = 11; p.coop = 1;
    void* args[] = {&p};
    hipError_t e = hipLaunchCooperativeKernel((const void*)fwd_kernel, dim3(grid), dim3(512), args, LDS_BYTES, stream);
    if (e != hipSuccess) fprintf(stderr, "cooperative launch failed: %s (grid %d)\n", hipGetErrorString(e), grid);
#else
    for (int ph = 0; ph < 11; ++ph) {
        p.ph_lo = ph; p.ph_hi = ph + 1; p.coop = 0;
        hipLaunchKernelGGL(fwd_kernel, dim3(grid), dim3(512), LDS_BYTES, stream, p);
    }
#endif
}
```

```cpp
#include <hip/hip_runtime.h>
#include <hip/hip_cooperative_groups.h>
#include <cstdio>
#include <cstdint>
namespace cg = cooperative_groups;

#ifndef MK_COOP
#define MK_COOP 1
#endif

#define LAS __attribute__((address_space(3)))
typedef unsigned short bf16_t;
typedef short bf16x8 __attribute__((ext_vector_type(8)));
typedef short s16x4 __attribute__((ext_vector_type(4)));
typedef float f32x2 __attribute__((ext_vector_type(2)));
typedef float f32x4 __attribute__((ext_vector_type(4)));
typedef float f32x16 __attribute__((ext_vector_type(16)));
typedef unsigned u32x2 __attribute__((ext_vector_type(2)));
typedef unsigned u32x4 __attribute__((ext_vector_type(4)));
typedef __bf16 bf16x2_t __attribute__((ext_vector_type(2)));

__device__ __forceinline__ unsigned pkbf(float lo, float hi) { f32x2 v = {lo, hi}; bf16x2_t b = __builtin_convertvector(v, bf16x2_t); return __builtin_bit_cast(unsigned, b); }
__device__ __forceinline__ float bf_lo(unsigned w) { return __uint_as_float(w << 16); }
__device__ __forceinline__ float bf_hi(unsigned w) { return __uint_as_float(w & 0xffff0000u); }
__device__ __forceinline__ int fresh_lane() { int t = __builtin_amdgcn_mbcnt_hi(~0u, __builtin_amdgcn_mbcnt_lo(~0u, 0u)); asm volatile("" : "+v"(t)); return t; }
__device__ __forceinline__ float fast_exp2(float x) { return __builtin_amdgcn_exp2f(x); }
__device__ __forceinline__ float fast_rcp(float x) { return __builtin_amdgcn_rcpf(x); }

constexpr int DM = 1024, NBATCH = 4, SEQ = 8192, MP = NBATCH * SEQ;
constexpr int NSEQ = 32, TS = 8, MSMP = NSEQ * TS;
constexpr int MTOK = MP + MSMP;
constexpr int NMEM = 256, MMEM = NBATCH * NMEM;
constexpr int MALL = MTOK + MMEM;
constexpr int AW = 768, CWD = 256, NIN = 2816, DFF = 2816, NH = 12, HD = 64;
constexpr int WBUF = 2048;
constexpr float EPS = 1e-6f;
constexpr float LOG2E = 1.4426950408889634f;
constexpr float QSCALE = 0.125f * LOG2E;
constexpr float XQSCALE = 0.0625f * LOG2E;

constexpr size_t OFF_Y = 0;
constexpr size_t OFF_PWK = 33816576, OFF_PWV = 40108032, OFF_PCONV = 46399488, OFF_PMK = 46430208, OFF_PMV = 47478784;
constexpr size_t OFF_SWK = 48527360, OFF_SWV = 98859008, OFF_SCONV = 149190656, OUT_TOTAL = 149436416;

constexpr size_t MiB = 1u << 20;
constexpr size_t WS_CTL = 0, CTL_ZERO_BYTES = 65536;
constexpr size_t WS_WALL = 2 * MiB;
constexpr size_t WS_WOUT = 12 * MiB, WS_WXQ = 14 * MiB, WS_WXO = 16 * MiB;
constexpr size_t WS_WGU = 18 * MiB;
constexpr size_t WS_WDN = 30 * MiB;
constexpr size_t WS_XN = 36 * MiB;
constexpr size_t WS_QB = 104 * MiB, WS_KB = 154 * MiB, WS_VB = 204 * MiB;
constexpr size_t WS_U = 254 * MiB;
constexpr size_t WS_OP = 288 * MiB;
constexpr size_t OP_STRIDE = (size_t)MTOK * AW;
constexpr size_t WS_LSE = 434 * MiB;
constexpr size_t LSE_STRIDE = (size_t)MTOK * NH;
constexpr size_t WS_ATT = 440 * MiB;
constexpr size_t WS_X1 = 506 * MiB;
constexpr size_t WS_SSQ = 636 * MiB;
constexpr size_t SSQ_STRIDE = (size_t)MTOK * 16;
constexpr size_t WS_MKB = 644 * MiB, WS_MVT = 646 * MiB;
constexpr size_t WS_LSUM = 648 * MiB;
constexpr size_t WS_XQ = 353 * MiB;
constexpr size_t WS_PB = 652 * MiB;
constexpr size_t WS_XO = 288 * MiB;
constexpr size_t WS_H = 104 * MiB;
constexpr size_t WS_TABG = 651 * MiB;
constexpr size_t WS_SLOT = 650 * MiB;
constexpr size_t WS_END = 716 * MiB;

namespace pg8 {
constexpr int BM = 256, BK = 64, HALF = 128, HTB = HALF * BK * 2, STAGE_BYTES = 8 * HTB, NXCD = 8, WGM = 8;
__host__ __device__ __forceinline__ int lds_byte(int r, int c) { const int st = (r >> 4) * 2 + (c >> 5), rr = r & 15, cc = c & 31, ob = rr * 64 + cc * 2; return st * 1024 + (ob ^ (((ob >> 9) & 1) << 5)); }
__host__ __device__ __forceinline__ void stage_rc(int b, int& R, int& C) { const int st = b / 1024, sb = b % 1024, swz = sb ^ (((sb >> 9) & 1) << 5); R = (st >> 1) * 16 + swz / 64; C = (st & 1) * 32 + (swz % 64) / 2; }
__host__ __device__ __forceinline__ int perm32(int rho) { const int n = rho >> 4, i = rho & 15; return 8 * (i >> 2) + 4 * n + (i & 3); }

struct Unit { int pm, pn, kind; };
struct Cfg { int K, lda, ldb; };

template <class Epi, class Sched, bool ALIGN_EPI>
__device__ __forceinline__ void gemm_phase(LAS unsigned char* lds, const Cfg g, const Sched& S, const Epi& E, const int wid) {
    const int lane = fresh_lane(), tid = wid * 64 + lane, wr = wid >> 2, wc = wid & 3, fr = lane & 15, fq = lane >> 4;
    const int K = g.K, nt = K / BK;
    unsigned voffA[2], voffB[2];
#pragma unroll
    for (int i = 0; i < 2; ++i) { int R, C; stage_rc(tid * 16 + i * 8192, R, C); const int Rb = (R & ~31) + perm32(R & 31);
        voffA[i] = (unsigned)(R * g.lda + C) * 2u; voffB[i] = (unsigned)(Rb * g.ldb + C) * 2u; }
    const size_t kstep = (size_t)(BK * 2);
    const size_t hA = (size_t)HALF * g.lda * 2, hB = (size_t)HALF * g.ldb * 2;
    const unsigned ldsw = (unsigned)wid * 1024u;
    const int aoff = lds_byte(wr * 64 + fr, fq * 8), boff = lds_byte(wc * 32 + fr, fq * 8);
#define PG8_SA(b, h) (((b) * 2 + (h)) * HTB)
#define PG8_SB(b, h) ((4 + (b) * 2 + (h)) * HTB)
#define PG8_STAGE(bufoff, gbase, voff) do { _Pragma("unroll") for (int _i = 0; _i < 2; ++_i) \
        __builtin_amdgcn_global_load_lds((const unsigned*)((const char*)(gbase) + (voff)[_i]), (LAS unsigned*)(lds + (bufoff) + ldsw + _i * 8192), 16, 0, 0); } while (0)
#define PG8_LDA(dst, b, h) do { _Pragma("unroll") for (int m = 0; m < 4; ++m) _Pragma("unroll") for (int k = 0; k < 2; ++k) dst[m][k] = *(const LAS bf16x8*)(lds + PG8_SA(b, h) + aoff + m * 2048 + k * 1024); } while (0)
#define PG8_LDB(dst, b, h) do { _Pragma("unroll") for (int n = 0; n < 2; ++n) _Pragma("unroll") for (int k = 0; k < 2; ++k) dst[n][k] = *(const LAS bf16x8*)(lds + PG8_SB(b, h) + boff + n * 2048 + k * 1024); } while (0)
#define PG8_MMA(ai, bj, At, Bt) do { __builtin_amdgcn_s_setprio(1); _Pragma("unroll") for (int m = 0; m < 4; ++m) _Pragma("unroll") for (int n = 0; n < 2; ++n) _Pragma("unroll") for (int k = 0; k < 2; ++k) \
        acc[ai][bj][m][n] = __builtin_amdgcn_mfma_f32_16x16x32_bf16(Bt[n][k], At[m][k], acc[ai][bj][m][n], 0, 0, 0); __builtin_amdgcn_s_setprio(0); } while (0)
#define PG8_WAIT_V(n) asm volatile("s_waitcnt vmcnt(" #n ")" ::: "memory")
#define PG8_WAIT_L(n) asm volatile("s_waitcnt lgkmcnt(" #n ")" ::: "memory")
#define PG8_BAR __builtin_amdgcn_s_barrier()
#define PG8_SCHED __builtin_amdgcn_sched_barrier(0)
    Unit cur, nxt; int ui = 0;
    if (!S.next(0, cur)) return;
    f32x4 acc[2][2][4][2];
    E.init(acc, cur, wr, wc, fr, fq);
    bf16x8 At[4][2], B0[2][2], B1[2][2];
    const char* cA = S.aptr(cur); const char* cB = S.bptr(cur);
    PG8_STAGE(PG8_SB(0, 0), cB, voffB); PG8_STAGE(PG8_SB(0, 1), cB + hB, voffB); PG8_STAGE(PG8_SA(0, 0), cA, voffA); PG8_STAGE(PG8_SA(0, 1), cA + hA, voffA);
    if (wr == 1) PG8_BAR;
    PG8_WAIT_V(2); PG8_BAR;
    PG8_STAGE(PG8_SB(1, 0), cB + kstep, voffB); PG8_STAGE(PG8_SA(1, 0), cA + kstep, voffA); PG8_STAGE(PG8_SB(1, 1), cB + hB + kstep, voffB);
    PG8_WAIT_V(6); PG8_BAR;
    for (;;) {
        const bool has_next = S.next(ui + 1, nxt);
        const char* nA = has_next ? S.aptr(nxt) : cA; const char* nB = has_next ? S.bptr(nxt) : cB;
#pragma unroll 1
        for (int t = 0; t < nt; t += 2) {
            const bool last = (t == nt - 2);
            const char* a1 = cA + (size_t)(t + 1) * kstep;
            const char* a2 = last ? nA : cA + (size_t)(t + 2) * kstep; const char* b2 = last ? nB : cB + (size_t)(t + 2) * kstep;
            const char* a3 = a2 + kstep; const char* b3 = b2 + kstep;
            PG8_LDB(B0, 0, 0); PG8_LDB(B1, 0, 1); PG8_SCHED; PG8_LDA(At, 0, 0); PG8_STAGE(PG8_SA(1, 1), a1 + hA, voffA);
            PG8_WAIT_V(8); PG8_WAIT_L(0); PG8_BAR; PG8_MMA(0, 0, At, B0); PG8_MMA(0, 1, At, B1); PG8_BAR; PG8_SCHED;
            PG8_LDA(At, 0, 1); PG8_STAGE(PG8_SB(0, 0), b2, voffB); PG8_STAGE(PG8_SB(0, 1), b2 + hB, voffB); PG8_STAGE(PG8_SA(0, 0), a2, voffA);
            PG8_WAIT_V(8); PG8_WAIT_L(0); PG8_BAR; PG8_MMA(1, 0, At, B0); PG8_MMA(1, 1, At, B1); PG8_BAR; PG8_SCHED;
            PG8_LDB(B0, 1, 0); PG8_LDB(B1, 1, 1); PG8_SCHED; PG8_LDA(At, 1, 0); PG8_STAGE(PG8_SA(0, 1), a2 + hA, voffA);
            PG8_WAIT_V(8); PG8_WAIT_L(0); PG8_BAR; PG8_MMA(0, 0, At, B0); PG8_MMA(0, 1, At, B1); PG8_BAR; PG8_SCHED;
            PG8_LDA(At, 1, 1); PG8_STAGE(PG8_SB(1, 0), b3, voffB); PG8_STAGE(PG8_SB(1, 1), b3 + hB, voffB); PG8_STAGE(PG8_SA(1, 0), a3, voffA);
            PG8_WAIT_V(8); PG8_WAIT_L(0); PG8_BAR; PG8_MMA(1, 0, At, B0); PG8_MMA(1, 1, At, B1); PG8_BAR; PG8_SCHED;
        }
        if constexpr (ALIGN_EPI) { if (wr == 0) PG8_BAR; }
        E(acc, cur, wr, wc, fr, fq);
        if (!has_next) break;
        E.init(acc, nxt, wr, wc, fr, fq);
        cur = nxt; cA = nA; cB = nB; ++ui;
        if constexpr (ALIGN_EPI) { if (wr == 1) PG8_BAR; }
    }
    PG8_WAIT_V(0);
    if constexpr (!ALIGN_EPI) { if (wr == 0) PG8_BAR; }
    PG8_BAR;
#undef PG8_SA
#undef PG8_SB
#undef PG8_STAGE
#undef PG8_LDA
#undef PG8_LDB
#undef PG8_MMA
#undef PG8_WAIT_V
#undef PG8_WAIT_L
#undef PG8_BAR
#undef PG8_SCHED
}

__device__ __forceinline__ void swz_tile(int L, int nM, int nN, int& pm, int& pn) {
    const int nwg = nM * nN; int wgid = L;
    { const int q = nwg / NXCD, r = nwg % NXCD, xcd = wgid % NXCD, off = wgid / NXCD; wgid = (xcd < r ? xcd * (q + 1) : r * (q + 1) + (xcd - r) * q) + off; }
    const int nig = WGM * nN, gid = wgid / nig, fm = gid * WGM, gsz = (nM - fm) < WGM ? (nM - fm) : WGM;
    pm = fm + ((wgid % nig) % gsz); pn = (wgid % nig) / gsz;
}
struct SchedGrid {
    int nM, nN, G, c; const char* A; const char* B; size_t tA, tB;
    __device__ __forceinline__ bool next(int i, Unit& u) const { const long L = (long)i * G + c; if (L >= (long)nM * nN) return false; swz_tile((int)L, nM, nN, u.pm, u.pn); u.kind = 0; return true; }
    __device__ __forceinline__ const char* aptr(const Unit& u) const { return A + (size_t)u.pm * tA; }
    __device__ __forceinline__ const char* bptr(const Unit& u) const { return B + (size_t)u.pn * tB; }
};
struct SchedMem {
    int c; const char* XN; const char* W;
    static constexpr size_t TS_ = (size_t)256 * 1024 * 2;
    __device__ __forceinline__ bool next(int i, Unit& u) const {
        if (i > 0 || c < 0 || c >= 48) return false;
        if (c < 32) { u.pm = 129 + (c >> 3); u.pn = 11 + (c & 7); u.kind = 1; } else { const int f = c - 32; u.pm = f >> 2; u.pn = f & 3; u.kind = 2; }
        return true;
    }
    __device__ __forceinline__ const char* aptr(const Unit& u) const { return u.kind == 2 ? W + (size_t)(15 + u.pm) * TS_ : XN + (size_t)u.pm * TS_; }
    __device__ __forceinline__ const char* bptr(const Unit& u) const { return u.kind == 2 ? XN + (size_t)(129 + u.pn) * TS_ : W + (size_t)u.pn * TS_; }
};
struct SchedX {
    int G, c; const char* A; const char* B; int bmode;
    __device__ __forceinline__ bool next(int i, Unit& u) const { const long L = (long)i * G + c; if (L >= 512) return false; u.pm = (int)L >> 2; u.pn = (int)L & 3; u.kind = 0; return true; }
    __device__ __forceinline__ const char* aptr(const Unit& u) const { return A + ((size_t)u.pm * 256 * 1024 + (size_t)u.pn * 256) * 2; }
    __device__ __forceinline__ const char* bptr(const Unit& u) const { const int b = u.pm >> 5; return bmode == 0 ? B + ((size_t)b * 256 * 1024 + (size_t)u.pn * 256) * 2 : B + ((size_t)u.pn * 256 * 1024 + (size_t)b * 256) * 2; }
};

struct SchedPanel {
    int G, vcu; const char* A; const char* B; size_t tA, tB;
    __device__ __forceinline__ bool next(int i, Unit& u) const { const int L = i * G + vcu; if (L >= 516) return false; u.pm = L >> 2; u.pn = L & 3; u.kind = 0; return true; }
    __device__ __forceinline__ const char* aptr(const Unit& u) const { return A + (size_t)u.pm * tA; }
    __device__ __forceinline__ const char* bptr(const Unit& u) const { return B + (size_t)u.pn * tB; }
};
struct SchedXL {
    int nl, rk, xi, nx; const char* A; const char* B; size_t tA, tB; int skip128;
    __device__ __forceinline__ bool next(int i, Unit& u) const { const int Lx = i * nl + rk, pm = xi + nx * (Lx >> 2); if (pm >= 129 || (skip128 && pm == 128)) return false; u.pm = pm; u.pn = Lx & 3; u.kind = 0; return true; }
    __device__ __forceinline__ const char* aptr(const Unit& u) const { return A + (size_t)u.pm * tA; }
    __device__ __forceinline__ const char* bptr(const Unit& u) const { return B + (size_t)u.pn * tB; }
};
struct SchedOne {
    int pm, pn; const char* A; const char* B; size_t tA, tB;
    __device__ __forceinline__ bool next(int i, Unit& u) const { if (i > 0) return false; u.pm = pm; u.pn = pn; u.kind = 0; return true; }
    __device__ __forceinline__ const char* aptr(const Unit& u) const { return A + (size_t)u.pm * tA; }
    __device__ __forceinline__ const char* bptr(const Unit& u) const { return B + (size_t)u.pn * tB; }
};
struct SchedXL22 {
    int nl, rk, xi, nx; const char* A; const char* B; size_t tA, tB;
    __device__ __forceinline__ bool next(int i, Unit& u) const { const int Lx = i * nl + rk, q = Lx / 22, pm = xi + nx * q; if (pm >= 129) return false; u.pm = pm; u.pn = Lx - q * 22; u.kind = 0; return true; }
    __device__ __forceinline__ const char* aptr(const Unit& u) const { return A + (size_t)u.pm * tA; }
    __device__ __forceinline__ const char* bptr(const Unit& u) const { return B + (size_t)u.pn * tB; }
};
struct SchedXLs {
    int nl, rk, xi, nx; const char* A; const char* B; int bmode;
    __device__ __forceinline__ bool next(int i, Unit& u) const {
        int idx = 0;
#pragma unroll 1
        for (int j = 0; j < 16; ++j) { const int Lx = j * nl + rk, pm = xi + nx * (Lx >> 2); if (pm >= 129) break; if (pm == 128) continue;
            if (idx == i) { u.pm = pm; u.pn = Lx & 3; u.kind = 0; return true; } ++idx; }
        return false;
    }
    __device__ __forceinline__ const char* aptr(const Unit& u) const { return A + ((size_t)u.pm * 256 * 1024 + (size_t)u.pn * 256) * 2; }
    __device__ __forceinline__ const char* bptr(const Unit& u) const { const int b = u.pm >> 5; return bmode == 0 ? B + ((size_t)b * 256 * 1024 + (size_t)u.pn * 256) * 2 : B + ((size_t)u.pn * 256 * 1024 + (size_t)b * 256) * 2; }
};
struct SchedXs {
    int G, c; const char* A; const char* B; int bmode;
    __device__ __forceinline__ bool next(int i, Unit& u) const {
        int idx = 0;
#pragma unroll
        for (int j = 0; j < 3; ++j) { const int L = j * G + c; if (L >= 516) break; int pm, pn; swz_tile(L, 129, 4, pm, pn); if (pm == 128) continue;
            if (idx == i) { u.pm = pm; u.pn = pn; u.kind = 0; return true; } ++idx; }
        return false;
    }
    __device__ __forceinline__ const char* aptr(const Unit& u) const { return A + ((size_t)u.pm * 256 * 1024 + (size_t)u.pn * 256) * 2; }
    __device__ __forceinline__ const char* bptr(const Unit& u) const { const int b = u.pm >> 5; return bmode == 0 ? B + ((size_t)b * 256 * 1024 + (size_t)u.pn * 256) * 2 : B + ((size_t)u.pn * 256 * 1024 + (size_t)b * 256) * 2; }
};

#define EPI_ARGS const f32x4 (&acc)[2][2][4][2], const Unit& u, int wr, int wc, int fr, int fq
#define EPI_ZERO_INIT __device__ __forceinline__ void init(f32x4 (&acc)[2][2][4][2], const Unit&, int, int, int, int) const { \
    _Pragma("unroll") for (int a = 0; a < 2; ++a) _Pragma("unroll") for (int b = 0; b < 2; ++b) _Pragma("unroll") for (int m = 0; m < 4; ++m) _Pragma("unroll") for (int n = 0; n < 2; ++n) acc[a][b][m][n] = (f32x4){0.f, 0.f, 0.f, 0.f}; }
struct EpiIn {
    unsigned char* ws; float* out;
    EPI_ZERO_INIT
    __device__ __forceinline__ void operator()(EPI_ARGS) const {
        const int lr0 = wr * 64 + fr, lc0 = wc * 32 + 8 * fq;
        const int pm = u.pm, pn = u.pn;
        const bool smp = (pm == 128);
#ifdef P1_NO_QKV
        if (false) {
#else
        if (pn < 9) {
#endif
            const int sec = pn / 3, cb = (pn - sec * 3) * 256 + lc0;
            bf16_t* dst = (bf16_t*)(ws + (sec == 0 ? WS_QB : (sec == 1 ? WS_KB : WS_VB)));
            const float sc = sec == 0 ? QSCALE : 1.f;
#pragma unroll
            for (int ai = 0; ai < 2; ++ai)
#pragma unroll
                for (int m = 0; m < 4; ++m) {
                    bf16_t* rowp = dst + ((size_t)pm * 256 + lr0 + 128 * ai + 16 * m) * AW + cb;
#pragma unroll
                    for (int bj = 0; bj < 2; ++bj) {
                        const f32x4 v0 = acc[ai][bj][m][0] * sc, v1 = acc[ai][bj][m][1] * sc;
                        u32x4 w; w.x = pkbf(v0[0], v0[1]); w.y = pkbf(v0[2], v0[3]); w.z = pkbf(v1[0], v1[1]); w.w = pkbf(v1[2], v1[3]);
                        __builtin_nontemporal_store(w, (u32x4*)(rowp + bj * 128));
                    }
                }
            if (sec > 0 && (smp || (pm & 31) >= 24)) {
                float* fb; size_t sa, sm;
                if (smp) { fb = out + (sec == 1 ? OFF_SWK : OFF_SWV) + ((size_t)(8 * wr + (fr >> 3)) * WBUF + (WBUF - TS) + (fr & 7)) * AW + cb; sa = (size_t)16 * WBUF * AW; sm = (size_t)2 * WBUF * AW; }
                else { fb = out + (sec == 1 ? OFF_PWK : OFF_PWV) + ((size_t)(pm >> 5) * WBUF + ((pm & 31) - 24) * 256 + lr0) * AW + cb; sa = (size_t)128 * AW; sm = (size_t)16 * AW; }
#pragma unroll
                for (int ai = 0; ai < 2; ++ai)
#pragma unroll
                    for (int m = 0; m < 4; ++m)
#pragma unroll
                        for (int bj = 0; bj < 2; ++bj) { float* fp = fb + ai * sa + m * sm + bj * 128; __builtin_nontemporal_store(acc[ai][bj][m][0], (f32x4*)fp); __builtin_nontemporal_store(acc[ai][bj][m][1], (f32x4*)(fp + 4)); }
            }
#ifdef P1_NO_GLU
        } else if (false) {
#else
        } else {
#endif
            const int c0 = (pn - 9) * 128 + lc0;
            float* U = (float*)(ws + WS_U);
#pragma unroll
            for (int ai = 0; ai < 2; ++ai)
#pragma unroll
                for (int m = 0; m < 4; ++m) {
                    const size_t grow = (size_t)pm * 256 + lr0 + 128 * ai + 16 * m;
#pragma unroll
                    for (int n = 0; n < 2; ++n) {
                        const f32x4 a = acc[ai][0][m][n], gg = acc[ai][1][m][n]; f32x4 uu;
#pragma unroll
                        for (int e = 0; e < 4; ++e) uu[e] = a[e] * fast_rcp(1.f + fast_exp2(-gg[e] * LOG2E));
                        __builtin_nontemporal_store(uu, (f32x4*)(U + grow * CWD + c0 + 4 * n));
                    }
                }
            if (smp) {
                float* fb = out + OFF_SCONV + ((size_t)(8 * wr + (fr >> 3)) * 30 + 22 + (fr & 7)) * CWD + c0;
#pragma unroll
                for (int ai = 0; ai < 2; ++ai)
#pragma unroll
                    for (int m = 0; m < 4; ++m)
#pragma unroll
                        for (int n = 0; n < 2; ++n) {
                            const f32x4 a = acc[ai][0][m][n], gg = acc[ai][1][m][n]; f32x4 uu;
#pragma unroll
                            for (int e = 0; e < 4; ++e) uu[e] = a[e] * fast_rcp(1.f + fast_exp2(-gg[e] * LOG2E));
                            *(f32x4*)(fb + (size_t)(16 * ai + 2 * m) * 30 * CWD + 4 * n) = uu;
                        }
            } else if ((pm & 31) == 31 && wr == 1) {
#pragma unroll
                for (int m = 2; m < 4; ++m) {
                    const int lr = lr0 + 128 + 16 * m;
                    if (lr >= 226) {
                        float* fb = out + OFF_PCONV + ((size_t)(pm >> 5) * 30 + (lr - 226)) * CWD + c0;
#pragma unroll
                        for (int n = 0; n < 2; ++n) {
                            const f32x4 a = acc[1][0][m][n], gg = acc[1][1][m][n]; f32x4 uu;
#pragma unroll
                            for (int e = 0; e < 4; ++e) uu[e] = a[e] * fast_rcp(1.f + fast_exp2(-gg[e] * LOG2E));
                            *(f32x4*)(fb + 4 * n) = uu;
                        }
                    }
                }
            }
        }
    }
};
struct EpiMem {
    unsigned char* ws; float* out;
    EPI_ZERO_INIT
    __device__ __forceinline__ void operator()(EPI_ARGS) const {
        const int lr0 = wr * 64 + fr, lc0 = wc * 32 + 8 * fq;
        if (u.kind == 1) {
            const int sec = (u.pn - 11) >> 2, cb = ((u.pn - 11) & 3) * 256 + lc0;
            float* fo = out + (sec ? OFF_PMV : OFF_PMK); bf16_t* MKB = (bf16_t*)(ws + WS_MKB);
#pragma unroll
            for (int ai = 0; ai < 2; ++ai)
#pragma unroll
                for (int m = 0; m < 4; ++m) {
                    const size_t mr = (size_t)(u.pm - 129) * 256 + lr0 + 128 * ai + 16 * m;
#pragma unroll
                    for (int bj = 0; bj < 2; ++bj) {
                        const f32x4 v0 = acc[ai][bj][m][0], v1 = acc[ai][bj][m][1];
                        float* fp = fo + mr * 1024 + cb + bj * 128; *(f32x4*)fp = v0; *(f32x4*)(fp + 4) = v1;
                        if (sec == 0) { u32x4 w; w.x = pkbf(v0[0], v0[1]); w.y = pkbf(v0[2], v0[3]); w.z = pkbf(v1[0], v1[1]); w.w = pkbf(v1[2], v1[3]); *(u32x4*)(MKB + mr * 1024 + cb + bj * 128) = w; }
                    }
                }
        } else {
            bf16_t* MVT = (bf16_t*)(ws + WS_MVT);
#pragma unroll
            for (int ai = 0; ai < 2; ++ai)
#pragma unroll
                for (int m = 0; m < 4; ++m) {
                    const size_t nr = (size_t)u.pm * 256 + lr0 + 128 * ai + 16 * m;
#pragma unroll
                    for (int bj = 0; bj < 2; ++bj) {
                        const f32x4 v0 = acc[ai][bj][m][0], v1 = acc[ai][bj][m][1];
                        u32x4 w; w.x = pkbf(v0[0], v0[1]); w.y = pkbf(v0[2], v0[3]); w.z = pkbf(v1[0], v1[1]); w.w = pkbf(v1[2], v1[3]);
                        *(u32x4*)(MVT + nr * 1024 + u.pn * 256 + lc0 + bj * 128) = w;
                    }
                }
        }
    }
};
__device__ __forceinline__ void init_from_xn(f32x4 (&acc)[2][2][4][2], const bf16_t* XN, const float* g, const Unit& u, int wr, int wc, int fr, int fq) {
    const int lr0 = wr * 64 + fr, c0 = u.pn * 256 + wc * 32 + 8 * fq;
    f32x4 rg[2][2];
#pragma unroll
    for (int bj = 0; bj < 2; ++bj)
#pragma unroll
        for (int n = 0; n < 2; ++n) { const f32x4 gg = *(const f32x4*)(g + c0 + bj * 128 + 4 * n); rg[bj][n] = (f32x4){fast_rcp(gg[0]), fast_rcp(gg[1]), fast_rcp(gg[2]), fast_rcp(gg[3])}; }
#pragma unroll
    for (int ai = 0; ai < 2; ++ai)
#pragma unroll
        for (int m = 0; m < 4; ++m) {
            const unsigned ro = (unsigned)((u.pm * 256 + lr0 + 128 * ai + 16 * m) * DM + c0) * 2u;
#pragma unroll
            for (int bj = 0; bj < 2; ++bj) { const u32x4 w = *(const u32x4*)((const char*)XN + ro + bj * 256);
                acc[ai][bj][m][0] = (f32x4){bf_lo(w.x), bf_hi(w.x), bf_lo(w.y), bf_hi(w.y)} * rg[bj][0];
                acc[ai][bj][m][1] = (f32x4){bf_lo(w.z), bf_hi(w.z), bf_lo(w.w), bf_hi(w.w)} * rg[bj][1]; }
        }
}
template <bool RESX> struct EpiRes {
    const float* resP; const float* resS; const float* gp; bf16_t* XN; const float* g; float* SSQ;
    __device__ __forceinline__ void init(f32x4 (&acc)[2][2][4][2], const Unit& u, int wr, int wc, int fr, int fq) const {
        if (RESX) {
            const int lr0 = wr * 64 + fr, c0 = u.pn * 256 + wc * 32 + 8 * fq;
            const float* res = (u.pm == 128) ? resS - (size_t)MP * DM : resP;
#pragma unroll
            for (int ai = 0; ai < 2; ++ai)
#pragma unroll
                for (int m = 0; m < 4; ++m) {
                    const float* rp = res + ((size_t)u.pm * 256 + lr0 + 128 * ai + 16 * m) * DM + c0;
#pragma unroll
                    for (int bj = 0; bj < 2; ++bj) { acc[ai][bj][m][0] = *(const f32x4*)(rp + bj * 128); acc[ai][bj][m][1] = *(const f32x4*)(rp + bj * 128 + 4); }
                }
        } else init_from_xn(acc, XN, gp, u, wr, wc, fr, fq);
    }
    __device__ __forceinline__ void operator()(EPI_ARGS) const {
        const int lr0 = wr * 64 + fr, c0 = u.pn * 256 + wc * 32 + 8 * fq;
        f32x4 gv[2][2];
#pragma unroll
        for (int bj = 0; bj < 2; ++bj)
#pragma unroll
            for (int n = 0; n < 2; ++n) gv[bj][n] = *(const f32x4*)(g + c0 + bj * 128 + 4 * n);
#pragma unroll
        for (int ai = 0; ai < 2; ++ai)
#pragma unroll
            for (int m = 0; m < 4; ++m) {
                const size_t grow = (size_t)u.pm * 256 + lr0 + 128 * ai + 16 * m; const size_t off = grow * DM + c0;
                float ss = 0.f;
#pragma unroll
                for (int bj = 0; bj < 2; ++bj) {
                    f32x4 x0 = acc[ai][bj][m][0], x1 = acc[ai][bj][m][1];
                    ss += (x0[0] * x0[0] + x0[1] * x0[1]) + (x0[2] * x0[2] + x0[3] * x0[3]) + (x1[0] * x1[0] + x1[1] * x1[1]) + (x1[2] * x1[2] + x1[3] * x1[3]);
                    x0 = x0 * gv[bj][0]; x1 = x1 * gv[bj][1];
                    u32x4 w; w.x = pkbf(x0[0], x0[1]); w.y = pkbf(x0[2], x0[3]); w.z = pkbf(x1[0], x1[1]); w.w = pkbf(x1[2], x1[3]);
                    *(u32x4*)(XN + off + bj * 128) = w;
                }
                ss += __shfl_xor(ss, 16); ss += __shfl_xor(ss, 32);
                if (fq == 0) SSQ[grow * 16 + u.pn * 4 + wc] = ss;
            }
    }
};
struct EpiFinal {
    const bf16_t* XN; const float* gp; float* Y; const float* g; float* slots; unsigned* cnt; LAS float* xl; int wave;
    __device__ __forceinline__ void init(f32x4 (&acc)[2][2][4][2], const Unit& u, int wr, int wc, int fr, int fq) const { init_from_xn(acc, XN, gp, u, wr, wc, fr, fq); }
    __device__ __forceinline__ void operator()(EPI_ARGS) const {
        const int lr0 = wr * 64 + fr, c0 = u.pn * 256 + wc * 32 + 8 * fq;
        const int lane = fr + 16 * fq;
#pragma unroll
        for (int ai = 0; ai < 2; ++ai)
#pragma unroll
            for (int m = 0; m < 4; ++m) {
                float ss = 0.f;
#pragma unroll
                for (int bj = 0; bj < 2; ++bj)
#pragma unroll
                    for (int n = 0; n < 2; ++n) { const f32x4 x = acc[ai][bj][m][n]; ss += (x[0] * x[0] + x[1] * x[1]) + (x[2] * x[2] + x[3] * x[3]); }
                ss += __shfl_xor(ss, 16); ss += __shfl_xor(ss, 32);
                if (fq == 0) xl[(lr0 + 128 * ai + 16 * m) * 4 + wc] = ss;
            }
        asm volatile("s_waitcnt lgkmcnt(0)" ::: "memory"); __builtin_amdgcn_s_barrier(); asm volatile("" ::: "memory");
        const int row = wave * 32 + (lane & 31);
        if (lane < 32) { const f32x4 q4 = *(const LAS f32x4*)(xl + row * 4);
            __hip_atomic_store(slots + ((size_t)u.pm * 256 + row) * 4 + u.pn, (q4[0] + q4[1]) + (q4[2] + q4[3]), __ATOMIC_RELAXED, __HIP_MEMORY_SCOPE_AGENT); }
        asm volatile("s_waitcnt vmcnt(0)" ::: "memory");
        if (lane == 0) __hip_atomic_fetch_add(cnt + 64 * u.pm, 1u, __ATOMIC_RELAXED, __HIP_MEMORY_SCOPE_AGENT);
        if (wave == 0) {
            unsigned sp = 0;
            while ((unsigned)__builtin_amdgcn_readfirstlane(__hip_atomic_load(cnt + 64 * u.pm, __ATOMIC_RELAXED, __HIP_MEMORY_SCOPE_AGENT)) < 32u) { __builtin_amdgcn_s_sleep(2); if (++sp > (1u << 21)) break; }
            __builtin_amdgcn_fence(__ATOMIC_ACQUIRE, "agent");
        }
        asm volatile("s_waitcnt vmcnt(0) lgkmcnt(0)" ::: "memory"); __builtin_amdgcn_s_barrier(); asm volatile("" ::: "memory");
        if (lane < 32) { const float* sl = slots + ((size_t)u.pm * 256 + row) * 4; float t = 0.f;
#pragma unroll
            for (int k = 0; k < 4; ++k) t += __hip_atomic_load(sl + k, __ATOMIC_RELAXED, __HIP_MEMORY_SCOPE_AGENT);
            xl[1024 + row] = 1.0f / sqrtf(t * (1.0f / DM) + EPS); }
        asm volatile("s_waitcnt vmcnt(0) lgkmcnt(0)" ::: "memory"); __builtin_amdgcn_s_barrier(); asm volatile("" ::: "memory");
#pragma unroll
        for (int ai = 0; ai < 2; ++ai)
#pragma unroll
            for (int m = 0; m < 4; ++m) {
                const int lr = lr0 + 128 * ai + 16 * m; const float rs = xl[1024 + lr]; float* yp = Y + ((size_t)u.pm * 256 + lr) * DM + c0;
#pragma unroll
                for (int bj = 0; bj < 2; ++bj) { const f32x4 g0 = *(const f32x4*)(g + c0 + bj * 128), g1 = *(const f32x4*)(g + c0 + bj * 128 + 4);
                    *(f32x4*)(yp + bj * 128) = acc[ai][bj][m][0] * rs * g0; *(f32x4*)(yp + bj * 128 + 4) = acc[ai][bj][m][1] * rs * g1; }
                asm volatile("" ::: "memory");
            }
        asm volatile("s_waitcnt lgkmcnt(0)" ::: "memory"); __builtin_amdgcn_s_barrier(); asm volatile("" ::: "memory");
    }
};
__device__ __forceinline__ float row_rstd(const float* SSQ, size_t grow) {
    const f32x4* p = (const f32x4*)(SSQ + grow * 16); const f32x4 a = p[0], b = p[1], c = p[2], d = p[3];
    const float s = ((a[0] + a[1]) + (a[2] + a[3])) + ((b[0] + b[1]) + (b[2] + b[3])) + ((c[0] + c[1]) + (c[2] + c[3])) + ((d[0] + d[1]) + (d[2] + d[3]));
    return 1.0f / sqrtf(s * (1.0f / DM) + EPS);
}
__device__ __forceinline__ void rows_rstd8(const float* SSQ, size_t row0, int fq, float (&rs)[2][4]) {
    f32x4 pre[2][4];
#pragma unroll
    for (int ai = 0; ai < 2; ++ai)
#pragma unroll
        for (int m = 0; m < 4; ++m) pre[ai][m] = *(const f32x4*)(SSQ + (row0 + 128 * ai + 16 * m) * 16 + fq * 4);
    __builtin_amdgcn_sched_barrier(0);
#pragma unroll
    for (int ai = 0; ai < 2; ++ai)
#pragma unroll
        for (int m = 0; m < 4; ++m) { float sq = (pre[ai][m][0] + pre[ai][m][1]) + (pre[ai][m][2] + pre[ai][m][3]); sq += __shfl_xor(sq, 16); sq += __shfl_xor(sq, 32);
            rs[ai][m] = 1.0f / sqrtf(sq * (1.0f / DM) + EPS); }
}
struct EpiScale {
    bf16_t* O; const float* SSQ; float sc;
    EPI_ZERO_INIT
    __device__ __forceinline__ void operator()(EPI_ARGS) const {
        const int lr0 = wr * 64 + fr, c0 = u.pn * 256 + wc * 32 + 8 * fq;
        float rsv[2][4]; rows_rstd8(SSQ, (size_t)u.pm * 256 + lr0, fq, rsv);
#pragma unroll
        for (int ai = 0; ai < 2; ++ai)
#pragma unroll
            for (int m = 0; m < 4; ++m) {
                const size_t grow = (size_t)u.pm * 256 + lr0 + 128 * ai + 16 * m; const float rs = rsv[ai][m] * sc;
#pragma unroll
                for (int bj = 0; bj < 2; ++bj) {
                    const f32x4 v0 = acc[ai][bj][m][0] * rs, v1 = acc[ai][bj][m][1] * rs;
                    u32x4 w; w.x = pkbf(v0[0], v0[1]); w.y = pkbf(v0[2], v0[3]); w.z = pkbf(v1[0], v1[1]); w.w = pkbf(v1[2], v1[3]);
                    *(u32x4*)(O + grow * DM + c0 + bj * 128) = w;
                }
            }
    }
};
struct EpiSwiGLU {
    bf16_t* H; const float* SSQ;
    EPI_ZERO_INIT
    __device__ __forceinline__ void operator()(EPI_ARGS) const {
        const int lr0 = wr * 64 + fr, c0 = u.pn * 128 + wc * 32 + 8 * fq;
        float rsv[2][4]; rows_rstd8(SSQ, (size_t)u.pm * 256 + lr0, fq, rsv);
#pragma unroll
        for (int ai = 0; ai < 2; ++ai)
#pragma unroll
            for (int m = 0; m < 4; ++m) {
                const size_t grow = (size_t)u.pm * 256 + lr0 + 128 * ai + 16 * m; const float rs = rsv[ai][m];
                float hv[8];
#pragma unroll
                for (int n = 0; n < 2; ++n)
#pragma unroll
                    for (int e = 0; e < 4; ++e) { const float gt = acc[ai][0][m][n][e] * rs, up = acc[ai][1][m][n][e] * rs; hv[4 * n + e] = gt * fast_rcp(1.f + fast_exp2(-gt * LOG2E)) * up; }
                u32x4 w; w.x = pkbf(hv[0], hv[1]); w.y = pkbf(hv[2], hv[3]); w.z = pkbf(hv[4], hv[5]); w.w = pkbf(hv[6], hv[7]);
                *(u32x4*)(H + grow * DFF + c0) = w;
            }
    }
};
struct EpiSoftmax {
    bf16_t* P; float* LSUM; LAS float* xch;
    EPI_ZERO_INIT
    __device__ __forceinline__ void operator()(EPI_ARGS) const {
        const int lr0 = wr * 64 + fr, c0 = u.pn * 256 + wc * 32 + 8 * fq;
#pragma unroll
        for (int ai = 0; ai < 2; ++ai)
#pragma unroll
            for (int m = 0; m < 4; ++m) {
                float v = -3.0e38f;
#pragma unroll
                for (int bj = 0; bj < 2; ++bj)
#pragma unroll
                    for (int n = 0; n < 2; ++n) { const f32x4 x = acc[ai][bj][m][n]; v = fmaxf(v, fmaxf(fmaxf(x[0], x[1]), fmaxf(x[2], x[3]))); }
                v = fmaxf(v, __shfl_xor(v, 16)); v = fmaxf(v, __shfl_xor(v, 32));
                if (fq == 0) xch[(lr0 + 128 * ai + 16 * m) * 4 + wc] = v;
            }
        asm volatile("s_waitcnt lgkmcnt(0)" ::: "memory"); __builtin_amdgcn_s_barrier(); asm volatile("" ::: "memory");
#pragma unroll
        for (int ai = 0; ai < 2; ++ai)
#pragma unroll
            for (int m = 0; m < 4; ++m) {
                const f32x4 q4 = *(const LAS f32x4*)(xch + (lr0 + 128 * ai + 16 * m) * 4); const float mx = fmaxf(fmaxf(q4[0], q4[1]), fmaxf(q4[2], q4[3]));
                const size_t grow = (size_t)u.pm * 256 + lr0 + 128 * ai + 16 * m; float ss = 0.f;
#pragma unroll
                for (int bj = 0; bj < 2; ++bj) {
                    f32x4 p0, p1;
#pragma unroll
                    for (int e = 0; e < 4; ++e) { p0[e] = fast_exp2(acc[ai][bj][m][0][e] - mx); p1[e] = fast_exp2(acc[ai][bj][m][1][e] - mx); }
                    ss += ((p0[0] + p0[1]) + (p0[2] + p0[3])) + ((p1[0] + p1[1]) + (p1[2] + p1[3]));
                    u32x4 w; w.x = pkbf(p0[0], p0[1]); w.y = pkbf(p0[2], p0[3]); w.z = pkbf(p1[0], p1[1]); w.w = pkbf(p1[2], p1[3]);
                    *(u32x4*)(P + grow * DM + c0 + bj * 128) = w;
                }
                ss += __shfl_xor(ss, 16); ss += __shfl_xor(ss, 32);
                if (fq == 0) LSUM[grow * 16 + u.pn * 4 + wc] = ss;
                asm volatile("" ::: "memory"); __builtin_amdgcn_sched_barrier(0);
            }
    }
};
struct EpiPV {
    bf16_t* O; const float* LSUM;
    EPI_ZERO_INIT
    __device__ __forceinline__ void operator()(EPI_ARGS) const {
        const int lr0 = wr * 64 + fr, c0 = u.pn * 256 + wc * 32 + 8 * fq;
        f32x4 pre[2][4];
#pragma unroll
        for (int ai = 0; ai < 2; ++ai)
#pragma unroll
            for (int m = 0; m < 4; ++m) pre[ai][m] = *(const f32x4*)(LSUM + ((size_t)u.pm * 256 + lr0 + 128 * ai + 16 * m) * 16 + u.pn * 4);
        __builtin_amdgcn_sched_barrier(0);
#pragma unroll
        for (int ai = 0; ai < 2; ++ai)
#pragma unroll
            for (int m = 0; m < 4; ++m) {
                const size_t grow = (size_t)u.pm * 256 + lr0 + 128 * ai + 16 * m;
                const f32x4 l4 = pre[ai][m]; const float rs = 1.0f / ((l4[0] + l4[1]) + (l4[2] + l4[3]));
#pragma unroll
                for (int bj = 0; bj < 2; ++bj) {
                    const f32x4 v0 = acc[ai][bj][m][0] * rs, v1 = acc[ai][bj][m][1] * rs;
                    u32x4 w; w.x = pkbf(v0[0], v0[1]); w.y = pkbf(v0[2], v0[3]); w.z = pkbf(v1[0], v1[1]); w.w = pkbf(v1[2], v1[3]);
                    *(u32x4*)(O + grow * DM + c0 + bj * 128) = w;
                }
            }
    }
};
}

#define XB_TMO      128
#define XB_XCNT(j)  (256  + 64 * (j))
#define XB_XSUB(j)  (1280 + 64 * (j))
#define XB_XGEN(j)  (2304 + 64 * (j))
#define XB_TOP      3328
#define XB_TOPGEN   3392
#define XCD_BAR_WORDS 3456
#define XB_SPIN_CAP (1u << 18)
__device__ __forceinline__ unsigned xb_ld(unsigned* p)              { return __hip_atomic_load(p, __ATOMIC_RELAXED, __HIP_MEMORY_SCOPE_AGENT); }
__device__ __forceinline__ unsigned xb_add(unsigned* p, unsigned v) { return __hip_atomic_fetch_add(p, v, __ATOMIC_RELAXED, __HIP_MEMORY_SCOPE_AGENT); }
__device__ __forceinline__ unsigned xb_xcc_id() { return (unsigned)__builtin_amdgcn_s_getreg((3 << 11) | 20) & 0xFu; }
#define XB_SPIN(cond, bar) do { unsigned _sp = 0; while (cond) { __builtin_amdgcn_s_sleep(1); \
    if ((++_sp & 255u) == 0u) { if (xb_ld(&(bar)[XB_TMO])) break; if (_sp > XB_SPIN_CAP) { atomicAdd(&(bar)[XB_TMO], 1u); break; } } } } while (0)
struct XcdBarrier { unsigned* bar; unsigned x; volatile LAS unsigned* st; };
__device__ __forceinline__ XcdBarrier xcd_barrier_post(unsigned* bar, volatile LAS unsigned* st) {
    XcdBarrier b; b.bar = bar; b.x = xb_xcc_id(); b.st = st;
    if (threadIdx.x == 0) st[3] = xb_add(&bar[XB_XCNT(b.x)], 1u);
    return b;
}
__device__ __forceinline__ void xcd_barrier_complete(unsigned* bar, unsigned x, unsigned& nloc, unsigned& nx, unsigned& xi) {
    const unsigned G = gridDim.x * gridDim.y * gridDim.z;
    unsigned sum, cnt, mine, sp = 0u;
    for (;;) {
        sum = 0u; cnt = 0u; mine = 0u; xi = 0u;
#pragma unroll
        for (unsigned j = 0; j < 16; ++j) { const unsigned c = xb_ld(&bar[XB_XCNT(j)]); sum += c; cnt += (c > 0u) ? 1u : 0u; mine = (j == x) ? c : mine; xi += (c > 0u && j < x) ? 1u : 0u; }
        if (sum == G) break;
        __builtin_amdgcn_s_sleep(1);
        if ((++sp & 255u) == 0u) { if (xb_ld(&bar[XB_TMO])) break; if (sp > XB_SPIN_CAP) { atomicAdd(&bar[XB_TMO], 1u); break; } }
    }
    nloc = mine > 0u ? mine : 1u; nx = cnt > 0u ? cnt : 1u;
}
__device__ __forceinline__ void xcd_barrier(const XcdBarrier& b) {
    asm volatile("s_waitcnt vmcnt(0)" ::: "memory");
    __syncthreads();
    if (threadIdx.x == 0) {
        unsigned* bar = b.bar;
        __builtin_amdgcn_s_waitcnt(0);
        unsigned nloc = b.st[0], nx = b.st[1];
        if (nloc == 0u) { unsigned xi; xcd_barrier_complete(bar, b.x, nloc, nx, xi); b.st[0] = nloc; b.st[1] = nx; b.st[2] = xi; }
        const unsigned old = xb_add(&bar[XB_XSUB(b.x)], 1u);
        const unsigned gen = old / nloc;
        if (old + 1u == (gen + 1u) * nloc) {
            __builtin_amdgcn_fence(__ATOMIC_RELEASE, "agent");
            asm volatile("s_waitcnt vmcnt(0)" ::: "memory");
            const unsigned og = xb_add(&bar[XB_TOP], 1u);
            const unsigned tg = og / nx;
            if (og + 1u == (tg + 1u) * nx) xb_add(&bar[XB_TOPGEN], 1u);
            else XB_SPIN(xb_ld(&bar[XB_TOPGEN]) == tg, bar);
            __builtin_amdgcn_fence(__ATOMIC_ACQUIRE, "agent");
            xb_add(&bar[XB_XGEN(b.x)], 1u);
            asm volatile("s_waitcnt vmcnt(0)" ::: "memory");
        } else {
            XB_SPIN(xb_ld(&bar[XB_XGEN(b.x)]) == gen, bar);
            __builtin_amdgcn_fence(__ATOMIC_ACQUIRE, "agent");
            asm volatile("s_waitcnt vmcnt(0)" ::: "memory");
        }
    }
    __syncthreads();
}

#define XL_SUB(j) (3584 + 64 * (j))
#define XL_GEN(j) (12416 + 64 * (j))
__device__ __forceinline__ void xl_barrier(const XcdBarrier& b) {
    asm volatile("s_waitcnt vmcnt(0)" ::: "memory");
    __syncthreads();
    if (threadIdx.x == 0) {
        unsigned* bar = b.bar; const unsigned nloc = b.st[0], xd = b.st[2] & 7u;
        const unsigned old = xb_add(&bar[XL_SUB(xd)], 1u), gen = old / nloc;
        if (old + 1u == (gen + 1u) * nloc) xb_add(&bar[XL_GEN(xd)], 1u);
        else XB_SPIN(xb_ld(&bar[XL_GEN(xd)]) == gen, bar);
        __builtin_amdgcn_fence(__ATOMIC_ACQUIRE, "agent");
        asm volatile("s_waitcnt vmcnt(0)" ::: "memory");
    }
    __syncthreads();
}

constexpr int RING_BYTES = 131072;
constexpr int XCH_OFF = RING_BYTES;
constexpr int MISC_OFF = RING_BYTES + 6144;
constexpr int LDS_BYTES = RING_BYTES + 8192;
constexpr int ATT_V_OFF = 0, ATT_WBUF = 12800, ATT_TAB_OFF = 8 * ATT_WBUF, ATT_CW_OFF = 65536;

struct Params {
    const float* in[27]; float* out; unsigned char* ws; int ph_lo, ph_hi, coop, pad;
};

__device__ __forceinline__ float wave_sum(float v) {
#pragma unroll
    for (int o = 1; o < 64; o <<= 1) v += __shfl_xor(v, o);
    return v;
}
__device__ __forceinline__ void transpose_item(const float* W, int K, int N, bf16_t* WT, int item, int mode, LAS float* scr, int lane) {
    const int nblk = N / 32, kb = item / nblk, nb = item % nblk, k0 = 64 * kb, n0 = 32 * nb;
    int r0 = n0;
    if (mode == 1) { if (n0 >= 2304) { const int isg = n0 >= 2560, cch = n0 - (isg ? 2560 : 2304); r0 = 2304 + (cch >> 7) * 256 + isg * 128 + (cch & 127); } }
    else if (mode == 2) r0 = (n0 >> 7) * 256 + (n0 & 127);
    else if (mode == 3) r0 = (n0 >> 7) * 256 + 128 + (n0 & 127);
    float wv[32];
#pragma unroll
    for (int i = 0; i < 32; ++i) wv[i] = W[(size_t)(k0 + 2 * i + (lane >> 5)) * N + n0 + (lane & 31)];
#pragma unroll
    for (int i = 0; i < 32; ++i) scr[(2 * i + (lane >> 5)) * 33 + (lane & 31)] = wv[i];
    asm volatile("s_waitcnt lgkmcnt(0)" ::: "memory");
    const int c = lane & 7;
#pragma unroll
    for (int j = 0; j < 4; ++j) { const int n = (lane >> 3) + 8 * j; const LAS float* s = scr + (8 * c) * 33 + n;
        u32x4 o; o.x = pkbf(s[0 * 33], s[1 * 33]); o.y = pkbf(s[2 * 33], s[3 * 33]); o.z = pkbf(s[4 * 33], s[5 * 33]); o.w = pkbf(s[6 * 33], s[7 * 33]);
        *(u32x4*)(WT + (size_t)(r0 + n) * K + k0 + 8 * c) = o; }
    asm volatile("s_waitcnt lgkmcnt(0)" ::: "memory");
}
template <int NR> __device__ __forceinline__ void rms_rows_bf16(const float* const (&xrow)[NR], const float* g, bf16_t* const (&orow)[NR], int lane) {
    f32x4 v[NR][4];
#pragma unroll
    for (int r = 0; r < NR; ++r)
#pragma unroll
        for (int j = 0; j < 4; ++j) v[r][j] = ((const f32x4*)xrow[r] + lane)[64 * j];
    const f32x4* gr = (const f32x4*)g + lane;
    f32x4 gg[4];
#pragma unroll
    for (int j = 0; j < 4; ++j) gg[j] = gr[64 * j];
#pragma unroll
    for (int r = 0; r < NR; ++r) {
        float s = 0.f;
#pragma unroll
        for (int j = 0; j < 4; ++j) s += (v[r][j][0] * v[r][j][0] + v[r][j][1] * v[r][j][1]) + (v[r][j][2] * v[r][j][2] + v[r][j][3] * v[r][j][3]);
        const float rstd = 1.0f / sqrtf(wave_sum(s) * (1.0f / DM) + EPS);
        u32x2* o8 = (u32x2*)orow[r] + lane;
#pragma unroll
        for (int j = 0; j < 4; ++j) { u32x2 w; w.x = pkbf(v[r][j][0] * rstd * gg[j][0], v[r][j][1] * rstd * gg[j][1]); w.y = pkbf(v[r][j][2] * rstd * gg[j][2], v[r][j][3] * rstd * gg[j][3]); o8[64 * j] = w; }
    }
}

namespace att {
__device__ __forceinline__ int crow(int r, int hi) { return (r & 3) + 8 * (r >> 2) + 4 * hi; }
struct Ctx {
    const bf16_t *QB, *KB, *VB; const float *CK, *CV;
    bf16_t* OP; float* LSE; bf16_t* ATT;
};
__device__ __forceinline__ bf16x8 ld8_bf16(const bf16_t* p) { return *(const bf16x8*)p; }
__device__ __forceinline__ bf16x8 ld8_f32(const float* p) {
    const f32x4 a = *(const f32x4*)p, b = *(const f32x4*)(p + 4); u32x4 w; w.x = pkbf(a[0], a[1]); w.y = pkbf(a[2], a[3]); w.z = pkbf(b[0], b[1]); w.w = pkbf(b[2], b[3]);
    return __builtin_bit_cast(bf16x8, w);
}
template <int MODE> __device__ __forceinline__ bf16x8 ld_kv(const bf16_t* B16, const float* C32, int bq, int h, int dil, int r, int idx, int doff, bool newrows) {
    if (MODE == 0) { const int ii = idx < 0 ? 0 : idx; return ld8_bf16(B16 + ((size_t)bq * SEQ + r + (size_t)dil * ii) * AW + h * HD + doff); }
    int p = r + dil * idx;
    if (!newrows) return ld8_f32(C32 + (((size_t)bq * WBUF + p) * NH + h) * HD + doff);
    p = p > (WBUF + TS - 1) ? (WBUF + TS - 1) : p;
    return ld8_bf16(B16 + ((size_t)MP + bq * TS + (p - WBUF)) * AW + h * HD + doff);
}
template <int MODE> __device__ __forceinline__ void ld_kv4(bf16x8 (&dst)[4], const bf16_t* B16, const float* C32, int bq, int h, int dil, int r, int idx0, int doff, bool newrows) {
    if (MODE == 1 && !newrows) {
        f32x4 raw[4][2];
#pragma unroll
        for (int i = 0; i < 4; ++i) { const float* p = C32 + (((size_t)bq * WBUF + (r + dil * (idx0 + 8 * i))) * NH + h) * HD + doff; raw[i][0] = *(const f32x4*)p; raw[i][1] = *(const f32x4*)(p + 4); }
        __builtin_amdgcn_sched_barrier(0);
#pragma unroll
        for (int i = 0; i < 4; ++i) { u32x4 w; w.x = pkbf(raw[i][0][0], raw[i][0][1]); w.y = pkbf(raw[i][0][2], raw[i][0][3]); w.z = pkbf(raw[i][1][0], raw[i][1][1]); w.w = pkbf(raw[i][1][2], raw[i][1][3]);
            dst[i] = __builtin_bit_cast(bf16x8, w); }
    } else {
#pragma unroll
        for (int i = 0; i < 4; ++i) dst[i] = ld_kv<MODE>(B16, C32, bq, h, dil, r, idx0 + 8 * i, doff, newrows);
    }
}
template <int MODE> __device__ __forceinline__ void wave_block(const Ctx& c, int bq, int h, int g, int dil, int r, int i0, int nq, const LAS float* tab, LAS unsigned char* wbuf) {
    const int lane = fresh_lane(), r32 = lane & 31, hi = lane >> 5;
    const int vkey = lane >> 3, vch = lane & 7;
    const bool qvalid = r32 < nq; const int qq = qvalid ? r32 : 0;
    size_t qtok;
    if (MODE == 0) qtok = (size_t)bq * SEQ + r + (size_t)dil * (i0 + qq);
    else qtok = (size_t)MP + bq * TS + (r + dil * (i0 + qq) - WBUF);
    LAS unsigned char* kb = wbuf; LAS unsigned char* vbuf = wbuf + 4608;
    bf16x8 qv[4];
#pragma unroll
    for (int i = 0; i < 4; ++i) { int qi = 8 * i + vkey; qi = qi < nq ? qi : 0;
        const size_t tk = (MODE == 0) ? (size_t)bq * SEQ + r + (size_t)dil * (i0 + qi) : (size_t)MP + bq * TS + (r + dil * (i0 + qi) - WBUF);
        qv[i] = ld8_bf16(c.QB + tk * AW + h * HD + vch * 8); }
    bf16x8 kr[5][4];
    constexpr int KA = (MODE == 0) ? 5 : 2;
#pragma unroll
    for (int s = 0; s < KA; ++s)
        ld_kv4<MODE>(kr[s], c.KB, c.CK, bq, h, dil, r, i0 - 128 + 32 * s + vkey, vch * 8, s == 4);
#pragma unroll
    for (int i = 0; i < 4; ++i) *(LAS bf16x8*)(kb + (8 * i + vkey) * 144 + vch * 16) = qv[i];
    bf16x8 qr[4];
#pragma unroll
    for (int d0 = 0; d0 < 4; ++d0) qr[d0] = *(const LAS bf16x8*)(kb + r32 * 144 + d0 * 32 + hi * 16);
    f32x16 S[5];
#pragma unroll
    for (int s = 0; s < 5; ++s) {
        if (MODE != 0 && s + KA < 5) {
            ld_kv4<MODE>(kr[s + KA], c.KB, c.CK, bq, h, dil, r, i0 - 128 + 32 * (s + KA) + vkey, vch * 8, s + KA == 4);
        }
#pragma unroll
        for (int i = 0; i < 4; ++i) *(LAS bf16x8*)(kb + (8 * i + vkey) * 144 + vch * 16) = kr[s][i];
        bf16x8 kf[4];
#pragma unroll
        for (int d0 = 0; d0 < 4; ++d0) kf[d0] = *(const LAS bf16x8*)(kb + r32 * 144 + d0 * 32 + hi * 16);
        f32x16 a = {};
#pragma unroll
        for (int d0 = 0; d0 < 4; ++d0) a = __builtin_amdgcn_mfma_f32_32x32x16_bf16(kf[d0], qr[d0], a, 0, 0, 0);
        S[s] = a;
        __builtin_amdgcn_sched_barrier(0);
    }
    bf16x8 vr[5][4];
#pragma unroll
    for (int s = 0; s < KA; ++s)
        ld_kv4<MODE>(vr[s], c.VB, c.CV, bq, h, dil, r, i0 - 128 + 32 * s + vkey, vch * 8, s == 4);
    __builtin_amdgcn_sched_barrier(0);
    const LAS float* tb = tab + 159 + r32 - 4 * hi;
#pragma unroll
    for (int s = 0; s < 5; ++s)
#pragma unroll
        for (int rr = 0; rr < 16; ++rr) S[s][rr] += tb[-(32 * s + (rr & 3) + 8 * (rr >> 2))];
    if (MODE == 0 && i0 < 128) {
#pragma unroll
        for (int s = 0; s < 5; ++s)
#pragma unroll
            for (int rr = 0; rr < 16; ++rr) if (i0 - 128 + 32 * s + crow(rr, hi) < 0) S[s][rr] = -1e30f;
    }
    float mx = -3.0e38f;
#pragma unroll
    for (int s = 0; s < 5; ++s)
#pragma unroll
        for (int rr = 0; rr < 16; ++rr) mx = fmaxf(mx, S[s][rr]);
    mx = fmaxf(mx, __shfl_xor(mx, 32));
    float l = 0.f;
#pragma unroll
    for (int s = 0; s < 5; ++s)
#pragma unroll
        for (int rr = 0; rr < 16; ++rr) { const float p = fast_exp2(S[s][rr] - mx); S[s][rr] = p; l += p; }
    l += __shfl_xor(l, 32);
    f32x16 o[2]; o[0] = (f32x16){}; o[1] = (f32x16){};
    const int vrd = (4 * hi + ((lane & 15) >> 2)) * 64 + ((lane >> 4) & 1) * 32 + (lane & 3) * 8;
    __builtin_amdgcn_sched_barrier(0);
#pragma unroll
    for (int s = 0; s < 5; ++s) {
        LAS unsigned char* vb = vbuf + (s & 1) * 4096;
#pragma unroll
        for (int i = 0; i < 4; ++i) *(LAS bf16x8*)(vb + (vch >> 2) * 2048 + (8 * i + vkey) * 64 + (vch & 3) * 16) = vr[s][i];
        if (MODE != 0 && s + KA < 5) {
            ld_kv4<MODE>(vr[s + KA], c.VB, c.CV, bq, h, dil, r, i0 - 128 + 32 * (s + KA) + vkey, vch * 8, s + KA == 4);
        }
#pragma unroll
        for (int sp = 0; sp < 2; ++sp) {
            u32x4 pw; pw.x = pkbf(S[s][8 * sp + 0], S[s][8 * sp + 1]); pw.y = pkbf(S[s][8 * sp + 2], S[s][8 * sp + 3]); pw.z = pkbf(S[s][8 * sp + 4], S[s][8 * sp + 5]); pw.w = pkbf(S[s][8 * sp + 6], S[s][8 * sp + 7]);
            const bf16x8 pf = __builtin_bit_cast(bf16x8, pw);
#pragma unroll
            for (int dt = 0; dt < 2; ++dt) {
                const s16x4 lo = __builtin_bit_cast(s16x4, __builtin_amdgcn_ds_read_tr16_b64_v4i16((LAS s16x4*)(vb + vrd + dt * 2048 + sp * 1024)));
                const s16x4 hh = __builtin_bit_cast(s16x4, __builtin_amdgcn_ds_read_tr16_b64_v4i16((LAS s16x4*)(vb + vrd + dt * 2048 + sp * 1024 + 512)));
                const bf16x8 vf = (bf16x8){lo[0], lo[1], lo[2], lo[3], hh[0], hh[1], hh[2], hh[3]};
                o[dt] = __builtin_amdgcn_mfma_f32_32x32x16_bf16(vf, pf, o[dt], 0, 0, 0);
            }
        }
        __builtin_amdgcn_sched_barrier(0);
    }
    {
        const float inv = 1.0f / l;
#pragma unroll
        for (int dt = 0; dt < 2; ++dt)
#pragma unroll
            for (int rg = 0; rg < 4; ++rg) { u32x2 w; w.x = pkbf(o[dt][4 * rg] * inv, o[dt][4 * rg + 1] * inv); w.y = pkbf(o[dt][4 * rg + 2] * inv, o[dt][4 * rg + 3] * inv);
                *(LAS u32x2*)(kb + r32 * 144 + (32 * dt + 8 * rg + 4 * hi) * 2) = w; }
        if (qvalid && hi == 0) c.LSE[(size_t)g * LSE_STRIDE + qtok * NH + h] = mx + __log2f(l);
#pragma unroll
        for (int i = 0; i < 4; ++i) { const int qi = 8 * i + vkey;
            if (qi < nq) {
                const size_t tk = (MODE == 0) ? (size_t)bq * SEQ + r + (size_t)dil * (i0 + qi) : (size_t)MP + bq * TS + (r + dil * (i0 + qi) - WBUF);
                *(u32x4*)(c.OP + (size_t)g * OP_STRIDE + tk * AW + h * HD + vch * 8) = *(const LAS u32x4*)(kb + qi * 144 + vch * 16);
            } }
    }
}
struct PDesc { int b, h, g, dil, r, i0; };
__device__ __forceinline__ unsigned ptok(const PDesc& d, int idx) { return (unsigned)(d.b * SEQ + d.r + d.dil * idx); }
__device__ __forceinline__ bf16x8 ld8_off(const bf16_t* base, unsigned byte_off) { return *(const bf16x8*)((const char*)base + byte_off); }
__device__ __forceinline__ void p_load_q(const Ctx& c, const PDesc& d, bf16x8 (&qv)[4], int vkey, int vch) {
    const unsigned o0 = (ptok(d, d.i0 + vkey) * AW + d.h * HD + vch * 8) * 2u, st = (unsigned)(8 * d.dil * AW * 2);
#pragma unroll
    for (int i = 0; i < 4; ++i) qv[i] = ld8_off(c.QB, o0 + i * st);
}
__device__ __forceinline__ void p_load_kv(const bf16_t* B, const PDesc& d, int s, bf16x8 (&x)[4], int vkey, int vch) {
    const unsigned cb = (unsigned)((d.b * SEQ + d.r) * AW + d.h * HD + vch * 8) * 2u, st = (unsigned)(d.dil * AW * 2);
#pragma unroll
    for (int i = 0; i < 4; ++i) { int idx = d.i0 - 128 + 32 * s + 8 * i + vkey; idx = idx < 0 ? 0 : idx; x[i] = ld8_off(B, cb + (unsigned)idx * st); }
}
__device__ __forceinline__ void pblock(const Ctx& c, const PDesc& cur, const PDesc& nxt, bool has_next, bf16x8 (&qv)[4], bf16x8 (&kr)[5][4], const LAS float* tabs, LAS unsigned char* wbuf) {
    const int lane = fresh_lane(), r32 = lane & 31, hi = lane >> 5, vkey = lane >> 3, vch = lane & 7;
    LAS unsigned char* vbuf = wbuf;
    LAS unsigned char* kb = wbuf + 8192;
    const int kwr = vkey * 128 + ((vch ^ (vkey & 7)) << 4);
    const int krd0 = r32 * 128, kx = r32 & 7;
    const int i0 = cur.i0;
#pragma unroll
    for (int i = 0; i < 4; ++i) *(LAS bf16x8*)(kb + (8 * i + vkey) * 144 + vch * 16) = qv[i];
    bf16x8 qr[4];
#pragma unroll
    for (int d0 = 0; d0 < 4; ++d0) qr[d0] = *(const LAS bf16x8*)(kb + r32 * 144 + d0 * 32 + hi * 16);
    f32x16 S[5];
    bf16x8 vr[5][4];
    p_load_kv(c.KB, cur, 2, kr[2], vkey, vch); p_load_kv(c.KB, cur, 3, kr[3], vkey, vch); p_load_kv(c.KB, cur, 4, kr[4], vkey, vch);
#pragma unroll
    for (int s = 0; s < 5; ++s) {
        LAS unsigned char* kp = vbuf + (s & 1) * 4096;
#pragma unroll
        for (int i = 0; i < 4; ++i) *(LAS bf16x8*)(kp + i * 1024 + kwr) = kr[s][i];
        if (s < 3) p_load_kv(c.VB, cur, s, vr[s], vkey, vch);
        bf16x8 kf[4];
#pragma unroll
        for (int d0 = 0; d0 < 4; ++d0) kf[d0] = *(const LAS bf16x8*)(kp + krd0 + (((2 * d0 + hi) ^ kx) << 4));
        f32x16 a = {};
#pragma unroll
        for (int d0 = 0; d0 < 4; ++d0) a = __builtin_amdgcn_mfma_f32_32x32x16_bf16(kf[d0], qr[d0], a, 0, 0, 0);
        S[s] = a;
    }
    __builtin_amdgcn_sched_barrier(0);
    const LAS float* tb = tabs + (cur.g * 12 + cur.h) * 192 + 159 + r32 - 4 * hi;
#pragma unroll
    for (int s = 0; s < 5; ++s)
#pragma unroll
        for (int rr = 0; rr < 16; ++rr) S[s][rr] += tb[-(32 * s + (rr & 3) + 8 * (rr >> 2))];
    if (i0 < 128) {
#pragma unroll
        for (int s = 0; s < 5; ++s)
#pragma unroll
            for (int rr = 0; rr < 16; ++rr) if (i0 - 128 + 32 * s + crow(rr, hi) < 0) S[s][rr] = -1e30f;
    }
    float mx = -3.0e38f;
#pragma unroll
    for (int s = 0; s < 5; ++s)
#pragma unroll
        for (int rr = 0; rr < 16; ++rr) mx = fmaxf(mx, S[s][rr]);
    mx = fmaxf(mx, __shfl_xor(mx, 32));
    float l = 0.f;
    bf16x8 pf[5][2];
#pragma unroll
    for (int s = 0; s < 5; ++s) {
#pragma unroll
        for (int rr = 0; rr < 16; ++rr) { const float p = fast_exp2(S[s][rr] - mx); S[s][rr] = p; l += p; }
#pragma unroll
        for (int sp = 0; sp < 2; ++sp) { u32x4 pw; pw.x = pkbf(S[s][8 * sp + 0], S[s][8 * sp + 1]); pw.y = pkbf(S[s][8 * sp + 2], S[s][8 * sp + 3]); pw.z = pkbf(S[s][8 * sp + 4], S[s][8 * sp + 5]); pw.w = pkbf(S[s][8 * sp + 6], S[s][8 * sp + 7]);
            pf[s][sp] = __builtin_bit_cast(bf16x8, pw); asm volatile("" : "+v"(pf[s][sp])); }
    }
    l += __shfl_xor(l, 32);
    __builtin_amdgcn_sched_barrier(0);
    p_load_kv(c.VB, cur, 3, vr[3], vkey, vch); p_load_kv(c.VB, cur, 4, vr[4], vkey, vch);
    f32x16 o[2]; o[0] = (f32x16){}; o[1] = (f32x16){};
    const int vrd = (4 * hi + ((lane & 15) >> 2)) * 64 + ((lane >> 4) & 1) * 32 + (lane & 3) * 8;
    __builtin_amdgcn_sched_barrier(0);
#pragma unroll
    for (int s = 0; s < 5; ++s) {
        LAS unsigned char* vb = vbuf + (s & 1) * 4096;
#pragma unroll
        for (int i = 0; i < 4; ++i) *(LAS bf16x8*)(vb + (vch >> 2) * 2048 + (8 * i + vkey) * 64 + (vch & 3) * 16) = vr[s][i];
        if (has_next && s < 2) p_load_kv(c.KB, nxt, s, kr[s], vkey, vch);
        if (has_next && s == 2) p_load_q(c, nxt, qv, vkey, vch);
#pragma unroll
        for (int sp = 0; sp < 2; ++sp)
#pragma unroll
            for (int dt = 0; dt < 2; ++dt) {
                const s16x4 lo = __builtin_bit_cast(s16x4, __builtin_amdgcn_ds_read_tr16_b64_v4i16((LAS s16x4*)(vb + vrd + dt * 2048 + sp * 1024)));
                const s16x4 hh = __builtin_bit_cast(s16x4, __builtin_amdgcn_ds_read_tr16_b64_v4i16((LAS s16x4*)(vb + vrd + dt * 2048 + sp * 1024 + 512)));
                const bf16x8 vf = (bf16x8){lo[0], lo[1], lo[2], lo[3], hh[0], hh[1], hh[2], hh[3]};
                o[dt] = __builtin_amdgcn_mfma_f32_32x32x16_bf16(vf, pf[s][sp], o[dt], 0, 0, 0);
            }
    }
    __builtin_amdgcn_sched_barrier(0);
    {
        const float inv = 1.0f / l;
#pragma unroll
        for (int dt = 0; dt < 2; ++dt)
#pragma unroll
            for (int rg = 0; rg < 4; ++rg) { u32x2 w; w.x = pkbf(o[dt][4 * rg] * inv, o[dt][4 * rg + 1] * inv); w.y = pkbf(o[dt][4 * rg + 2] * inv, o[dt][4 * rg + 3] * inv);
                *(LAS u32x2*)(kb + r32 * 144 + (32 * dt + 8 * rg + 4 * hi) * 2) = w; }
        if (hi == 0) c.LSE[(size_t)cur.g * LSE_STRIDE + (size_t)ptok(cur, i0 + r32) * NH + cur.h] = mx + __log2f(l);
#pragma unroll
        for (int i = 0; i < 4; ++i) { const int qi = 8 * i + vkey;
            *(u32x4*)(c.OP + (size_t)cur.g * OP_STRIDE + (size_t)ptok(cur, i0 + qi) * AW + cur.h * HD + vch * 8) = *(const LAS u32x4*)(kb + qi * 144 + vch * 16); }
    }
}
struct TDesc { int b, h, g, dil, r, j0; };
constexpr int TK_OFF = 0, TV_OFF = 49152, TB_OFF = 98304, TT_OFF = TB_OFF + 8 * 4608;
__device__ __forceinline__ void glds16(const void* sbase, unsigned voff, unsigned lds_dst) { unsigned keep;
    asm volatile("s_mov_b32 %0, m0\n\ts_mov_b32 m0, %3\n\ts_nop 4\n\tglobal_load_lds_dwordx4 %1, %2\n\ts_mov_b32 m0, %0" : "=&s"(keep) : "v"(voff), "s"(sbase), "s"(lds_dst) : "memory"); }
__device__ __forceinline__ void glds4(const void* sbase, unsigned voff, unsigned lds_dst) { unsigned keep;
    asm volatile("s_mov_b32 %0, m0\n\ts_mov_b32 m0, %3\n\ts_nop 4\n\tglobal_load_lds_dword %1, %2\n\ts_mov_b32 m0, %0" : "=&s"(keep) : "v"(voff), "s"(sbase), "s"(lds_dst) : "memory"); }
__device__ __forceinline__ void t_issue_tab(const float* tabg, const TDesc& d, LAS unsigned char* lds, int wave, int lane) {
    if (wave < 3) glds4(tabg, (unsigned)(((d.g * 12 + d.h) * 192 + wave * 64 + lane) * 4), (unsigned)__builtin_amdgcn_readfirstlane((int)((unsigned)(uintptr_t)lds + TT_OFF + wave * 256)));
}
__device__ __forceinline__ void t_issue_k(const Ctx& c, const TDesc& d, LAS unsigned char* lds, int wave, int lane) {
    const int rr = lane >> 3, ch = (lane & 7) ^ ((4 * (wave & 1) + (rr >> 1)) & 7);
    const unsigned cb = (unsigned)((d.b * SEQ + d.r) * AW + d.h * HD + ch * 8) * 2u, st = (unsigned)(d.dil * AW * 2);
    const unsigned l0 = (unsigned)(uintptr_t)lds + TK_OFF;
#pragma unroll
    for (int i = 0; i < 6; ++i) { const int e = wave + 8 * i; int idx = d.j0 - 128 + 8 * e + rr; idx = idx < 0 ? 0 : idx;
        glds16(c.KB, cb + (unsigned)idx * st, (unsigned)__builtin_amdgcn_readfirstlane((int)(l0 + e * 1024))); }
}
__device__ __forceinline__ void t_issue_v(const Ctx& c, const TDesc& d, LAS unsigned char* lds, int wave, int lane) {
    const int kq = lane >> 2, q4 = lane & 3;
    const unsigned cb = (unsigned)((d.b * SEQ + d.r) * AW + d.h * HD + q4 * 8) * 2u, st = (unsigned)(d.dil * AW * 2);
    const unsigned l0 = (unsigned)(uintptr_t)lds + TV_OFF;
#pragma unroll
    for (int i = 0; i < 6; ++i) { const int e = 6 * wave + i, hf = e / 24, e24 = e - hf * 24; int idx = d.j0 - 128 + 16 * e24 + kq; idx = idx < 0 ? 0 : idx;
        glds16(c.VB, cb + (unsigned)idx * st + (unsigned)hf * 64u, (unsigned)__builtin_amdgcn_readfirstlane((int)(l0 + e * 1024))); }
}
__device__ __forceinline__ void t_issue_q(const Ctx& c, const TDesc& d, LAS unsigned char* lds, int wave, int lane) {
    const int rr = lane >> 3, i0 = d.j0 + 32 * wave;
    const unsigned qo0 = ((unsigned)(d.b * SEQ + d.r + d.dil * (i0 + rr)) * AW + d.h * HD) * 2u, qst = (unsigned)(8 * d.dil * AW * 2);
    const unsigned l0 = (unsigned)(uintptr_t)lds + TB_OFF + wave * 4608;
#pragma unroll
    for (int i = 0; i < 4; ++i) { const int ch = (lane & 7) ^ ((4 * (i & 1) + (rr >> 1)) & 7);
        glds16(c.QB, qo0 + i * qst + ch * 16, (unsigned)__builtin_amdgcn_readfirstlane((int)(l0 + i * 1024))); }
}
struct TOut { f32x16 o[2]; float l, mx; };
__device__ __forceinline__ void* sgpr_ptr(const void* p) { const unsigned long long u = (unsigned long long)(uintptr_t)p;
    const unsigned lo = (unsigned)__builtin_amdgcn_readfirstlane((int)(unsigned)u), hi = (unsigned)__builtin_amdgcn_readfirstlane((int)(unsigned)(u >> 32));
    return (void*)(uintptr_t)(((unsigned long long)hi << 32) | lo); }
__device__ __forceinline__ void gst16(void* sbase, unsigned voff, u32x4 v) { asm volatile("s_nop 4\n\tglobal_store_dwordx4 %0, %1, %2\n\ts_nop 1" :: "v"(voff), "v"(v), "s"(sbase) : "memory"); }
__device__ __forceinline__ void gst4(void* sbase, unsigned voff, float v) { asm volatile("s_nop 4\n\tglobal_store_dword %0, %1, %2\n\ts_nop 1" :: "v"(voff), "v"(v), "s"(sbase) : "memory"); }
__device__ __forceinline__ void t_out1(const TOut& po, LAS unsigned char* kb, int r32, int hi) {
    const float inv = 1.0f / po.l;
#pragma unroll
    for (int dt = 0; dt < 2; ++dt)
#pragma unroll
        for (int rg = 0; rg < 4; ++rg) { u32x2 w; w.x = pkbf(po.o[dt][4 * rg] * inv, po.o[dt][4 * rg + 1] * inv); w.y = pkbf(po.o[dt][4 * rg + 2] * inv, po.o[dt][4 * rg + 3] * inv);
            *(LAS u32x2*)(kb + r32 * 144 + (32 * dt + 8 * rg + 4 * hi) * 2) = w; }
}
__device__ __forceinline__ void t_out2(const Ctx& c, const TDesc& d, const TOut& po, const LAS unsigned char* kb, int wave, int r32, int hi, int vkey, int vch, u32x4 (&ow)[4]) {
    const int i0 = d.j0 + 32 * wave;
#pragma unroll
    for (int i = 0; i < 4; ++i) ow[i] = *(const LAS u32x4*)(kb + (8 * i + vkey) * 144 + vch * 16);
    const unsigned tq = (unsigned)(d.b * SEQ + d.r + d.dil * (i0 + r32));
    if (hi == 0) gst4(sgpr_ptr(c.LSE + (size_t)d.g * LSE_STRIDE + d.h), tq * (unsigned)(NH * 4), po.mx + __log2f(po.l));
}
__device__ __forceinline__ void t_out3(const Ctx& c, const TDesc& d, int wave, int vkey, int vch, const u32x4 (&ow)[4]) {
    const int i0 = d.j0 + 32 * wave; void* ob = sgpr_ptr(c.OP + (size_t)d.g * OP_STRIDE + d.h * HD);
#pragma unroll
    for (int i = 0; i < 4; ++i) { const int qi = 8 * i + vkey; const unsigned tk = (unsigned)(d.b * SEQ + d.r + d.dil * (i0 + qi));
        gst16(ob, tk * (unsigned)(AW * 2) + (unsigned)(vch * 16), ow[i]); }
}
__device__ __forceinline__ void t_unit(const Ctx& c, const TDesc& prv, const TDesc& cur, const TDesc& nxt, bool has_next, const float* tabg, LAS unsigned char* lds, int wave, TOut& po) {
    const int lane = fresh_lane(), r32 = lane & 31, hi = lane >> 5, vkey = lane >> 3, vch = lane & 7;
    LAS unsigned char* qb = lds + TB_OFF + wave * 4608;
    const LAS float* tt = (const LAS float*)(lds + TT_OFF);
    const int i0 = cur.j0 + 32 * wave;
    asm volatile("s_waitcnt vmcnt(6) lgkmcnt(0)\n\ts_barrier" ::: "memory");
    const int kx = (r32 >> 1) & 7;
    bf16x8 qr[4];
#pragma unroll
    for (int d0 = 0; d0 < 4; ++d0) qr[d0] = *(const LAS bf16x8*)(qb + r32 * 128 + (((2 * d0 + hi) ^ kx) << 4));
    asm volatile("" ::: "memory");
    t_out1(po, qb, r32, hi);
    f32x16 S[5];
    const LAS float* tb = tt + 159 + r32 - 4 * hi;
    const LAS unsigned char* kt = lds + TK_OFF + (32 * wave + r32) * 128;
    float mx;
    {   bf16x8 kf[4];
#pragma unroll
        for (int d0 = 0; d0 < 4; ++d0) kf[d0] = *(const LAS bf16x8*)(kt + 4 * 4096 + (((2 * d0 + hi) ^ kx) << 4));
        f32x16 a = {};
#pragma unroll
        for (int d0 = 0; d0 < 4; ++d0) a = __builtin_amdgcn_mfma_f32_32x32x16_bf16(kf[d0], qr[d0], a, 0, 0, 0);
#pragma unroll
        for (int rr = 0; rr < 16; ++rr) a[rr] += tb[-(128 + (rr & 3) + 8 * (rr >> 2))];
        float m1 = fmaxf(fmaxf(a[0], a[1]), a[2]);
#pragma unroll
        for (int rr = 3; rr < 15; rr += 2) m1 = fmaxf(fmaxf(m1, a[rr]), a[rr + 1]);
        m1 = fmaxf(m1, a[15]);
        mx = fmaxf(m1, __shfl_xor(m1, 32));
        S[4] = a; }
    u32x4 ow[4];
    asm volatile("" ::: "memory");
    t_out2(c, prv, po, qb, wave, r32, hi, vkey, vch, ow);
#pragma unroll
    for (int s = 0; s < 4; s += 2) {
        bf16x8 kfa[4], kfb[4];
#pragma unroll
        for (int d0 = 0; d0 < 4; ++d0) { kfa[d0] = *(const LAS bf16x8*)(kt + s * 4096 + (((2 * d0 + hi) ^ kx) << 4)); kfb[d0] = *(const LAS bf16x8*)(kt + (s + 1) * 4096 + (((2 * d0 + hi) ^ kx) << 4)); }
        f32x16 a, b;
#pragma unroll
        for (int rr = 0; rr < 16; ++rr) { a[rr] = tb[-(32 * s + (rr & 3) + 8 * (rr >> 2))] - mx; b[rr] = tb[-(32 * (s + 1) + (rr & 3) + 8 * (rr >> 2))] - mx; }
#pragma unroll
        for (int d0 = 0; d0 < 4; ++d0) { a = __builtin_amdgcn_mfma_f32_32x32x16_bf16(kfa[d0], qr[d0], a, 0, 0, 0); b = __builtin_amdgcn_mfma_f32_32x32x16_bf16(kfb[d0], qr[d0], b, 0, 0, 0); }
        S[s] = a; S[s + 1] = b;
        if (s == 0) { asm volatile("" ::: "memory"); t_out3(c, prv, wave, vkey, vch, ow); }
    }
    asm volatile("s_waitcnt vmcnt(5) lgkmcnt(0)\n\ts_barrier" ::: "memory");
    if (has_next) { t_issue_tab(tabg, nxt, lds, wave, lane); t_issue_k(c, nxt, lds, wave, lane); t_issue_q(c, nxt, lds, wave, lane); }
    if (i0 < 128) {
#pragma unroll
        for (int s = 0; s < 5; ++s)
#pragma unroll
            for (int rr = 0; rr < 16; ++rr) if (i0 - 128 + 32 * s + crow(rr, hi) < 0) S[s][rr] = -1e30f;
    }
    bf16x8 pf[5][2];
#pragma unroll
    for (int s = 0; s < 5; ++s) {
#pragma unroll
        for (int rr = 0; rr < 16; ++rr) S[s][rr] = fast_exp2(s == 4 ? S[s][rr] - mx : S[s][rr]);
#pragma unroll
        for (int sp = 0; sp < 2; ++sp) { u32x4 pw; pw.x = pkbf(S[s][8 * sp + 0], S[s][8 * sp + 1]); pw.y = pkbf(S[s][8 * sp + 2], S[s][8 * sp + 3]); pw.z = pkbf(S[s][8 * sp + 4], S[s][8 * sp + 5]); pw.w = pkbf(S[s][8 * sp + 6], S[s][8 * sp + 7]);
            pf[s][sp] = __builtin_bit_cast(bf16x8, pw); asm volatile("" : "+v"(pf[s][sp])); }
    }
    f32x16 o[2]; o[0] = (f32x16){}; o[1] = (f32x16){};
    f32x16 ol = {};
    const bf16x8 ones = __builtin_bit_cast(bf16x8, (u32x4){0x3F803F80u, 0x3F803F80u, 0x3F803F80u, 0x3F803F80u});
    const LAS unsigned char* vt = lds + TV_OFF + (32 * wave + 4 * hi + ((lane & 15) >> 2)) * 64 + ((lane >> 4) & 1) * 32 + (lane & 3) * 8;
#pragma unroll
    for (int s = 0; s < 5; ++s)
#pragma unroll
        for (int sp = 0; sp < 2; ++sp)
#pragma unroll
            for (int dt = 0; dt < 2; ++dt) {
                const s16x4 lo = __builtin_bit_cast(s16x4, __builtin_amdgcn_ds_read_tr16_b64_v4i16((LAS s16x4*)(vt + dt * 24576 + s * 2048 + sp * 1024)));
                const s16x4 hh = __builtin_bit_cast(s16x4, __builtin_amdgcn_ds_read_tr16_b64_v4i16((LAS s16x4*)(vt + dt * 24576 + s * 2048 + sp * 1024 + 512)));
                const bf16x8 vf = (bf16x8){lo[0], lo[1], lo[2], lo[3], hh[0], hh[1], hh[2], hh[3]};
                o[dt] = __builtin_amdgcn_mfma_f32_32x32x16_bf16(vf, pf[s][sp], o[dt], 0, 0, 0);
                if (dt == 1) ol = __builtin_amdgcn_mfma_f32_32x32x16_bf16(ones, pf[s][sp], ol, 0, 0, 0);
            }
    const float l = ol[0];
    asm volatile("s_waitcnt lgkmcnt(0)\n\ts_barrier" ::: "memory");
    if (has_next) t_issue_v(c, nxt, lds, wave, lane);
    po.o[0] = o[0]; po.o[1] = o[1]; po.l = l; po.mx = mx;
}
__device__ __forceinline__ void t_flush(const Ctx& c, const TDesc& d, const TOut& po, LAS unsigned char* lds, int wave) {
    const int lane = fresh_lane(), r32 = lane & 31, hi = lane >> 5, vkey = lane >> 3, vch = lane & 7;
    LAS unsigned char* qb = lds + TB_OFF + wave * 4608;
    u32x4 ow[4];
    t_out1(po, qb, r32, hi); t_out2(c, d, po, qb, wave, r32, hi, vkey, vch, ow); t_out3(c, d, wave, vkey, vch, ow);
}
template <int NQ> __device__ __forceinline__ void sample_vblock(const Ctx& c, int n, int h, int g, int dil, int r, int i0, const LAS float* tab, LAS float* sbuf) {
    const int lane = fresh_lane(), sub = lane & 15, rgp = lane >> 4;
    constexpr int NT = (NQ + 3) / 4, NSA = 32 + NT;
    f32x4 q4[NQ];
#pragma unroll
    for (int qq = 0; qq < NQ; ++qq) { const size_t row = (size_t)MP + n * TS + (r + dil * (i0 + qq) - WBUF);
        const u32x2 w = *(const u32x2*)(c.QB + row * AW + h * HD + 4 * sub); q4[qq] = (f32x4){bf_lo(w.x), bf_hi(w.x), bf_lo(w.y), bf_hi(w.y)}; }
    const unsigned cbase = (unsigned)((((n * WBUF) + r + dil * (i0 - 128 + rgp)) * NH + h) * HD + 4 * sub) * 4u, cstep = (unsigned)(4 * dil * NH * HD * 4);
    auto new_row = [&](const bf16_t* B16, int tt) -> f32x4 { const int tc = tt < NQ ? tt : NQ - 1;
        const u32x2 w = *(const u32x2*)(B16 + ((size_t)MP + n * TS + (r + dil * (i0 + tc) - WBUF)) * AW + h * HD + 4 * sub);
        return (f32x4){bf_lo(w.x), bf_hi(w.x), bf_lo(w.y), bf_hi(w.y)}; };
    auto score = [&](const f32x4 kv, int kk) {
#pragma unroll
        for (int qq = 0; qq < NQ; ++qq) {
            float d = (kv[0] * q4[qq][0] + kv[1] * q4[qq][1]) + (kv[2] * q4[qq][2] + kv[3] * q4[qq][3]);
            d += __shfl_xor(d, 1); d += __shfl_xor(d, 2); d += __shfl_xor(d, 4); d += __shfl_xor(d, 8);
            if (sub == 0) sbuf[qq * 136 + kk] = (kk < 128 + NQ) ? d + tab[159 + qq - kk] : -1e30f;
        } };
    {   f32x4 nk[NT];
#pragma unroll
        for (int i = 0; i < NT; ++i) nk[i] = new_row(c.KB, 4 * i + rgp);
        {   f32x4 kv[32];
#pragma unroll
            for (int i = 0; i < 32; ++i) kv[i] = *(const f32x4*)((const char*)c.CK + cbase + (unsigned)i * cstep);
#pragma unroll
            for (int i = 0; i < 32; ++i) score(kv[i], 4 * i + rgp);
        }
#pragma unroll
        for (int i = 0; i < NT; ++i) score(nk[i], 128 + 4 * i + rgp);
    }
    asm volatile("s_waitcnt lgkmcnt(0)" ::: "memory");
    float lq[NQ], lse[NQ];
#pragma unroll
    for (int qq = 0; qq < NQ; ++qq) {
        float v[3]; float mx = -3.0e38f;
#pragma unroll
        for (int j = 0; j < 3; ++j) { const int kk = lane + 64 * j; v[j] = (kk < 4 * NSA) ? sbuf[qq * 136 + kk] : -1e30f; mx = fmaxf(mx, v[j]); }
#pragma unroll
        for (int o = 1; o < 64; o <<= 1) mx = fmaxf(mx, __shfl_xor(mx, o));
        float sm = 0.f;
#pragma unroll
        for (int j = 0; j < 3; ++j) { const int kk = lane + 64 * j; const float pv = fast_exp2(v[j] - mx); sm += pv; if (kk < 4 * NSA) sbuf[qq * 136 + kk] = pv; }
        sm = wave_sum(sm); lq[qq] = sm; lse[qq] = mx + __log2f(sm);
    }
    asm volatile("s_waitcnt lgkmcnt(0)" ::: "memory");
    f32x4 oa[NQ];
#pragma unroll
    for (int qq = 0; qq < NQ; ++qq) oa[qq] = (f32x4){0.f, 0.f, 0.f, 0.f};
    {   f32x4 nv[NT];
#pragma unroll
        for (int i = 0; i < NT; ++i) nv[i] = new_row(c.VB, 4 * i + rgp);
        {   f32x4 vv[32];
#pragma unroll
            for (int i = 0; i < 32; ++i) vv[i] = *(const f32x4*)((const char*)c.CV + cbase + (unsigned)i * cstep);
#pragma unroll
            for (int i = 0; i < 32; ++i) { const int kk = 4 * i + rgp;
#pragma unroll
                for (int qq = 0; qq < NQ; ++qq) { const float pv = sbuf[qq * 136 + kk]; oa[qq] += vv[i] * pv; } }
        }
#pragma unroll
        for (int i = 0; i < NT; ++i) { const int kk = 128 + 4 * i + rgp;
#pragma unroll
            for (int qq = 0; qq < NQ; ++qq) { const float pv = sbuf[qq * 136 + kk]; oa[qq] += nv[i] * pv; } }
    }
#pragma unroll
    for (int qq = 0; qq < NQ; ++qq) {
#pragma unroll
        for (int e = 0; e < 4; ++e) { float x = oa[qq][e]; x += __shfl_xor(x, 16); x += __shfl_xor(x, 32); oa[qq][e] = x; }
        const size_t tok = (size_t)MP + n * TS + (r + dil * (i0 + qq) - WBUF);
        if (rgp == 0) { const float inv = 1.0f / lq[qq]; u32x2 w; w.x = pkbf(oa[qq][0] * inv, oa[qq][1] * inv); w.y = pkbf(oa[qq][2] * inv, oa[qq][3] * inv);
            *(u32x2*)(c.OP + (size_t)g * OP_STRIDE + tok * AW + h * HD + 4 * sub) = w;
            if (sub == 0) c.LSE[(size_t)g * LSE_STRIDE + tok * NH + h] = lse[qq]; }
    }
    asm volatile("s_waitcnt lgkmcnt(0)" ::: "memory");
}
template <int NP> __device__ __forceinline__ void merge_pieces(const Ctx& c, size_t tok0, size_t tstride, int h, int piece) {
    float ls[NP][3]; u32x4 ov[NP][3];
#pragma unroll
    for (int q = 0; q < NP; ++q)
#pragma unroll
        for (int g = 0; g < 3; ++g) { const size_t tok = tok0 + q * tstride; ls[q][g] = c.LSE[(size_t)g * LSE_STRIDE + tok * NH + h]; ov[q][g] = *(const u32x4*)(c.OP + (size_t)g * OP_STRIDE + tok * AW + h * HD + piece * 8); }
#pragma unroll
    for (int q = 0; q < NP; ++q) {
        const float M = fmaxf(fmaxf(ls[q][0], ls[q][1]), ls[q][2]);
        float w0 = fast_exp2(ls[q][0] - M), w1 = fast_exp2(ls[q][1] - M), w2 = fast_exp2(ls[q][2] - M); const float inv = 1.0f / (w0 + w1 + w2); w0 *= inv; w1 *= inv; w2 *= inv;
        u32x4 o;
#pragma unroll
        for (int e = 0; e < 4; ++e) {
            const float lo = w0 * bf_lo(ov[q][0][e]) + w1 * bf_lo(ov[q][1][e]) + w2 * bf_lo(ov[q][2][e]);
            const float hi_ = w0 * bf_hi(ov[q][0][e]) + w1 * bf_hi(ov[q][1][e]) + w2 * bf_hi(ov[q][2][e]);
            o[e] = pkbf(lo, hi_);
        }
        *(u32x4*)(c.ATT + (tok0 + q * tstride) * DM + h * HD + piece * 8) = o;
    }
}
__device__ __forceinline__ void copy_slot(const float* ck, const float* cv, float* out, int sl, int lane) {
    const int sq = sl / 576, j0 = (sl - sq * 576) * 680, which = sq >> 5, n = sq & 31;
    const f32x4* src = (const f32x4*)((which ? cv : ck) + (size_t)n * WBUF * AW + (size_t)TS * AW) + j0 + lane;
    f32x4* dst = (f32x4*)(out + (which ? OFF_SWV : OFF_SWK) + (size_t)n * WBUF * AW) + j0 + lane;
    f32x4 v[11];
#pragma unroll
    for (int i = 0; i < 10; ++i) v[i] = __builtin_nontemporal_load(src + 64 * i);
    if (lane < 40) v[10] = __builtin_nontemporal_load(src + 640);
#pragma unroll
    for (int i = 0; i < 10; ++i) __builtin_nontemporal_store(v[i], dst + 64 * i);
    if (lane < 40) __builtin_nontemporal_store(v[10], dst + 640);
}
__device__ __forceinline__ void copy_range(const float* ck, const float* cv, float* out, unsigned first, unsigned count, int widx, int nw, int tid) {
    constexpr unsigned PER = (unsigned)(WBUF - TS) * AW / 4;
    const unsigned end = first + count;
    for (unsigned i0 = first + (unsigned)widx * 4096u + tid; i0 < end; i0 += (unsigned)nw * 4096u) {
        f32x4 v[8];
#pragma unroll
        for (int k = 0; k < 8; ++k) { const unsigned i = i0 + 512u * k; if (i < end) { const unsigned sq = i / PER, j = i - sq * PER, which = sq >> 5, n = sq & 31;
            v[k] = __builtin_nontemporal_load((const f32x4*)((which ? cv : ck) + (size_t)n * WBUF * AW + (size_t)TS * AW) + j); } }
#pragma unroll
        for (int k = 0; k < 8; ++k) { const unsigned i = i0 + 512u * k; if (i < end) { const unsigned sq = i / PER, j = i - sq * PER, which = sq >> 5, n = sq & 31;
            __builtin_nontemporal_store(v[k], (f32x4*)(out + (which ? OFF_SWV : OFF_SWK) + (size_t)n * WBUF * AW) + j); } }
    }
}
}

template <int NTW, bool SAMPLE> __device__ __forceinline__ void conv_unit(const float* U, const float* cache_conv, int seq, int t0, LAS float* tile, const LAS float* cw,
                                                                          const float* cb, const float* lg, const float* lb, bf16_t* ATT, int tid, int lane, int wave) {
    constexpr int NROW = 8 * NTW + 30;
    const size_t rowbase = SAMPLE ? (size_t)MP + (size_t)seq * TS : (size_t)seq * SEQ;
    for (int idx = tid; idx < NROW * 64; idx += 512) {
        const int rr = idx >> 6, c4 = idx & 63, tau = rr - 30; f32x4 v = (f32x4){0.f, 0.f, 0.f, 0.f};
        if (SAMPLE) { v = tau < 0 ? *(const f32x4*)(cache_conv + ((size_t)seq * 30 + (30 + tau)) * CWD + 4 * c4) : *(const f32x4*)(U + (rowbase + tau) * CWD + 4 * c4); }
        else if (t0 + tau >= 0) v = *(const f32x4*)(U + (rowbase + t0 + tau) * CWD + 4 * c4);
        *(LAS f32x4*)(tile + rr * CWD + 4 * c4) = v;
    }
    __syncthreads();
    f32x4 acc[NTW], uw[NTW];
    const LAS float* tw = tile + (NTW * wave) * CWD + 4 * lane;
#pragma unroll
    for (int i = 0; i < NTW; ++i) { acc[i] = (f32x4){0.f, 0.f, 0.f, 0.f}; uw[i] = *(const LAS f32x4*)(tw + i * CWD); }
#pragma unroll 1
    for (int j = 0; j < 31; ++j) {
        const f32x4 w = *(const LAS f32x4*)(cw + j * CWD + 4 * lane);
        const f32x4 nx = *(const LAS f32x4*)(tw + (NTW + j) * CWD);
#pragma unroll
        for (int i = 0; i < NTW; ++i) acc[i] += w * uw[i];
#pragma unroll
        for (int i = 0; i + 1 < NTW; ++i) uw[i] = uw[i + 1];
        uw[NTW - 1] = nx;
    }
    const f32x4 bv = *(const f32x4*)(cb + 4 * lane), gv = *(const f32x4*)(lg + 4 * lane), lv = *(const f32x4*)(lb + 4 * lane);
#pragma unroll
    for (int i = 0; i < NTW; ++i) {
        f32x4 y = acc[i] + bv;
        const float mean = wave_sum((y[0] + y[1]) + (y[2] + y[3])) * (1.0f / CWD);
        y = y - mean;
        const float var = wave_sum((y[0] * y[0] + y[1] * y[1]) + (y[2] * y[2] + y[3] * y[3])) * (1.0f / CWD);
        const float rstd = 1.0f / sqrtf(var + EPS);
        f32x4 z = y * rstd * gv + lv;
#pragma unroll
        for (int e = 0; e < 4; ++e) z[e] = z[e] * fast_rcp(1.f + fast_exp2(-z[e] * LOG2E));
        u32x2 w; w.x = pkbf(z[0], z[1]); w.y = pkbf(z[2], z[3]);
        *(u32x2*)(ATT + (rowbase + t0 + NTW * wave + i) * DM + AW + 4 * lane) = w;
    }
    __syncthreads();
}

__global__ void __launch_bounds__(512, 2) fwd_kernel(Params p) {
    extern __shared__ __attribute__((aligned(16))) unsigned char lds_raw[];
    LAS unsigned char* lds = (LAS unsigned char*)lds_raw;
    const int G = gridDim.x, bid = blockIdx.x;
    const int wave = __builtin_amdgcn_readfirstlane(threadIdx.x >> 6);
#define PHASE_IDS const int lane = fresh_lane(), tid = wave * 64 + lane; (void)tid
    unsigned char* ws = p.ws; float* out = p.out;
    bf16_t* WALL = (bf16_t*)(ws + WS_WALL); bf16_t* WOUT = (bf16_t*)(ws + WS_WOUT); bf16_t* WXQ = (bf16_t*)(ws + WS_WXQ); bf16_t* WXO = (bf16_t*)(ws + WS_WXO);
    bf16_t* WGU = (bf16_t*)(ws + WS_WGU); bf16_t* WDN = (bf16_t*)(ws + WS_WDN); bf16_t* XN = (bf16_t*)(ws + WS_XN);
    bf16_t* QB = (bf16_t*)(ws + WS_QB); bf16_t* KB = (bf16_t*)(ws + WS_KB); bf16_t* VB = (bf16_t*)(ws + WS_VB); float* U = (float*)(ws + WS_U);
    bf16_t* OP = (bf16_t*)(ws + WS_OP); float* LSE = (float*)(ws + WS_LSE); bf16_t* ATT = (bf16_t*)(ws + WS_ATT); float* X1 = (float*)(ws + WS_X1);
    float* SSQ = (float*)(ws + WS_SSQ); bf16_t* MKB = (bf16_t*)(ws + WS_MKB); bf16_t* MVT = (bf16_t*)(ws + WS_MVT); float* LSUM = (float*)(ws + WS_LSUM);
    bf16_t* XQ = (bf16_t*)(ws + WS_XQ); bf16_t* PB = (bf16_t*)(ws + WS_PB); bf16_t* XO = (bf16_t*)(ws + WS_XO); bf16_t* HB = (bf16_t*)(ws + WS_H);
    const int lo = p.ph_lo, hi = p.ph_hi;
    if (threadIdx.x < 4) ((volatile LAS unsigned*)(lds + MISC_OFF))[threadIdx.x] = 0u;
    __syncthreads();
    XcdBarrier xbar; xbar.bar = (unsigned*)(ws + WS_CTL); xbar.x = 0; xbar.st = nullptr;
    if (p.coop) xbar = xcd_barrier_post((unsigned*)(ws + WS_CTL), (volatile LAS unsigned*)(lds + MISC_OFF));
#ifndef PH_MASK
#define PH_MASK 0x7ff
#endif
#define IN(k) (((PH_MASK >> (k)) & 1) && lo <= (k) && (k) < hi)
#ifndef PROBE_DUP
#define PROBE_DUP 0
#endif
#define REP(k) for (int rep_ = 0; rep_ <= ((PROBE_DUP >> (k)) & 1); ++rep_)
#define REPSYNC if (rep_) xcd_barrier(xbar)
#define SEAM(k) do { if (IN(k) && IN((k) + 1)) { if (p.coop == 2) cg::this_grid().sync(); else xcd_barrier(xbar); } } while (0)

    if (IN(0)) REP(0) {
        REPSYNC;
        PHASE_IDS;
        LAS float* scr = (LAS float*)(lds + wave * 16384);
        const int gw = bid * 8 + wave, NGW = G * 8;
        constexpr int I_IN = 16 * 88, I_SQ = 16 * 32, I_FF = 16 * 88, I_DN = 44 * 32;
        constexpr int NITEMS = I_IN + 5 * I_SQ + 2 * I_FF + I_DN;
        for (int it = gw; it < NITEMS; it += NGW) {
            int r = it;
            if (r < I_IN) { transpose_item(p.in[10], DM, NIN, WALL, r, 1, scr, lane); continue; } r -= I_IN;
            if (r < I_SQ) { transpose_item(p.in[19], DM, DM, WALL + (size_t)2816 * DM, r, 0, scr, lane); continue; } r -= I_SQ;
            if (r < I_SQ) { transpose_item(p.in[20], DM, DM, WALL + (size_t)3840 * DM, r, 0, scr, lane); continue; } r -= I_SQ;
            if (r < I_SQ) { transpose_item(p.in[15], DM, DM, WOUT, r, 0, scr, lane); continue; } r -= I_SQ;
            if (r < I_SQ) { transpose_item(p.in[18], DM, DM, WXQ, r, 0, scr, lane); continue; } r -= I_SQ;
            if (r < I_SQ) { transpose_item(p.in[21], DM, DM, WXO, r, 0, scr, lane); continue; } r -= I_SQ;
            if (r < I_FF) { transpose_item(p.in[23], DM, DFF, WGU, r, 2, scr, lane); continue; } r -= I_FF;
            if (r < I_FF) { transpose_item(p.in[24], DM, DFF, WGU, r, 3, scr, lane); continue; } r -= I_FF;
            transpose_item(p.in[25], DFF, DM, WDN, r, 0, scr, lane);
        }
        for (int m0 = gw * 4; m0 < MALL; m0 += NGW * 4) {
            const float* base; const float* g;
            if (m0 < MP) { base = p.in[0] + (size_t)m0 * DM; g = p.in[9]; }
            else if (m0 < MTOK) { base = p.in[1] + (size_t)(m0 - MP) * DM; g = p.in[9]; }
            else { base = p.in[2] + (size_t)(m0 - MTOK) * DM; g = p.in[17]; }
            const float* const xr[4] = {base, base + DM, base + 2 * DM, base + 3 * DM};
            bf16_t* ob = XN + (size_t)m0 * DM; bf16_t* const orr[4] = {ob, ob + DM, ob + 2 * DM, ob + 3 * DM};
            rms_rows_bf16<4>(xr, g, orr, lane);
        }
        if (bid == 0) {
            float* tabg = (float*)(ws + WS_TABG);
            for (int i = tid; i < 36 * 192; i += 512) {
                const int gh = i / 192, e = i - gh * 192, g = gh / 12, h = gh - g * 12, dist = e - 31; float v = -1e30f;
                if (dist >= 0 && dist <= 128) { const int n = dist << (2 * g); int bk;
                    if (n < 16) bk = n; else { const float vv = logf((float)n / 16.0f) / 4.852030263919617f * 16.0f; bk = 16 + (int)vv; bk = bk > 31 ? 31 : bk; }
                    v = p.in[8][bk * NH + h] * LOG2E; }
                tabg[i] = v;
            }
        }
        {
            constexpr int CPER = (30 - TS) * CWD / 4;
            for (int i = bid * 512 + tid; i < NSEQ * CPER; i += G * 512) { const int n = i / CPER, j = i - n * CPER;
                ((f32x4*)(out + OFF_SCONV + (size_t)n * 30 * CWD))[j] = ((const f32x4*)(p.in[5] + (size_t)n * 30 * CWD + TS * CWD))[j]; }
        }
    }
    SEAM(0);
    if (IN(1)) REP(1) {
        REPSYNC;
#ifndef P1_NO_MAIN
        { pg8::SchedGrid S{129, 11, G, bid, (const char*)XN, (const char*)WALL, (size_t)256 * DM * 2, (size_t)256 * DM * 2};
          pg8::EpiIn E{ws, out};
          pg8::gemm_phase<pg8::EpiIn, pg8::SchedGrid, true>(lds, pg8::Cfg{DM, DM, DM}, S, E, wave); }
#endif
#ifndef P1_NO_MEM
        { const int cfirst = (129 * 11) % G;
          pg8::SchedMem S{(bid - cfirst + G) % G, (const char*)XN, (const char*)WALL};
          pg8::EpiMem E{ws, out};
          pg8::gemm_phase<pg8::EpiMem, pg8::SchedMem, true>(lds, pg8::Cfg{DM, DM, DM}, S, E, wave); }
        if (bid >= 187 && rep_ == 0) { PHASE_IDS; att::copy_range(p.in[3], p.in[4], out, 0u, 2000000u, bid - 187, G - 187, tid); }
#endif
    }
    SEAM(1);
    if (IN(2)) REP(2) {
        REPSYNC;
        PHASE_IDS;
        LAS float* tab = (LAS float*)(lds + ATT_TAB_OFF); LAS float* cw = (LAS float*)(lds + ATT_CW_OFF);
#ifndef MK_TILE_ATT
#define MK_TILE_ATT 1
#endif
        const float* tabg = (const float*)(ws + WS_TABG);
#if !MK_TILE_ATT
        for (int i = tid; i < 36 * 192; i += 512) tab[i] = tabg[i];
        __syncthreads();
#endif
        att::Ctx c{QB, KB, VB, p.in[3], p.in[4], OP, LSE, ATT};
        LAS unsigned char* vbuf = lds + ATT_V_OFF + wave * ATT_WBUF;
#ifndef PROBE_P2
#define PROBE_P2 0
#endif
#if MK_TILE_ATT
        {
            const int nl2 = __builtin_amdgcn_readfirstlane((int)((volatile LAS unsigned*)(lds + MISC_OFF))[0]), nx2 = __builtin_amdgcn_readfirstlane((int)((volatile LAS unsigned*)(lds + MISC_OFF))[1]);
            const int xi2 = __builtin_amdgcn_readfirstlane((int)((volatile LAS unsigned*)(lds + MISC_OFF))[2]), rk2 = __builtin_amdgcn_readfirstlane((int)((volatile LAS unsigned*)(lds + MISC_OFF))[3]);
            const int npair = (48 - xi2 + nx2 - 1) / nx2, nun = npair * 96;
            auto mk = [&](int Lx) -> att::TDesc { att::TDesc d; const int pair = Lx / 96, u = Lx - pair * 96, pp = xi2 + nx2 * pair; d.b = pp / 12; d.h = pp - d.b * 12; d.g = u >> 5; const int cj = u & 31;
                if (d.g == 0) { d.dil = 1; d.r = 0; d.j0 = 256 * cj; } else if (d.g == 1) { d.dil = 4; d.r = cj >> 3; d.j0 = 256 * (cj & 7); } else { d.dil = 16; d.r = cj >> 1; d.j0 = 256 * (cj & 1); }
                return d; };
            int Lx = rk2;
            att::TDesc cur = mk(Lx < nun ? Lx : 0), prv = cur;
            att::TOut po; po.o[0] = (f32x16){}; po.o[1] = (f32x16){}; po.l = 1.f; po.mx = 0.f;
            const bool any = Lx < nun;
            __builtin_amdgcn_s_waitcnt(0x0070);
            if (any) { att::t_issue_tab(tabg, cur, lds, wave, lane);
                att::t_issue_k(c, cur, lds, wave, lane); att::t_issue_q(c, cur, lds, wave, lane); att::t_issue_v(c, cur, lds, wave, lane); }
            while (Lx < nun) {
                const int Lx2 = Lx + nl2; const bool has_next = Lx2 < nun;
                const att::TDesc nxt = mk(has_next ? Lx2 : Lx);
                att::t_unit(c, prv, cur, nxt, has_next, tabg, lds, wave, po);
                prv = cur; cur = nxt; Lx = Lx2;
            }
            if (any) att::t_flush(c, prv, po, lds, wave);
            xl_barrier(xbar);
            for (int k = 0; k < npair; ++k) { const int pp = xi2 + nx2 * k, b = pp / 12, h = pp - b * 12;
                for (int ck = rk2; ck < 32; ck += nl2) att::merge_pieces<4>(c, (size_t)b * SEQ + ck * 256 + (tid >> 3), 64, h, tid & 7); }
            __syncthreads();
            for (int i = tid; i < 36 * 192; i += 512) tab[i] = tabg[i];
            __syncthreads();
        }
#endif
#if !defined(P2_NO_PROMPT) && !MK_TILE_ATT
        for (int rp_ = 0; rp_ <= (PROBE_P2 & 1) + ((PROBE_P2 >> 3) & 1); ++rp_) {
            auto mkdesc = [&](int un, int it) -> att::PDesc {
                att::PDesc d; d.b = un / 192; const int rem = un - d.b * 192; d.h = rem >> 4; const int ch = rem & 15; d.g = it >> 4; const int j = it & 15;
                if (d.g == 0) { d.dil = 1; d.r = 0; d.i0 = ch * 512 + 32 * j; } else if (d.g == 1) { d.dil = 4; d.r = j >> 2; d.i0 = ch * 128 + 32 * (j & 3); } else { d.dil = 16; d.r = j; d.i0 = ch * 32; }
                return d; };
            bf16x8 qv[4], kr[5][4];
            const int vkey_ = lane >> 3, vch_ = lane & 7;
            const int vcu = (G % 8 == 0) ? (bid & 7) * (G >> 3) + (bid >> 3) : bid;
            int un = vcu, it = wave;
            att::PDesc cur = mkdesc(un < 768 ? un : 0, it);
            if (un < 768) { att::p_load_q(c, cur, qv, vkey_, vch_);
#pragma unroll
                for (int s5 = 0; s5 < 2; ++s5) att::p_load_kv(c.KB, cur, s5, kr[s5], vkey_, vch_); }
            while (un < 768) {
                int un2 = un, it2 = it + 8; if (it2 >= 48) { it2 = wave; un2 = un + G; }
                const bool has_next = un2 < 768;
                const att::PDesc nxt = mkdesc(has_next ? un2 : un, has_next ? it2 : it);
                att::pblock(c, cur, nxt, has_next, qv, kr, tab, vbuf);
                if (un2 != un) {
                    __syncthreads();
                    const int b = un / 192, rem = un - b * 192, h = rem >> 4, ch = rem & 15;
#pragma unroll 1
                    for (int ps = 0; ps < 8; ps += 4) att::merge_pieces<4>(c, (size_t)b * SEQ + ch * 512 + ps * 64 + (tid >> 3), 64, h, tid & 7);
                }
                cur = nxt; un = un2; it = it2;
            }
        }
#endif
        {
            unsigned* cq = (unsigned*)(ws + WS_CTL) + 13200;
            volatile LAS unsigned* qw = (volatile LAS unsigned*)(lds + MISC_OFF) + 8;
            constexpr unsigned NSU = NSEQ * NH, NCP = (unsigned)(MP / 64), NIT = NSU + NCP + NSEQ;
            LAS float* cw8 = (LAS float*)(lds + 98304);
            unsigned tk_ = 0;
            if (threadIdx.x == 0) { tk_ = xb_add(cq, 1u); qw[0] = tk_; }
            __syncthreads();
            unsigned q = (unsigned)__builtin_amdgcn_readfirstlane((int)qw[0]);
            bool conv_ready = false;
            while (q < NIT) {
                __syncthreads();
                if (threadIdx.x == 0) tk_ = xb_add(cq, 1u);
                if (q < NSU) {
                    const int n = (int)q / NH, h = (int)q - n * NH;
                    if (wave == 0) att::wave_block<1>(c, n, h, 0, 1, 0, 2048, 8, tab + (0 * 12 + h) * 192, vbuf);
                    else for (int it = wave; it < 13; it += 7) {
                        LAS float* sb = (LAS float*)vbuf;
                        if (it < 5) att::sample_vblock<2>(c, n, h, 1, 4, it - 1, 512, tab + (1 * 12 + h) * 192, sb);
                        else att::sample_vblock<1>(c, n, h, 2, 16, it - 5, 128, tab + (2 * 12 + h) * 192, sb);
                    }
                    __syncthreads();
                    if (tid < 64) att::merge_pieces<1>(c, (size_t)MP + n * TS + (tid >> 3), 0, h, tid & 7);
                } else {
                    if (!conv_ready) { __syncthreads(); for (int i = tid; i < 31 * CWD; i += 512) cw8[i] = p.in[11][i]; conv_ready = true; }
                    const int un = (int)(q - NSU);
                    if (un < (int)NCP) conv_unit<8, false>(U, p.in[5], un >> 7, (un & 127) * 64, (LAS float*)(lds + ATT_V_OFF), cw8, p.in[12], p.in[13], p.in[14], ATT, tid, lane, wave);
                    else conv_unit<1, true>(U, p.in[5], un - (int)NCP, 0, (LAS float*)(lds + ATT_V_OFF), cw8, p.in[12], p.in[13], p.in[14], ATT, tid, lane, wave);
                }
                if (threadIdx.x == 0) qw[0] = tk_;
                __syncthreads();
                q = (unsigned)__builtin_amdgcn_readfirstlane((int)qw[0]);
            }
        }
    }
    SEAM(2);
    const int nl = __builtin_amdgcn_readfirstlane((int)((volatile LAS unsigned*)(lds + MISC_OFF))[0]), nx = __builtin_amdgcn_readfirstlane((int)((volatile LAS unsigned*)(lds + MISC_OFF))[1]);
    const int xi = __builtin_amdgcn_readfirstlane((int)((volatile LAS unsigned*)(lds + MISC_OFF))[2]), rk = __builtin_amdgcn_readfirstlane((int)((volatile LAS unsigned*)(lds + MISC_OFF))[3]);
    unsigned* xq_flag = (unsigned*)(ws + WS_CTL) + 3520; unsigned* xo_flag = (unsigned*)(ws + WS_CTL) + 13000;
    bool own128 = false;
    { for (int j = 0; j < 16; ++j) { const int Lx = j * nl + rk, pm = xi + nx * (Lx >> 2); if (pm >= 129) break; own128 |= (pm == 128); } }
    if (IN(3)) {
        pg8::SchedXL S{nl, rk, xi, nx, (const char*)ATT, (const char*)WOUT, (size_t)256 * DM * 2, (size_t)256 * DM * 2, 0};
        pg8::EpiRes<true> E{p.in[0], p.in[1], nullptr, XN, p.in[16], SSQ};
        pg8::gemm_phase<pg8::EpiRes<true>, pg8::SchedXL, true>(lds, pg8::Cfg{DM, DM, DM}, S, E, wave);
    }
    xl_barrier(xbar);
    if (IN(4)) {
        {   pg8::SchedXL S{nl, rk, xi, nx, (const char*)XN, (const char*)WXQ, (size_t)256 * DM * 2, (size_t)256 * DM * 2, 0};
            pg8::EpiScale E{XQ, SSQ, XQSCALE};
            pg8::gemm_phase<pg8::EpiScale, pg8::SchedXL, true>(lds, pg8::Cfg{DM, DM, DM}, S, E, wave); }
        if (own128 && threadIdx.x == 0) { __builtin_amdgcn_fence(__ATOMIC_RELEASE, "agent"); asm volatile("s_waitcnt vmcnt(0)" ::: "memory"); (void)xb_add(xq_flag, 1u); }
        {   pg8::SchedXLs S{nl, rk, xi, nx, (const char*)XQ, (const char*)MKB, 0};
            pg8::EpiSoftmax E{PB, LSUM, (LAS float*)(lds + XCH_OFF)};
            pg8::gemm_phase<pg8::EpiSoftmax, pg8::SchedXLs, true>(lds, pg8::Cfg{256, DM, DM}, S, E, wave); }
        {   pg8::SchedXLs S{nl, rk, xi, nx, (const char*)PB, (const char*)MVT, 1};
            pg8::EpiPV E{XO, LSUM};
            pg8::gemm_phase<pg8::EpiPV, pg8::SchedXLs, true>(lds, pg8::Cfg{256, DM, DM}, S, E, wave); }
        PHASE_IDS;
        if (threadIdx.x == 0) { unsigned sp = 0; while (xb_ld(xq_flag) < 4u) { __builtin_amdgcn_s_sleep(2); if (++sp > (1u << 22)) break; }
            __builtin_amdgcn_fence(__ATOMIC_ACQUIRE, "agent"); asm volatile("s_waitcnt vmcnt(0)" ::: "memory"); }
        LAS float* qs = (LAS float*)lds;
        LAS float* sc = (LAS float*)(lds + 4096);
        LAS float* red = (LAS float*)(lds + 8192);
        for (int un = bid; un < NSEQ * 4 * 2; un += G) {
            const int n = un >> 3, h = (un >> 1) & 3, half = un & 1;
            __syncthreads();
            for (int i = tid; i < 4 * 256; i += 512) { const int t = i >> 8, d = i & 255; qs[i] = __uint_as_float((unsigned)XQ[((size_t)MP + n * TS + 4 * half + t) * DM + h * 256 + d] << 16); }
            __syncthreads();
            const float* Kc = p.in[6] + ((size_t)n * NMEM * 4 + h) * 256; const float* Vc = p.in[7] + ((size_t)n * NMEM * 4 + h) * 256;
            f32x4 qv[4];
#pragma unroll
            for (int t = 0; t < 4; ++t) qv[t] = *(const LAS f32x4*)(qs + t * 256 + 4 * lane);
#pragma unroll 1
            for (int mb = 0; mb < 2; ++mb) {
                f32x4 kv[16];
#pragma unroll
                for (int k = 0; k < 16; ++k) kv[k] = *(const f32x4*)(Kc + (size_t)(wave * 32 + mb * 16 + k) * 1024 + 4 * lane);
#pragma unroll
                for (int k = 0; k < 16; ++k) {
                    float pt[4];
#pragma unroll
                    for (int t = 0; t < 4; ++t) pt[t] = wave_sum((kv[k][0] * qv[t][0] + kv[k][1] * qv[t][1]) + (kv[k][2] * qv[t][2] + kv[k][3] * qv[t][3]));
                    if (lane == 0) *(LAS f32x4*)(sc + (wave * 32 + mb * 16 + k) * 4) = (f32x4){pt[0], pt[1], pt[2], pt[3]};
                }
            }
            __syncthreads();
            if (wave < 4) {
                const int t = wave; float v[4]; float mx = -3.0e38f;
#pragma unroll
                for (int j = 0; j < 4; ++j) { v[j] = sc[(lane + 64 * j) * 4 + t]; mx = fmaxf(mx, v[j]); }
#pragma unroll
                for (int o = 1; o < 64; o <<= 1) mx = fmaxf(mx, __shfl_xor(mx, o));
                float sm = 0.f;
#pragma unroll
                for (int j = 0; j < 4; ++j) { v[j] = fast_exp2(v[j] - mx); sm += v[j]; }
                sm = wave_sum(sm); const float inv = 1.0f / sm;
#pragma unroll
                for (int j = 0; j < 4; ++j) sc[(lane + 64 * j) * 4 + t] = v[j] * inv;
            }
            __syncthreads();
            {
                const int d = tid & 255, mh = tid >> 8; f32x4 o = (f32x4){0.f, 0.f, 0.f, 0.f};
                const float* vp = Vc + (size_t)(mh * 128) * 1024 + d; const LAS float* pp = sc + (mh * 128) * 4;
#pragma unroll 1
                for (int m0 = 0; m0 < 128; m0 += 32) {
                    float vv[32];
#pragma unroll
                    for (int m = 0; m < 32; ++m) vv[m] = vp[(size_t)(m0 + m) * 1024];
#pragma unroll
                    for (int m = 0; m < 32; ++m) { const f32x4 pw = *(const LAS f32x4*)(pp + (m0 + m) * 4); o += pw * vv[m]; }
                }
                if (mh == 1) *(LAS f32x4*)(red + d * 4) = o;
                __syncthreads();
                if (mh == 0) { o += *(const LAS f32x4*)(red + d * 4);
#pragma unroll
                    for (int e = 0; e < 4; ++e) { const unsigned mine = pkbf(o[e], 0.f) & 0xffffu, nb = (unsigned)__shfl_down((int)mine, 1);
                        if (!(d & 1)) __hip_atomic_store((unsigned*)(XO + ((size_t)MP + n * TS + 4 * half + e) * DM + h * 256 + d), mine | (nb << 16), __ATOMIC_RELAXED, __HIP_MEMORY_SCOPE_AGENT); } }
            }
            asm volatile("s_waitcnt vmcnt(0)" ::: "memory"); __syncthreads();
            if (threadIdx.x == 0) (void)xb_add(xo_flag, 1u);
        }
        __syncthreads();
    }
    xl_barrier(xbar);
    if (IN(7)) {
        if (own128) {
            if (threadIdx.x == 0) { unsigned sp = 0; while (xb_ld(xo_flag) < (unsigned)(NSEQ * 8)) { __builtin_amdgcn_s_sleep(2); if (++sp > (1u << 22)) break; }
                __builtin_amdgcn_fence(__ATOMIC_ACQUIRE, "agent"); asm volatile("s_waitcnt vmcnt(0)" ::: "memory"); }
            __syncthreads();
        }
        pg8::SchedXL S{nl, rk, xi, nx, (const char*)XO, (const char*)WXO, (size_t)256 * DM * 2, (size_t)256 * DM * 2, 0};
        pg8::EpiRes<false> E{nullptr, nullptr, p.in[16], XN, p.in[22], SSQ + SSQ_STRIDE};
        pg8::gemm_phase<pg8::EpiRes<false>, pg8::SchedXL, true>(lds, pg8::Cfg{DM, DM, DM}, S, E, wave);
    }
    xl_barrier(xbar);
    const int xi0 = 128 % nx;
    const int xi9 = (nx > 1 && nl >= 4) ? (xi0 + 1) % nx : xi0;
    unsigned* h_flag = (unsigned*)(ws + WS_CTL) + 13064;
    if (IN(8)) {
        pg8::SchedXL22 S{nl, rk, xi, nx, (const char*)XN, (const char*)WGU, (size_t)256 * DM * 2, (size_t)256 * DM * 2};
        pg8::EpiSwiGLU E{HB, SSQ + SSQ_STRIDE};
        pg8::gemm_phase<pg8::EpiSwiGLU, pg8::SchedXL22, true>(lds, pg8::Cfg{DM, DM, DM}, S, E, wave);
        bool had = false;
        for (int j = 0; j < 16; ++j) { const int Lx = j * nl + rk, pm = xi + nx * (Lx / 22); if (pm >= 129) break; had |= (pm == 128); }
        if (had && threadIdx.x == 0) { __builtin_amdgcn_fence(__ATOMIC_RELEASE, "agent"); asm volatile("s_waitcnt vmcnt(0)" ::: "memory"); (void)xb_add(h_flag, 1u); }
    }
    xl_barrier(xbar);
    if (IN(9)) {
        pg8::EpiFinal E{XN, p.in[22], out + OFF_Y, p.in[26], (float*)(ws + WS_SLOT), (unsigned*)(ws + WS_CTL) + 4096, (LAS float*)(lds + XCH_OFF), wave};
        {   pg8::SchedXL S{nl, rk, xi, nx, (const char*)HB, (const char*)WDN, (size_t)256 * DFF * 2, (size_t)256 * DFF * 2, 1};
            pg8::gemm_phase<pg8::EpiFinal, pg8::SchedXL, true>(lds, pg8::Cfg{DFF, DFF, DFF}, S, E, wave); }
        if (xi == xi9 && rk < 4) {
            if (threadIdx.x == 0) { unsigned sp = 0; while (xb_ld(h_flag) < 22u) { __builtin_amdgcn_s_sleep(2); if (++sp > (1u << 22)) break; }
                __builtin_amdgcn_fence(__ATOMIC_ACQUIRE, "agent"); asm volatile("s_waitcnt vmcnt(0)" ::: "memory"); }
            __syncthreads();
            pg8::SchedOne S{128, rk, (const char*)HB, (const char*)WDN, (size_t)256 * DFF * 2, (size_t)256 * DFF * 2};
            pg8::gemm_phase<pg8::EpiFinal, pg8::SchedOne, true>(lds, pg8::Cfg{DFF, DFF, DFF}, S, E, wave);
        }
    }
    {   const bool all = (nx <= 1);
        int before = 0; for (int x = 0; x < xi; ++x) if (x != xi0) before += (x == xi9 && xi9 != xi0) ? nl - 4 : nl;
        const int mine = (xi == xi9 && xi9 != xi0) ? rk - 4 : rk;
        const int nwk = all ? nl : (nx - 1) * nl - (xi9 != xi0 ? 4 : 0), widx = all ? rk : before + mine;
        if (all || (xi != xi0 && mine >= 0)) { PHASE_IDS; att::copy_range(p.in[3], p.in[4], out, 2000000u, 23067520u, widx, nwk, tid); } }
#undef IN
#undef SEAM
}

extern "C" void kernel_launch(void* const* d_in, const int* in_sizes, int n_in, void* d_out, int out_size, void* d_ws, size_t ws_size, hipStream_t stream) {
    static int grid = 0;
    if (grid == 0) {
        if (n_in != 27 || (size_t)out_size != OUT_TOTAL || ws_size < WS_END) { fprintf(stderr, "kernel_launch: unexpected shapes: n_in %d out %d ws %zu\n", n_in, out_size, ws_size); grid = -1; return; }
        int dev = 0, cus = 0, per_cu = 0;
        (void)hipGetDevice(&dev); (void)hipDeviceGetAttribute(&cus, hipDeviceAttributeMultiprocessorCount, dev);
        if (hipFuncSetAttribute((const void*)fwd_kernel, hipFuncAttributeMaxDynamicSharedMemorySize, LDS_BYTES) != hipSuccess) { fprintf(stderr, "kernel_launch: hipFuncSetAttribute failed\n"); grid = -1; return; }
        if (hipOccupancyMaxActiveBlocksPerMultiprocessor(&per_cu, (const void*)fwd_kernel, 512, LDS_BYTES) != hipSuccess || per_cu < 1) { fprintf(stderr, "kernel_launch: occupancy query failed (%d)\n", per_cu); (void)hipGetLastError(); per_cu = 1; }
        grid = cus * 1;
        if (per_cu < 1) grid = -1;
    }
    if (grid < 0) return;
    Params p{};
    for (int i = 0; i < 27; ++i) p.in[i] = (const float*)d_in[i];
    p.out = (float*)d_out; p.ws = (unsigned char*)d_ws;
#if MK_COOP
    if (hipMemsetAsync((char*)d_ws + WS_CTL, 0, CTL_ZERO_BYTES, stream) != hipSuccess) { fprintf(stderr, "kernel_launch: memset of the barrier words failed\n"); return; }
    p.ph_lo = 0; p.ph_hi = 11; p.coop = 1;
    void* args[] = {&p};
    hipError_t e = hipLaunchCooperativeKernel((const void*)fwd_kernel, dim3(grid), dim3(512), args, LDS_BYTES, stream);
    if (e != hipSuccess) fprintf(stderr, "cooperative launch failed: %s (grid %d)\n", hipGetErrorString(e), grid);
#else
    for (int ph = 0; ph < 11; ++ph) {
        p.ph_lo = ph; p.ph_hi = ph + 1; p.coop = 0;
        hipLaunchKernelGGL(fwd_kernel, dim3(grid), dim3(512), LDS_BYTES, stream, p);
    }
#endif
}
```

```cpp
#include <hip/hip_runtime.h>
#include <hip/hip_cooperative_groups.h>
#include <cstdio>
#include <cstdint>
namespace cg = cooperative_groups;

#ifndef MK_COOP
#define MK_COOP 1
#endif

#define LAS __attribute__((address_space(3)))
typedef unsigned short bf16_t;
typedef short bf16x8 __attribute__((ext_vector_type(8)));
typedef short s16x4 __attribute__((ext_vector_type(4)));
typedef float f32x2 __attribute__((ext_vector_type(2)));
typedef float f32x4 __attribute__((ext_vector_type(4)));
typedef float f32x16 __attribute__((ext_vector_type(16)));
typedef unsigned u32x2 __attribute__((ext_vector_type(2)));
typedef unsigned u32x4 __attribute__((ext_vector_type(4)));
typedef __bf16 bf16x2_t __attribute__((ext_vector_type(2)));

__device__ __forceinline__ unsigned pkbf(float lo, float hi) { f32x2 v = {lo, hi}; bf16x2_t b = __builtin_convertvector(v, bf16x2_t); return __builtin_bit_cast(unsigned, b); }
__device__ __forceinline__ float bf_lo(unsigned w) { return __uint_as_float(w << 16); }
__device__ __forceinline__ float bf_hi(unsigned w) { return __uint_as_float(w & 0xffff0000u); }
__device__ __forceinline__ int fresh_lane() { int t = __builtin_amdgcn_mbcnt_hi(~0u, __builtin_amdgcn_mbcnt_lo(~0u, 0u)); asm volatile("" : "+v"(t)); return t; }
__device__ __forceinline__ float fast_exp2(float x) { return __builtin_amdgcn_exp2f(x); }
__device__ __forceinline__ float fast_rcp(float x) { return __builtin_amdgcn_rcpf(x); }

constexpr int DM = 1024, NBATCH = 4, SEQ = 8192, MP = NBATCH * SEQ;
constexpr int NSEQ = 32, TS = 8, MSMP = NSEQ * TS;
constexpr int MTOK = MP + MSMP;
constexpr int NMEM = 256, MMEM = NBATCH * NMEM;
constexpr int MALL = MTOK + MMEM;
constexpr int AW = 768, CWD = 256, NIN = 2816, DFF = 2816, NH = 12, HD = 64;
constexpr int WBUF = 2048;
constexpr float EPS = 1e-6f;
constexpr float LOG2E = 1.4426950408889634f;
constexpr float QSCALE = 0.125f * LOG2E;
constexpr float XQSCALE = 0.0625f * LOG2E;

constexpr size_t OFF_Y = 0;
constexpr size_t OFF_PWK = 33816576, OFF_PWV = 40108032, OFF_PCONV = 46399488, OFF_PMK = 46430208, OFF_PMV = 47478784;
constexpr size_t OFF_SWK = 48527360, OFF_SWV = 98859008, OFF_SCONV = 149190656, OUT_TOTAL = 149436416;

constexpr size_t MiB = 1u << 20;
constexpr size_t WS_CTL = 0, CTL_ZERO_BYTES = 65536;
constexpr size_t WS_WALL = 2 * MiB;
constexpr size_t WS_WOUT = 12 * MiB, WS_WXQ = 14 * MiB, WS_WXO = 16 * MiB;
constexpr size_t WS_WGU = 18 * MiB;
constexpr size_t WS_WDN = 30 * MiB;
constexpr size_t WS_XN = 36 * MiB;
constexpr size_t WS_QB = 104 * MiB, WS_KB = 154 * MiB, WS_VB = 204 * MiB;
constexpr size_t WS_U = 254 * MiB;
constexpr size_t WS_OP = 288 * MiB;
constexpr size_t OP_STRIDE = (size_t)MTOK * AW;
constexpr size_t WS_LSE = 434 * MiB;
constexpr size_t LSE_STRIDE = (size_t)MTOK * NH;
constexpr size_t WS_ATT = 440 * MiB;
constexpr size_t WS_X1 = 506 * MiB;
constexpr size_t WS_SSQ = 636 * MiB;
constexpr size_t SSQ_STRIDE = (size_t)MTOK * 16;
constexpr size_t WS_MKB = 644 * MiB, WS_MVT = 646 * MiB;
constexpr size_t WS_LSUM = 648 * MiB;
constexpr size_t WS_XQ = 353 * MiB;
constexpr size_t WS_PB = 652 * MiB;
constexpr size_t WS_XO = 288 * MiB;
constexpr size_t WS_H = 104 * MiB;
constexpr size_t WS_TABG = 651 * MiB;
constexpr size_t WS_SLOT = 650 * MiB;
constexpr size_t WS_END = 716 * MiB;

namespace pg8 {
constexpr int BM = 256, BK = 64, HALF = 128, HTB = HALF * BK * 2, STAGE_BYTES = 8 * HTB, NXCD = 8, WGM = 8;
__host__ __device__ __forceinline__ int lds_byte(int r, int c) { const int st = (r >> 4) * 2 + (c >> 5), rr = r & 15, cc = c & 31, ob = rr * 64 + cc * 2; return st * 1024 + (ob ^ (((ob >> 9) & 1) << 5)); }
__host__ __device__ __forceinline__ void stage_rc(int b, int& R, int& C) { const int st = b / 1024, sb = b % 1024, swz = sb ^ (((sb >> 9) & 1) << 5); R = (st >> 1) * 16 + swz / 64; C = (st & 1) * 32 + (swz % 64) / 2; }
__host__ __device__ __forceinline__ int perm32(int rho) { const int n = rho >> 4, i = rho & 15; return 8 * (i >> 2) + 4 * n + (i & 3); }

struct Unit { int pm, pn, kind; };
struct Cfg { int K, lda, ldb; };

template <class Epi, class Sched, bool ALIGN_EPI>
__device__ __forceinline__ void gemm_phase(LAS unsigned char* lds, const Cfg g, const Sched& S, const Epi& E, const int wid) {
    const int lane = fresh_lane(), tid = wid * 64 + lane, wr = wid >> 2, wc = wid & 3, fr = lane & 15, fq = lane >> 4;
    const int K = g.K, nt = K / BK;
    unsigned voffA[2], voffB[2];
#pragma unroll
    for (int i = 0; i < 2; ++i) { int R, C; stage_rc(tid * 16 + i * 8192, R, C); const int Rb = (R & ~31) + perm32(R & 31);
        voffA[i] = (unsigned)(R * g.lda + C) * 2u; voffB[i] = (unsigned)(Rb * g.ldb + C) * 2u; }
    const size_t kstep = (size_t)(BK * 2);
    const size_t hA = (size_t)HALF * g.lda * 2, hB = (size_t)HALF * g.ldb * 2;
    const unsigned ldsw = (unsigned)wid * 1024u;
    const int aoff = lds_byte(wr * 64 + fr, fq * 8), boff = lds_byte(wc * 32 + fr, fq * 8);
#define PG8_SA(b, h) (((b) * 2 + (h)) * HTB)
#define PG8_SB(b, h) ((4 + (b) * 2 + (h)) * HTB)
#define PG8_STAGE(bufoff, gbase, voff) do { _Pragma("unroll") for (int _i = 0; _i < 2; ++_i) \
        __builtin_amdgcn_global_load_lds((const unsigned*)((const char*)(gbase) + (voff)[_i]), (LAS unsigned*)(lds + (bufoff) + ldsw + _i * 8192), 16, 0, 0); } while (0)
#define PG8_LDA(dst, b, h) do { _Pragma("unroll") for (int m = 0; m < 4; ++m) _Pragma("unroll") for (int k = 0; k < 2; ++k) dst[m][k] = *(const LAS bf16x8*)(lds + PG8_SA(b, h) + aoff + m * 2048 + k * 1024); } while (0)
#define PG8_LDB(dst, b, h) do { _Pragma("unroll") for (int n = 0; n < 2; ++n) _Pragma("unroll") for (int k = 0; k < 2; ++k) dst[n][k] = *(const LAS bf16x8*)(lds + PG8_SB(b, h) + boff + n * 2048 + k * 1024); } while (0)
#define PG8_MMA(ai, bj, At, Bt) do { __builtin_amdgcn_s_setprio(1); _Pragma("unroll") for (int m = 0; m < 4; ++m) _Pragma("unroll") for (int n = 0; n < 2; ++n) _Pragma("unroll") for (int k = 0; k < 2; ++k) \
        acc[ai][bj][m][n] = __builtin_amdgcn_mfma_f32_16x16x32_bf16(Bt[n][k], At[m][k], acc[ai][bj][m][n], 0, 0, 0); __builtin_amdgcn_s_setprio(0); } while (0)
#define PG8_WAIT_V(n) asm volatile("s_waitcnt vmcnt(" #n ")" ::: "memory")
#define PG8_WAIT_L(n) asm volatile("s_waitcnt lgkmcnt(" #n ")" ::: "memory")
#define PG8_BAR __builtin_amdgcn_s_barrier()
#define PG8_SCHED __builtin_amdgcn_sched_barrier(0)
    Unit cur, nxt; int ui = 0;
    if (!S.next(0, cur)) return;
    f32x4 acc[2][2][4][2];
    E.init(acc, cur, wr, wc, fr, fq);
    bf16x8 At[4][2], B0[2][2], B1[2][2];
    const char* cA = S.aptr(cur); const char* cB = S.bptr(cur);
    PG8_STAGE(PG8_SB(0, 0), cB, voffB); PG8_STAGE(PG8_SB(0, 1), cB + hB, voffB); PG8_STAGE(PG8_SA(0, 0), cA, voffA); PG8_STAGE(PG8_SA(0, 1), cA + hA, voffA);
    if (wr == 1) PG8_BAR;
    PG8_WAIT_V(2); PG8_BAR;
    PG8_STAGE(PG8_SB(1, 0), cB + kstep, voffB); PG8_STAGE(PG8_SA(1, 0), cA + kstep, voffA); PG8_STAGE(PG8_SB(1, 1), cB + hB + kstep, voffB);
    PG8_WAIT_V(6); PG8_BAR;
    for (;;) {
        const bool has_next = S.next(ui + 1, nxt);
        const char* nA = has_next ? S.aptr(nxt) : cA; const char* nB = has_next ? S.bptr(nxt) : cB;
#pragma unroll 1
        for (int t = 0; t < nt; t += 2) {
            const bool last = (t == nt - 2);
            const char* a1 = cA + (size_t)(t + 1) * kstep;
            const char* a2 = last ? nA : cA + (size_t)(t + 2) * kstep; const char* b2 = last ? nB : cB + (size_t)(t + 2) * kstep;
            const char* a3 = a2 + kstep; const char* b3 = b2 + kstep;
            PG8_LDB(B0, 0, 0); PG8_LDB(B1, 0, 1); PG8_SCHED; PG8_LDA(At, 0, 0); PG8_STAGE(PG8_SA(1, 1), a1 + hA, voffA);
            PG8_WAIT_V(8); PG8_WAIT_L(0); PG8_BAR; PG8_MMA(0, 0, At, B0); PG8_MMA(0, 1, At, B1); PG8_BAR; PG8_SCHED;
            PG8_LDA(At, 0, 1); PG8_STAGE(PG8_SB(0, 0), b2, voffB); PG8_STAGE(PG8_SB(0, 1), b2 + hB, voffB); PG8_STAGE(PG8_SA(0, 0), a2, voffA);
            PG8_WAIT_V(8); PG8_WAIT_L(0); PG8_BAR; PG8_MMA(1, 0, At, B0); PG8_MMA(1, 1, At, B1); PG8_BAR; PG8_SCHED;
            PG8_LDB(B0, 1, 0); PG8_LDB(B1, 1, 1); PG8_SCHED; PG8_LDA(At, 1, 0); PG8_STAGE(PG8_SA(0, 1), a2 + hA, voffA);
            PG8_WAIT_V(8); PG8_WAIT_L(0); PG8_BAR; PG8_MMA(0, 0, At, B0); PG8_MMA(0, 1, At, B1); PG8_BAR; PG8_SCHED;
            PG8_LDA(At, 1, 1); PG8_STAGE(PG8_SB(1, 0), b3, voffB); PG8_STAGE(PG8_SB(1, 1), b3 + hB, voffB); PG8_STAGE(PG8_SA(1, 0), a3, voffA);
            PG8_WAIT_V(8); PG8_WAIT_L(0); PG8_BAR; PG8_MMA(1, 0, At, B0); PG8_MMA(1, 1, At, B1); PG8_BAR; PG8_SCHED;
        }
        if constexpr (ALIGN_EPI) { if (wr == 0) PG8_BAR; }
        E(acc, cur, wr, wc, fr, fq);
        if (!has_next) break;
        E.init(acc, nxt, wr, wc, fr, fq);
        cur = nxt; cA = nA; cB = nB; ++ui;
        if constexpr (ALIGN_EPI) { if (wr == 1) PG8_BAR; }
    }
    PG8_WAIT_V(0);
    if constexpr (!ALIGN_EPI) { if (wr == 0) PG8_BAR; }
    PG8_BAR;
#undef PG8_SA
#undef PG8_SB
#undef PG8_STAGE
#undef PG8_LDA
#undef PG8_LDB
#undef PG8_MMA
#undef PG8_WAIT_V
#undef PG8_WAIT_L
#undef PG8_BAR
#undef PG8_SCHED
}

__device__ __forceinline__ void swz_tile(int L, int nM, int nN, int& pm, int& pn) {
    const int nwg = nM * nN; int wgid = L;
    { const int q = nwg / NXCD, r = nwg % NXCD, xcd = wgid % NXCD, off = wgid / NXCD; wgid = (xcd < r ? xcd * (q + 1) : r * (q + 1) + (xcd - r) * q) + off; }
    const int nig = WGM * nN, gid = wgid / nig, fm = gid * WGM, gsz = (nM - fm) < WGM ? (nM - fm) : WGM;
    pm = fm + ((wgid % nig) % gsz); pn = (wgid % nig) / gsz;
}
struct SchedGrid {
    int nM, nN, G, c; const char* A; const char* B; size_t tA, tB;
    __device__ __forceinline__ bool next(int i, Unit& u) const { const long L = (long)i * G + c; if (L >= (long)nM * nN) return false; swz_tile((int)L, nM, nN, u.pm, u.pn); u.kind = 0; return true; }
    __device__ __forceinline__ const char* aptr(const Unit& u) const { return A + (size_t)u.pm * tA; }
    __device__ __forceinline__ const char* bptr(const Unit& u) const { return B + (size_t)u.pn * tB; }
};
struct SchedMem {
    int c; const char* XN; const char* W;
    static constexpr size_t TS_ = (size_t)256 * 1024 * 2;
    __device__ __forceinline__ bool next(int i, Unit& u) const {
        if (i > 0 || c < 0 || c >= 48) return false;
        if (c < 32) { u.pm = 129 + (c >> 3); u.pn = 11 + (c & 7); u.kind = 1; } else { const int f = c - 32; u.pm = f >> 2; u.pn = f & 3; u.kind = 2; }
        return true;
    }
    __device__ __forceinline__ const char* aptr(const Unit& u) const { return u.kind == 2 ? W + (size_t)(15 + u.pm) * TS_ : XN + (size_t)u.pm * TS_; }
    __device__ __forceinline__ const char* bptr(const Unit& u) const { return u.kind == 2 ? XN + (size_t)(129 + u.pn) * TS_ : W + (size_t)u.pn * TS_; }
};
struct SchedX {
    int G, c; const char* A; const char* B; int bmode;
    __device__ __forceinline__ bool next(int i, Unit& u) const { const long L = (long)i * G + c; if (L >= 512) return false; u.pm = (int)L >> 2; u.pn = (int)L & 3; u.kind = 0; return true; }
    __device__ __forceinline__ const char* aptr(const Unit& u) const { return A + ((size_t)u.pm * 256 * 1024 + (size_t)u.pn * 256) * 2; }
    __device__ __forceinline__ const char* bptr(const Unit& u) const { const int b = u.pm >> 5; return bmode == 0 ? B + ((size_t)b * 256 * 1024 + (size_t)u.pn * 256) * 2 : B + ((size_t)u.pn * 256 * 1024 + (size_t)b * 256) * 2; }
};

struct SchedPanel {
    int G, vcu; const char* A; const char* B; size_t tA, tB;
    __device__ __forceinline__ bool next(int i, Unit& u) const { const int L = i * G + vcu; if (L >= 516) return false; u.pm = L >> 2; u.pn = L & 3; u.kind = 0; return true; }
    __device__ __forceinline__ const char* aptr(const Unit& u) const { return A + (size_t)u.pm * tA; }
    __device__ __forceinline__ const char* bptr(const Unit& u) const { return B + (size_t)u.pn * tB; }
};
struct SchedXL {
    int nl, rk, xi, nx; const char* A; const char* B; size_t tA, tB; int skip128;
    __device__ __forceinline__ bool next(int i, Unit& u) const { const int Lx = i * nl + rk, pm = xi + nx * (Lx >> 2); if (pm >= 129 || (skip128 && pm == 128)) return false; u.pm = pm; u.pn = Lx & 3; u.kind = 0; return true; }
    __device__ __forceinline__ const char* aptr(const Unit& u) const { return A + (size_t)u.pm * tA; }
    __device__ __forceinline__ const char* bptr(const Unit& u) const { return B + (size_t)u.pn * tB; }
};
struct SchedOne {
    int pm, pn; const char* A; const char* B; size_t tA, tB;
    __device__ __forceinline__ bool next(int i, Unit& u) const { if (i > 0) return false; u.pm = pm; u.pn = pn; u.kind = 0; return true; }
    __device__ __forceinline__ const char* aptr(const Unit& u) const { return A + (size_t)u.pm * tA; }
    __device__ __forceinline__ const char* bptr(const Unit& u) const { return B + (size_t)u.pn * tB; }
};
struct SchedXL22 {
    int nl, rk, xi, nx; const char* A; const char* B; size_t tA, tB;
    __device__ __forceinline__ bool next(int i, Unit& u) const { const int Lx = i * nl + rk, q = Lx / 22, pm = xi + nx * q; if (pm >= 129) return false; u.pm = pm; u.pn = Lx - q * 22; u.kind = 0; return true; }
    __device__ __forceinline__ const char* aptr(const Unit& u) const { return A + (size_t)u.pm * tA; }
    __device__ __forceinline__ const char* bptr(const Unit& u) const { return B + (size_t)u.pn * tB; }
};
struct SchedXLs {
    int nl, rk, xi, nx; const char* A; const char* B; int bmode;
    __device__ __forceinline__ bool next(int i, Unit& u) const {
        int idx = 0;
#pragma unroll 1
        for (int j = 0; j < 16; ++j) { const int Lx = j * nl + rk, pm = xi + nx * (Lx >> 2); if (pm >= 129) break; if (pm == 128) continue;
            if (idx == i) { u.pm = pm; u.pn = Lx & 3; u.kind = 0; return true; } ++idx; }
        return false;
    }
    __device__ __forceinline__ const char* aptr(const Unit& u) const { return A + ((size_t)u.pm * 256 * 1024 + (size_t)u.pn * 256) * 2; }
    __device__ __forceinline__ const char* bptr(const Unit& u) const { const int b = u.pm >> 5; return bmode == 0 ? B + ((size_t)b * 256 * 1024 + (size_t)u.pn * 256) * 2 : B + ((size_t)u.pn * 256 * 1024 + (size_t)b * 256) * 2; }
};
struct SchedXs {
    int G, c; const char* A; const char* B; int bmode;
    __device__ __forceinline__ bool next(int i, Unit& u) const {
        int idx = 0;
#pragma unroll
        for (int j = 0; j < 3; ++j) { const int L = j * G + c; if (L >= 516) break; int pm, pn; swz_tile(L, 129, 4, pm, pn); if (pm == 128) continue;
            if (idx == i) { u.pm = pm; u.pn = pn; u.kind = 0; return true; } ++idx; }
        return false;
    }
    __device__ __forceinline__ const char* aptr(const Unit& u) const { return A + ((size_t)u.pm * 256 * 1024 + (size_t)u.pn * 256) * 2; }
    __device__ __forceinline__ const char* bptr(const Unit& u) const { const int b = u.pm >> 5; return bmode == 0 ? B + ((size_t)b * 256 * 1024 + (size_t)u.pn * 256) * 2 : B + ((size_t)u.pn * 256 * 1024 + (size_t)b * 256) * 2; }
};

#define EPI_ARGS const f32x4 (&acc)[2][2][4][2], const Unit& u, int wr, int wc, int fr, int fq
#define EPI_ZERO_INIT __device__ __forceinline__ void init(f32x4 (&acc)[2][2][4][2], const Unit&, int, int, int, int) const { \
    _Pragma("unroll") for (int a = 0; a < 2; ++a) _Pragma("unroll") for (int b = 0; b < 2; ++b) _Pragma("unroll") for (int m = 0; m < 4; ++m) _Pragma("unroll") for (int n = 0; n < 2; ++n) acc[a][b][m][n] = (f32x4){0.f, 0.f, 0.f, 0.f}; }
struct EpiIn {
    unsigned char* ws; float* out;
    EPI_ZERO_INIT
    __device__ __forceinline__ void operator()(EPI_ARGS) const {
        const int lr0 = wr * 64 + fr, lc0 = wc * 32 + 8 * fq;
        const int pm = u.pm, pn = u.pn;
        const bool smp = (pm == 128);
#ifdef P1_NO_QKV
        if (false) {
#else
        if (pn < 9) {
#endif
            const int sec = pn / 3, cb = (pn - sec * 3) * 256 + lc0;
            bf16_t* dst = (bf16_t*)(ws + (sec == 0 ? WS_QB : (sec == 1 ? WS_KB : WS_VB)));
            const float sc = sec == 0 ? QSCALE : 1.f;
#pragma unroll
            for (int ai = 0; ai < 2; ++ai)
#pragma unroll
                for (int m = 0; m < 4; ++m) {
                    bf16_t* rowp = dst + ((size_t)pm * 256 + lr0 + 128 * ai + 16 * m) * AW + cb;
#pragma unroll
                    for (int bj = 0; bj < 2; ++bj) {
                        const f32x4 v0 = acc[ai][bj][m][0] * sc, v1 = acc[ai][bj][m][1] * sc;
                        u32x4 w; w.x = pkbf(v0[0], v0[1]); w.y = pkbf(v0[2], v0[3]); w.z = pkbf(v1[0], v1[1]); w.w = pkbf(v1[2], v1[3]);
                        __builtin_nontemporal_store(w, (u32x4*)(rowp + bj * 128));
                    }
                }
            if (sec > 0 && (smp || (pm & 31) >= 24)) {
                float* fb; size_t sa, sm;
                if (smp) { fb = out + (sec == 1 ? OFF_SWK : OFF_SWV) + ((size_t)(8 * wr + (fr >> 3)) * WBUF + (WBUF - TS) + (fr & 7)) * AW + cb; sa = (size_t)16 * WBUF * AW; sm = (size_t)2 * WBUF * AW; }
                else { fb = out + (sec == 1 ? OFF_PWK : OFF_PWV) + ((size_t)(pm >> 5) * WBUF + ((pm & 31) - 24) * 256 + lr0) * AW + cb; sa = (size_t)128 * AW; sm = (size_t)16 * AW; }
#pragma unroll
                for (int ai = 0; ai < 2; ++ai)
#pragma unroll
                    for (int m = 0; m < 4; ++m)
#pragma unroll
                        for (int bj = 0; bj < 2; ++bj) { float* fp = fb + ai * sa + m * sm + bj * 128; __builtin_nontemporal_store(acc[ai][bj][m][0], (f32x4*)fp); __builtin_nontemporal_store(acc[ai][bj][m][1], (f32x4*)(fp + 4)); }
            }
#ifdef P1_NO_GLU
        } else if (false) {
#else
        } else {
#endif
            const int c0 = (pn - 9) * 128 + lc0;
            float* U = (float*)(ws + WS_U);
#pragma unroll
            for (int ai = 0; ai < 2; ++ai)
#pragma unroll
                for (int m = 0; m < 4; ++m) {
                    const size_t grow = (size_t)pm * 256 + lr0 + 128 * ai + 16 * m;
#pragma unroll
                    for (int n = 0; n < 2; ++n) {
                        const f32x4 a = acc[ai][0][m][n], gg = acc[ai][1][m][n]; f32x4 uu;
#pragma unroll
                        for (int e = 0; e < 4; ++e) uu[e] = a[e] * fast_rcp(1.f + fast_exp2(-gg[e] * LOG2E));
                        __builtin_nontemporal_store(uu, (f32x4*)(U + grow * CWD + c0 + 4 * n));
                    }
                }
            if (smp) {
                float* fb = out + OFF_SCONV + ((size_t)(8 * wr + (fr >> 3)) * 30 + 22 + (fr & 7)) * CWD + c0;
#pragma unroll
                for (int ai = 0; ai < 2; ++ai)
#pragma unroll
                    for (int m = 0; m < 4; ++m)
#pragma unroll
                        for (int n = 0; n < 2; ++n) {
                            const f32x4 a = acc[ai][0][m][n], gg = acc[ai][1][m][n]; f32x4 uu;
#pragma unroll
                            for (int e = 0; e < 4; ++e) uu[e] = a[e] * fast_rcp(1.f + fast_exp2(-gg[e] * LOG2E));
                            *(f32x4*)(fb + (size_t)(16 * ai + 2 * m) * 30 * CWD + 4 * n) = uu;
                        }
            } else if ((pm & 31) == 31 && wr == 1) {
#pragma unroll
                for (int m = 2; m < 4; ++m) {
                    const int lr = lr0 + 128 + 16 * m;
                    if (lr >= 226) {
                        float* fb = out + OFF_PCONV + ((size_t)(pm >> 5) * 30 + (lr - 226)) * CWD + c0;
#pragma unroll
                        for (int n = 0; n < 2; ++n) {
                            const f32x4 a = acc[1][0][m][n], gg = acc[1][1][m][n]; f32x4 uu;
#pragma unroll
                            for (int e = 0; e < 4; ++e) uu[e] = a[e] * fast_rcp(1.f + fast_exp2(-gg[e] * LOG2E));
                            *(f32x4*)(fb + 4 * n) = uu;
                        }
                    }
                }
            }
        }
    }
};
struct EpiMem {
    unsigned char* ws; float* out;
    EPI_ZERO_INIT
    __device__ __forceinline__ void operator()(EPI_ARGS) const {
        const int lr0 = wr * 64 + fr, lc0 = wc * 32 + 8 * fq;
        if (u.kind == 1) {
            const int sec = (u.pn - 11) >> 2, cb = ((u.pn - 11) & 3) * 256 + lc0;
            float* fo = out + (sec ? OFF_PMV : OFF_PMK); bf16_t* MKB = (bf16_t*)(ws + WS_MKB);
#pragma unroll
            for (int ai = 0; ai < 2; ++ai)
#pragma unroll
                for (int m = 0; m < 4; ++m) {
                    const size_t mr = (size_t)(u.pm - 129) * 256 + lr0 + 128 * ai + 16 * m;
#pragma unroll
                    for (int bj = 0; bj < 2; ++bj) {
                        const f32x4 v0 = acc[ai][bj][m][0], v1 = acc[ai][bj][m][1];
                        float* fp = fo + mr * 1024 + cb + bj * 128; *(f32x4*)fp = v0; *(f32x4*)(fp + 4) = v1;
                        if (sec == 0) { u32x4 w; w.x = pkbf(v0[0], v0[1]); w.y = pkbf(v0[2], v0[3]); w.z = pkbf(v1[0], v1[1]); w.w = pkbf(v1[2], v1[3]); *(u32x4*)(MKB + mr * 1024 + cb + bj * 128) = w; }
                    }
                }
        } else {
            bf16_t* MVT = (bf16_t*)(ws + WS_MVT);
#pragma unroll
            for (int ai = 0; ai < 2; ++ai)
#pragma unroll
                for (int m = 0; m < 4; ++m) {
                    const size_t nr = (size_t)u.pm * 256 + lr0 + 128 * ai + 16 * m;
#pragma unroll
                    for (int bj = 0; bj < 2; ++bj) {
                        const f32x4 v0 = acc[ai][bj][m][0], v1 = acc[ai][bj][m][1];
                        u32x4 w; w.x = pkbf(v0[0], v0[1]); w.y = pkbf(v0[2], v0[3]); w.z = pkbf(v1[0], v1[1]); w.w = pkbf(v1[2], v1[3]);
                        *(u32x4*)(MVT + nr * 1024 + u.pn * 256 + lc0 + bj * 128) = w;
                    }
                }
        }
    }
};
__device__ __forceinline__ void init_from_xn(f32x4 (&acc)[2][2][4][2], const bf16_t* XN, const float* g, const Unit& u, int wr, int wc, int fr, int fq) {
    const int lr0 = wr * 64 + fr, c0 = u.pn * 256 + wc * 32 + 8 * fq;
    f32x4 rg[2][2];
#pragma unroll
    for (int bj = 0; bj < 2; ++bj)
#pragma unroll
        for (int n = 0; n < 2; ++n) { const f32x4 gg = *(const f32x4*)(g + c0 + bj * 128 + 4 * n); rg[bj][n] = (f32x4){fast_rcp(gg[0]), fast_rcp(gg[1]), fast_rcp(gg[2]), fast_rcp(gg[3])}; }
#pragma unroll
    for (int ai = 0; ai < 2; ++ai)
#pragma unroll
        for (int m = 0; m < 4; ++m) {
            const unsigned ro = (unsigned)((u.pm * 256 + lr0 + 128 * ai + 16 * m) * DM + c0) * 2u;
#pragma unroll
            for (int bj = 0; bj < 2; ++bj) { const u32x4 w = *(const u32x4*)((const char*)XN + ro + bj * 256);
                acc[ai][bj][m][0] = (f32x4){bf_lo(w.x), bf_hi(w.x), bf_lo(w.y), bf_hi(w.y)} * rg[bj][0];
                acc[ai][bj][m][1] = (f32x4){bf_lo(w.z), bf_hi(w.z), bf_lo(w.w), bf_hi(w.w)} * rg[bj][1]; }
        }
}
template <bool RESX> struct EpiRes {
    const float* resP; const float* resS; const float* gp; bf16_t* XN; const float* g; float* SSQ;
    __device__ __forceinline__ void init(f32x4 (&acc)[2][2][4][2], const Unit& u, int wr, int wc, int fr, int fq) const {
        if (RESX) {
            const int lr0 = wr * 64 + fr, c0 = u.pn * 256 + wc * 32 + 8 * fq;
            const float* res = (u.pm == 128) ? resS - (size_t)MP * DM : resP;
#pragma unroll
            for (int ai = 0; ai < 2; ++ai)
#pragma unroll
                for (int m = 0; m < 4; ++m) {
                    const float* rp = res + ((size_t)u.pm * 256 + lr0 + 128 * ai + 16 * m) * DM + c0;
#pragma unroll
                    for (int bj = 0; bj < 2; ++bj) { acc[ai][bj][m][0] = *(const f32x4*)(rp + bj * 128); acc[ai][bj][m][1] = *(const f32x4*)(rp + bj * 128 + 4); }
                }
        } else init_from_xn(acc, XN, gp, u, wr, wc, fr, fq);
    }
    __device__ __forceinline__ void operator()(EPI_ARGS) const {
        const int lr0 = wr * 64 + fr, c0 = u.pn * 256 + wc * 32 + 8 * fq;
        f32x4 gv[2][2];
#pragma unroll
        for (int bj = 0; bj < 2; ++bj)
#pragma unroll
            for (int n = 0; n < 2; ++n) gv[bj][n] = *(const f32x4*)(g + c0 + bj * 128 + 4 * n);
#pragma unroll
        for (int ai = 0; ai < 2; ++ai)
#pragma unroll
            for (int m = 0; m < 4; ++m) {
                const size_t grow = (size_t)u.pm * 256 + lr0 + 128 * ai + 16 * m; const size_t off = grow * DM + c0;
                float ss = 0.f;
#pragma unroll
                for (int bj = 0; bj < 2; ++bj) {
                    f32x4 x0 = acc[ai][bj][m][0], x1 = acc[ai][bj][m][1];
                    ss += (x0[0] * x0[0] + x0[1] * x0[1]) + (x0[2] * x0[2] + x0[3] * x0[3]) + (x1[0] * x1[0] + x1[1] * x1[1]) + (x1[2] * x1[2] + x1[3] * x1[3]);
                    x0 = x0 * gv[bj][0]; x1 = x1 * gv[bj][1];
                    u32x4 w; w.x = pkbf(x0[0], x0[1]); w.y = pkbf(x0[2], x0[3]); w.z = pkbf(x1[0], x1[1]); w.w = pkbf(x1[2], x1[3]);
                    *(u32x4*)(XN + off + bj * 128) = w;
                }
                ss += __shfl_xor(ss, 16); ss += __shfl_xor(ss, 32);
                if (fq == 0) SSQ[grow * 16 + u.pn * 4 + wc] = ss;
            }
    }
};
struct EpiFinal {
    const bf16_t* XN; const float* gp; float* Y; const float* g; float* slots; unsigned* cnt; LAS float* xl; int wave;
    __device__ __forceinline__ void init(f32x4 (&acc)[2][2][4][2], const Unit& u, int wr, int wc, int fr, int fq) const { init_from_xn(acc, XN, gp, u, wr, wc, fr, fq); }
    __device__ __forceinline__ void operator()(EPI_ARGS) const {
        const int lr0 = wr * 64 + fr, c0 = u.pn * 256 + wc * 32 + 8 * fq;
        const int lane = fr + 16 * fq;
#pragma unroll
        for (int ai = 0; ai < 2; ++ai)
#pragma unroll
            for (int m = 0; m < 4; ++m) {
                float ss = 0.f;
#pragma unroll
                for (int bj = 0; bj < 2; ++bj)
#pragma unroll
                    for (int n = 0; n < 2; ++n) { const f32x4 x = acc[ai][bj][m][n]; ss += (x[0] * x[0] + x[1] * x[1]) + (x[2] * x[2] + x[3] * x[3]); }
                ss += __shfl_xor(ss, 16); ss += __shfl_xor(ss, 32);
                if (fq == 0) xl[(lr0 + 128 * ai + 16 * m) * 4 + wc] = ss;
            }
        asm volatile("s_waitcnt lgkmcnt(0)" ::: "memory"); __builtin_amdgcn_s_barrier(); asm volatile("" ::: "memory");
        const int row = wave * 32 + (lane & 31);
        if (lane < 32) { const f32x4 q4 = *(const LAS f32x4*)(xl + row * 4);
            __hip_atomic_store(slots + ((size_t)u.pm * 256 + row) * 4 + u.pn, (q4[0] + q4[1]) + (q4[2] + q4[3]), __ATOMIC_RELAXED, __HIP_MEMORY_SCOPE_AGENT); }
        asm volatile("s_waitcnt vmcnt(0)" ::: "memory");
        if (lane == 0) __hip_atomic_fetch_add(cnt + 64 * u.pm, 1u, __ATOMIC_RELAXED, __HIP_MEMORY_SCOPE_AGENT);
        if (wave == 0) {
            unsigned sp = 0;
            while ((unsigned)__builtin_amdgcn_readfirstlane(__hip_atomic_load(cnt + 64 * u.pm, __ATOMIC_RELAXED, __HIP_MEMORY_SCOPE_AGENT)) < 32u) { __builtin_amdgcn_s_sleep(2); if (++sp > (1u << 21)) break; }
            __builtin_amdgcn_fence(__ATOMIC_ACQUIRE, "agent");
        }
        asm volatile("s_waitcnt vmcnt(0) lgkmcnt(0)" ::: "memory"); __builtin_amdgcn_s_barrier(); asm volatile("" ::: "memory");
        if (lane < 32) { const float* sl = slots + ((size_t)u.pm * 256 + row) * 4; float t = 0.f;
#pragma unroll
            for (int k = 0; k < 4; ++k) t += __hip_atomic_load(sl + k, __ATOMIC_RELAXED, __HIP_MEMORY_SCOPE_AGENT);
            xl[1024 + row] = 1.0f / sqrtf(t * (1.0f / DM) + EPS); }
        asm volatile("s_waitcnt vmcnt(0) lgkmcnt(0)" ::: "memory"); __builtin_amdgcn_s_barrier(); asm volatile("" ::: "memory");
#pragma unroll
        for (int ai = 0; ai < 2; ++ai)
#pragma unroll
            for (int m = 0; m < 4; ++m) {
                const int lr = lr0 + 128 * ai + 16 * m; const float rs = xl[1024 + lr]; float* yp = Y + ((size_t)u.pm * 256 + lr) * DM + c0;
#pragma unroll
                for (int bj = 0; bj < 2; ++bj) { const f32x4 g0 = *(const f32x4*)(g + c0 + bj * 128), g1 = *(const f32x4*)(g + c0 + bj * 128 + 4);
                    *(f32x4*)(yp + bj * 128) = acc[ai][bj][m][0] * rs * g0; *(f32x4*)(yp + bj * 128 + 4) = acc[ai][bj][m][1] * rs * g1; }
                asm volatile("" ::: "memory");
            }
        asm volatile("s_waitcnt lgkmcnt(0)" ::: "memory"); __builtin_amdgcn_s_barrier(); asm volatile("" ::: "memory");
    }
};
__device__ __forceinline__ float row_rstd(const float* SSQ, size_t grow) {
    const f32x4* p = (const f32x4*)(SSQ + grow * 16); const f32x4 a = p[0], b = p[1], c = p[2], d = p[3];
    const float s = ((a[0] + a[1]) + (a[2] + a[3])) + ((b[0] + b[1]) + (b[2] + b[3])) + ((c[0] + c[1]) + (c[2] + c[3])) + ((d[0] + d[1]) + (d[2] + d[3]));
    return 1.0f / sqrtf(s * (1.0f / DM) + EPS);
}
__device__ __forceinline__ void rows_rstd8(const float* SSQ, size_t row0, int fq, float (&rs)[2][4]) {
    f32x4 pre[2][4];
#pragma unroll
    for (int ai = 0; ai < 2; ++ai)
#pragma unroll
        for (int m = 0; m < 4; ++m) pre[ai][m] = *(const f32x4*)(SSQ + (row0 + 128 * ai + 16 * m) * 16 + fq * 4);
    __builtin_amdgcn_sched_barrier(0);
#pragma unroll
    for (int ai = 0; ai < 2; ++ai)
#pragma unroll
        for (int m = 0; m < 4; ++m) { float sq = (pre[ai][m][0] + pre[ai][m][1]) + (pre[ai][m][2] + pre[ai][m][3]); sq += __shfl_xor(sq, 16); sq += __shfl_xor(sq, 32);
            rs[ai][m] = 1.0f / sqrtf(sq * (1.0f / DM) + EPS); }
}
struct EpiScale {
    bf16_t* O; const float* SSQ; float sc;
    EPI_ZERO_INIT
    __device__ __forceinline__ void operator()(EPI_ARGS) const {
        const int lr0 = wr * 64 + fr, c0 = u.pn * 256 + wc * 32 + 8 * fq;
        float rsv[2][4]; rows_rstd8(SSQ, (size_t)u.pm * 256 + lr0, fq, rsv);
#pragma unroll
        for (int ai = 0; ai < 2; ++ai)
#pragma unroll
            for (int m = 0; m < 4; ++m) {
                const size_t grow = (size_t)u.pm * 256 + lr0 + 128 * ai + 16 * m; const float rs = rsv[ai][m] * sc;
#pragma unroll
                for (int bj = 0; bj < 2; ++bj) {
                    const f32x4 v0 = acc[ai][bj][m][0] * rs, v1 = acc[ai][bj][m][1] * rs;
                    u32x4 w; w.x = pkbf(v0[0], v0[1]); w.y = pkbf(v0[2], v0[3]); w.z = pkbf(v1[0], v1[1]); w.w = pkbf(v1[2], v1[3]);
                    *(u32x4*)(O + grow * DM + c0 + bj * 128) = w;
                }
            }
    }
};
struct EpiSwiGLU {
    bf16_t* H; const float* SSQ;
    EPI_ZERO_INIT
    __device__ __forceinline__ void operator()(EPI_ARGS) const {
        const int lr0 = wr * 64 + fr, c0 = u.pn * 128 + wc * 32 + 8 * fq;
        float rsv[2][4]; rows_rstd8(SSQ, (size_t)u.pm * 256 + lr0, fq, rsv);
#pragma unroll
        for (int ai = 0; ai < 2; ++ai)
#pragma unroll
            for (int m = 0; m < 4; ++m) {
                const size_t grow = (size_t)u.pm * 256 + lr0 + 128 * ai + 16 * m; const float rs = rsv[ai][m];
                float hv[8];
#pragma unroll
                for (int n = 0; n < 2; ++n)
#pragma unroll
                    for (int e = 0; e < 4; ++e) { const float gt = acc[ai][0][m][n][e] * rs, up = acc[ai][1][m][n][e] * rs; hv[4 * n + e] = gt * fast_rcp(1.f + fast_exp2(-gt * LOG2E)) * up; }
                u32x4 w; w.x = pkbf(hv[0], hv[1]); w.y = pkbf(hv[2], hv[3]); w.z = pkbf(hv[4], hv[5]); w.w = pkbf(hv[6], hv[7]);
                *(u32x4*)(H + grow * DFF + c0) = w;
            }
    }
};
struct EpiSoftmax {
    bf16_t* P; float* LSUM; LAS float* xch;
    EPI_ZERO_INIT
    __device__ __forceinline__ void operator()(EPI_ARGS) const {
        const int lr0 = wr * 64 + fr, c0 = u.pn * 256 + wc * 32 + 8 * fq;
#pragma unroll
        for (int ai = 0; ai < 2; ++ai)
#pragma unroll
            for (int m = 0; m < 4; ++m) {
                float v = -3.0e38f;
#pragma unroll
                for (int bj = 0; bj < 2; ++bj)
#pragma unroll
                    for (int n = 0; n < 2; ++n) { const f32x4 x = acc[ai][bj][m][n]; v = fmaxf(v, fmaxf(fmaxf(x[0], x[1]), fmaxf(x[2], x[3]))); }
                v = fmaxf(v, __shfl_xor(v, 16)); v = fmaxf(v, __shfl_xor(v, 32));
                if (fq == 0) xch[(lr0 + 128 * ai + 16 * m) * 4 + wc] = v;
            }
        asm volatile("s_waitcnt lgkmcnt(0)" ::: "memory"); __builtin_amdgcn_s_barrier(); asm volatile("" ::: "memory");
#pragma unroll
        for (int ai = 0; ai < 2; ++ai)
#pragma unroll
            for (int m = 0; m < 4; ++m) {
                const f32x4 q4 = *(const LAS f32x4*)(xch + (lr0 + 128 * ai + 16 * m) * 4); const float mx = fmaxf(fmaxf(q4[0], q4[1]), fmaxf(q4[2], q4[3]));
                const size_t grow = (size_t)u.pm * 256 + lr0 + 128 * ai + 16 * m; float ss = 0.f;
#pragma unroll
                for (int bj = 0; bj < 2; ++bj) {
                    f32x4 p0, p1;
#pragma unroll
                    for (int e = 0; e < 4; ++e) { p0[e] = fast_exp2(acc[ai][bj][m][0][e] - mx); p1[e] = fast_exp2(acc[ai][bj][m][1][e] - mx); }
                    ss += ((p0[0] + p0[1]) + (p0[2] + p0[3])) + ((p1[0] + p1[1]) + (p1[2] + p1[3]));
                    u32x4 w; w.x = pkbf(p0[0], p0[1]); w.y = pkbf(p0[2], p0[3]); w.z = pkbf(p1[0], p1[1]); w.w = pkbf(p1[2], p1[3]);
                    *(u32x4*)(P + grow * DM + c0 + bj * 128) = w;
                }
                ss += __shfl_xor(ss, 16); ss += __shfl_xor(ss, 32);
                if (fq == 0) LSUM[grow * 16 + u.pn * 4 + wc] = ss;
                asm volatile("" ::: "memory"); __builtin_amdgcn_sched_barrier(0);
            }
    }
};
struct EpiPV {
    bf16_t* O; const float* LSUM;
    EPI_ZERO_INIT
    __device__ __forceinline__ void operator()(EPI_ARGS) const {
        const int lr0 = wr * 64 + fr, c0 = u.pn * 256 + wc * 32 + 8 * fq;
        f32x4 pre[2][4];
#pragma unroll
        for (int ai = 0; ai < 2; ++ai)
#pragma unroll
            for (int m = 0; m < 4; ++m) pre[ai][m] = *(const f32x4*)(LSUM + ((size_t)u.pm * 256 + lr0 + 128 * ai + 16 * m) * 16 + u.pn * 4);
        __builtin_amdgcn_sched_barrier(0);
#pragma unroll
        for (int ai = 0; ai < 2; ++ai)
#pragma unroll
            for (int m = 0; m < 4; ++m) {
                const size_t grow = (size_t)u.pm * 256 + lr0 + 128 * ai + 16 * m;
                const f32x4 l4 = pre[ai][m]; const float rs = 1.0f / ((l4[0] + l4[1]) + (l4[2] + l4[3]));
#pragma unroll
                for (int bj = 0; bj < 2; ++bj) {
                    const f32x4 v0 = acc[ai][bj][m][0] * rs, v1 = acc[ai][bj][m][1] * rs;
                    u32x4 w; w.x = pkbf(v0[0], v0[1]); w.y = pkbf(v0[2], v0[3]); w.z = pkbf(v1[0], v1[1]); w.w = pkbf(v1[2], v1[3]);
                    *(u32x4*)(O + grow * DM + c0 + bj * 128) = w;
                }
            }
    }
};
}

#define XB_TMO      128
#define XB_XCNT(j)  (256  + 64 * (j))
#define XB_XSUB(j)  (1280 + 64 * (j))
#define XB_XGEN(j)  (2304 + 64 * (j))
#define XB_TOP      3328
#define XB_TOPGEN   3392
#define XCD_BAR_WORDS 3456
#define XB_SPIN_CAP (1u << 18)
__device__ __forceinline__ unsigned xb_ld(unsigned* p)              { return __hip_atomic_load(p, __ATOMIC_RELAXED, __HIP_MEMORY_SCOPE_AGENT); }
__device__ __forceinline__ unsigned xb_add(unsigned* p, unsigned v) { return __hip_atomic_fetch_add(p, v, __ATOMIC_RELAXED, __HIP_MEMORY_SCOPE_AGENT); }
__device__ __forceinline__ unsigned xb_xcc_id() { return (unsigned)__builtin_amdgcn_s_getreg((3 << 11) | 20) & 0xFu; }
#define XB_SPIN(cond, bar) do { unsigned _sp = 0; while (cond) { __builtin_amdgcn_s_sleep(1); \
    if ((++_sp & 255u) == 0u) { if (xb_ld(&(bar)[XB_TMO])) break; if (_sp > XB_SPIN_CAP) { atomicAdd(&(bar)[XB_TMO], 1u); break; } } } } while (0)
struct XcdBarrier { unsigned* bar; unsigned x; volatile LAS unsigned* st; };
__device__ __forceinline__ XcdBarrier xcd_barrier_post(unsigned* bar, volatile LAS unsigned* st) {
    XcdBarrier b; b.bar = bar; b.x = xb_xcc_id(); b.st = st;
    if (threadIdx.x == 0) st[3] = xb_add(&bar[XB_XCNT(b.x)], 1u);
    return b;
}
__device__ __forceinline__ void xcd_barrier_complete(unsigned* bar, unsigned x, unsigned& nloc, unsigned& nx, unsigned& xi) {
    const unsigned G = gridDim.x * gridDim.y * gridDim.z;
    unsigned sum, cnt, mine, sp = 0u;
    for (;;) {
        sum = 0u; cnt = 0u; mine = 0u; xi = 0u;
#pragma unroll
        for (unsigned j = 0; j < 16; ++j) { const unsigned c = xb_ld(&bar[XB_XCNT(j)]); sum += c; cnt += (c > 0u) ? 1u : 0u; mine = (j == x) ? c : mine; xi += (c > 0u && j < x) ? 1u : 0u; }
        if (sum == G) break;
        __builtin_amdgcn_s_sleep(1);
        if ((++sp & 255u) == 0u) { if (xb_ld(&bar[XB_TMO])) break; if (sp > XB_SPIN_CAP) { atomicAdd(&bar[XB_TMO], 1u); break; } }
    }
    nloc = mine > 0u ? mine : 1u; nx = cnt > 0u ? cnt : 1u;
}
__device__ __forceinline__ void xcd_barrier(const XcdBarrier& b) {
    asm volatile("s_waitcnt vmcnt(0)" ::: "memory");
    __syncthreads();
    if (threadIdx.x == 0) {
        unsigned* bar = b.bar;
        __builtin_amdgcn_s_waitcnt(0);
        unsigned nloc = b.st[0], nx = b.st[1];
        if (nloc == 0u) { unsigned xi; xcd_barrier_complete(bar, b.x, nloc, nx, xi); b.st[0] = nloc; b.st[1] = nx; b.st[2] = xi; }
        const unsigned old = xb_add(&bar[XB_XSUB(b.x)], 1u);
        const unsigned gen = old / nloc;
        if (old + 1u == (gen + 1u) * nloc) {
            __builtin_amdgcn_fence(__ATOMIC_RELEASE, "agent");
            asm volatile("s_waitcnt vmcnt(0)" ::: "memory");
            const unsigned og = xb_add(&bar[XB_TOP], 1u);
            const unsigned tg = og / nx;
            if (og + 1u == (tg + 1u) * nx) xb_add(&bar[XB_TOPGEN], 1u);
            else XB_SPIN(xb_ld(&bar[XB_TOPGEN]) == tg, bar);
            __builtin_amdgcn_fence(__ATOMIC_ACQUIRE, "agent");
            xb_add(&bar[XB_XGEN(b.x)], 1u);
            asm volatile("s_waitcnt vmcnt(0)" ::: "memory");
        } else {
            XB_SPIN(xb_ld(&bar[XB_XGEN(b.x)]) == gen, bar);
            __builtin_amdgcn_fence(__ATOMIC_ACQUIRE, "agent");
            asm volatile("s_waitcnt vmcnt(0)" ::: "memory");
        }
    }
    __syncthreads();
}

#define XL_SUB(j) (3584 + 64 * (j))
#define XL_GEN(j) (12416 + 64 * (j))
__device__ __forceinline__ void xl_barrier(const XcdBarrier& b) {
    asm volatile("s_waitcnt vmcnt(0)" ::: "memory");
    __syncthreads();
    if (threadIdx.x == 0) {
        unsigned* bar = b.bar; const unsigned nloc = b.st[0], xd = b.st[2] & 7u;
        const unsigned old = xb_add(&bar[XL_SUB(xd)], 1u), gen = old / nloc;
        if (old + 1u == (gen + 1u) * nloc) xb_add(&bar[XL_GEN(xd)], 1u);
        else XB_SPIN(xb_ld(&bar[XL_GEN(xd)]) == gen, bar);
        __builtin_amdgcn_fence(__ATOMIC_ACQUIRE, "agent");
        asm volatile("s_waitcnt vmcnt(0)" ::: "memory");
    }
    __syncthreads();
}

constexpr int RING_BYTES = 131072;
constexpr int XCH_OFF = RING_BYTES;
constexpr int MISC_OFF = RING_BYTES + 6144;
constexpr int LDS_BYTES = RING_BYTES + 8192;
constexpr int ATT_V_OFF = 0, ATT_WBUF = 12800, ATT_TAB_OFF = 8 * ATT_WBUF, ATT_CW_OFF = 65536;

struct Params {
    const float* in[27]; float* out; unsigned char* ws; int ph_lo, ph_hi, coop, pad;
};

__device__ __forceinline__ float wave_sum(float v) {
#pragma unroll
    for (int o = 1; o < 64; o <<= 1) v += __shfl_xor(v, o);
    return v;
}
__device__ __forceinline__ void transpose_item(const float* W, int K, int N, bf16_t* WT, int item, int mode, LAS float* scr, int lane) {
    const int nblk = N / 32, kb = item / nblk, nb = item % nblk, k0 = 64 * kb, n0 = 32 * nb;
    int r0 = n0;
    if (mode == 1) { if (n0 >= 2304) { const int isg = n0 >= 2560, cch = n0 - (isg ? 2560 : 2304); r0 = 2304 + (cch >> 7) * 256 + isg * 128 + (cch & 127); } }
    else if (mode == 2) r0 = (n0 >> 7) * 256 + (n0 & 127);
    else if (mode == 3) r0 = (n0 >> 7) * 256 + 128 + (n0 & 127);
    float wv[32];
#pragma unroll
    for (int i = 0; i < 32; ++i) wv[i] = W[(size_t)(k0 + 2 * i + (lane >> 5)) * N + n0 + (lane & 31)];
#pragma unroll
    for (int i = 0; i < 32; ++i) scr[(2 * i + (lane >> 5)) * 33 + (lane & 31)] = wv[i];
    asm volatile("s_waitcnt lgkmcnt(0)" ::: "memory");
    const int c = lane & 7;
#pragma unroll
    for (int j = 0; j < 4; ++j) { const int n = (lane >> 3) + 8 * j; const LAS float* s = scr + (8 * c) * 33 + n;
        u32x4 o; o.x = pkbf(s[0 * 33], s[1 * 33]); o.y = pkbf(s[2 * 33], s[3 * 33]); o.z = pkbf(s[4 * 33], s[5 * 33]); o.w = pkbf(s[6 * 33], s[7 * 33]);
        *(u32x4*)(WT + (size_t)(r0 + n) * K + k0 + 8 * c) = o; }
    asm volatile("s_waitcnt lgkmcnt(0)" ::: "memory");
}
template <int NR> __device__ __forceinline__ void rms_rows_bf16(const float* const (&xrow)[NR], const float* g, bf16_t* const (&orow)[NR], int lane) {
    f32x4 v[NR][4];
#pragma unroll
    for (int r = 0; r < NR; ++r)
#pragma unroll
        for (int j = 0; j < 4; ++j) v[r][j] = ((const f32x4*)xrow[r] + lane)[64 * j];
    const f32x4* gr = (const f32x4*)g + lane;
    f32x4 gg[4];
#pragma unroll
    for (int j = 0; j < 4; ++j) gg[j] = gr[64 * j];
#pragma unroll
    for (int r = 0; r < NR; ++r) {
        float s = 0.f;
#pragma unroll
        for (int j = 0; j < 4; ++j) s += (v[r][j][0] * v[r][j][0] + v[r][j][1] * v[r][j][1]) + (v[r][j][2] * v[r][j][2] + v[r][j][3] * v[r][j][3]);
        const float rstd = 1.0f / sqrtf(wave_sum(s) * (1.0f / DM) + EPS);
        u32x2* o8 = (u32x2*)orow[r] + lane;
#pragma unroll
        for (int j = 0; j < 4; ++j) { u32x2 w; w.x = pkbf(v[r][j][0] * rstd * gg[j][0], v[r][j][1] * rstd * gg[j][1]); w.y = pkbf(v[r][j][2] * rstd * gg[j][2], v[r][j][3] * rstd * gg[j][3]); o8[64 * j] = w; }
    }
}

namespace att {
__device__ __forceinline__ int crow(int r, int hi) { return (r & 3) + 8 * (r >> 2) + 4 * hi; }
struct Ctx {
    const bf16_t *QB, *KB, *VB; const float *CK, *CV;
    bf16_t* OP; float* LSE; bf16_t* ATT;
};
__device__ __forceinline__ bf16x8 ld8_bf16(const bf16_t* p) { return *(const bf16x8*)p; }
__device__ __forceinline__ bf16x8 ld8_f32(const float* p) {
    const f32x4 a = *(const f32x4*)p, b = *(const f32x4*)(p + 4); u32x4 w; w.x = pkbf(a[0], a[1]); w.y = pkbf(a[2], a[3]); w.z = pkbf(b[0], b[1]); w.w = pkbf(b[2], b[3]);
    return __builtin_bit_cast(bf16x8, w);
}
template <int MODE> __device__ __forceinline__ bf16x8 ld_kv(const bf16_t* B16, const float* C32, int bq, int h, int dil, int r, int idx, int doff, bool newrows) {
    if (MODE == 0) { const int ii = idx < 0 ? 0 : idx; return ld8_bf16(B16 + ((size_t)bq * SEQ + r + (size_t)dil * ii) * AW + h * HD + doff); }
    int p = r + dil * idx;
    if (!newrows) return ld8_f32(C32 + (((size_t)bq * WBUF + p) * NH + h) * HD + doff);
    p = p > (WBUF + TS - 1) ? (WBUF + TS - 1) : p;
    return ld8_bf16(B16 + ((size_t)MP + bq * TS + (p - WBUF)) * AW + h * HD + doff);
}
template <int MODE> __device__ __forceinline__ void ld_kv4(bf16x8 (&dst)[4], const bf16_t* B16, const float* C32, int bq, int h, int dil, int r, int idx0, int doff, bool newrows) {
    if (MODE == 1 && !newrows) {
        f32x4 raw[4][2];
#pragma unroll
        for (int i = 0; i < 4; ++i) { const float* p = C32 + (((size_t)bq * WBUF + (r + dil * (idx0 + 8 * i))) * NH + h) * HD + doff; raw[i][0] = *(const f32x4*)p; raw[i][1] = *(const f32x4*)(p + 4); }
        __builtin_amdgcn_sched_barrier(0);
#pragma unroll
        for (int i = 0; i < 4; ++i) { u32x4 w; w.x = pkbf(raw[i][0][0], raw[i][0][1]); w.y = pkbf(raw[i][0][2], raw[i][0][3]); w.z = pkbf(raw[i][1][0], raw[i][1][1]); w.w = pkbf(raw[i][1][2], raw[i][1][3]);
            dst[i] = __builtin_bit_cast(bf16x8, w); }
    } else {
#pragma unroll
        for (int i = 0; i < 4; ++i) dst[i] = ld_kv<MODE>(B16, C32, bq, h, dil, r, idx0 + 8 * i, doff, newrows);
    }
}
template <int MODE> __device__ __forceinline__ void wave_block(const Ctx& c, int bq, int h, int g, int dil, int r, int i0, int nq, const LAS float* tab, LAS unsigned char* wbuf) {
    const int lane = fresh_lane(), r32 = lane & 31, hi = lane >> 5;
    const int vkey = lane >> 3, vch = lane & 7;
    const bool qvalid = r32 < nq; const int qq = qvalid ? r32 : 0;
    size_t qtok;
    if (MODE == 0) qtok = (size_t)bq * SEQ + r + (size_t)dil * (i0 + qq);
    else qtok = (size_t)MP + bq * TS + (r + dil * (i0 + qq) - WBUF);
    LAS unsigned char* kb = wbuf; LAS unsigned char* vbuf = wbuf + 4608;
    bf16x8 qv[4];
#pragma unroll
    for (int i = 0; i < 4; ++i) { int qi = 8 * i + vkey; qi = qi < nq ? qi : 0;
        const size_t tk = (MODE == 0) ? (size_t)bq * SEQ + r + (size_t)dil * (i0 + qi) : (size_t)MP + bq * TS + (r + dil * (i0 + qi) - WBUF);
        qv[i] = ld8_bf16(c.QB + tk * AW + h * HD + vch * 8); }
    bf16x8 kr[5][4];
    constexpr int KA = (MODE == 0) ? 5 : 2;
#pragma unroll
    for (int s = 0; s < KA; ++s)
        ld_kv4<MODE>(kr[s], c.KB, c.CK, bq, h, dil, r, i0 - 128 + 32 * s + vkey, vch * 8, s == 4);
#pragma unroll
    for (int i = 0; i < 4; ++i) *(LAS bf16x8*)(kb + (8 * i + vkey) * 144 + vch * 16) = qv[i];
    bf16x8 qr[4];
#pragma unroll
    for (int d0 = 0; d0 < 4; ++d0) qr[d0] = *(const LAS bf16x8*)(kb + r32 * 144 + d0 * 32 + hi * 16);
    f32x16 S[5];
#pragma unroll
    for (int s = 0; s < 5; ++s) {
        if (MODE != 0 && s + KA < 5) {
            ld_kv4<MODE>(kr[s + KA], c.KB, c.CK, bq, h, dil, r, i0 - 128 + 32 * (s + KA) + vkey, vch * 8, s + KA == 4);
        }
#pragma unroll
        for (int i = 0; i < 4; ++i) *(LAS bf16x8*)(kb + (8 * i + vkey) * 144 + vch * 16) = kr[s][i];
        bf16x8 kf[4];
#pragma unroll
        for (int d0 = 0; d0 < 4; ++d0) kf[d0] = *(const LAS bf16x8*)(kb + r32 * 144 + d0 * 32 + hi * 16);
        f32x16 a = {};
#pragma unroll
        for (int d0 = 0; d0 < 4; ++d0) a = __builtin_amdgcn_mfma_f32_32x32x16_bf16(kf[d0], qr[d0], a, 0, 0, 0);
        S[s] = a;
        __builtin_amdgcn_sched_barrier(0);
    }
    bf16x8 vr[5][4];
#pragma unroll
    for (int s = 0; s < KA; ++s)
        ld_kv4<MODE>(vr[s], c.VB, c.CV, bq, h, dil, r, i0 - 128 + 32 * s + vkey, vch * 8, s == 4);
    __builtin_amdgcn_sched_barrier(0);
    const LAS float* tb = tab + 159 + r32 - 4 * hi;
#pragma unroll
    for (int s = 0; s < 5; ++s)
#pragma unroll
        for (int rr = 0; rr < 16; ++rr) S[s][rr] += tb[-(32 * s + (rr & 3) + 8 * (rr >> 2))];
    if (MODE == 0 && i0 < 128) {
#pragma unroll
        for (int s = 0; s < 5; ++s)
#pragma unroll
            for (int rr = 0; rr < 16; ++rr) if (i0 - 128 + 32 * s + crow(rr, hi) < 0) S[s][rr] = -1e30f;
    }
    float mx = -3.0e38f;
#pragma unroll
    for (int s = 0; s < 5; ++s)
#pragma unroll
        for (int rr = 0; rr < 16; ++rr) mx = fmaxf(mx, S[s][rr]);
    mx = fmaxf(mx, __shfl_xor(mx, 32));
    float l = 0.f;
#pragma unroll
    for (int s = 0; s < 5; ++s)
#pragma unroll
        for (int rr = 0; rr < 16; ++rr) { const float p = fast_exp2(S[s][rr] - mx); S[s][rr] = p; l += p; }
    l += __shfl_xor(l, 32);
    f32x16 o[2]; o[0] = (f32x16){}; o[1] = (f32x16){};
    const int vrd = (4 * hi + ((lane & 15) >> 2)) * 64 + ((lane >> 4) & 1) * 32 + (lane & 3) * 8;
    __builtin_amdgcn_sched_barrier(0);
#pragma unroll
    for (int s = 0; s < 5; ++s) {
        LAS unsigned char* vb = vbuf + (s & 1) * 4096;
#pragma unroll
        for (int i = 0; i < 4; ++i) *(LAS bf16x8*)(vb + (vch >> 2) * 2048 + (8 * i + vkey) * 64 + (vch & 3) * 16) = vr[s][i];
        if (MODE != 0 && s + KA < 5) {
            ld_kv4<MODE>(vr[s + KA], c.VB, c.CV, bq, h, dil, r, i0 - 128 + 32 * (s + KA) + vkey, vch * 8, s + KA == 4);
        }
#pragma unroll
        for (int sp = 0; sp < 2; ++sp) {
            u32x4 pw; pw.x = pkbf(S[s][8 * sp + 0], S[s][8 * sp + 1]); pw.y = pkbf(S[s][8 * sp + 2], S[s][8 * sp + 3]); pw.z = pkbf(S[s][8 * sp + 4], S[s][8 * sp + 5]); pw.w = pkbf(S[s][8 * sp + 6], S[s][8 * sp + 7]);
            const bf16x8 pf = __builtin_bit_cast(bf16x8, pw);
#pragma unroll
            for (int dt = 0; dt < 2; ++dt) {
                const s16x4 lo = __builtin_bit_cast(s16x4, __builtin_amdgcn_ds_read_tr16_b64_v4i16((LAS s16x4*)(vb + vrd + dt * 2048 + sp * 1024)));
                const s16x4 hh = __builtin_bit_cast(s16x4, __builtin_amdgcn_ds_read_tr16_b64_v4i16((LAS s16x4*)(vb + vrd + dt * 2048 + sp * 1024 + 512)));
                const bf16x8 vf = (bf16x8){lo[0], lo[1], lo[2], lo[3], hh[0], hh[1], hh[2], hh[3]};
                o[dt] = __builtin_amdgcn_mfma_f32_32x32x16_bf16(vf, pf, o[dt], 0, 0, 0);
            }
        }
        __builtin_amdgcn_sched_barrier(0);
    }
    {
        const float inv = 1.0f / l;
#pragma unroll
        for (int dt = 0; dt < 2; ++dt)
#pragma unroll
            for (int rg = 0; rg < 4; ++rg) { u32x2 w; w.x = pkbf(o[dt][4 * rg] * inv, o[dt][4 * rg + 1] * inv); w.y = pkbf(o[dt][4 * rg + 2] * inv, o[dt][4 * rg + 3] * inv);
                *(LAS u32x2*)(kb + r32 * 144 + (32 * dt + 8 * rg + 4 * hi) * 2) = w; }
        if (qvalid && hi == 0) c.LSE[(size_t)g * LSE_STRIDE + qtok * NH + h] = mx + __log2f(l);
#pragma unroll
        for (int i = 0; i < 4; ++i) { const int qi = 8 * i + vkey;
            if (qi < nq) {
                const size_t tk = (MODE == 0) ? (size_t)bq * SEQ + r + (size_t)dil * (i0 + qi) : (size_t)MP + bq * TS + (r + dil * (i0 + qi) - WBUF);
                *(u32x4*)(c.OP + (size_t)g * OP_STRIDE + tk * AW + h * HD + vch * 8) = *(const LAS u32x4*)(kb + qi * 144 + vch * 16);
            } }
    }
}
struct PDesc { int b, h, g, dil, r, i0; };
__device__ __forceinline__ unsigned ptok(const PDesc& d, int idx) { return (unsigned)(d.b * SEQ + d.r + d.dil * idx); }
__device__ __forceinline__ bf16x8 ld8_off(const bf16_t* base, unsigned byte_off) { return *(const bf16x8*)((const char*)base + byte_off); }
__device__ __forceinline__ void p_load_q(const Ctx& c, const PDesc& d, bf16x8 (&qv)[4], int vkey, int vch) {
    const unsigned o0 = (ptok(d, d.i0 + vkey) * AW + d.h * HD + vch * 8) * 2u, st = (unsigned)(8 * d.dil * AW * 2);
#pragma unroll
    for (int i = 0; i < 4; ++i) qv[i] = ld8_off(c.QB, o0 + i * st);
}
__device__ __forceinline__ void p_load_kv(const bf16_t* B, const PDesc& d, int s, bf16x8 (&x)[4], int vkey, int vch) {
    const unsigned cb = (unsigned)((d.b * SEQ + d.r) * AW + d.h * HD + vch * 8) * 2u, st = (unsigned)(d.dil * AW * 2);
#pragma unroll
    for (int i = 0; i < 4; ++i) { int idx = d.i0 - 128 + 32 * s + 8 * i + vkey; idx = idx < 0 ? 0 : idx; x[i] = ld8_off(B, cb + (unsigned)idx * st); }
}
__device__ __forceinline__ void pblock(const Ctx& c, const PDesc& cur, const PDesc& nxt, bool has_next, bf16x8 (&qv)[4], bf16x8 (&kr)[5][4], const LAS float* tabs, LAS unsigned char* wbuf) {
    const int lane = fresh_lane(), r32 = lane & 31, hi = lane >> 5, vkey = lane >> 3, vch = lane & 7;
    LAS unsigned char* vbuf = wbuf;
    LAS unsigned char* kb = wbuf + 8192;
    const int kwr = vkey * 128 + ((vch ^ (vkey & 7)) << 4);
    const int krd0 = r32 * 128, kx = r32 & 7;
    const int i0 = cur.i0;
#pragma unroll
    for (int i = 0; i < 4; ++i) *(LAS bf16x8*)(kb + (8 * i + vkey) * 144 + vch * 16) = qv[i];
    bf16x8 qr[4];
#pragma unroll
    for (int d0 = 0; d0 < 4; ++d0) qr[d0] = *(const LAS bf16x8*)(kb + r32 * 144 + d0 * 32 + hi * 16);
    f32x16 S[5];
    bf16x8 vr[5][4];
    p_load_kv(c.KB, cur, 2, kr[2], vkey, vch); p_load_kv(c.KB, cur, 3, kr[3], vkey, vch); p_load_kv(c.KB, cur, 4, kr[4], vkey, vch);
#pragma unroll
    for (int s = 0; s < 5; ++s) {
        LAS unsigned char* kp = vbuf + (s & 1) * 4096;
#pragma unroll
        for (int i = 0; i < 4; ++i) *(LAS bf16x8*)(kp + i * 1024 + kwr) = kr[s][i];
        if (s < 3) p_load_kv(c.VB, cur, s, vr[s], vkey, vch);
        bf16x8 kf[4];
#pragma unroll
        for (int d0 = 0; d0 < 4; ++d0) kf[d0] = *(const LAS bf16x8*)(kp + krd0 + (((2 * d0 + hi) ^ kx) << 4));
        f32x16 a = {};
#pragma unroll
        for (int d0 = 0; d0 < 4; ++d0) a = __builtin_amdgcn_mfma_f32_32x32x16_bf16(kf[d0], qr[d0], a, 0, 0, 0);
        S[s] = a;
    }
    __builtin_amdgcn_sched_barrier(0);
    const LAS float* tb = tabs + (cur.g * 12 + cur.h) * 192 + 159 + r32 - 4 * hi;
#pragma unroll
    for (int s = 0; s < 5; ++s)
#pragma unroll
        for (int rr = 0; rr < 16; ++rr) S[s][rr] += tb[-(32 * s + (rr & 3) + 8 * (rr >> 2))];
    if (i0 < 128) {
#pragma unroll
        for (int s = 0; s < 5; ++s)
#pragma unroll
            for (int rr = 0; rr < 16; ++rr) if (i0 - 128 + 32 * s + crow(rr, hi) < 0) S[s][rr] = -1e30f;
    }
    float mx = -3.0e38f;
#pragma unroll
    for (int s = 0; s < 5; ++s)
#pragma unroll
        for (int rr = 0; rr < 16; ++rr) mx = fmaxf(mx, S[s][rr]);
    mx = fmaxf(mx, __shfl_xor(mx, 32));
    float l = 0.f;
    bf16x8 pf[5][2];
#pragma unroll
    for (int s = 0; s < 5; ++s) {
#pragma unroll
        for (int rr = 0; rr < 16; ++rr) { const float p = fast_exp2(S[s][rr] - mx); S[s][rr] = p; l += p; }
#pragma unroll
        for (int sp = 0; sp < 2; ++sp) { u32x4 pw; pw.x = pkbf(S[s][8 * sp + 0], S[s][8 * sp + 1]); pw.y = pkbf(S[s][8 * sp + 2], S[s][8 * sp + 3]); pw.z = pkbf(S[s][8 * sp + 4], S[s][8 * sp + 5]); pw.w = pkbf(S[s][8 * sp + 6], S[s][8 * sp + 7]);
            pf[s][sp] = __builtin_bit_cast(bf16x8, pw); asm volatile("" : "+v"(pf[s][sp])); }
    }
    l += __shfl_xor(l, 32);
    __builtin_amdgcn_sched_barrier(0);
    p_load_kv(c.VB, cur, 3, vr[3], vkey, vch); p_load_kv(c.VB, cur, 4, vr[4], vkey, vch);
    f32x16 o[2]; o[0] = (f32x16){}; o[1] = (f32x16){};
    const int vrd = (4 * hi + ((lane & 15) >> 2)) * 64 + ((lane >> 4) & 1) * 32 + (lane & 3) * 8;
    __builtin_amdgcn_sched_barrier(0);
#pragma unroll
    for (int s = 0; s < 5; ++s) {
        LAS unsigned char* vb = vbuf + (s & 1) * 4096;
#pragma unroll
        for (int i = 0; i < 4; ++i) *(LAS bf16x8*)(vb + (vch >> 2) * 2048 + (8 * i + vkey) * 64 + (vch & 3) * 16) = vr[s][i];
        if (has_next && s < 2) p_load_kv(c.KB, nxt, s, kr[s], vkey, vch);
        if (has_next && s == 2) p_load_q(c, nxt, qv, vkey, vch);
#pragma unroll
        for (int sp = 0; sp < 2; ++sp)
#pragma unroll
            for (int dt = 0; dt < 2; ++dt) {
                const s16x4 lo = __builtin_bit_cast(s16x4, __builtin_amdgcn_ds_read_tr16_b64_v4i16((LAS s16x4*)(vb + vrd + dt * 2048 + sp * 1024)));
                const s16x4 hh = __builtin_bit_cast(s16x4, __builtin_amdgcn_ds_read_tr16_b64_v4i16((LAS s16x4*)(vb + vrd + dt * 2048 + sp * 1024 + 512)));
                const bf16x8 vf = (bf16x8){lo[0], lo[1], lo[2], lo[3], hh[0], hh[1], hh[2], hh[3]};
                o[dt] = __builtin_amdgcn_mfma_f32_32x32x16_bf16(vf, pf[s][sp], o[dt], 0, 0, 0);
            }
    }
    __builtin_amdgcn_sched_barrier(0);
    {
        const float inv = 1.0f / l;
#pragma unroll
        for (int dt = 0; dt < 2; ++dt)
#pragma unroll
            for (int rg = 0; rg < 4; ++rg) { u32x2 w; w.x = pkbf(o[dt][4 * rg] * inv, o[dt][4 * rg + 1] * inv); w.y = pkbf(o[dt][4 * rg + 2] * inv, o[dt][4 * rg + 3] * inv);
                *(LAS u32x2*)(kb + r32 * 144 + (32 * dt + 8 * rg + 4 * hi) * 2) = w; }
        if (hi == 0) c.LSE[(size_t)cur.g * LSE_STRIDE + (size_t)ptok(cur, i0 + r32) * NH + cur.h] = mx + __log2f(l);
#pragma unroll
        for (int i = 0; i < 4; ++i) { const int qi = 8 * i + vkey;
            *(u32x4*)(c.OP + (size_t)cur.g * OP_STRIDE + (size_t)ptok(cur, i0 + qi) * AW + cur.h * HD + vch * 8) = *(const LAS u32x4*)(kb + qi * 144 + vch * 16); }
    }
}
struct TDesc { int b, h, g, dil, r, j0; };
constexpr int TK_OFF = 0, TV_OFF = 49152, TB_OFF = 98304, TT_OFF = TB_OFF + 8 * 4608;
__device__ __forceinline__ void glds16(const void* sbase, unsigned voff, unsigned lds_dst) { unsigned keep;
    asm volatile("s_mov_b32 %0, m0\n\ts_mov_b32 m0, %3\n\ts_nop 4\n\tglobal_load_lds_dwordx4 %1, %2\n\ts_mov_b32 m0, %0" : "=&s"(keep) : "v"(voff), "s"(sbase), "s"(lds_dst) : "memory"); }
__device__ __forceinline__ void glds4(const void* sbase, unsigned voff, unsigned lds_dst) { unsigned keep;
    asm volatile("s_mov_b32 %0, m0\n\ts_mov_b32 m0, %3\n\ts_nop 4\n\tglobal_load_lds_dword %1, %2\n\ts_mov_b32 m0, %0" : "=&s"(keep) : "v"(voff), "s"(sbase), "s"(lds_dst) : "memory"); }
__device__ __forceinline__ void t_issue_tab(const float* tabg, const TDesc& d, LAS unsigned char* lds, int wave, int lane) {
    if (wave < 3) glds4(tabg, (unsigned)(((d.g * 12 + d.h) * 192 + wave * 64 + lane) * 4), (unsigned)__builtin_amdgcn_readfirstlane((int)((unsigned)(uintptr_t)lds + TT_OFF + wave * 256)));
}
__device__ __forceinline__ void t_issue_k(const Ctx& c, const TDesc& d, LAS unsigned char* lds, int wave, int lane) {
    const int rr = lane >> 3, ch = (lane & 7) ^ ((4 * (wave & 1) + (rr >> 1)) & 7);
    const unsigned cb = (unsigned)((d.b * SEQ + d.r) * AW + d.h * HD + ch * 8) * 2u, st = (unsigned)(d.dil * AW * 2);
    const unsigned l0 = (unsigned)(uintptr_t)lds + TK_OFF;
#pragma unroll
    for (int i = 0; i < 6; ++i) { const int e = wave + 8 * i; int idx = d.j0 - 128 + 8 * e + rr; idx = idx < 0 ? 0 : idx;
        glds16(c.KB, cb + (unsigned)idx * st, (unsigned)__builtin_amdgcn_readfirstlane((int)(l0 + e * 1024))); }
}
__device__ __forceinline__ void t_issue_v(const Ctx& c, const TDesc& d, LAS unsigned char* lds, int wave, int lane) {
    const int kq = lane >> 2, q4 = lane & 3;
    const unsigned cb = (unsigned)((d.b * SEQ + d.r) * AW + d.h * HD + q4 * 8) * 2u, st = (unsigned)(d.dil * AW * 2);
    const unsigned l0 = (unsigned)(uintptr_t)lds + TV_OFF;
#pragma unroll
    for (int i = 0; i < 6; ++i) { const int e = 6 * wave + i, hf = e / 24, e24 = e - hf * 24; int idx = d.j0 - 128 + 16 * e24 + kq; idx = idx < 0 ? 0 : idx;
        glds16(c.VB, cb + (unsigned)idx * st + (unsigned)hf * 64u, (unsigned)__builtin_amdgcn_readfirstlane((int)(l0 + e * 1024))); }
}
__device__ __forceinline__ void t_issue_q(const Ctx& c, const TDesc& d, LAS unsigned char* lds, int wave, int lane) {
    const int rr = lane >> 3, i0 = d.j0 + 32 * wave;
    const unsigned qo0 = ((unsigned)(d.b * SEQ + d.r + d.dil * (i0 + rr)) * AW + d.h * HD) * 2u, qst = (unsigned)(8 * d.dil * AW * 2);
    const unsigned l0 = (unsigned)(uintptr_t)lds + TB_OFF + wave * 4608;
#pragma unroll
    for (int i = 0; i < 4; ++i) { const int ch = (lane & 7) ^ ((4 * (i & 1) + (rr >> 1)) & 7);
        glds16(c.QB, qo0 + i * qst + ch * 16, (unsigned)__builtin_amdgcn_readfirstlane((int)(l0 + i * 1024))); }
}
struct TOut { f32x16 o[2]; float l, mx; };
__device__ __forceinline__ void* sgpr_ptr(const void* p) { const unsigned long long u = (unsigned long long)(uintptr_t)p;
    const unsigned lo = (unsigned)__builtin_amdgcn_readfirstlane((int)(unsigned)u), hi = (unsigned)__builtin_amdgcn_readfirstlane((int)(unsigned)(u >> 32));
    return (void*)(uintptr_t)(((unsigned long long)hi << 32) | lo); }
__device__ __forceinline__ void gst16(void* sbase, unsigned voff, u32x4 v) { asm volatile("s_nop 4\n\tglobal_store_dwordx4 %0, %1, %2\n\ts_nop 1" :: "v"(voff), "v"(v), "s"(sbase) : "memory"); }
__device__ __forceinline__ void gst4(void* sbase, unsigned voff, float v) { asm volatile("s_nop 4\n\tglobal_store_dword %0, %1, %2\n\ts_nop 1" :: "v"(voff), "v"(v), "s"(sbase) : "memory"); }
__device__ __forceinline__ void t_out1(const TOut& po, LAS unsigned char* kb, int r32, int hi) {
    const float inv = 1.0f / po.l;
#pragma unroll
    for (int dt = 0; dt < 2; ++dt)
#pragma unroll
        for (int rg = 0; rg < 4; ++rg) { u32x2 w; w.x = pkbf(po.o[dt][4 * rg] * inv, po.o[dt][4 * rg + 1] * inv); w.y = pkbf(po.o[dt][4 * rg + 2] * inv, po.o[dt][4 * rg + 3] * inv);
            *(LAS u32x2*)(kb + r32 * 144 + (32 * dt + 8 * rg + 4 * hi) * 2) = w; }
}
__device__ __forceinline__ void t_out2(const Ctx& c, const TDesc& d, const TOut& po, const LAS unsigned char* kb, int wave, int r32, int hi, int vkey, int vch, u32x4 (&ow)[4]) {
    const int i0 = d.j0 + 32 * wave;
#pragma unroll
    for (int i = 0; i < 4; ++i) ow[i] = *(const LAS u32x4*)(kb + (8 * i + vkey) * 144 + vch * 16);
    const unsigned tq = (unsigned)(d.b * SEQ + d.r + d.dil * (i0 + r32));
    if (hi == 0) gst4(sgpr_ptr(c.LSE + (size_t)d.g * LSE_STRIDE + d.h), tq * (unsigned)(NH * 4), po.mx + __log2f(po.l));
}
__device__ __forceinline__ void t_out3(const Ctx& c, const TDesc& d, int wave, int vkey, int vch, const u32x4 (&ow)[4]) {
    const int i0 = d.j0 + 32 * wave; void* ob = sgpr_ptr(c.OP + (size_t)d.g * OP_STRIDE + d.h * HD);
#pragma unroll
    for (int i = 0; i < 4; ++i) { const int qi = 8 * i + vkey; const unsigned tk = (unsigned)(d.b * SEQ + d.r + d.dil * (i0 + qi));
        gst16(ob, tk * (unsigned)(AW * 2) + (unsigned)(vch * 16), ow[i]); }
}
__device__ __forceinline__ void t_unit(const Ctx& c, const TDesc& prv, const TDesc& cur, const TDesc& nxt, bool has_next, const float* tabg, LAS unsigned char* lds, int wave, TOut& po) {
    const int lane = fresh_lane(), r32 = lane & 31, hi = lane >> 5, vkey = lane >> 3, vch = lane & 7;
    LAS unsigned char* qb = lds + TB_OFF + wave * 4608;
    const LAS float* tt = (const LAS float*)(lds + TT_OFF);
    const int i0 = cur.j0 + 32 * wave;
    asm volatile("s_waitcnt vmcnt(6) lgkmcnt(0)\n\ts_barrier" ::: "memory");
    const int kx = (r32 >> 1) & 7;
    bf16x8 qr[4];
#pragma unroll
    for (int d0 = 0; d0 < 4; ++d0) qr[d0] = *(const LAS bf16x8*)(qb + r32 * 128 + (((2 * d0 + hi) ^ kx) << 4));
    asm volatile("" ::: "memory");
    t_out1(po, qb, r32, hi);
    f32x16 S[5];
    const LAS float* tb = tt + 159 + r32 - 4 * hi;
    const LAS unsigned char* kt = lds + TK_OFF + (32 * wave + r32) * 128;
    float mx;
    {   bf16x8 kf[4];
#pragma unroll
        for (int d0 = 0; d0 < 4; ++d0) kf[d0] = *(const LAS bf16x8*)(kt + 4 * 4096 + (((2 * d0 + hi) ^ kx) << 4));
        f32x16 a = {};
#pragma unroll
        for (int d0 = 0; d0 < 4; ++d0) a = __builtin_amdgcn_mfma_f32_32x32x16_bf16(kf[d0], qr[d0], a, 0, 0, 0);
#pragma unroll
        for (int rr = 0; rr < 16; ++rr) a[rr] += tb[-(128 + (rr & 3) + 8 * (rr >> 2))];
        float m1 = fmaxf(fmaxf(a[0], a[1]), a[2]);
#pragma unroll
        for (int rr = 3; rr < 15; rr += 2) m1 = fmaxf(fmaxf(m1, a[rr]), a[rr + 1]);
        m1 = fmaxf(m1, a[15]);
        mx = fmaxf(m1, __shfl_xor(m1, 32));
        S[4] = a; }
    u32x4 ow[4];
    asm volatile("" ::: "memory");
    t_out2(c, prv, po, qb, wave, r32, hi, vkey, vch, ow);
#pragma unroll
    for (int s = 0; s < 4; s += 2) {
        bf16x8 kfa[4], kfb[4];
#pragma unroll
        for (int d0 = 0; d0 < 4; ++d0) { kfa[d0] = *(const LAS bf16x8*)(kt + s * 4096 + (((2 * d0 + hi) ^ kx) << 4)); kfb[d0] = *(const LAS bf16x8*)(kt + (s + 1) * 4096 + (((2 * d0 + hi) ^ kx) << 4)); }
        f32x16 a, b;
#pragma unroll
        for (int rr = 0; rr < 16; ++rr) { a[rr] = tb[-(32 * s + (rr & 3) + 8 * (rr >> 2))] - mx; b[rr] = tb[-(32 * (s + 1) + (rr & 3) + 8 * (rr >> 2))] - mx; }
#pragma unroll
        for (int d0 = 0; d0 < 4; ++d0) { a = __builtin_amdgcn_mfma_f32_32x32x16_bf16(kfa[d0], qr[d0], a, 0, 0, 0); b = __builtin_amdgcn_mfma_f32_32x32x16_bf16(kfb[d0], qr[d0], b, 0, 0, 0); }
        S[s] = a; S[s + 1] = b;
        if (s == 0) { asm volatile("" ::: "memory"); t_out3(c, prv, wave, vkey, vch, ow); }
    }
    asm volatile("s_waitcnt vmcnt(5) lgkmcnt(0)\n\ts_barrier" ::: "memory");
    if (has_next) { t_issue_tab(tabg, nxt, lds, wave, lane); t_issue_k(c, nxt, lds, wave, lane); t_issue_q(c, nxt, lds, wave, lane); }
    if (i0 < 128) {
#pragma unroll
        for (int s = 0; s < 5; ++s)
#pragma unroll
            for (int rr = 0; rr < 16; ++rr) if (i0 - 128 + 32 * s + crow(rr, hi) < 0) S[s][rr] = -1e30f;
    }
    bf16x8 pf[5][2];
#pragma unroll
    for (int s = 0; s < 5; ++s) {
#pragma unroll
        for (int rr = 0; rr < 16; ++rr) S[s][rr] = fast_exp2(s == 4 ? S[s][rr] - mx : S[s][rr]);
#pragma unroll
        for (int sp = 0; sp < 2; ++sp) { u32x4 pw; pw.x = pkbf(S[s][8 * sp + 0], S[s][8 * sp + 1]); pw.y = pkbf(S[s][8 * sp + 2], S[s][8 * sp + 3]); pw.z = pkbf(S[s][8 * sp + 4], S[s][8 * sp + 5]); pw.w = pkbf(S[s][8 * sp + 6], S[s][8 * sp + 7]);
            pf[s][sp] = __builtin_bit_cast(bf16x8, pw); asm volatile("" : "+v"(pf[s][sp])); }
    }
    f32x16 o[2]; o[0] = (f32x16){}; o[1] = (f32x16){};
    f32x16 ol = {};
    const bf16x8 ones = __builtin_bit_cast(bf16x8, (u32x4){0x3F803F80u, 0x3F803F80u, 0x3F803F80u, 0x3F803F80u});
    const LAS unsigned char* vt = lds + TV_OFF + (32 * wave + 4 * hi + ((lane & 15) >> 2)) * 64 + ((lane >> 4) & 1) * 32 + (lane & 3) * 8;
#pragma unroll
    for (int s = 0; s < 5; ++s)
#pragma unroll
        for (int sp = 0; sp < 2; ++sp)
#pragma unroll
            for (int dt = 0; dt < 2; ++dt) {
                const s16x4 lo = __builtin_bit_cast(s16x4, __builtin_amdgcn_ds_read_tr16_b64_v4i16((LAS s16x4*)(vt + dt * 24576 + s * 2048 + sp * 1024)));
                const s16x4 hh = __builtin_bit_cast(s16x4, __builtin_amdgcn_ds_read_tr16_b64_v4i16((LAS s16x4*)(vt + dt * 24576 + s * 2048 + sp * 1024 + 512)));
                const bf16x8 vf = (bf16x8){lo[0], lo[1], lo[2], lo[3], hh[0], hh[1], hh[2], hh[3]};
                o[dt] = __builtin_amdgcn_mfma_f32_32x32x16_bf16(vf, pf[s][sp], o[dt], 0, 0, 0);
                if (dt == 1) ol = __builtin_amdgcn_mfma_f32_32x32x16_bf16(ones, pf[s][sp], ol, 0, 0, 0);
            }
    const float l = ol[0];
    asm volatile("s_waitcnt lgkmcnt(0)\n\ts_barrier" ::: "memory");
    if (has_next) t_issue_v(c, nxt, lds, wave, lane);
    po.o[0] = o[0]; po.o[1] = o[1]; po.l = l; po.mx = mx;
}
__device__ __forceinline__ void t_flush(const Ctx& c, const TDesc& d, const TOut& po, LAS unsigned char* lds, int wave) {
    const int lane = fresh_lane(), r32 = lane & 31, hi = lane >> 5, vkey = lane >> 3, vch = lane & 7;
    LAS unsigned char* qb = lds + TB_OFF + wave * 4608;
    u32x4 ow[4];
    t_out1(po, qb, r32, hi); t_out2(c, d, po, qb, wave, r32, hi, vkey, vch, ow); t_out3(c, d, wave, vkey, vch, ow);
}
template <int NQ> __device__ __forceinline__ void sample_vblock(const Ctx& c, int n, int h, int g, int dil, int r, int i0, const LAS float* tab, LAS float* sbuf) {
    const int lane = fresh_lane(), sub = lane & 15, rgp = lane >> 4;
    constexpr int NT = (NQ + 3) / 4, NSA = 32 + NT;
    f32x4 q4[NQ];
#pragma unroll
    for (int qq = 0; qq < NQ; ++qq) { const size_t row = (size_t)MP + n * TS + (r + dil * (i0 + qq) - WBUF);
        const u32x2 w = *(const u32x2*)(c.QB + row * AW + h * HD + 4 * sub); q4[qq] = (f32x4){bf_lo(w.x), bf_hi(w.x), bf_lo(w.y), bf_hi(w.y)}; }
    const unsigned cbase = (unsigned)((((n * WBUF) + r + dil * (i0 - 128 + rgp)) * NH + h) * HD + 4 * sub) * 4u, cstep = (unsigned)(4 * dil * NH * HD * 4);
    auto new_row = [&](const bf16_t* B16, int tt) -> f32x4 { const int tc = tt < NQ ? tt : NQ - 1;
        const u32x2 w = *(const u32x2*)(B16 + ((size_t)MP + n * TS + (r + dil * (i0 + tc) - WBUF)) * AW + h * HD + 4 * sub);
        return (f32x4){bf_lo(w.x), bf_hi(w.x), bf_lo(w.y), bf_hi(w.y)}; };
    auto score = [&](const f32x4 kv, int kk) {
#pragma unroll
        for (int qq = 0; qq < NQ; ++qq) {
            float d = (kv[0] * q4[qq][0] + kv[1] * q4[qq][1]) + (kv[2] * q4[qq][2] + kv[3] * q4[qq][3]);
            d += __shfl_xor(d, 1); d += __shfl_xor(d, 2); d += __shfl_xor(d, 4); d += __shfl_xor(d, 8);
            if (sub == 0) sbuf[qq * 136 + kk] = (kk < 128 + NQ) ? d + tab[159 + qq - kk] : -1e30f;
        } };
    {   f32x4 nk[NT];
#pragma unroll
        for (int i = 0; i < NT; ++i) nk[i] = new_row(c.KB, 4 * i + rgp);
        {   f32x4 kv[32];
#pragma unroll
            for (int i = 0; i < 32; ++i) kv[i] = *(const f32x4*)((const char*)c.CK + cbase + (unsigned)i * cstep);
#pragma unroll
            for (int i = 0; i < 32; ++i) score(kv[i], 4 * i + rgp);
        }
#pragma unroll
        for (int i = 0; i < NT; ++i) score(nk[i], 128 + 4 * i + rgp);
    }
    asm volatile("s_waitcnt lgkmcnt(0)" ::: "memory");
    float lq[NQ], lse[NQ];
#pragma unroll
    for (int qq = 0; qq < NQ; ++qq) {
        float v[3]; float mx = -3.0e38f;
#pragma unroll
        for (int j = 0; j < 3; ++j) { const int kk = lane + 64 * j; v[j] = (kk < 4 * NSA) ? sbuf[qq * 136 + kk] : -1e30f; mx = fmaxf(mx, v[j]); }
#pragma unroll
        for (int o = 1; o < 64; o <<= 1) mx = fmaxf(mx, __shfl_xor(mx, o));
        float sm = 0.f;
#pragma unroll
        for (int j = 0; j < 3; ++j) { const int kk = lane + 64 * j; const float pv = fast_exp2(v[j] - mx); sm += pv; if (kk < 4 * NSA) sbuf[qq * 136 + kk] = pv; }
        sm = wave_sum(sm); lq[qq] = sm; lse[qq] = mx + __log2f(sm);
    }
    asm volatile("s_waitcnt lgkmcnt(0)" ::: "memory");
    f32x4 oa[NQ];
#pragma unroll
    for (int qq = 0; qq < NQ; ++qq) oa[qq] = (f32x4){0.f, 0.f, 0.f, 0.f};
    {   f32x4 nv[NT];
#pragma unroll
        for (int i = 0; i < NT; ++i) nv[i] = new_row(c.VB, 4 * i + rgp);
        {   f32x4 vv[32];
#pragma unroll
            for (int i = 0; i < 32; ++i) vv[i] = *(const f32x4*)((const char*)c.CV + cbase + (unsigned)i * cstep);
#pragma unroll
            for (int i = 0; i < 32; ++i) { const int kk = 4 * i + rgp;
#pragma unroll
                for (int qq = 0; qq < NQ; ++qq) { const float pv = sbuf[qq * 136 + kk]; oa[qq] += vv[i] * pv; } }
        }
#pragma unroll
        for (int i = 0; i < NT; ++i) { const int kk = 128 + 4 * i + rgp;
#pragma unroll
            for (int qq = 0; qq < NQ; ++qq) { const float pv = sbuf[qq * 136 + kk]; oa[qq] += nv[i] * pv; } }
    }
#pragma unroll
    for (int qq = 0; qq < NQ; ++qq) {
#pragma unroll
        for (int e = 0; e < 4; ++e) { float x = oa[qq][e]; x += __shfl_xor(x, 16); x += __shfl_xor(x, 32); oa[qq][e] = x; }
        const size_t tok = (size_t)MP + n * TS + (r + dil * (i0 + qq) - WBUF);
        if (rgp == 0) { const float inv = 1.0f / lq[qq]; u32x2 w; w.x = pkbf(oa[qq][0] * inv, oa[qq][1] * inv); w.y = pkbf(oa[qq][2] * inv, oa[qq][3] * inv);
            *(u32x2*)(c.OP + (size_t)g * OP_STRIDE + tok * AW + h * HD + 4 * sub) = w;
            if (sub == 0) c.LSE[(size_t)g * LSE_STRIDE + tok * NH + h] = lse[qq]; }
    }
    asm volatile("s_waitcnt lgkmcnt(0)" ::: "memory");
}
template <int NP> __device__ __forceinline__ void merge_pieces(const Ctx& c, size_t tok0, size_t tstride, int h, int piece) {
    float ls[NP][3]; u32x4 ov[NP][3];
#pragma unroll
    for (int q = 0; q < NP; ++q)
#pragma unroll
        for (int g = 0; g < 3; ++g) { const size_t tok = tok0 + q * tstride; ls[q][g] = c.LSE[(size_t)g * LSE_STRIDE + tok * NH + h]; ov[q][g] = *(const u32x4*)(c.OP + (size_t)g * OP_STRIDE + tok * AW + h * HD + piece * 8); }
#pragma unroll
    for (int q = 0; q < NP; ++q) {
        const float M = fmaxf(fmaxf(ls[q][0], ls[q][1]), ls[q][2]);
        float w0 = fast_exp2(ls[q][0] - M), w1 = fast_exp2(ls[q][1] - M), w2 = fast_exp2(ls[q][2] - M); const float inv = 1.0f / (w0 + w1 + w2); w0 *= inv; w1 *= inv; w2 *= inv;
        u32x4 o;
#pragma unroll
        for (int e = 0; e < 4; ++e) {
            const float lo = w0 * bf_lo(ov[q][0][e]) + w1 * bf_lo(ov[q][1][e]) + w2 * bf_lo(ov[q][2][e]);
            const float hi_ = w0 * bf_hi(ov[q][0][e]) + w1 * bf_hi(ov[q][1][e]) + w2 * bf_hi(ov[q][2][e]);
            o[e] = pkbf(lo, hi_);
        }
        *(u32x4*)(c.ATT + (tok0 + q * tstride) * DM + h * HD + piece * 8) = o;
    }
}
__device__ __forceinline__ void copy_slot(const float* ck, const float* cv, float* out, int sl, int lane) {
    const int sq = sl / 576, j0 = (sl - sq * 576) * 680, which = sq >> 5, n = sq & 31;
    const f32x4* src = (const f32x4*)((which ? cv : ck) + (size_t)n * WBUF * AW + (size_t)TS * AW) + j0 + lane;
    f32x4* dst = (f32x4*)(out + (which ? OFF_SWV : OFF_SWK) + (size_t)n * WBUF * AW) + j0 + lane;
    f32x4 v[11];
#pragma unroll
    for (int i = 0; i < 10; ++i) v[i] = __builtin_nontemporal_load(src + 64 * i);
    if (lane < 40) v[10] = __builtin_nontemporal_load(src + 640);
#pragma unroll
    for (int i = 0; i < 10; ++i) __builtin_nontemporal_store(v[i], dst + 64 * i);
    if (lane < 40) __builtin_nontemporal_store(v[10], dst + 640);
}
__device__ __forceinline__ void copy_range(const float* ck, const float* cv, float* out, unsigned first, unsigned count, int widx, int nw, int tid) {
    constexpr unsigned PER = (unsigned)(WBUF - TS) * AW / 4;
    const unsigned end = first + count;
    for (unsigned i0 = first + (unsigned)widx * 4096u + tid; i0 < end; i0 += (unsigned)nw * 4096u) {
        f32x4 v[8];
#pragma unroll
        for (int k = 0; k < 8; ++k) { const unsigned i = i0 + 512u * k; if (i < end) { const unsigned sq = i / PER, j = i - sq * PER, which = sq >> 5, n = sq & 31;
            v[k] = __builtin_nontemporal_load((const f32x4*)((which ? cv : ck) + (size_t)n * WBUF * AW + (size_t)TS * AW) + j); } }
#pragma unroll
        for (int k = 0; k < 8; ++k) { const unsigned i = i0 + 512u * k; if (i < end) { const unsigned sq = i / PER, j = i - sq * PER, which = sq >> 5, n = sq & 31;
            __builtin_nontemporal_store(v[k], (f32x4*)(out + (which ? OFF_SWV : OFF_SWK) + (size_t)n * WBUF * AW) + j); } }
    }
}
}

template <int NTW, bool SAMPLE> __device__ __forceinline__ void conv_unit(const float* U, const float* cache_conv, int seq, int t0, LAS float* tile, const LAS float* cw,
                                                                          const float* cb, const float* lg, const float* lb, bf16_t* ATT, int tid, int lane, int wave) {
    constexpr int NROW = 8 * NTW + 30;
    const size_t rowbase = SAMPLE ? (size_t)MP + (size_t)seq * TS : (size_t)seq * SEQ;
    for (int idx = tid; idx < NROW * 64; idx += 512) {
        const int rr = idx >> 6, c4 = idx & 63, tau = rr - 30; f32x4 v = (f32x4){0.f, 0.f, 0.f, 0.f};
        if (SAMPLE) { v = tau < 0 ? *(const f32x4*)(cache_conv + ((size_t)seq * 30 + (30 + tau)) * CWD + 4 * c4) : *(const f32x4*)(U + (rowbase + tau) * CWD + 4 * c4); }
        else if (t0 + tau >= 0) v = *(const f32x4*)(U + (rowbase + t0 + tau) * CWD + 4 * c4);
        *(LAS f32x4*)(tile + rr * CWD + 4 * c4) = v;
    }
    __syncthreads();
    f32x4 acc[NTW], uw[NTW];
    const LAS float* tw = tile + (NTW * wave) * CWD + 4 * lane;
#pragma unroll
    for (int i = 0; i < NTW; ++i) { acc[i] = (f32x4){0.f, 0.f, 0.f, 0.f}; uw[i] = *(const LAS f32x4*)(tw + i * CWD); }
#pragma unroll 1
    for (int j = 0; j < 31; ++j) {
        const f32x4 w = *(const LAS f32x4*)(cw + j * CWD + 4 * lane);
        const f32x4 nx = *(const LAS f32x4*)(tw + (NTW + j) * CWD);
#pragma unroll
        for (int i = 0; i < NTW; ++i) acc[i] += w * uw[i];
#pragma unroll
        for (int i = 0; i + 1 < NTW; ++i) uw[i] = uw[i + 1];
        uw[NTW - 1] = nx;
    }
    const f32x4 bv = *(const f32x4*)(cb + 4 * lane), gv = *(const f32x4*)(lg + 4 * lane), lv = *(const f32x4*)(lb + 4 * lane);
#pragma unroll
    for (int i = 0; i < NTW; ++i) {
        f32x4 y = acc[i] + bv;
        const float mean = wave_sum((y[0] + y[1]) + (y[2] + y[3])) * (1.0f / CWD);
        y = y - mean;
        const float var = wave_sum((y[0] * y[0] + y[1] * y[1]) + (y[2] * y[2] + y[3] * y[3])) * (1.0f / CWD);
        const float rstd = 1.0f / sqrtf(var + EPS);
        f32x4 z = y * rstd * gv + lv;
#pragma unroll
        for (int e = 0; e < 4; ++e) z[e] = z[e] * fast_rcp(1.f + fast_exp2(-z[e] * LOG2E));
        u32x2 w; w.x = pkbf(z[0], z[1]); w.y = pkbf(z[2], z[3]);
        *(u32x2*)(ATT + (rowbase + t0 + NTW * wave + i) * DM + AW + 4 * lane) = w;
    }
    __syncthreads();
}

__global__ void __launch_bounds__(512, 2) fwd_kernel(Params p) {
    extern __shared__ __attribute__((aligned(16))) unsigned char lds_raw[];
    LAS unsigned char* lds = (LAS unsigned char*)lds_raw;
    const int G = gridDim.x, bid = blockIdx.x;
    const int wave = __builtin_amdgcn_readfirstlane(threadIdx.x >> 6);
#define PHASE_IDS const int lane = fresh_lane(), tid = wave * 64 + lane; (void)tid
    unsigned char* ws = p.ws; float* out = p.out;
    bf16_t* WALL = (bf16_t*)(ws + WS_WALL); bf16_t* WOUT = (bf16_t*)(ws + WS_WOUT); bf16_t* WXQ = (bf16_t*)(ws + WS_WXQ); bf16_t* WXO = (bf16_t*)(ws + WS_WXO);
    bf16_t* WGU = (bf16_t*)(ws + WS_WGU); bf16_t* WDN = (bf16_t*)(ws + WS_WDN); bf16_t* XN = (bf16_t*)(ws + WS_XN);
    bf16_t* QB = (bf16_t*)(ws + WS_QB); bf16_t* KB = (bf16_t*)(ws + WS_KB); bf16_t* VB = (bf16_t*)(ws + WS_VB); float* U = (float*)(ws + WS_U);
    bf16_t* OP = (bf16_t*)(ws + WS_OP); float* LSE = (float*)(ws + WS_LSE); bf16_t* ATT = (bf16_t*)(ws + WS_ATT); float* X1 = (float*)(ws + WS_X1);
    float* SSQ = (float*)(ws + WS_SSQ); bf16_t* MKB = (bf16_t*)(ws + WS_MKB); bf16_t* MVT = (bf16_t*)(ws + WS_MVT); float* LSUM = (float*)(ws + WS_LSUM);
    bf16_t* XQ = (bf16_t*)(ws + WS_XQ); bf16_t* PB = (bf16_t*)(ws + WS_PB); bf16_t* XO = (bf16_t*)(ws + WS_XO); bf16_t* HB = (bf16_t*)(ws + WS_H);
    const int lo = p.ph_lo, hi = p.ph_hi;
    if (threadIdx.x < 4) ((volatile LAS unsigned*)(lds + MISC_OFF))[threadIdx.x] = 0u;
    __syncthreads();
    XcdBarrier xbar; xbar.bar = (unsigned*)(ws + WS_CTL); xbar.x = 0; xbar.st = nullptr;
    if (p.coop) xbar = xcd_barrier_post((unsigned*)(ws + WS_CTL), (volatile LAS unsigned*)(lds + MISC_OFF));
#ifndef PH_MASK
#define PH_MASK 0x7ff
#endif
#define IN(k) (((PH_MASK >> (k)) & 1) && lo <= (k) && (k) < hi)
#ifndef PROBE_DUP
#define PROBE_DUP 0
#endif
#define REP(k) for (int rep_ = 0; rep_ <= ((PROBE_DUP >> (k)) & 1); ++rep_)
#define REPSYNC if (rep_) xcd_barrier(xbar)
#define SEAM(k) do { if (IN(k) && IN((k) + 1)) { if (p.coop == 2) cg::this_grid().sync(); else xcd_barrier(xbar); } } while (0)

    if (IN(0)) REP(0) {
        REPSYNC;
        PHASE_IDS;
        LAS float* scr = (LAS float*)(lds + wave * 16384);
        const int gw = bid * 8 + wave, NGW = G * 8;
        constexpr int I_IN = 16 * 88, I_SQ = 16 * 32, I_FF = 16 * 88, I_DN = 44 * 32;
        constexpr int NITEMS = I_IN + 5 * I_SQ + 2 * I_FF + I_DN;
        for (int it = gw; it < NITEMS; it += NGW) {
            int r = it;
            if (r < I_IN) { transpose_item(p.in[10], DM, NIN, WALL, r, 1, scr, lane); continue; } r -= I_IN;
            if (r < I_SQ) { transpose_item(p.in[19], DM, DM, WALL + (size_t)2816 * DM, r, 0, scr, lane); continue; } r -= I_SQ;
            if (r < I_SQ) { transpose_item(p.in[20], DM, DM, WALL + (size_t)3840 * DM, r, 0, scr, lane); continue; } r -= I_SQ;
            if (r < I_SQ) { transpose_item(p.in[15], DM, DM, WOUT, r, 0, scr, lane); continue; } r -= I_SQ;
            if (r < I_SQ) { transpose_item(p.in[18], DM, DM, WXQ, r, 0, scr, lane); continue; } r -= I_SQ;
            if (r < I_SQ) { transpose_item(p.in[21], DM, DM, WXO, r, 0, scr, lane); continue; } r -= I_SQ;
            if (r < I_FF) { transpose_item(p.in[23], DM, DFF, WGU, r, 2, scr, lane); continue; } r -= I_FF;
            if (r < I_FF) { transpose_item(p.in[24], DM, DFF, WGU, r, 3, scr, lane); continue; } r -= I_FF;
            transpose_item(p.in[25], DFF, DM, WDN, r, 0, scr, lane);
        }
        for (int m0 = gw * 4; m0 < MALL; m0 += NGW * 4) {
            const float* base; const float* g;
            if (m0 < MP) { base = p.in[0] + (size_t)m0 * DM; g = p.in[9]; }
            else if (m0 < MTOK) { base = p.in[1] + (size_t)(m0 - MP) * DM; g = p.in[9]; }
            else { base = p.in[2] + (size_t)(m0 - MTOK) * DM; g = p.in[17]; }
            const float* const xr[4] = {base, base + DM, base + 2 * DM, base + 3 * DM};
            bf16_t* ob = XN + (size_t)m0 * DM; bf16_t* const orr[4] = {ob, ob + DM, ob + 2 * DM, ob + 3 * DM};
            rms_rows_bf16<4>(xr, g, orr, lane);
        }
        if (bid == 0) {
            float* tabg = (float*)(ws + WS_TABG);
            for (int i = tid; i < 36 * 192; i += 512) {
                const int gh = i / 192, e = i - gh * 192, g = gh / 12, h = gh - g * 12, dist = e - 31; float v = -1e30f;
                if (dist >= 0 && dist <= 128) { const int n = dist << (2 * g); int bk;
                    if (n < 16) bk = n; else { const float vv = logf((float)n / 16.0f) / 4.852030263919617f * 16.0f; bk = 16 + (int)vv; bk = bk > 31 ? 31 : bk; }
                    v = p.in[8][bk * NH + h] * LOG2E; }
                tabg[i] = v;
            }
        }
        {
            constexpr int CPER = (30 - TS) * CWD / 4;
            for (int i = bid * 512 + tid; i < NSEQ * CPER; i += G * 512) { const int n = i / CPER, j = i - n * CPER;
                ((f32x4*)(out + OFF_SCONV + (size_t)n * 30 * CWD))[j] = ((const f32x4*)(p.in[5] + (size_t)n * 30 * CWD + TS * CWD))[j]; }
        }
    }
    SEAM(0);
    if (IN(1)) REP(1) {
        REPSYNC;
#ifndef P1_NO_MAIN
        { pg8::SchedGrid S{129, 11, G, bid, (const char*)XN, (const char*)WALL, (size_t)256 * DM * 2, (size_t)256 * DM * 2};
          pg8::EpiIn E{ws, out};
          pg8::gemm_phase<pg8::EpiIn, pg8::SchedGrid, true>(lds, pg8::Cfg{DM, DM, DM}, S, E, wave); }
#endif
#ifndef P1_NO_MEM
        { const int cfirst = (129 * 11) % G;
          pg8::SchedMem S{(bid - cfirst + G) % G, (const char*)XN, (const char*)WALL};
          pg8::EpiMem E{ws, out};
          pg8::gemm_phase<pg8::EpiMem, pg8::SchedMem, true>(lds, pg8::Cfg{DM, DM, DM}, S, E, wave); }
        if (bid >= 187 && rep_ == 0) { PHASE_IDS; att::copy_range(p.in[3], p.in[4], out, 0u, 2000000u, bid - 187, G - 187, tid); }
#endif
    }
    SEAM(1);
    if (IN(2)) REP(2) {
        REPSYNC;
        PHASE_IDS;
        LAS float* tab = (LAS float*)(lds + ATT_TAB_OFF); LAS float* cw = (LAS float*)(lds + ATT_CW_OFF);
#ifndef MK_TILE_ATT
#define MK_TILE_ATT 1
#endif
        const float* tabg = (const float*)(ws + WS_TABG);
#if !MK_TILE_ATT
        for (int i = tid; i < 36 * 192; i += 512) tab[i] = tabg[i];
        __syncthreads();
#endif
        att::Ctx c{QB, KB, VB, p.in[3], p.in[4], OP, LSE, ATT};
        LAS unsigned char* vbuf = lds + ATT_V_OFF + wave * ATT_WBUF;
#ifndef PROBE_P2
#define PROBE_P2 0
#endif
#if MK_TILE_ATT
        {
            const int nl2 = __builtin_amdgcn_readfirstlane((int)((volatile LAS unsigned*)(lds + MISC_OFF))[0]), nx2 = __builtin_amdgcn_readfirstlane((int)((volatile LAS unsigned*)(lds + MISC_OFF))[1]);
            const int xi2 = __builtin_amdgcn_readfirstlane((int)((volatile LAS unsigned*)(lds + MISC_OFF))[2]), rk2 = __builtin_amdgcn_readfirstlane((int)((volatile LAS unsigned*)(lds + MISC_OFF))[3]);
            const int npair = (48 - xi2 + nx2 - 1) / nx2, nun = npair * 96;
            auto mk = [&](int Lx) -> att::TDesc { att::TDesc d; const int pair = Lx / 96, u = Lx - pair * 96, pp = xi2 + nx2 * pair; d.b = pp / 12; d.h = pp - d.b * 12; d.g = u >> 5; const int cj = u & 31;
                if (d.g == 0) { d.dil = 1; d.r = 0; d.j0 = 256 * cj; } else if (d.g == 1) { d.dil = 4; d.r = cj >> 3; d.j0 = 256 * (cj & 7); } else { d.dil = 16; d.r = cj >> 1; d.j0 = 256 * (cj & 1); }
                return d; };
            int Lx = rk2;
            att::TDesc cur = mk(Lx < nun ? Lx : 0), prv = cur;
            att::TOut po; po.o[0] = (f32x16){}; po.o[1] = (f32x16){}; po.l = 1.f; po.mx = 0.f;
            const bool any = Lx < nun;
            __builtin_amdgcn_s_waitcnt(0x0070);
            if (any) { att::t_issue_tab(tabg, cur, lds, wave, lane);
                att::t_issue_k(c, cur, lds, wave, lane); att::t_issue_q(c, cur, lds, wave, lane); att::t_issue_v(c, cur, lds, wave, lane); }
            while (Lx < nun) {
                const int Lx2 = Lx + nl2; const bool has_next = Lx2 < nun;
                const att::TDesc nxt = mk(has_next ? Lx2 : Lx);
                att::t_unit(c, prv, cur, nxt, has_next, tabg, lds, wave, po);
                prv = cur; cur = nxt; Lx = Lx2;
            }
            if (any) att::t_flush(c, prv, po, lds, wave);
            xl_barrier(xbar);
            for (int k = 0; k < npair; ++k) { const int pp = xi2 + nx2 * k, b = pp / 12, h = pp - b * 12;
                for (int ck = rk2; ck < 32; ck += nl2) att::merge_pieces<4>(c, (size_t)b * SEQ + ck * 256 + (tid >> 3), 64, h, tid & 7); }
            __syncthreads();
            for (int i = tid; i < 36 * 192; i += 512) tab[i] = tabg[i];
            __syncthreads();
        }
#endif
#if !defined(P2_NO_PROMPT) && !MK_TILE_ATT
        for (int rp_ = 0; rp_ <= (PROBE_P2 & 1) + ((PROBE_P2 >> 3) & 1); ++rp_) {
            auto mkdesc = [&](int un, int it) -> att::PDesc {
                att::PDesc d; d.b = un / 192; const int rem = un - d.b * 192; d.h = rem >> 4; const int ch = rem & 15; d.g = it >> 4; const int j = it & 15;
                if (d.g == 0) { d.dil = 1; d.r = 0; d.i0 = ch * 512 + 32 * j; } else if (d.g == 1) { d.dil = 4; d.r = j >> 2; d.i0 = ch * 128 + 32 * (j & 3); } else { d.dil = 16; d.r = j; d.i0 = ch * 32; }
                return d; };
            bf16x8 qv[4], kr[5][4];
            const int vkey_ = lane >> 3, vch_ = lane & 7;
            const int vcu = (G % 8 == 0) ? (bid & 7) * (G >> 3) + (bid >> 3) : bid;
            int un = vcu, it = wave;
            att::PDesc cur = mkdesc(un < 768 ? un : 0, it);
            if (un < 768) { att::p_load_q(c, cur, qv, vkey_, vch_);
#pragma unroll
                for (int s5 = 0; s5 < 2; ++s5) att::p_load_kv(c.KB, cur, s5, kr[s5], vkey_, vch_); }
            while (un < 768) {
                int un2 = un, it2 = it + 8; if (it2 >= 48) { it2 = wave; un2 = un + G; }
                const bool has_next = un2 < 768;
                const att::PDesc nxt = mkdesc(has_next ? un2 : un, has_next ? it2 : it);
                att::pblock(c, cur, nxt, has_next, qv, kr, tab, vbuf);
                if (un2 != un) {
                    __syncthreads();
                    const int b = un / 192, rem = un - b * 192, h = rem >> 4, ch = rem & 15;
#pragma unroll 1
                    for (int ps = 0; ps < 8; ps += 4) att::merge_pieces<4>(c, (size_t)b * SEQ + ch * 512 + ps * 64 + (tid >> 3), 64, h, tid & 7);
                }
                cur = nxt; un = un2; it = it2;
            }
        }
#endif
        {
            unsigned* cq = (unsigned*)(ws + WS_CTL) + 13200;
            volatile LAS unsigned* qw = (volatile LAS unsigned*)(lds + MISC_OFF) + 8;
            constexpr unsigned NSU = NSEQ * NH, NCP = (unsigned)(MP / 64), NIT = NSU + NCP + NSEQ;
            LAS float* cw8 = (LAS float*)(lds + 98304);
            unsigned tk_ = 0;
            if (threadIdx.x == 0) { tk_ = xb_add(cq, 1u); qw[0] = tk_; }
            __syncthreads();
            unsigned q = (unsigned)__builtin_amdgcn_readfirstlane((int)qw[0]);
            bool conv_ready = false;
            while (q < NIT) {
                __syncthreads();
                if (threadIdx.x == 0) tk_ = xb_add(cq, 1u);
                if (q < NSU) {
                    const int n = (int)q / NH, h = (int)q - n * NH;
                    if (wave == 0) att::wave_block<1>(c, n, h, 0, 1, 0, 2048, 8, tab + (0 * 12 + h) * 192, vbuf);
                    else for (int it = wave; it < 13; it += 7) {
                        LAS float* sb = (LAS float*)vbuf;
                        if (it < 5) att::sample_vblock<2>(c, n, h, 1, 4, it - 1, 512, tab + (1 * 12 + h) * 192, sb);
                        else att::sample_vblock<1>(c, n, h, 2, 16, it - 5, 128, tab + (2 * 12 + h) * 192, sb);
                    }
                    __syncthreads();
                    if (tid < 64) att::merge_pieces<1>(c, (size_t)MP + n * TS + (tid >> 3), 0, h, tid & 7);
                } else {
                    if (!conv_ready) { __syncthreads(); for (int i = tid; i < 31 * CWD; i += 512) cw8[i] = p.in[11][i]; conv_ready = true; }
                    const int un = (int)(q - NSU);
                    if (un < (int)NCP) conv_unit<8, false>(U, p.in[5], un >> 7, (un & 127) * 64, (LAS float*)(lds + ATT_V_OFF), cw8, p.in[12], p.in[13], p.in[14], ATT, tid, lane, wave);
                    else conv_unit<1, true>(U, p.in[5], un - (int)NCP, 0, (LAS float*)(lds + ATT_V_OFF), cw8, p.in[12], p.in[13], p.in[14], ATT, tid, lane, wave);
                }
                if (threadIdx.x == 0) qw[0] = tk_;
                __syncthreads();
                q = (unsigned)__builtin_amdgcn_readfirstlane((int)qw[0]);
            }
        }
    }
    SEAM(2);
    const int nl = __builtin_amdgcn_readfirstlane((int)((volatile LAS unsigned*)(lds + MISC_OFF))[0]), nx = __builtin_amdgcn_readfirstlane((int)((volatile LAS unsigned*)(lds + MISC_OFF))[1]);
    const int xi = __builtin_amdgcn_readfirstlane((int)((volatile LAS unsigned*)(lds + MISC_OFF))[2]), rk = __builtin_amdgcn_readfirstlane((int)((volatile LAS unsigned*)(lds + MISC_OFF))[3]);
    unsigned* xq_flag = (unsigned*)(ws + WS_CTL) + 3520; unsigned* xo_flag = (unsigned*)(ws + WS_CTL) + 13000;
    bool own128 = false;
    { for (int j = 0; j < 16; ++j) { const int Lx = j * nl + rk, pm = xi + nx * (Lx >> 2); if (pm >= 129) break; own128 |= (pm == 128); } }
    if (IN(3)) {
        pg8::SchedXL S{nl, rk, xi, nx, (const char*)ATT, (const char*)WOUT, (size_t)256 * DM * 2, (size_t)256 * DM * 2, 0};
        pg8::EpiRes<true> E{p.in[0], p.in[1], nullptr, XN, p.in[16], SSQ};
        pg8::gemm_phase<pg8::EpiRes<true>, pg8::SchedXL, true>(lds, pg8::Cfg{DM, DM, DM}, S, E, wave);
    }
    xl_barrier(xbar);
    if (IN(4)) {
        {   pg8::SchedXL S{nl, rk, xi, nx, (const char*)XN, (const char*)WXQ, (size_t)256 * DM * 2, (size_t)256 * DM * 2, 0};
            pg8::EpiScale E{XQ, SSQ, XQSCALE};
            pg8::gemm_phase<pg8::EpiScale, pg8::SchedXL, true>(lds, pg8::Cfg{DM, DM, DM}, S, E, wave); }
        if (own128 && threadIdx.x == 0) { __builtin_amdgcn_fence(__ATOMIC_RELEASE, "agent"); asm volatile("s_waitcnt vmcnt(0)" ::: "memory"); (void)xb_add(xq_flag, 1u); }
        {   pg8::SchedXLs S{nl, rk, xi, nx, (const char*)XQ, (const char*)MKB, 0};
            pg8::EpiSoftmax E{PB, LSUM, (LAS float*)(lds + XCH_OFF)};
            pg8::gemm_phase<pg8::EpiSoftmax, pg8::SchedXLs, true>(lds, pg8::Cfg{256, DM, DM}, S, E, wave); }
        {   pg8::SchedXLs S{nl, rk, xi, nx, (const char*)PB, (const char*)MVT, 1};
            pg8::EpiPV E{XO, LSUM};
            pg8::gemm_phase<pg8::EpiPV, pg8::SchedXLs, true>(lds, pg8::Cfg{256, DM, DM}, S, E, wave); }
        PHASE_IDS;
        if (threadIdx.x == 0) { unsigned sp = 0; while (xb_ld(xq_flag) < 4u) { __builtin_amdgcn_s_sleep(2); if (++sp > (1u << 22)) break; }
            __builtin_amdgcn_fence(__ATOMIC_ACQUIRE, "agent"); asm volatile("s_waitcnt vmcnt(0)" ::: "memory"); }
        LAS float* qs = (LAS float*)lds;
        LAS float* sc = (LAS float*)(lds + 4096);
        LAS float* red = (LAS float*)(lds + 8192);
        const int xown_ = 128 % nx; const bool dense_ = (nx * nl == G && G == NSEQ * 4 * 2 && nl >= 8);
        int un0_ = -1, un1_ = -1;
        if (dense_) { if (!(xi == xown_ && rk < 4)) un0_ = xi * nl + rk; if (xi == xown_ && rk >= 4 && rk < 8) un1_ = xown_ * nl + (rk - 4); }
        for (int it_ = 0; ; ++it_) {
            int un;
            if (dense_) { if (it_ > 1) break; un = it_ == 0 ? un0_ : un1_; if (un < 0) continue; }
            else { un = bid + it_ * G; if (un >= NSEQ * 4 * 2) break; }
            const int n = un >> 3, h = (un >> 1) & 3, half = un & 1;
            __syncthreads();
            for (int i = tid; i < 4 * 256; i += 512) { const int t = i >> 8, d = i & 255; qs[i] = __uint_as_float((unsigned)XQ[((size_t)MP + n * TS + 4 * half + t) * DM + h * 256 + d] << 16); }
            __syncthreads();
            const float* Kc = p.in[6] + ((size_t)n * NMEM * 4 + h) * 256; const float* Vc = p.in[7] + ((size_t)n * NMEM * 4 + h) * 256;
            f32x4 qv[4];
#pragma unroll
            for (int t = 0; t < 4; ++t) qv[t] = *(const LAS f32x4*)(qs + t * 256 + 4 * lane);
#pragma unroll 1
            for (int mb = 0; mb < 2; ++mb) {
                f32x4 kv[16];
#pragma unroll
                for (int k = 0; k < 16; ++k) kv[k] = *(const f32x4*)(Kc + (size_t)(wave * 32 + mb * 16 + k) * 1024 + 4 * lane);
#pragma unroll
                for (int k = 0; k < 16; ++k) {
                    float pt[4];
#pragma unroll
                    for (int t = 0; t < 4; ++t) pt[t] = wave_sum((kv[k][0] * qv[t][0] + kv[k][1] * qv[t][1]) + (kv[k][2] * qv[t][2] + kv[k][3] * qv[t][3]));
                    if (lane == 0) *(LAS f32x4*)(sc + (wave * 32 + mb * 16 + k) * 4) = (f32x4){pt[0], pt[1], pt[2], pt[3]};
                }
            }
            __syncthreads();
            if (wave < 4) {
                const int t = wave; float v[4]; float mx = -3.0e38f;
#pragma unroll
                for (int j = 0; j < 4; ++j) { v[j] = sc[(lane + 64 * j) * 4 + t]; mx = fmaxf(mx, v[j]); }
#pragma unroll
                for (int o = 1; o < 64; o <<= 1) mx = fmaxf(mx, __shfl_xor(mx, o));
                float sm = 0.f;
#pragma unroll
                for (int j = 0; j < 4; ++j) { v[j] = fast_exp2(v[j] - mx); sm += v[j]; }
                sm = wave_sum(sm); const float inv = 1.0f / sm;
#pragma unroll
                for (int j = 0; j < 4; ++j) sc[(lane + 64 * j) * 4 + t] = v[j] * inv;
            }
            __syncthreads();
            {
                const int d = tid & 255, mh = tid >> 8; f32x4 o = (f32x4){0.f, 0.f, 0.f, 0.f};
                const float* vp = Vc + (size_t)(mh * 128) * 1024 + d; const LAS float* pp = sc + (mh * 128) * 4;
#pragma unroll 1
                for (int m0 = 0; m0 < 128; m0 += 32) {
                    float vv[32];
#pragma unroll
                    for (int m = 0; m < 32; ++m) vv[m] = vp[(size_t)(m0 + m) * 1024];
#pragma unroll
                    for (int m = 0; m < 32; ++m) { const f32x4 pw = *(const LAS f32x4*)(pp + (m0 + m) * 4); o += pw * vv[m]; }
                }
                if (mh == 1) *(LAS f32x4*)(red + d * 4) = o;
                __syncthreads();
                if (mh == 0) { o += *(const LAS f32x4*)(red + d * 4);
#pragma unroll
                    for (int e = 0; e < 4; ++e) { const unsigned mine = pkbf(o[e], 0.f) & 0xffffu, nb = (unsigned)__shfl_down((int)mine, 1);
                        if (!(d & 1)) __hip_atomic_store((unsigned*)(XO + ((size_t)MP + n * TS + 4 * half + e) * DM + h * 256 + d), mine | (nb << 16), __ATOMIC_RELAXED, __HIP_MEMORY_SCOPE_AGENT); } }
            }
            asm volatile("s_waitcnt vmcnt(0)" ::: "memory"); __syncthreads();
            if (threadIdx.x == 0) (void)xb_add(xo_flag, 1u);
        }
        __syncthreads();
    }
    xl_barrier(xbar);
    if (IN(7)) {
        if (own128) {
            if (threadIdx.x == 0) { unsigned sp = 0; while (xb_ld(xo_flag) < (unsigned)(NSEQ * 8)) { __builtin_amdgcn_s_sleep(2); if (++sp > (1u << 22)) break; }
                __builtin_amdgcn_fence(__ATOMIC_ACQUIRE, "agent"); asm volatile("s_waitcnt vmcnt(0)" ::: "memory"); }
            __syncthreads();
        }
        pg8::SchedXL S{nl, rk, xi, nx, (const char*)XO, (const char*)WXO, (size_t)256 * DM * 2, (size_t)256 * DM * 2, 0};
        pg8::EpiRes<false> E{nullptr, nullptr, p.in[16], XN, p.in[22], SSQ + SSQ_STRIDE};
        pg8::gemm_phase<pg8::EpiRes<false>, pg8::SchedXL, true>(lds, pg8::Cfg{DM, DM, DM}, S, E, wave);
    }
    xl_barrier(xbar);
    const int xi0 = 128 % nx;
    const int xi9 = (nx > 1 && nl >= 4) ? (xi0 + 1) % nx : xi0;
    unsigned* h_flag = (unsigned*)(ws + WS_CTL) + 13064;
    if (IN(8)) {
        pg8::SchedXL22 S{nl, rk, xi, nx, (const char*)XN, (const char*)WGU, (size_t)256 * DM * 2, (size_t)256 * DM * 2};
        pg8::EpiSwiGLU E{HB, SSQ + SSQ_STRIDE};
        pg8::gemm_phase<pg8::EpiSwiGLU, pg8::SchedXL22, true>(lds, pg8::Cfg{DM, DM, DM}, S, E, wave);
        bool had = false;
        for (int j = 0; j < 16; ++j) { const int Lx = j * nl + rk, pm = xi + nx * (Lx / 22); if (pm >= 129) break; had |= (pm == 128); }
        if (had && threadIdx.x == 0) { __builtin_amdgcn_fence(__ATOMIC_RELEASE, "agent"); asm volatile("s_waitcnt vmcnt(0)" ::: "memory"); (void)xb_add(h_flag, 1u); }
    }
    xl_barrier(xbar);
    if (IN(9)) {
        pg8::EpiFinal E{XN, p.in[22], out + OFF_Y, p.in[26], (float*)(ws + WS_SLOT), (unsigned*)(ws + WS_CTL) + 4096, (LAS float*)(lds + XCH_OFF), wave};
        {   pg8::SchedXL S{nl, rk, xi, nx, (const char*)HB, (const char*)WDN, (size_t)256 * DFF * 2, (size_t)256 * DFF * 2, 1};
            pg8::gemm_phase<pg8::EpiFinal, pg8::SchedXL, true>(lds, pg8::Cfg{DFF, DFF, DFF}, S, E, wave); }
        if (xi == xi9 && rk < 4) {
            if (threadIdx.x == 0) { unsigned sp = 0; while (xb_ld(h_flag) < 22u) { __builtin_amdgcn_s_sleep(2); if (++sp > (1u << 22)) break; }
                __builtin_amdgcn_fence(__ATOMIC_ACQUIRE, "agent"); asm volatile("s_waitcnt vmcnt(0)" ::: "memory"); }
            __syncthreads();
            pg8::SchedOne S{128, rk, (const char*)HB, (const char*)WDN, (size_t)256 * DFF * 2, (size_t)256 * DFF * 2};
            pg8::gemm_phase<pg8::EpiFinal, pg8::SchedOne, true>(lds, pg8::Cfg{DFF, DFF, DFF}, S, E, wave);
        }
    }
    {   const bool all = (nx <= 1);
        int before = 0; for (int x = 0; x < xi; ++x) if (x != xi0) before += (x == xi9 && xi9 != xi0) ? nl - 4 : nl;
        const int mine = (xi == xi9 && xi9 != xi0) ? rk - 4 : rk;
        const int nwk = all ? nl : (nx - 1) * nl - (xi9 != xi0 ? 4 : 0), widx = all ? rk : before + mine;
        if (all || (xi != xi0 && mine >= 0)) { PHASE_IDS; att::copy_range(p.in[3], p.in[4], out, 2000000u, 23067520u, widx, nwk, tid); } }
#undef IN
#undef SEAM
}

extern "C" void kernel_launch(void* const* d_in, const int* in_sizes, int n_in, void* d_out, int out_size, void* d_ws, size_t ws_size, hipStream_t stream) {
    static int grid = 0;
    if (grid == 0) {
        if (n_in != 27 || (size_t)out_size != OUT_TOTAL || ws_size < WS_END) { fprintf(stderr, "kernel_launch: unexpected shapes: n_in %d out %d ws %zu\n", n_in, out_size, ws_size); grid = -1; return; }
        int dev = 0, cus = 0, per_cu = 0;
        (void)hipGetDevice(&dev); (void)hipDeviceGetAttribute(&cus, hipDeviceAttributeMultiprocessorCount, dev);
        if (hipFuncSetAttribute((const void*)fwd_kernel, hipFuncAttributeMaxDynamicSharedMemorySize, LDS_BYTES) != hipSuccess) { fprintf(stderr, "kernel_launch: hipFuncSetAttribute failed\n"); grid = -1; return; }
        if (hipOccupancyMaxActiveBlocksPerMultiprocessor(&per_cu, (const void*)fwd_kernel, 512, LDS_BYTES) != hipSuccess || per_cu < 1) { fprintf(stderr, "kernel_launch: occupancy query failed (%d)\n", per_cu); (void)hipGetLastError(); per_cu = 1; }
        grid = cus * 1;
        if (per_cu < 1) grid = -1;
    }
    if (grid < 0) return;
    Params p{};
    for (int i = 0; i < 27; ++i) p.in[i] = (const float*)d_in[i];
    p.out = (float*)d_out; p.ws = (unsigned char*)d_ws;
#if MK_COOP
    if (hipMemsetAsync((char*)d_ws + WS_CTL, 0, CTL_ZERO_BYTES, stream) != hipSuccess) { fprintf(stderr, "kernel_launch: memset of the barrier words failed\n"); return; }
    p.ph_lo = 0; p.ph_hi = 11; p.coop = 1;
    void* args[] = {&p};
    hipError_t e = hipLaunchCooperativeKernel((const void*)fwd_kernel, dim3(grid), dim3(512), args, LDS_BYTES, stream);
    if (e != hipSuccess) fprintf(stderr, "cooperative launch failed: %s (grid %d)\n", hipGetErrorString(e), grid);
#else
    for (int ph = 0; ph < 11; ++ph) {
        p.ph_lo = ph; p.ph_hi = ph + 1; p.coop = 0;
        hipLaunchKernelGGL(fwd_kernel, dim3(grid), dim3(512), LDS_BYTES, stream, p);
    }
#endif
}
```

```cpp
#include <hip/hip_runtime.h>
#include <hip/hip_cooperative_groups.h>
#include <cstdio>
#include <cstdint>
namespace cg = cooperative_groups;

#ifndef MK_COOP
#define MK_COOP 1
#endif

#define LAS __attribute__((address_space(3)))
typedef unsigned short bf16_t;
typedef short bf16x8 __attribute__((ext_vector_type(8)));
typedef short s16x4 __attribute__((ext_vector_type(4)));
typedef float f32x2 __attribute__((ext_vector_type(2)));
typedef float f32x4 __attribute__((ext_vector_type(4)));
typedef float f32x16 __attribute__((ext_vector_type(16)));
typedef unsigned u32x2 __attribute__((ext_vector_type(2)));
typedef unsigned u32x4 __attribute__((ext_vector_type(4)));
typedef __bf16 bf16x2_t __attribute__((ext_vector_type(2)));

__device__ __forceinline__ unsigned pkbf(float lo, float hi) { f32x2 v = {lo, hi}; bf16x2_t b = __builtin_convertvector(v, bf16x2_t); return __builtin_bit_cast(unsigned, b); }
__device__ __forceinline__ float bf_lo(unsigned w) { return __uint_as_float(w << 16); }
__device__ __forceinline__ float bf_hi(unsigned w) { return __uint_as_float(w & 0xffff0000u); }
__device__ __forceinline__ int fresh_lane() { int t = __builtin_amdgcn_mbcnt_hi(~0u, __builtin_amdgcn_mbcnt_lo(~0u, 0u)); asm volatile("" : "+v"(t)); return t; }
__device__ __forceinline__ float fast_exp2(float x) { return __builtin_amdgcn_exp2f(x); }
__device__ __forceinline__ float fast_rcp(float x) { return __builtin_amdgcn_rcpf(x); }

constexpr int DM = 1024, NBATCH = 4, SEQ = 8192, MP = NBATCH * SEQ;
constexpr int NSEQ = 32, TS = 8, MSMP = NSEQ * TS;
constexpr int MTOK = MP + MSMP;
constexpr int NMEM = 256, MMEM = NBATCH * NMEM;
constexpr int MALL = MTOK + MMEM;
constexpr int AW = 768, CWD = 256, NIN = 2816, DFF = 2816, NH = 12, HD = 64;
constexpr int WBUF = 2048;
constexpr float EPS = 1e-6f;
constexpr float LOG2E = 1.4426950408889634f;
constexpr float QSCALE = 0.125f * LOG2E;
constexpr float XQSCALE = 0.0625f * LOG2E;

constexpr size_t OFF_Y = 0;
constexpr size_t OFF_PWK = 33816576, OFF_PWV = 40108032, OFF_PCONV = 46399488, OFF_PMK = 46430208, OFF_PMV = 47478784;
constexpr size_t OFF_SWK = 48527360, OFF_SWV = 98859008, OFF_SCONV = 149190656, OUT_TOTAL = 149436416;

constexpr size_t MiB = 1u << 20;
constexpr size_t WS_CTL = 0, CTL_ZERO_BYTES = 65536;
constexpr size_t WS_WALL = 2 * MiB;
constexpr size_t WS_WOUT = 12 * MiB, WS_WXQ = 14 * MiB, WS_WXO = 16 * MiB;
constexpr size_t WS_WGU = 18 * MiB;
constexpr size_t WS_WDN = 30 * MiB;
constexpr size_t WS_XN = 36 * MiB;
constexpr size_t WS_QB = 104 * MiB, WS_KB = 154 * MiB, WS_VB = 204 * MiB;
constexpr size_t WS_U = 254 * MiB;
constexpr size_t WS_OP = 288 * MiB;
constexpr size_t OP_STRIDE = (size_t)MTOK * AW;
constexpr size_t WS_LSE = 434 * MiB;
constexpr size_t LSE_STRIDE = (size_t)MTOK * NH;
constexpr size_t WS_ATT = 440 * MiB;
constexpr size_t WS_X1 = 506 * MiB;
constexpr size_t WS_SSQ = 636 * MiB;
constexpr size_t SSQ_STRIDE = (size_t)MTOK * 16;
constexpr size_t WS_MKB = 644 * MiB, WS_MVT = 646 * MiB;
constexpr size_t WS_LSUM = 648 * MiB;
constexpr size_t WS_XQ = 353 * MiB;
constexpr size_t WS_PB = 652 * MiB;
constexpr size_t WS_XO = 288 * MiB;
constexpr size_t WS_H = 104 * MiB;
constexpr size_t WS_TABG = 651 * MiB;
constexpr size_t WS_SLOT = 650 * MiB;
constexpr size_t WS_END = 716 * MiB;

namespace pg8 {
constexpr int BM = 256, BK = 64, HALF = 128, HTB = HALF * BK * 2, STAGE_BYTES = 8 * HTB, NXCD = 8, WGM = 8;
__host__ __device__ __forceinline__ int lds_byte(int r, int c) { const int st = (r >> 4) * 2 + (c >> 5), rr = r & 15, cc = c & 31, ob = rr * 64 + cc * 2; return st * 1024 + (ob ^ (((ob >> 9) & 1) << 5)); }
__host__ __device__ __forceinline__ void stage_rc(int b, int& R, int& C) { const int st = b / 1024, sb = b % 1024, swz = sb ^ (((sb >> 9) & 1) << 5); R = (st >> 1) * 16 + swz / 64; C = (st & 1) * 32 + (swz % 64) / 2; }
__host__ __device__ __forceinline__ int perm32(int rho) { const int n = rho >> 4, i = rho & 15; return 8 * (i >> 2) + 4 * n + (i & 3); }

struct Unit { int pm, pn, kind; };
struct Cfg { int K, lda, ldb; };

template <class Epi, class Sched, bool ALIGN_EPI>
__device__ __forceinline__ void gemm_phase(LAS unsigned char* lds, const Cfg g, const Sched& S, const Epi& E, const int wid) {
    const int lane = fresh_lane(), tid = wid * 64 + lane, wr = wid >> 2, wc = wid & 3, fr = lane & 15, fq = lane >> 4;
    const int K = g.K, nt = K / BK;
    unsigned voffA[2], voffB[2];
#pragma unroll
    for (int i = 0; i < 2; ++i) { int R, C; stage_rc(tid * 16 + i * 8192, R, C); const int Rb = (R & ~31) + perm32(R & 31);
        voffA[i] = (unsigned)(R * g.lda + C) * 2u; voffB[i] = (unsigned)(Rb * g.ldb + C) * 2u; }
    const size_t kstep = (size_t)(BK * 2);
    const size_t hA = (size_t)HALF * g.lda * 2, hB = (size_t)HALF * g.ldb * 2;
    const unsigned ldsw = (unsigned)wid * 1024u;
    const int aoff = lds_byte(wr * 64 + fr, fq * 8), boff = lds_byte(wc * 32 + fr, fq * 8);
#define PG8_SA(b, h) (((b) * 2 + (h)) * HTB)
#define PG8_SB(b, h) ((4 + (b) * 2 + (h)) * HTB)
#define PG8_STAGE(bufoff, gbase, voff) do { _Pragma("unroll") for (int _i = 0; _i < 2; ++_i) \
        __builtin_amdgcn_global_load_lds((const unsigned*)((const char*)(gbase) + (voff)[_i]), (LAS unsigned*)(lds + (bufoff) + ldsw + _i * 8192), 16, 0, 0); } while (0)
#define PG8_LDA(dst, b, h) do { _Pragma("unroll") for (int m = 0; m < 4; ++m) _Pragma("unroll") for (int k = 0; k < 2; ++k) dst[m][k] = *(const LAS bf16x8*)(lds + PG8_SA(b, h) + aoff + m * 2048 + k * 1024); } while (0)
#define PG8_LDB(dst, b, h) do { _Pragma("unroll") for (int n = 0; n < 2; ++n) _Pragma("unroll") for (int k = 0; k < 2; ++k) dst[n][k] = *(const LAS bf16x8*)(lds + PG8_SB(b, h) + boff + n * 2048 + k * 1024); } while (0)
#define PG8_MMA(ai, bj, At, Bt) do { __builtin_amdgcn_s_setprio(1); _Pragma("unroll") for (int m = 0; m < 4; ++m) _Pragma("unroll") for (int n = 0; n < 2; ++n) _Pragma("unroll") for (int k = 0; k < 2; ++k) \
        acc[ai][bj][m][n] = __builtin_amdgcn_mfma_f32_16x16x32_bf16(Bt[n][k], At[m][k], acc[ai][bj][m][n], 0, 0, 0); __builtin_amdgcn_s_setprio(0); } while (0)
#define PG8_WAIT_V(n) asm volatile("s_waitcnt vmcnt(" #n ")" ::: "memory")
#define PG8_WAIT_L(n) asm volatile("s_waitcnt lgkmcnt(" #n ")" ::: "memory")
#define PG8_BAR __builtin_amdgcn_s_barrier()
#define PG8_SCHED __builtin_amdgcn_sched_barrier(0)
    Unit cur, nxt; int ui = 0;
    if (!S.next(0, cur)) return;
    f32x4 acc[2][2][4][2];
    E.init(acc, cur, wr, wc, fr, fq);
    bf16x8 At[4][2], B0[2][2], B1[2][2];
    const char* cA = S.aptr(cur); const char* cB = S.bptr(cur);
    PG8_STAGE(PG8_SB(0, 0), cB, voffB); PG8_STAGE(PG8_SB(0, 1), cB + hB, voffB); PG8_STAGE(PG8_SA(0, 0), cA, voffA); PG8_STAGE(PG8_SA(0, 1), cA + hA, voffA);
    if (wr == 1) PG8_BAR;
    PG8_WAIT_V(2); PG8_BAR;
    PG8_STAGE(PG8_SB(1, 0), cB + kstep, voffB); PG8_STAGE(PG8_SA(1, 0), cA + kstep, voffA); PG8_STAGE(PG8_SB(1, 1), cB + hB + kstep, voffB);
    PG8_WAIT_V(6); PG8_BAR;
    for (;;) {
        const bool has_next = S.next(ui + 1, nxt);
        const char* nA = has_next ? S.aptr(nxt) : cA; const char* nB = has_next ? S.bptr(nxt) : cB;
#pragma unroll 1
        for (int t = 0; t < nt; t += 2) {
            const bool last = (t == nt - 2);
            const char* a1 = cA + (size_t)(t + 1) * kstep;
            const char* a2 = last ? nA : cA + (size_t)(t + 2) * kstep; const char* b2 = last ? nB : cB + (size_t)(t + 2) * kstep;
            const char* a3 = a2 + kstep; const char* b3 = b2 + kstep;
            PG8_LDB(B0, 0, 0); PG8_LDB(B1, 0, 1); PG8_SCHED; PG8_LDA(At, 0, 0); PG8_STAGE(PG8_SA(1, 1), a1 + hA, voffA);
            PG8_WAIT_V(8); PG8_WAIT_L(0); PG8_BAR; PG8_MMA(0, 0, At, B0); PG8_MMA(0, 1, At, B1); PG8_BAR; PG8_SCHED;
            PG8_LDA(At, 0, 1); PG8_STAGE(PG8_SB(0, 0), b2, voffB); PG8_STAGE(PG8_SB(0, 1), b2 + hB, voffB); PG8_STAGE(PG8_SA(0, 0), a2, voffA);
            PG8_WAIT_V(8); PG8_WAIT_L(0); PG8_BAR; PG8_MMA(1, 0, At, B0); PG8_MMA(1, 1, At, B1); PG8_BAR; PG8_SCHED;
            PG8_LDB(B0, 1, 0); PG8_LDB(B1, 1, 1); PG8_SCHED; PG8_LDA(At, 1, 0); PG8_STAGE(PG8_SA(0, 1), a2 + hA, voffA);
            PG8_WAIT_V(8); PG8_WAIT_L(0); PG8_BAR; PG8_MMA(0, 0, At, B0); PG8_MMA(0, 1, At, B1); PG8_BAR; PG8_SCHED;
            PG8_LDA(At, 1, 1); PG8_STAGE(PG8_SB(1, 0), b3, voffB); PG8_STAGE(PG8_SB(1, 1), b3 + hB, voffB); PG8_STAGE(PG8_SA(1, 0), a3, voffA);
            PG8_WAIT_V(8); PG8_WAIT_L(0); PG8_BAR; PG8_MMA(1, 0, At, B0); PG8_MMA(1, 1, At, B1); PG8_BAR; PG8_SCHED;
        }
        if constexpr (ALIGN_EPI) { if (wr == 0) PG8_BAR; }
        E(acc, cur, wr, wc, fr, fq);
        if (!has_next) break;
        E.init(acc, nxt, wr, wc, fr, fq);
        cur = nxt; cA = nA; cB = nB; ++ui;
        if constexpr (ALIGN_EPI) { if (wr == 1) PG8_BAR; }
    }
    PG8_WAIT_V(0);
    if constexpr (!ALIGN_EPI) { if (wr == 0) PG8_BAR; }
    PG8_BAR;
#undef PG8_SA
#undef PG8_SB
#undef PG8_STAGE
#undef PG8_LDA
#undef PG8_LDB
#undef PG8_MMA
#undef PG8_WAIT_V
#undef PG8_WAIT_L
#undef PG8_BAR
#undef PG8_SCHED
}

__device__ __forceinline__ void swz_tile(int L, int nM, int nN, int& pm, int& pn) {
    const int nwg = nM * nN; int wgid = L;
    { const int q = nwg / NXCD, r = nwg % NXCD, xcd = wgid % NXCD, off = wgid / NXCD; wgid = (xcd < r ? xcd * (q + 1) : r * (q + 1) + (xcd - r) * q) + off; }
    const int nig = WGM * nN, gid = wgid / nig, fm = gid * WGM, gsz = (nM - fm) < WGM ? (nM - fm) : WGM;
    pm = fm + ((wgid % nig) % gsz); pn = (wgid % nig) / gsz;
}
struct SchedGrid {
    int nM, nN, G, c; const char* A; const char* B; size_t tA, tB;
    __device__ __forceinline__ bool next(int i, Unit& u) const { const long L = (long)i * G + c; if (L >= (long)nM * nN) return false; swz_tile((int)L, nM, nN, u.pm, u.pn); u.kind = 0; return true; }
    __device__ __forceinline__ const char* aptr(const Unit& u) const { return A + (size_t)u.pm * tA; }
    __device__ __forceinline__ const char* bptr(const Unit& u) const { return B + (size_t)u.pn * tB; }
};
struct SchedMem {
    int c; const char* XN; const char* W;
    static constexpr size_t TS_ = (size_t)256 * 1024 * 2;
    __device__ __forceinline__ bool next(int i, Unit& u) const {
        if (i > 0 || c < 0 || c >= 48) return false;
        if (c < 32) { u.pm = 129 + (c >> 3); u.pn = 11 + (c & 7); u.kind = 1; } else { const int f = c - 32; u.pm = f >> 2; u.pn = f & 3; u.kind = 2; }
        return true;
    }
    __device__ __forceinline__ const char* aptr(const Unit& u) const { return u.kind == 2 ? W + (size_t)(15 + u.pm) * TS_ : XN + (size_t)u.pm * TS_; }
    __device__ __forceinline__ const char* bptr(const Unit& u) const { return u.kind == 2 ? XN + (size_t)(129 + u.pn) * TS_ : W + (size_t)u.pn * TS_; }
};
struct SchedX {
    int G, c; const char* A; const char* B; int bmode;
    __device__ __forceinline__ bool next(int i, Unit& u) const { const long L = (long)i * G + c; if (L >= 512) return false; u.pm = (int)L >> 2; u.pn = (int)L & 3; u.kind = 0; return true; }
    __device__ __forceinline__ const char* aptr(const Unit& u) const { return A + ((size_t)u.pm * 256 * 1024 + (size_t)u.pn * 256) * 2; }
    __device__ __forceinline__ const char* bptr(const Unit& u) const { const int b = u.pm >> 5; return bmode == 0 ? B + ((size_t)b * 256 * 1024 + (size_t)u.pn * 256) * 2 : B + ((size_t)u.pn * 256 * 1024 + (size_t)b * 256) * 2; }
};

struct SchedPanel {
    int G, vcu; const char* A; const char* B; size_t tA, tB;
    __device__ __forceinline__ bool next(int i, Unit& u) const { const int L = i * G + vcu; if (L >= 516) return false; u.pm = L >> 2; u.pn = L & 3; u.kind = 0; return true; }
    __device__ __forceinline__ const char* aptr(const Unit& u) const { return A + (size_t)u.pm * tA; }
    __device__ __forceinline__ const char* bptr(const Unit& u) const { return B + (size_t)u.pn * tB; }
};
struct SchedXL {
    int nl, rk, xi, nx; const char* A; const char* B; size_t tA, tB; int skip128;
    __device__ __forceinline__ bool next(int i, Unit& u) const { const int Lx = i * nl + rk, pm = xi + nx * (Lx >> 2); if (pm >= 129 || (skip128 && pm == 128)) return false; u.pm = pm; u.pn = Lx & 3; u.kind = 0; return true; }
    __device__ __forceinline__ const char* aptr(const Unit& u) const { return A + (size_t)u.pm * tA; }
    __device__ __forceinline__ const char* bptr(const Unit& u) const { return B + (size_t)u.pn * tB; }
};
struct SchedOne {
    int pm, pn; const char* A; const char* B; size_t tA, tB;
    __device__ __forceinline__ bool next(int i, Unit& u) const { if (i > 0) return false; u.pm = pm; u.pn = pn; u.kind = 0; return true; }
    __device__ __forceinline__ const char* aptr(const Unit& u) const { return A + (size_t)u.pm * tA; }
    __device__ __forceinline__ const char* bptr(const Unit& u) const { return B + (size_t)u.pn * tB; }
};
struct SchedXL22 {
    int nl, rk, xi, nx; const char* A; const char* B; size_t tA, tB; int skip128;
    __device__ __forceinline__ bool next(int i, Unit& u) const { const int Lx = i * nl + rk, q = Lx / 22, pm = xi + nx * q; if (pm >= 129 || (skip128 && pm == 128)) return false; u.pm = pm; u.pn = Lx - q * 22; u.kind = 0; return true; }
    __device__ __forceinline__ const char* aptr(const Unit& u) const { return A + (size_t)u.pm * tA; }
    __device__ __forceinline__ const char* bptr(const Unit& u) const { return B + (size_t)u.pn * tB; }
};
struct SchedXLs {
    int nl, rk, xi, nx; const char* A; const char* B; int bmode;
    __device__ __forceinline__ bool next(int i, Unit& u) const {
        int idx = 0;
#pragma unroll 1
        for (int j = 0; j < 16; ++j) { const int Lx = j * nl + rk, pm = xi + nx * (Lx >> 2); if (pm >= 129) break; if (pm == 128) continue;
            if (idx == i) { u.pm = pm; u.pn = Lx & 3; u.kind = 0; return true; } ++idx; }
        return false;
    }
    __device__ __forceinline__ const char* aptr(const Unit& u) const { return A + ((size_t)u.pm * 256 * 1024 + (size_t)u.pn * 256) * 2; }
    __device__ __forceinline__ const char* bptr(const Unit& u) const { const int b = u.pm >> 5; return bmode == 0 ? B + ((size_t)b * 256 * 1024 + (size_t)u.pn * 256) * 2 : B + ((size_t)u.pn * 256 * 1024 + (size_t)b * 256) * 2; }
};
struct SchedXs {
    int G, c; const char* A; const char* B; int bmode;
    __device__ __forceinline__ bool next(int i, Unit& u) const {
        int idx = 0;
#pragma unroll
        for (int j = 0; j < 3; ++j) { const int L = j * G + c; if (L >= 516) break; int pm, pn; swz_tile(L, 129, 4, pm, pn); if (pm == 128) continue;
            if (idx == i) { u.pm = pm; u.pn = pn; u.kind = 0; return true; } ++idx; }
        return false;
    }
    __device__ __forceinline__ const char* aptr(const Unit& u) const { return A + ((size_t)u.pm * 256 * 1024 + (size_t)u.pn * 256) * 2; }
    __device__ __forceinline__ const char* bptr(const Unit& u) const { const int b = u.pm >> 5; return bmode == 0 ? B + ((size_t)b * 256 * 1024 + (size_t)u.pn * 256) * 2 : B + ((size_t)u.pn * 256 * 1024 + (size_t)b * 256) * 2; }
};

#define EPI_ARGS const f32x4 (&acc)[2][2][4][2], const Unit& u, int wr, int wc, int fr, int fq
#define EPI_ZERO_INIT __device__ __forceinline__ void init(f32x4 (&acc)[2][2][4][2], const Unit&, int, int, int, int) const { \
    _Pragma("unroll") for (int a = 0; a < 2; ++a) _Pragma("unroll") for (int b = 0; b < 2; ++b) _Pragma("unroll") for (int m = 0; m < 4; ++m) _Pragma("unroll") for (int n = 0; n < 2; ++n) acc[a][b][m][n] = (f32x4){0.f, 0.f, 0.f, 0.f}; }
struct EpiIn {
    unsigned char* ws; float* out;
    EPI_ZERO_INIT
    __device__ __forceinline__ void operator()(EPI_ARGS) const {
        const int lr0 = wr * 64 + fr, lc0 = wc * 32 + 8 * fq;
        const int pm = u.pm, pn = u.pn;
        const bool smp = (pm == 128);
#ifdef P1_NO_QKV
        if (false) {
#else
        if (pn < 9) {
#endif
            const int sec = pn / 3, cb = (pn - sec * 3) * 256 + lc0;
            bf16_t* dst = (bf16_t*)(ws + (sec == 0 ? WS_QB : (sec == 1 ? WS_KB : WS_VB)));
            const float sc = sec == 0 ? QSCALE : 1.f;
#pragma unroll
            for (int ai = 0; ai < 2; ++ai)
#pragma unroll
                for (int m = 0; m < 4; ++m) {
                    bf16_t* rowp = dst + ((size_t)pm * 256 + lr0 + 128 * ai + 16 * m) * AW + cb;
#pragma unroll
                    for (int bj = 0; bj < 2; ++bj) {
                        const f32x4 v0 = acc[ai][bj][m][0] * sc, v1 = acc[ai][bj][m][1] * sc;
                        u32x4 w; w.x = pkbf(v0[0], v0[1]); w.y = pkbf(v0[2], v0[3]); w.z = pkbf(v1[0], v1[1]); w.w = pkbf(v1[2], v1[3]);
                        __builtin_nontemporal_store(w, (u32x4*)(rowp + bj * 128));
                    }
                }
            if (sec > 0 && (smp || (pm & 31) >= 24)) {
                float* fb; size_t sa, sm;
                if (smp) { fb = out + (sec == 1 ? OFF_SWK : OFF_SWV) + ((size_t)(8 * wr + (fr >> 3)) * WBUF + (WBUF - TS) + (fr & 7)) * AW + cb; sa = (size_t)16 * WBUF * AW; sm = (size_t)2 * WBUF * AW; }
                else { fb = out + (sec == 1 ? OFF_PWK : OFF_PWV) + ((size_t)(pm >> 5) * WBUF + ((pm & 31) - 24) * 256 + lr0) * AW + cb; sa = (size_t)128 * AW; sm = (size_t)16 * AW; }
#pragma unroll
                for (int ai = 0; ai < 2; ++ai)
#pragma unroll
                    for (int m = 0; m < 4; ++m)
#pragma unroll
                        for (int bj = 0; bj < 2; ++bj) { float* fp = fb + ai * sa + m * sm + bj * 128; __builtin_nontemporal_store(acc[ai][bj][m][0], (f32x4*)fp); __builtin_nontemporal_store(acc[ai][bj][m][1], (f32x4*)(fp + 4)); }
            }
#ifdef P1_NO_GLU
        } else if (false) {
#else
        } else {
#endif
            const int c0 = (pn - 9) * 128 + lc0;
            float* U = (float*)(ws + WS_U);
#pragma unroll
            for (int ai = 0; ai < 2; ++ai)
#pragma unroll
                for (int m = 0; m < 4; ++m) {
                    const size_t grow = (size_t)pm * 256 + lr0 + 128 * ai + 16 * m;
#pragma unroll
                    for (int n = 0; n < 2; ++n) {
                        const f32x4 a = acc[ai][0][m][n], gg = acc[ai][1][m][n]; f32x4 uu;
#pragma unroll
                        for (int e = 0; e < 4; ++e) uu[e] = a[e] * fast_rcp(1.f + fast_exp2(-gg[e] * LOG2E));
                        __builtin_nontemporal_store(uu, (f32x4*)(U + grow * CWD + c0 + 4 * n));
                    }
                }
            if (smp) {
                float* fb = out + OFF_SCONV + ((size_t)(8 * wr + (fr >> 3)) * 30 + 22 + (fr & 7)) * CWD + c0;
#pragma unroll
                for (int ai = 0; ai < 2; ++ai)
#pragma unroll
                    for (int m = 0; m < 4; ++m)
#pragma unroll
                        for (int n = 0; n < 2; ++n) {
                            const f32x4 a = acc[ai][0][m][n], gg = acc[ai][1][m][n]; f32x4 uu;
#pragma unroll
                            for (int e = 0; e < 4; ++e) uu[e] = a[e] * fast_rcp(1.f + fast_exp2(-gg[e] * LOG2E));
                            *(f32x4*)(fb + (size_t)(16 * ai + 2 * m) * 30 * CWD + 4 * n) = uu;
                        }
            } else if ((pm & 31) == 31 && wr == 1) {
#pragma unroll
                for (int m = 2; m < 4; ++m) {
                    const int lr = lr0 + 128 + 16 * m;
                    if (lr >= 226) {
                        float* fb = out + OFF_PCONV + ((size_t)(pm >> 5) * 30 + (lr - 226)) * CWD + c0;
#pragma unroll
                        for (int n = 0; n < 2; ++n) {
                            const f32x4 a = acc[1][0][m][n], gg = acc[1][1][m][n]; f32x4 uu;
#pragma unroll
                            for (int e = 0; e < 4; ++e) uu[e] = a[e] * fast_rcp(1.f + fast_exp2(-gg[e] * LOG2E));
                            *(f32x4*)(fb + 4 * n) = uu;
                        }
                    }
                }
            }
        }
    }
};
struct EpiMem {
    unsigned char* ws; float* out;
    EPI_ZERO_INIT
    __device__ __forceinline__ void operator()(EPI_ARGS) const {
        const int lr0 = wr * 64 + fr, lc0 = wc * 32 + 8 * fq;
        if (u.kind == 1) {
            const int sec = (u.pn - 11) >> 2, cb = ((u.pn - 11) & 3) * 256 + lc0;
            float* fo = out + (sec ? OFF_PMV : OFF_PMK); bf16_t* MKB = (bf16_t*)(ws + WS_MKB);
#pragma unroll
            for (int ai = 0; ai < 2; ++ai)
#pragma unroll
                for (int m = 0; m < 4; ++m) {
                    const size_t mr = (size_t)(u.pm - 129) * 256 + lr0 + 128 * ai + 16 * m;
#pragma unroll
                    for (int bj = 0; bj < 2; ++bj) {
                        const f32x4 v0 = acc[ai][bj][m][0], v1 = acc[ai][bj][m][1];
                        float* fp = fo + mr * 1024 + cb + bj * 128; *(f32x4*)fp = v0; *(f32x4*)(fp + 4) = v1;
                        if (sec == 0) { u32x4 w; w.x = pkbf(v0[0], v0[1]); w.y = pkbf(v0[2], v0[3]); w.z = pkbf(v1[0], v1[1]); w.w = pkbf(v1[2], v1[3]); *(u32x4*)(MKB + mr * 1024 + cb + bj * 128) = w; }
                    }
                }
        } else {
            bf16_t* MVT = (bf16_t*)(ws + WS_MVT);
#pragma unroll
            for (int ai = 0; ai < 2; ++ai)
#pragma unroll
                for (int m = 0; m < 4; ++m) {
                    const size_t nr = (size_t)u.pm * 256 + lr0 + 128 * ai + 16 * m;
#pragma unroll
                    for (int bj = 0; bj < 2; ++bj) {
                        const f32x4 v0 = acc[ai][bj][m][0], v1 = acc[ai][bj][m][1];
                        u32x4 w; w.x = pkbf(v0[0], v0[1]); w.y = pkbf(v0[2], v0[3]); w.z = pkbf(v1[0], v1[1]); w.w = pkbf(v1[2], v1[3]);
                        *(u32x4*)(MVT + nr * 1024 + u.pn * 256 + lc0 + bj * 128) = w;
                    }
                }
        }
    }
};
__device__ __forceinline__ void init_from_xn(f32x4 (&acc)[2][2][4][2], const bf16_t* XN, const float* g, const Unit& u, int wr, int wc, int fr, int fq) {
    const int lr0 = wr * 64 + fr, c0 = u.pn * 256 + wc * 32 + 8 * fq;
    f32x4 rg[2][2];
#pragma unroll
    for (int bj = 0; bj < 2; ++bj)
#pragma unroll
        for (int n = 0; n < 2; ++n) { const f32x4 gg = *(const f32x4*)(g + c0 + bj * 128 + 4 * n); rg[bj][n] = (f32x4){fast_rcp(gg[0]), fast_rcp(gg[1]), fast_rcp(gg[2]), fast_rcp(gg[3])}; }
#pragma unroll
    for (int ai = 0; ai < 2; ++ai)
#pragma unroll
        for (int m = 0; m < 4; ++m) {
            const unsigned ro = (unsigned)((u.pm * 256 + lr0 + 128 * ai + 16 * m) * DM + c0) * 2u;
#pragma unroll
            for (int bj = 0; bj < 2; ++bj) { const u32x4 w = *(const u32x4*)((const char*)XN + ro + bj * 256);
                acc[ai][bj][m][0] = (f32x4){bf_lo(w.x), bf_hi(w.x), bf_lo(w.y), bf_hi(w.y)} * rg[bj][0];
                acc[ai][bj][m][1] = (f32x4){bf_lo(w.z), bf_hi(w.z), bf_lo(w.w), bf_hi(w.w)} * rg[bj][1]; }
        }
}
struct HostCopy {
    const float* ck; const float* cv; float* out; unsigned base; int ncol, xskip;
    static constexpr unsigned PER_ = (unsigned)(2048 - 8) * 768 / 4;
    __device__ __forceinline__ bool on(const Unit& u) const { return ck != nullptr && !((xskip >> (u.pm & 7)) & 1); }
    __device__ __forceinline__ unsigned first(const Unit& u, int wr, int wc, int fr, int fq) const { return base + (unsigned)(ncol * u.pm + u.pn) * 4096u + (unsigned)((wr * 4 + wc) * 64 + fr + 16 * fq); }
    __device__ __forceinline__ void load(const Unit& u, int wr, int wc, int fr, int fq, f32x4 (&v)[8]) const {
        if (!on(u)) return;
        const unsigned cb = first(u, wr, wc, fr, fq);
#pragma unroll
        for (int k = 0; k < 8; ++k) { const unsigned i = cb + 512u * k, sq = i / PER_, j = i - sq * PER_, which = sq >> 5, n = sq & 31;
            v[k] = __builtin_nontemporal_load((const f32x4*)((which ? cv : ck) + (size_t)n * 2048 * 768 + (size_t)8 * 768) + j); }
    }
    __device__ __forceinline__ void store(const Unit& u, int wr, int wc, int fr, int fq, const f32x4 (&v)[8]) const {
        if (!on(u)) return;
        const unsigned cb = first(u, wr, wc, fr, fq);
#pragma unroll
        for (int k = 0; k < 8; ++k) { const unsigned i = cb + 512u * k, sq = i / PER_, j = i - sq * PER_, which = sq >> 5, n = sq & 31;
            __builtin_nontemporal_store(v[k], (f32x4*)(out + (which ? (size_t)98859008 : (size_t)48527360) + (size_t)n * 2048 * 768) + j); }
    }
};
template <bool RESX> struct EpiRes {
    const float* resP; const float* resS; const float* gp; bf16_t* XN; const float* g; float* SSQ; HostCopy hc;
    __device__ __forceinline__ void init(f32x4 (&acc)[2][2][4][2], const Unit& u, int wr, int wc, int fr, int fq) const {
        if (RESX) {
            const int lr0 = wr * 64 + fr, c0 = u.pn * 256 + wc * 32 + 8 * fq;
            const float* res = (u.pm == 128) ? resS - (size_t)MP * DM : resP;
#pragma unroll
            for (int ai = 0; ai < 2; ++ai)
#pragma unroll
                for (int m = 0; m < 4; ++m) {
                    const float* rp = res + ((size_t)u.pm * 256 + lr0 + 128 * ai + 16 * m) * DM + c0;
#pragma unroll
                    for (int bj = 0; bj < 2; ++bj) { acc[ai][bj][m][0] = *(const f32x4*)(rp + bj * 128); acc[ai][bj][m][1] = *(const f32x4*)(rp + bj * 128 + 4); }
                }
        } else init_from_xn(acc, XN, gp, u, wr, wc, fr, fq);
    }
    __device__ __forceinline__ void operator()(EPI_ARGS) const {
        const int lr0 = wr * 64 + fr, c0 = u.pn * 256 + wc * 32 + 8 * fq;
        f32x4 cpv[8]; hc.load(u, wr, wc, fr, fq, cpv);
        f32x4 gv[2][2];
#pragma unroll
        for (int bj = 0; bj < 2; ++bj)
#pragma unroll
            for (int n = 0; n < 2; ++n) gv[bj][n] = *(const f32x4*)(g + c0 + bj * 128 + 4 * n);
#pragma unroll
        for (int ai = 0; ai < 2; ++ai)
#pragma unroll
            for (int m = 0; m < 4; ++m) {
                const size_t grow = (size_t)u.pm * 256 + lr0 + 128 * ai + 16 * m; const size_t off = grow * DM + c0;
                float ss = 0.f;
#pragma unroll
                for (int bj = 0; bj < 2; ++bj) {
                    f32x4 x0 = acc[ai][bj][m][0], x1 = acc[ai][bj][m][1];
                    ss += (x0[0] * x0[0] + x0[1] * x0[1]) + (x0[2] * x0[2] + x0[3] * x0[3]) + (x1[0] * x1[0] + x1[1] * x1[1]) + (x1[2] * x1[2] + x1[3] * x1[3]);
                    x0 = x0 * gv[bj][0]; x1 = x1 * gv[bj][1];
                    u32x4 w; w.x = pkbf(x0[0], x0[1]); w.y = pkbf(x0[2], x0[3]); w.z = pkbf(x1[0], x1[1]); w.w = pkbf(x1[2], x1[3]);
                    *(u32x4*)(XN + off + bj * 128) = w;
                }
                ss += __shfl_xor(ss, 16); ss += __shfl_xor(ss, 32);
                if (fq == 0) SSQ[grow * 16 + u.pn * 4 + wc] = ss;
            }
        hc.store(u, wr, wc, fr, fq, cpv);
    }
};
struct EpiFinal {
    const bf16_t* XN; const float* gp; float* Y; const float* g; float* slots; unsigned* cnt; LAS float* xl; int wave;
    __device__ __forceinline__ void init(f32x4 (&acc)[2][2][4][2], const Unit& u, int wr, int wc, int fr, int fq) const { init_from_xn(acc, XN, gp, u, wr, wc, fr, fq); }
    __device__ __forceinline__ void operator()(EPI_ARGS) const {
        const int lr0 = wr * 64 + fr, c0 = u.pn * 256 + wc * 32 + 8 * fq;
        const int lane = fr + 16 * fq;
#pragma unroll
        for (int ai = 0; ai < 2; ++ai)
#pragma unroll
            for (int m = 0; m < 4; ++m) {
                float ss = 0.f;
#pragma unroll
                for (int bj = 0; bj < 2; ++bj)
#pragma unroll
                    for (int n = 0; n < 2; ++n) { const f32x4 x = acc[ai][bj][m][n]; ss += (x[0] * x[0] + x[1] * x[1]) + (x[2] * x[2] + x[3] * x[3]); }
                ss += __shfl_xor(ss, 16); ss += __shfl_xor(ss, 32);
                if (fq == 0) xl[(lr0 + 128 * ai + 16 * m) * 4 + wc] = ss;
            }
        asm volatile("s_waitcnt lgkmcnt(0)" ::: "memory"); __builtin_amdgcn_s_barrier(); asm volatile("" ::: "memory");
        const int row = wave * 32 + (lane & 31);
        if (lane < 32) { const f32x4 q4 = *(const LAS f32x4*)(xl + row * 4);
            __hip_atomic_store(slots + ((size_t)u.pm * 256 + row) * 4 + u.pn, (q4[0] + q4[1]) + (q4[2] + q4[3]), __ATOMIC_RELAXED, __HIP_MEMORY_SCOPE_AGENT); }
        asm volatile("s_waitcnt vmcnt(0)" ::: "memory");
        if (lane == 0) __hip_atomic_fetch_add(cnt + 64 * u.pm, 1u, __ATOMIC_RELAXED, __HIP_MEMORY_SCOPE_AGENT);
        if (wave == 0) {
            unsigned sp = 0;
            while ((unsigned)__builtin_amdgcn_readfirstlane(__hip_atomic_load(cnt + 64 * u.pm, __ATOMIC_RELAXED, __HIP_MEMORY_SCOPE_AGENT)) < 32u) { __builtin_amdgcn_s_sleep(2); if (++sp > (1u << 21)) break; }
            __builtin_amdgcn_fence(__ATOMIC_ACQUIRE, "agent");
        }
        asm volatile("s_waitcnt vmcnt(0) lgkmcnt(0)" ::: "memory"); __builtin_amdgcn_s_barrier(); asm volatile("" ::: "memory");
        if (lane < 32) { const float* sl = slots + ((size_t)u.pm * 256 + row) * 4; float t = 0.f;
#pragma unroll
            for (int k = 0; k < 4; ++k) t += __hip_atomic_load(sl + k, __ATOMIC_RELAXED, __HIP_MEMORY_SCOPE_AGENT);
            xl[1024 + row] = 1.0f / sqrtf(t * (1.0f / DM) + EPS); }
        asm volatile("s_waitcnt vmcnt(0) lgkmcnt(0)" ::: "memory"); __builtin_amdgcn_s_barrier(); asm volatile("" ::: "memory");
        f32x4 gg[2][2];
#pragma unroll
        for (int bj = 0; bj < 2; ++bj) { gg[bj][0] = *(const f32x4*)(g + c0 + bj * 128); gg[bj][1] = *(const f32x4*)(g + c0 + bj * 128 + 4); }
#pragma unroll
        for (int ai = 0; ai < 2; ++ai)
#pragma unroll
            for (int m = 0; m < 4; ++m) {
                const int lr = lr0 + 128 * ai + 16 * m; const float rs = xl[1024 + lr]; float* yp = Y + ((size_t)u.pm * 256 + lr) * DM + c0;
#pragma unroll
                for (int bj = 0; bj < 2; ++bj) { *(f32x4*)(yp + bj * 128) = acc[ai][bj][m][0] * rs * gg[bj][0]; *(f32x4*)(yp + bj * 128 + 4) = acc[ai][bj][m][1] * rs * gg[bj][1]; }
                asm volatile("" ::: "memory");
            }
        asm volatile("s_waitcnt lgkmcnt(0)" ::: "memory"); __builtin_amdgcn_s_barrier(); asm volatile("" ::: "memory");
    }
};
__device__ __forceinline__ float row_rstd(const float* SSQ, size_t grow) {
    const f32x4* p = (const f32x4*)(SSQ + grow * 16); const f32x4 a = p[0], b = p[1], c = p[2], d = p[3];
    const float s = ((a[0] + a[1]) + (a[2] + a[3])) + ((b[0] + b[1]) + (b[2] + b[3])) + ((c[0] + c[1]) + (c[2] + c[3])) + ((d[0] + d[1]) + (d[2] + d[3]));
    return 1.0f / sqrtf(s * (1.0f / DM) + EPS);
}
__device__ __forceinline__ void rows_rstd8(const float* SSQ, size_t row0, int fq, float (&rs)[2][4]) {
    f32x4 pre[2][4];
#pragma unroll
    for (int ai = 0; ai < 2; ++ai)
#pragma unroll
        for (int m = 0; m < 4; ++m) pre[ai][m] = *(const f32x4*)(SSQ + (row0 + 128 * ai + 16 * m) * 16 + fq * 4);
    __builtin_amdgcn_sched_barrier(0);
#pragma unroll
    for (int ai = 0; ai < 2; ++ai)
#pragma unroll
        for (int m = 0; m < 4; ++m) { float sq = (pre[ai][m][0] + pre[ai][m][1]) + (pre[ai][m][2] + pre[ai][m][3]); sq += __shfl_xor(sq, 16); sq += __shfl_xor(sq, 32);
            rs[ai][m] = 1.0f / sqrtf(sq * (1.0f / DM) + EPS); }
}
struct EpiScale {
    bf16_t* O; const float* SSQ; float sc; HostCopy hc;
    EPI_ZERO_INIT
    __device__ __forceinline__ void operator()(EPI_ARGS) const {
        const int lr0 = wr * 64 + fr, c0 = u.pn * 256 + wc * 32 + 8 * fq;
        float rsv[2][4]; rows_rstd8(SSQ, (size_t)u.pm * 256 + lr0, fq, rsv);
        f32x4 cpv[8]; hc.load(u, wr, wc, fr, fq, cpv);
#pragma unroll
        for (int ai = 0; ai < 2; ++ai)
#pragma unroll
            for (int m = 0; m < 4; ++m) {
                const size_t grow = (size_t)u.pm * 256 + lr0 + 128 * ai + 16 * m; const float rs = rsv[ai][m] * sc;
#pragma unroll
                for (int bj = 0; bj < 2; ++bj) {
                    const f32x4 v0 = acc[ai][bj][m][0] * rs, v1 = acc[ai][bj][m][1] * rs;
                    u32x4 w; w.x = pkbf(v0[0], v0[1]); w.y = pkbf(v0[2], v0[3]); w.z = pkbf(v1[0], v1[1]); w.w = pkbf(v1[2], v1[3]);
                    *(u32x4*)(O + grow * DM + c0 + bj * 128) = w;
                }
            }
        hc.store(u, wr, wc, fr, fq, cpv);
    }
};
struct EpiSwiGLU {
    bf16_t* H; const float* SSQ; const float* ck; const float* cv; float* out; int xskip;
    EPI_ZERO_INIT
    __device__ __forceinline__ void operator()(EPI_ARGS) const {
        const int lr0 = wr * 64 + fr, c0 = u.pn * 128 + wc * 32 + 8 * fq;
        float rsv[2][4]; rows_rstd8(SSQ, (size_t)u.pm * 256 + lr0, fq, rsv);
        constexpr unsigned PER_ = (unsigned)(WBUF - TS) * AW / 4;
        const unsigned cbase = (unsigned)(u.pm * 22 + u.pn) * 6144u + (unsigned)((wr * 4 + wc) * 64 + fr + 16 * fq);
        const bool host = !((xskip >> (u.pm & 7)) & 1);
        f32x4 cpv[12];
        if (host)
#pragma unroll
        for (int k = 0; k < 12; ++k) { const unsigned i = cbase + 512u * k, sq = i / PER_, j = i - sq * PER_, which = sq >> 5, n = sq & 31;
            cpv[k] = __builtin_nontemporal_load((const f32x4*)((which ? cv : ck) + (size_t)n * WBUF * AW + (size_t)TS * AW) + j); }
#pragma unroll
        for (int ai = 0; ai < 2; ++ai)
#pragma unroll
            for (int m = 0; m < 4; ++m) {
                const size_t grow = (size_t)u.pm * 256 + lr0 + 128 * ai + 16 * m; const float rs = rsv[ai][m];
                float hv[8];
#pragma unroll
                for (int n = 0; n < 2; ++n)
#pragma unroll
                    for (int e = 0; e < 4; ++e) { const float gt = acc[ai][0][m][n][e] * rs, up = acc[ai][1][m][n][e] * rs; hv[4 * n + e] = gt * fast_rcp(1.f + fast_exp2(-gt * LOG2E)) * up; }
                u32x4 w; w.x = pkbf(hv[0], hv[1]); w.y = pkbf(hv[2], hv[3]); w.z = pkbf(hv[4], hv[5]); w.w = pkbf(hv[6], hv[7]);
                *(u32x4*)(H + grow * DFF + c0) = w;
            }
        if (host)
#pragma unroll
        for (int k = 0; k < 12; ++k) { const unsigned i = cbase + 512u * k, sq = i / PER_, j = i - sq * PER_, which = sq >> 5, n = sq & 31;
            __builtin_nontemporal_store(cpv[k], (f32x4*)(out + (which ? OFF_SWV : OFF_SWK) + (size_t)n * WBUF * AW) + j); }
    }
};
struct EpiSoftmax {
    bf16_t* P; float* LSUM; LAS float* xch;
    EPI_ZERO_INIT
    __device__ __forceinline__ void operator()(EPI_ARGS) const {
        const int lr0 = wr * 64 + fr, c0 = u.pn * 256 + wc * 32 + 8 * fq;
#pragma unroll
        for (int ai = 0; ai < 2; ++ai)
#pragma unroll
            for (int m = 0; m < 4; ++m) {
                float v = -3.0e38f;
#pragma unroll
                for (int bj = 0; bj < 2; ++bj)
#pragma unroll
                    for (int n = 0; n < 2; ++n) { const f32x4 x = acc[ai][bj][m][n]; v = fmaxf(v, fmaxf(fmaxf(x[0], x[1]), fmaxf(x[2], x[3]))); }
                v = fmaxf(v, __shfl_xor(v, 16)); v = fmaxf(v, __shfl_xor(v, 32));
                if (fq == 0) xch[(lr0 + 128 * ai + 16 * m) * 4 + wc] = v;
            }
        asm volatile("s_waitcnt lgkmcnt(0)" ::: "memory"); __builtin_amdgcn_s_barrier(); asm volatile("" ::: "memory");
#pragma unroll
        for (int ai = 0; ai < 2; ++ai)
#pragma unroll
            for (int m = 0; m < 4; ++m) {
                const f32x4 q4 = *(const LAS f32x4*)(xch + (lr0 + 128 * ai + 16 * m) * 4); const float mx = fmaxf(fmaxf(q4[0], q4[1]), fmaxf(q4[2], q4[3]));
                const size_t grow = (size_t)u.pm * 256 + lr0 + 128 * ai + 16 * m; float ss = 0.f;
#pragma unroll
                for (int bj = 0; bj < 2; ++bj) {
                    f32x4 p0, p1;
#pragma unroll
                    for (int e = 0; e < 4; ++e) { p0[e] = fast_exp2(acc[ai][bj][m][0][e] - mx); p1[e] = fast_exp2(acc[ai][bj][m][1][e] - mx); }
                    ss += ((p0[0] + p0[1]) + (p0[2] + p0[3])) + ((p1[0] + p1[1]) + (p1[2] + p1[3]));
                    u32x4 w; w.x = pkbf(p0[0], p0[1]); w.y = pkbf(p0[2], p0[3]); w.z = pkbf(p1[0], p1[1]); w.w = pkbf(p1[2], p1[3]);
                    *(u32x4*)(P + grow * DM + c0 + bj * 128) = w;
                }
                ss += __shfl_xor(ss, 16); ss += __shfl_xor(ss, 32);
                if (fq == 0) LSUM[grow * 16 + u.pn * 4 + wc] = ss;
                asm volatile("" ::: "memory"); __builtin_amdgcn_sched_barrier(0);
            }
    }
};
struct EpiPV {
    bf16_t* O; const float* LSUM; HostCopy hc;
    EPI_ZERO_INIT
    __device__ __forceinline__ void operator()(EPI_ARGS) const {
        const int lr0 = wr * 64 + fr, c0 = u.pn * 256 + wc * 32 + 8 * fq;
        f32x4 pre[2][4];
#pragma unroll
        for (int ai = 0; ai < 2; ++ai)
#pragma unroll
            for (int m = 0; m < 4; ++m) pre[ai][m] = *(const f32x4*)(LSUM + ((size_t)u.pm * 256 + lr0 + 128 * ai + 16 * m) * 16 + u.pn * 4);
        f32x4 cpv[8]; hc.load(u, wr, wc, fr, fq, cpv);
        __builtin_amdgcn_sched_barrier(0);
#pragma unroll
        for (int ai = 0; ai < 2; ++ai)
#pragma unroll
            for (int m = 0; m < 4; ++m) {
                const size_t grow = (size_t)u.pm * 256 + lr0 + 128 * ai + 16 * m;
                const f32x4 l4 = pre[ai][m]; const float rs = 1.0f / ((l4[0] + l4[1]) + (l4[2] + l4[3]));
#pragma unroll
                for (int bj = 0; bj < 2; ++bj) {
                    const f32x4 v0 = acc[ai][bj][m][0] * rs, v1 = acc[ai][bj][m][1] * rs;
                    u32x4 w; w.x = pkbf(v0[0], v0[1]); w.y = pkbf(v0[2], v0[3]); w.z = pkbf(v1[0], v1[1]); w.w = pkbf(v1[2], v1[3]);
                    *(u32x4*)(O + grow * DM + c0 + bj * 128) = w;
                }
            }
        hc.store(u, wr, wc, fr, fq, cpv);
    }
};
}

#define XB_TMO      128
#define XB_XCNT(j)  (256  + 64 * (j))
#define XB_XSUB(j)  (1280 + 64 * (j))
#define XB_XGEN(j)  (2304 + 64 * (j))
#define XB_TOP      3328
#define XB_TOPGEN   3392
#define XCD_BAR_WORDS 3456
#define XB_SPIN_CAP (1u << 18)
__device__ __forceinline__ unsigned xb_ld(unsigned* p)              { return __hip_atomic_load(p, __ATOMIC_RELAXED, __HIP_MEMORY_SCOPE_AGENT); }
__device__ __forceinline__ unsigned xb_add(unsigned* p, unsigned v) { return __hip_atomic_fetch_add(p, v, __ATOMIC_RELAXED, __HIP_MEMORY_SCOPE_AGENT); }
__device__ __forceinline__ unsigned xb_xcc_id() { return (unsigned)__builtin_amdgcn_s_getreg((3 << 11) | 20) & 0xFu; }
#define XB_SPIN(cond, bar) do { unsigned _sp = 0; while (cond) { __builtin_amdgcn_s_sleep(1); \
    if ((++_sp & 255u) == 0u) { if (xb_ld(&(bar)[XB_TMO])) break; if (_sp > XB_SPIN_CAP) { atomicAdd(&(bar)[XB_TMO], 1u); break; } } } } while (0)
struct XcdBarrier { unsigned* bar; unsigned x; volatile LAS unsigned* st; };
__device__ __forceinline__ XcdBarrier xcd_barrier_post(unsigned* bar, volatile LAS unsigned* st) {
    XcdBarrier b; b.bar = bar; b.x = xb_xcc_id(); b.st = st;
    if (threadIdx.x == 0) st[3] = xb_add(&bar[XB_XCNT(b.x)], 1u);
    return b;
}
__device__ __forceinline__ void xcd_barrier_complete(unsigned* bar, unsigned x, unsigned& nloc, unsigned& nx, unsigned& xi) {
    const unsigned G = gridDim.x * gridDim.y * gridDim.z;
    unsigned sum, cnt, mine, sp = 0u;
    for (;;) {
        sum = 0u; cnt = 0u; mine = 0u; xi = 0u;
#pragma unroll
        for (unsigned j = 0; j < 16; ++j) { const unsigned c = xb_ld(&bar[XB_XCNT(j)]); sum += c; cnt += (c > 0u) ? 1u : 0u; mine = (j == x) ? c : mine; xi += (c > 0u && j < x) ? 1u : 0u; }
        if (sum == G) break;
        __builtin_amdgcn_s_sleep(1);
        if ((++sp & 255u) == 0u) { if (xb_ld(&bar[XB_TMO])) break; if (sp > XB_SPIN_CAP) { atomicAdd(&bar[XB_TMO], 1u); break; } }
    }
    nloc = mine > 0u ? mine : 1u; nx = cnt > 0u ? cnt : 1u;
}
__device__ __forceinline__ void xcd_barrier(const XcdBarrier& b) {
    asm volatile("s_waitcnt vmcnt(0)" ::: "memory");
    __syncthreads();
    if (threadIdx.x == 0) {
        unsigned* bar = b.bar;
        __builtin_amdgcn_s_waitcnt(0);
        unsigned nloc = b.st[0], nx = b.st[1];
        if (nloc == 0u) { unsigned xi; xcd_barrier_complete(bar, b.x, nloc, nx, xi); b.st[0] = nloc; b.st[1] = nx; b.st[2] = xi; }
        const unsigned old = xb_add(&bar[XB_XSUB(b.x)], 1u);
        const unsigned gen = old / nloc;
        if (old + 1u == (gen + 1u) * nloc) {
            __builtin_amdgcn_fence(__ATOMIC_RELEASE, "agent");
            asm volatile("s_waitcnt vmcnt(0)" ::: "memory");
            const unsigned og = xb_add(&bar[XB_TOP], 1u);
            const unsigned tg = og / nx;
            if (og + 1u == (tg + 1u) * nx) xb_add(&bar[XB_TOPGEN], 1u);
            else XB_SPIN(xb_ld(&bar[XB_TOPGEN]) == tg, bar);
            __builtin_amdgcn_fence(__ATOMIC_ACQUIRE, "agent");
            xb_add(&bar[XB_XGEN(b.x)], 1u);
            asm volatile("s_waitcnt vmcnt(0)" ::: "memory");
        } else {
            XB_SPIN(xb_ld(&bar[XB_XGEN(b.x)]) == gen, bar);
            __builtin_amdgcn_fence(__ATOMIC_ACQUIRE, "agent");
            asm volatile("s_waitcnt vmcnt(0)" ::: "memory");
        }
    }
    __syncthreads();
}

#define XL_SUB(j) (3584 + 64 * (j))
#define XL_GEN(j) (12416 + 64 * (j))
__device__ __forceinline__ void xl_barrier(const XcdBarrier& b) {
    asm volatile("s_waitcnt vmcnt(0)" ::: "memory");
    __syncthreads();
    if (threadIdx.x == 0) {
        unsigned* bar = b.bar; const unsigned nloc = b.st[0], xd = b.st[2] & 7u;
        const unsigned old = xb_add(&bar[XL_SUB(xd)], 1u), gen = old / nloc;
        if (old + 1u == (gen + 1u) * nloc) xb_add(&bar[XL_GEN(xd)], 1u);
        else XB_SPIN(xb_ld(&bar[XL_GEN(xd)]) == gen, bar);
        __builtin_amdgcn_fence(__ATOMIC_ACQUIRE, "agent");
        asm volatile("s_waitcnt vmcnt(0)" ::: "memory");
    }
    __syncthreads();
}

constexpr int RING_BYTES = 131072;
constexpr int XCH_OFF = RING_BYTES;
constexpr int MISC_OFF = RING_BYTES + 6144;
constexpr int LDS_BYTES = RING_BYTES + 8192;
constexpr int ATT_V_OFF = 0, ATT_WBUF = 12800, ATT_TAB_OFF = 8 * ATT_WBUF, ATT_CW_OFF = 65536;

struct Params {
    const float* in[27]; float* out; unsigned char* ws; int ph_lo, ph_hi, coop, pad;
};

__device__ __forceinline__ float wave_sum(float v) {
#pragma unroll
    for (int o = 1; o < 64; o <<= 1) v += __shfl_xor(v, o);
    return v;
}
__device__ __forceinline__ void transpose_item(const float* W, int K, int N, bf16_t* WT, int item, int mode, LAS float* scr, int lane) {
    const int nblk = N / 32, kb = item / nblk, nb = item % nblk, k0 = 64 * kb, n0 = 32 * nb;
    int r0 = n0;
    if (mode == 1) { if (n0 >= 2304) { const int isg = n0 >= 2560, cch = n0 - (isg ? 2560 : 2304); r0 = 2304 + (cch >> 7) * 256 + isg * 128 + (cch & 127); } }
    else if (mode == 2) r0 = (n0 >> 7) * 256 + (n0 & 127);
    else if (mode == 3) r0 = (n0 >> 7) * 256 + 128 + (n0 & 127);
    float wv[32];
#pragma unroll
    for (int i = 0; i < 32; ++i) wv[i] = W[(size_t)(k0 + 2 * i + (lane >> 5)) * N + n0 + (lane & 31)];
#pragma unroll
    for (int i = 0; i < 32; ++i) scr[(2 * i + (lane >> 5)) * 33 + (lane & 31)] = wv[i];
    asm volatile("s_waitcnt lgkmcnt(0)" ::: "memory");
    const int c = lane & 7;
#pragma unroll
    for (int j = 0; j < 4; ++j) { const int n = (lane >> 3) + 8 * j; const LAS float* s = scr + (8 * c) * 33 + n;
        u32x4 o; o.x = pkbf(s[0 * 33], s[1 * 33]); o.y = pkbf(s[2 * 33], s[3 * 33]); o.z = pkbf(s[4 * 33], s[5 * 33]); o.w = pkbf(s[6 * 33], s[7 * 33]);
        *(u32x4*)(WT + (size_t)(r0 + n) * K + k0 + 8 * c) = o; }
    asm volatile("s_waitcnt lgkmcnt(0)" ::: "memory");
}
template <int NR> __device__ __forceinline__ void rms_rows_bf16(const float* const (&xrow)[NR], const float* g, bf16_t* const (&orow)[NR], int lane) {
    f32x4 v[NR][4];
#pragma unroll
    for (int r = 0; r < NR; ++r)
#pragma unroll
        for (int j = 0; j < 4; ++j) v[r][j] = ((const f32x4*)xrow[r] + lane)[64 * j];
    const f32x4* gr = (const f32x4*)g + lane;
    f32x4 gg[4];
#pragma unroll
    for (int j = 0; j < 4; ++j) gg[j] = gr[64 * j];
#pragma unroll
    for (int r = 0; r < NR; ++r) {
        float s = 0.f;
#pragma unroll
        for (int j = 0; j < 4; ++j) s += (v[r][j][0] * v[r][j][0] + v[r][j][1] * v[r][j][1]) + (v[r][j][2] * v[r][j][2] + v[r][j][3] * v[r][j][3]);
        const float rstd = 1.0f / sqrtf(wave_sum(s) * (1.0f / DM) + EPS);
        u32x2* o8 = (u32x2*)orow[r] + lane;
#pragma unroll
        for (int j = 0; j < 4; ++j) { u32x2 w; w.x = pkbf(v[r][j][0] * rstd * gg[j][0], v[r][j][1] * rstd * gg[j][1]); w.y = pkbf(v[r][j][2] * rstd * gg[j][2], v[r][j][3] * rstd * gg[j][3]); o8[64 * j] = w; }
    }
}

namespace att {
__device__ __forceinline__ int crow(int r, int hi) { return (r & 3) + 8 * (r >> 2) + 4 * hi; }
struct Ctx {
    const bf16_t *QB, *KB, *VB; const float *CK, *CV;
    bf16_t* OP; float* LSE; bf16_t* ATT;
};
__device__ __forceinline__ bf16x8 ld8_bf16(const bf16_t* p) { return *(const bf16x8*)p; }
__device__ __forceinline__ bf16x8 ld8_f32(const float* p) {
    const f32x4 a = *(const f32x4*)p, b = *(const f32x4*)(p + 4); u32x4 w; w.x = pkbf(a[0], a[1]); w.y = pkbf(a[2], a[3]); w.z = pkbf(b[0], b[1]); w.w = pkbf(b[2], b[3]);
    return __builtin_bit_cast(bf16x8, w);
}
template <int MODE> __device__ __forceinline__ bf16x8 ld_kv(const bf16_t* B16, const float* C32, int bq, int h, int dil, int r, int idx, int doff, bool newrows) {
    if (MODE == 0) { const int ii = idx < 0 ? 0 : idx; return ld8_bf16(B16 + ((size_t)bq * SEQ + r + (size_t)dil * ii) * AW + h * HD + doff); }
    int p = r + dil * idx;
    if (!newrows) return ld8_f32(C32 + (((size_t)bq * WBUF + p) * NH + h) * HD + doff);
    p = p > (WBUF + TS - 1) ? (WBUF + TS - 1) : p;
    return ld8_bf16(B16 + ((size_t)MP + bq * TS + (p - WBUF)) * AW + h * HD + doff);
}
template <int MODE> __device__ __forceinline__ void ld_kv4(bf16x8 (&dst)[4], const bf16_t* B16, const float* C32, int bq, int h, int dil, int r, int idx0, int doff, bool newrows) {
    if (MODE == 1 && !newrows) {
        f32x4 raw[4][2];
#pragma unroll
        for (int i = 0; i < 4; ++i) { const float* p = C32 + (((size_t)bq * WBUF + (r + dil * (idx0 + 8 * i))) * NH + h) * HD + doff; raw[i][0] = *(const f32x4*)p; raw[i][1] = *(const f32x4*)(p + 4); }
        __builtin_amdgcn_sched_barrier(0);
#pragma unroll
        for (int i = 0; i < 4; ++i) { u32x4 w; w.x = pkbf(raw[i][0][0], raw[i][0][1]); w.y = pkbf(raw[i][0][2], raw[i][0][3]); w.z = pkbf(raw[i][1][0], raw[i][1][1]); w.w = pkbf(raw[i][1][2], raw[i][1][3]);
            dst[i] = __builtin_bit_cast(bf16x8, w); }
    } else {
#pragma unroll
        for (int i = 0; i < 4; ++i) dst[i] = ld_kv<MODE>(B16, C32, bq, h, dil, r, idx0 + 8 * i, doff, newrows);
    }
}
template <int MODE> __device__ __forceinline__ void wave_block(const Ctx& c, int bq, int h, int g, int dil, int r, int i0, int nq, const LAS float* tab, LAS unsigned char* wbuf) {
    const int lane = fresh_lane(), r32 = lane & 31, hi = lane >> 5;
    const int vkey = lane >> 3, vch = lane & 7;
    const bool qvalid = r32 < nq; const int qq = qvalid ? r32 : 0;
    size_t qtok;
    if (MODE == 0) qtok = (size_t)bq * SEQ + r + (size_t)dil * (i0 + qq);
    else qtok = (size_t)MP + bq * TS + (r + dil * (i0 + qq) - WBUF);
    LAS unsigned char* kb = wbuf; LAS unsigned char* vbuf = wbuf + 4608;
    bf16x8 qv[4];
#pragma unroll
    for (int i = 0; i < 4; ++i) { int qi = 8 * i + vkey; qi = qi < nq ? qi : 0;
        const size_t tk = (MODE == 0) ? (size_t)bq * SEQ + r + (size_t)dil * (i0 + qi) : (size_t)MP + bq * TS + (r + dil * (i0 + qi) - WBUF);
        qv[i] = ld8_bf16(c.QB + tk * AW + h * HD + vch * 8); }
    bf16x8 kr[5][4];
    constexpr int KA = (MODE == 0) ? 5 : 2;
#pragma unroll
    for (int s = 0; s < KA; ++s)
        ld_kv4<MODE>(kr[s], c.KB, c.CK, bq, h, dil, r, i0 - 128 + 32 * s + vkey, vch * 8, s == 4);
#pragma unroll
    for (int i = 0; i < 4; ++i) *(LAS bf16x8*)(kb + (8 * i + vkey) * 144 + vch * 16) = qv[i];
    bf16x8 qr[4];
#pragma unroll
    for (int d0 = 0; d0 < 4; ++d0) qr[d0] = *(const LAS bf16x8*)(kb + r32 * 144 + d0 * 32 + hi * 16);
    f32x16 S[5];
#pragma unroll
    for (int s = 0; s < 5; ++s) {
        if (MODE != 0 && s + KA < 5) {
            ld_kv4<MODE>(kr[s + KA], c.KB, c.CK, bq, h, dil, r, i0 - 128 + 32 * (s + KA) + vkey, vch * 8, s + KA == 4);
        }
#pragma unroll
        for (int i = 0; i < 4; ++i) *(LAS bf16x8*)(kb + (8 * i + vkey) * 144 + vch * 16) = kr[s][i];
        bf16x8 kf[4];
#pragma unroll
        for (int d0 = 0; d0 < 4; ++d0) kf[d0] = *(const LAS bf16x8*)(kb + r32 * 144 + d0 * 32 + hi * 16);
        f32x16 a = {};
#pragma unroll
        for (int d0 = 0; d0 < 4; ++d0) a = __builtin_amdgcn_mfma_f32_32x32x16_bf16(kf[d0], qr[d0], a, 0, 0, 0);
        S[s] = a;
        __builtin_amdgcn_sched_barrier(0);
    }
    bf16x8 vr[5][4];
#pragma unroll
    for (int s = 0; s < KA; ++s)
        ld_kv4<MODE>(vr[s], c.VB, c.CV, bq, h, dil, r, i0 - 128 + 32 * s + vkey, vch * 8, s == 4);
    __builtin_amdgcn_sched_barrier(0);
    const LAS float* tb = tab + 159 + r32 - 4 * hi;
#pragma unroll
    for (int s = 0; s < 5; ++s)
#pragma unroll
        for (int rr = 0; rr < 16; ++rr) S[s][rr] += tb[-(32 * s + (rr & 3) + 8 * (rr >> 2))];
    if (MODE == 0 && i0 < 128) {
#pragma unroll
        for (int s = 0; s < 5; ++s)
#pragma unroll
            for (int rr = 0; rr < 16; ++rr) if (i0 - 128 + 32 * s + crow(rr, hi) < 0) S[s][rr] = -1e30f;
    }
    float mx = -3.0e38f;
#pragma unroll
    for (int s = 0; s < 5; ++s)
#pragma unroll
        for (int rr = 0; rr < 16; ++rr) mx = fmaxf(mx, S[s][rr]);
    mx = fmaxf(mx, __shfl_xor(mx, 32));
    float l = 0.f;
#pragma unroll
    for (int s = 0; s < 5; ++s)
#pragma unroll
        for (int rr = 0; rr < 16; ++rr) { const float p = fast_exp2(S[s][rr] - mx); S[s][rr] = p; l += p; }
    l += __shfl_xor(l, 32);
    f32x16 o[2]; o[0] = (f32x16){}; o[1] = (f32x16){};
    const int vrd = (4 * hi + ((lane & 15) >> 2)) * 64 + ((lane >> 4) & 1) * 32 + (lane & 3) * 8;
    __builtin_amdgcn_sched_barrier(0);
#pragma unroll
    for (int s = 0; s < 5; ++s) {
        LAS unsigned char* vb = vbuf + (s & 1) * 4096;
#pragma unroll
        for (int i = 0; i < 4; ++i) *(LAS bf16x8*)(vb + (vch >> 2) * 2048 + (8 * i + vkey) * 64 + (vch & 3) * 16) = vr[s][i];
        if (MODE != 0 && s + KA < 5) {
            ld_kv4<MODE>(vr[s + KA], c.VB, c.CV, bq, h, dil, r, i0 - 128 + 32 * (s + KA) + vkey, vch * 8, s + KA == 4);
        }
#pragma unroll
        for (int sp = 0; sp < 2; ++sp) {
            u32x4 pw; pw.x = pkbf(S[s][8 * sp + 0], S[s][8 * sp + 1]); pw.y = pkbf(S[s][8 * sp + 2], S[s][8 * sp + 3]); pw.z = pkbf(S[s][8 * sp + 4], S[s][8 * sp + 5]); pw.w = pkbf(S[s][8 * sp + 6], S[s][8 * sp + 7]);
            const bf16x8 pf = __builtin_bit_cast(bf16x8, pw);
#pragma unroll
            for (int dt = 0; dt < 2; ++dt) {
                const s16x4 lo = __builtin_bit_cast(s16x4, __builtin_amdgcn_ds_read_tr16_b64_v4i16((LAS s16x4*)(vb + vrd + dt * 2048 + sp * 1024)));
                const s16x4 hh = __builtin_bit_cast(s16x4, __builtin_amdgcn_ds_read_tr16_b64_v4i16((LAS s16x4*)(vb + vrd + dt * 2048 + sp * 1024 + 512)));
                const bf16x8 vf = (bf16x8){lo[0], lo[1], lo[2], lo[3], hh[0], hh[1], hh[2], hh[3]};
                o[dt] = __builtin_amdgcn_mfma_f32_32x32x16_bf16(vf, pf, o[dt], 0, 0, 0);
            }
        }
        __builtin_amdgcn_sched_barrier(0);
    }
    {
        const float inv = 1.0f / l;
#pragma unroll
        for (int dt = 0; dt < 2; ++dt)
#pragma unroll
            for (int rg = 0; rg < 4; ++rg) { u32x2 w; w.x = pkbf(o[dt][4 * rg] * inv, o[dt][4 * rg + 1] * inv); w.y = pkbf(o[dt][4 * rg + 2] * inv, o[dt][4 * rg + 3] * inv);
                *(LAS u32x2*)(kb + r32 * 144 + (32 * dt + 8 * rg + 4 * hi) * 2) = w; }
        if (qvalid && hi == 0) c.LSE[(size_t)g * LSE_STRIDE + qtok * NH + h] = mx + __log2f(l);
#pragma unroll
        for (int i = 0; i < 4; ++i) { const int qi = 8 * i + vkey;
            if (qi < nq) {
                const size_t tk = (MODE == 0) ? (size_t)bq * SEQ + r + (size_t)dil * (i0 + qi) : (size_t)MP + bq * TS + (r + dil * (i0 + qi) - WBUF);
                *(u32x4*)(c.OP + (size_t)g * OP_STRIDE + tk * AW + h * HD + vch * 8) = *(const LAS u32x4*)(kb + qi * 144 + vch * 16);
            } }
    }
}
struct PDesc { int b, h, g, dil, r, i0; };
__device__ __forceinline__ unsigned ptok(const PDesc& d, int idx) { return (unsigned)(d.b * SEQ + d.r + d.dil * idx); }
__device__ __forceinline__ bf16x8 ld8_off(const bf16_t* base, unsigned byte_off) { return *(const bf16x8*)((const char*)base + byte_off); }
__device__ __forceinline__ void p_load_q(const Ctx& c, const PDesc& d, bf16x8 (&qv)[4], int vkey, int vch) {
    const unsigned o0 = (ptok(d, d.i0 + vkey) * AW + d.h * HD + vch * 8) * 2u, st = (unsigned)(8 * d.dil * AW * 2);
#pragma unroll
    for (int i = 0; i < 4; ++i) qv[i] = ld8_off(c.QB, o0 + i * st);
}
__device__ __forceinline__ void p_load_kv(const bf16_t* B, const PDesc& d, int s, bf16x8 (&x)[4], int vkey, int vch) {
    const unsigned cb = (unsigned)((d.b * SEQ + d.r) * AW + d.h * HD + vch * 8) * 2u, st = (unsigned)(d.dil * AW * 2);
#pragma unroll
    for (int i = 0; i < 4; ++i) { int idx = d.i0 - 128 + 32 * s + 8 * i + vkey; idx = idx < 0 ? 0 : idx; x[i] = ld8_off(B, cb + (unsigned)idx * st); }
}
__device__ __forceinline__ void pblock(const Ctx& c, const PDesc& cur, const PDesc& nxt, bool has_next, bf16x8 (&qv)[4], bf16x8 (&kr)[5][4], const LAS float* tabs, LAS unsigned char* wbuf) {
    const int lane = fresh_lane(), r32 = lane & 31, hi = lane >> 5, vkey = lane >> 3, vch = lane & 7;
    LAS unsigned char* vbuf = wbuf;
    LAS unsigned char* kb = wbuf + 8192;
    const int kwr = vkey * 128 + ((vch ^ (vkey & 7)) << 4);
    const int krd0 = r32 * 128, kx = r32 & 7;
    const int i0 = cur.i0;
#pragma unroll
    for (int i = 0; i < 4; ++i) *(LAS bf16x8*)(kb + (8 * i + vkey) * 144 + vch * 16) = qv[i];
    bf16x8 qr[4];
#pragma unroll
    for (int d0 = 0; d0 < 4; ++d0) qr[d0] = *(const LAS bf16x8*)(kb + r32 * 144 + d0 * 32 + hi * 16);
    f32x16 S[5];
    bf16x8 vr[5][4];
    p_load_kv(c.KB, cur, 2, kr[2], vkey, vch); p_load_kv(c.KB, cur, 3, kr[3], vkey, vch); p_load_kv(c.KB, cur, 4, kr[4], vkey, vch);
#pragma unroll
    for (int s = 0; s < 5; ++s) {
        LAS unsigned char* kp = vbuf + (s & 1) * 4096;
#pragma unroll
        for (int i = 0; i < 4; ++i) *(LAS bf16x8*)(kp + i * 1024 + kwr) = kr[s][i];
        if (s < 3) p_load_kv(c.VB, cur, s, vr[s], vkey, vch);
        bf16x8 kf[4];
#pragma unroll
        for (int d0 = 0; d0 < 4; ++d0) kf[d0] = *(const LAS bf16x8*)(kp + krd0 + (((2 * d0 + hi) ^ kx) << 4));
        f32x16 a = {};
#pragma unroll
        for (int d0 = 0; d0 < 4; ++d0) a = __builtin_amdgcn_mfma_f32_32x32x16_bf16(kf[d0], qr[d0], a, 0, 0, 0);
        S[s] = a;
    }
    __builtin_amdgcn_sched_barrier(0);
    const LAS float* tb = tabs + (cur.g * 12 + cur.h) * 192 + 159 + r32 - 4 * hi;
#pragma unroll
    for (int s = 0; s < 5; ++s)
#pragma unroll
        for (int rr = 0; rr < 16; ++rr) S[s][rr] += tb[-(32 * s + (rr & 3) + 8 * (rr >> 2))];
    if (i0 < 128) {
#pragma unroll
        for (int s = 0; s < 5; ++s)
#pragma unroll
            for (int rr = 0; rr < 16; ++rr) if (i0 - 128 + 32 * s + crow(rr, hi) < 0) S[s][rr] = -1e30f;
    }
    float mx = -3.0e38f;
#pragma unroll
    for (int s = 0; s < 5; ++s)
#pragma unroll
        for (int rr = 0; rr < 16; ++rr) mx = fmaxf(mx, S[s][rr]);
    mx = fmaxf(mx, __shfl_xor(mx, 32));
    float l = 0.f;
    bf16x8 pf[5][2];
#pragma unroll
    for (int s = 0; s < 5; ++s) {
#pragma unroll
        for (int rr = 0; rr < 16; ++rr) { const float p = fast_exp2(S[s][rr] - mx); S[s][rr] = p; l += p; }
#pragma unroll
        for (int sp = 0; sp < 2; ++sp) { u32x4 pw; pw.x = pkbf(S[s][8 * sp + 0], S[s][8 * sp + 1]); pw.y = pkbf(S[s][8 * sp + 2], S[s][8 * sp + 3]); pw.z = pkbf(S[s][8 * sp + 4], S[s][8 * sp + 5]); pw.w = pkbf(S[s][8 * sp + 6], S[s][8 * sp + 7]);
            pf[s][sp] = __builtin_bit_cast(bf16x8, pw); asm volatile("" : "+v"(pf[s][sp])); }
    }
    l += __shfl_xor(l, 32);
    __builtin_amdgcn_sched_barrier(0);
    p_load_kv(c.VB, cur, 3, vr[3], vkey, vch); p_load_kv(c.VB, cur, 4, vr[4], vkey, vch);
    f32x16 o[2]; o[0] = (f32x16){}; o[1] = (f32x16){};
    const int vrd = (4 * hi + ((lane & 15) >> 2)) * 64 + ((lane >> 4) & 1) * 32 + (lane & 3) * 8;
    __builtin_amdgcn_sched_barrier(0);
#pragma unroll
    for (int s = 0; s < 5; ++s) {
        LAS unsigned char* vb = vbuf + (s & 1) * 4096;
#pragma unroll
        for (int i = 0; i < 4; ++i) *(LAS bf16x8*)(vb + (vch >> 2) * 2048 + (8 * i + vkey) * 64 + (vch & 3) * 16) = vr[s][i];
        if (has_next && s < 2) p_load_kv(c.KB, nxt, s, kr[s], vkey, vch);
        if (has_next && s == 2) p_load_q(c, nxt, qv, vkey, vch);
#pragma unroll
        for (int sp = 0; sp < 2; ++sp)
#pragma unroll
            for (int dt = 0; dt < 2; ++dt) {
                const s16x4 lo = __builtin_bit_cast(s16x4, __builtin_amdgcn_ds_read_tr16_b64_v4i16((LAS s16x4*)(vb + vrd + dt * 2048 + sp * 1024)));
                const s16x4 hh = __builtin_bit_cast(s16x4, __builtin_amdgcn_ds_read_tr16_b64_v4i16((LAS s16x4*)(vb + vrd + dt * 2048 + sp * 1024 + 512)));
                const bf16x8 vf = (bf16x8){lo[0], lo[1], lo[2], lo[3], hh[0], hh[1], hh[2], hh[3]};
                o[dt] = __builtin_amdgcn_mfma_f32_32x32x16_bf16(vf, pf[s][sp], o[dt], 0, 0, 0);
            }
    }
    __builtin_amdgcn_sched_barrier(0);
    {
        const float inv = 1.0f / l;
#pragma unroll
        for (int dt = 0; dt < 2; ++dt)
#pragma unroll
            for (int rg = 0; rg < 4; ++rg) { u32x2 w; w.x = pkbf(o[dt][4 * rg] * inv, o[dt][4 * rg + 1] * inv); w.y = pkbf(o[dt][4 * rg + 2] * inv, o[dt][4 * rg + 3] * inv);
                *(LAS u32x2*)(kb + r32 * 144 + (32 * dt + 8 * rg + 4 * hi) * 2) = w; }
        if (hi == 0) c.LSE[(size_t)cur.g * LSE_STRIDE + (size_t)ptok(cur, i0 + r32) * NH + cur.h] = mx + __log2f(l);
#pragma unroll
        for (int i = 0; i < 4; ++i) { const int qi = 8 * i + vkey;
            *(u32x4*)(c.OP + (size_t)cur.g * OP_STRIDE + (size_t)ptok(cur, i0 + qi) * AW + cur.h * HD + vch * 8) = *(const LAS u32x4*)(kb + qi * 144 + vch * 16); }
    }
}
struct TDesc { int b, h, g, dil, r, j0; };
constexpr int TK_OFF = 0, TV_OFF = 49152, TB_OFF = 98304, TT_OFF = TB_OFF + 8 * 4608;
__device__ __forceinline__ void glds16(const void* sbase, unsigned voff, unsigned lds_dst) { unsigned keep;
    asm volatile("s_mov_b32 %0, m0\n\ts_mov_b32 m0, %3\n\ts_nop 4\n\tglobal_load_lds_dwordx4 %1, %2\n\ts_mov_b32 m0, %0" : "=&s"(keep) : "v"(voff), "s"(sbase), "s"(lds_dst) : "memory"); }
__device__ __forceinline__ void glds4(const void* sbase, unsigned voff, unsigned lds_dst) { unsigned keep;
    asm volatile("s_mov_b32 %0, m0\n\ts_mov_b32 m0, %3\n\ts_nop 4\n\tglobal_load_lds_dword %1, %2\n\ts_mov_b32 m0, %0" : "=&s"(keep) : "v"(voff), "s"(sbase), "s"(lds_dst) : "memory"); }
__device__ __forceinline__ void t_issue_tab(const float* tabg, const TDesc& d, LAS unsigned char* lds, int wave, int lane) {
    if (wave < 3) glds4(tabg, (unsigned)(((d.g * 12 + d.h) * 192 + wave * 64 + lane) * 4), (unsigned)__builtin_amdgcn_readfirstlane((int)((unsigned)(uintptr_t)lds + TT_OFF + wave * 256)));
}
__device__ __forceinline__ void t_issue_k(const Ctx& c, const TDesc& d, LAS unsigned char* lds, int wave, int lane) {
    const int rr = lane >> 3, ch = (lane & 7) ^ ((4 * (wave & 1) + (rr >> 1)) & 7);
    const unsigned cb = (unsigned)((d.b * SEQ + d.r) * AW + d.h * HD + ch * 8) * 2u, st = (unsigned)(d.dil * AW * 2);
    const unsigned l0 = (unsigned)(uintptr_t)lds + TK_OFF;
#pragma unroll
    for (int i = 0; i < 6; ++i) { const int e = wave + 8 * i; int idx = d.j0 - 128 + 8 * e + rr; idx = idx < 0 ? 0 : idx;
        glds16(c.KB, cb + (unsigned)idx * st, (unsigned)__builtin_amdgcn_readfirstlane((int)(l0 + e * 1024))); }
}
__device__ __forceinline__ void t_issue_v(const Ctx& c, const TDesc& d, LAS unsigned char* lds, int wave, int lane) {
    const int kq = lane >> 2, q4 = lane & 3;
    const unsigned cb = (unsigned)((d.b * SEQ + d.r) * AW + d.h * HD + q4 * 8) * 2u, st = (unsigned)(d.dil * AW * 2);
    const unsigned l0 = (unsigned)(uintptr_t)lds + TV_OFF;
#pragma unroll
    for (int i = 0; i < 6; ++i) { const int e = 6 * wave + i, hf = e / 24, e24 = e - hf * 24; int idx = d.j0 - 128 + 16 * e24 + kq; idx = idx < 0 ? 0 : idx;
        glds16(c.VB, cb + (unsigned)idx * st + (unsigned)hf * 64u, (unsigned)__builtin_amdgcn_readfirstlane((int)(l0 + e * 1024))); }
}
__device__ __forceinline__ void t_issue_q(const Ctx& c, const TDesc& d, LAS unsigned char* lds, int wave, int lane) {
    const int rr = lane >> 3, i0 = d.j0 + 32 * wave;
    const unsigned qo0 = ((unsigned)(d.b * SEQ + d.r + d.dil * (i0 + rr)) * AW + d.h * HD) * 2u, qst = (unsigned)(8 * d.dil * AW * 2);
    const unsigned l0 = (unsigned)(uintptr_t)lds + TB_OFF + wave * 4608;
#pragma unroll
    for (int i = 0; i < 4; ++i) { const int ch = (lane & 7) ^ ((4 * (i & 1) + (rr >> 1)) & 7);
        glds16(c.QB, qo0 + i * qst + ch * 16, (unsigned)__builtin_amdgcn_readfirstlane((int)(l0 + i * 1024))); }
}
struct TOut { f32x16 o[2]; float l, mx; };
__device__ __forceinline__ void* sgpr_ptr(const void* p) { const unsigned long long u = (unsigned long long)(uintptr_t)p;
    const unsigned lo = (unsigned)__builtin_amdgcn_readfirstlane((int)(unsigned)u), hi = (unsigned)__builtin_amdgcn_readfirstlane((int)(unsigned)(u >> 32));
    return (void*)(uintptr_t)(((unsigned long long)hi << 32) | lo); }
__device__ __forceinline__ void gst16(void* sbase, unsigned voff, u32x4 v) { asm volatile("s_nop 4\n\tglobal_store_dwordx4 %0, %1, %2\n\ts_nop 1" :: "v"(voff), "v"(v), "s"(sbase) : "memory"); }
__device__ __forceinline__ void gst4(void* sbase, unsigned voff, float v) { asm volatile("s_nop 4\n\tglobal_store_dword %0, %1, %2\n\ts_nop 1" :: "v"(voff), "v"(v), "s"(sbase) : "memory"); }
__device__ __forceinline__ void t_out1(const TOut& po, LAS unsigned char* kb, int r32, int hi) {
    const float inv = 1.0f / po.l;
#pragma unroll
    for (int dt = 0; dt < 2; ++dt)
#pragma unroll
        for (int rg = 0; rg < 4; ++rg) { u32x2 w; w.x = pkbf(po.o[dt][4 * rg] * inv, po.o[dt][4 * rg + 1] * inv); w.y = pkbf(po.o[dt][4 * rg + 2] * inv, po.o[dt][4 * rg + 3] * inv);
            *(LAS u32x2*)(kb + r32 * 144 + (32 * dt + 8 * rg + 4 * hi) * 2) = w; }
}
__device__ __forceinline__ void t_out2(const Ctx& c, const TDesc& d, const TOut& po, const LAS unsigned char* kb, int wave, int r32, int hi, int vkey, int vch, u32x4 (&ow)[4]) {
    const int i0 = d.j0 + 32 * wave;
#pragma unroll
    for (int i = 0; i < 4; ++i) ow[i] = *(const LAS u32x4*)(kb + (8 * i + vkey) * 144 + vch * 16);
    const unsigned tq = (unsigned)(d.b * SEQ + d.r + d.dil * (i0 + r32));
    if (hi == 0) gst4(sgpr_ptr(c.LSE + (size_t)d.g * LSE_STRIDE + d.h), tq * (unsigned)(NH * 4), po.mx + __log2f(po.l));
}
__device__ __forceinline__ void t_out3(const Ctx& c, const TDesc& d, int wave, int vkey, int vch, const u32x4 (&ow)[4]) {
    const int i0 = d.j0 + 32 * wave; void* ob = sgpr_ptr(c.OP + (size_t)d.g * OP_STRIDE + d.h * HD);
#pragma unroll
    for (int i = 0; i < 4; ++i) { const int qi = 8 * i + vkey; const unsigned tk = (unsigned)(d.b * SEQ + d.r + d.dil * (i0 + qi));
        gst16(ob, tk * (unsigned)(AW * 2) + (unsigned)(vch * 16), ow[i]); }
}
__device__ __forceinline__ void t_unit(const Ctx& c, const TDesc& prv, const TDesc& cur, const TDesc& nxt, bool has_next, const float* tabg, LAS unsigned char* lds, int wave, TOut& po) {
    const int lane = fresh_lane(), r32 = lane & 31, hi = lane >> 5, vkey = lane >> 3, vch = lane & 7;
    LAS unsigned char* qb = lds + TB_OFF + wave * 4608;
    const LAS float* tt = (const LAS float*)(lds + TT_OFF);
    const int i0 = cur.j0 + 32 * wave;
    asm volatile("s_waitcnt vmcnt(6) lgkmcnt(0)\n\ts_barrier" ::: "memory");
    const int kx = (r32 >> 1) & 7;
    bf16x8 qr[4];
#pragma unroll
    for (int d0 = 0; d0 < 4; ++d0) qr[d0] = *(const LAS bf16x8*)(qb + r32 * 128 + (((2 * d0 + hi) ^ kx) << 4));
    asm volatile("" ::: "memory");
    t_out1(po, qb, r32, hi);
    f32x16 S[5];
    const LAS float* tb = tt + 159 + r32 - 4 * hi;
    const LAS unsigned char* kt = lds + TK_OFF + (32 * wave + r32) * 128;
    float mx;
    {   bf16x8 kf[4];
#pragma unroll
        for (int d0 = 0; d0 < 4; ++d0) kf[d0] = *(const LAS bf16x8*)(kt + 4 * 4096 + (((2 * d0 + hi) ^ kx) << 4));
        f32x16 a = {};
#pragma unroll
        for (int d0 = 0; d0 < 4; ++d0) a = __builtin_amdgcn_mfma_f32_32x32x16_bf16(kf[d0], qr[d0], a, 0, 0, 0);
#pragma unroll
        for (int rr = 0; rr < 16; ++rr) a[rr] += tb[-(128 + (rr & 3) + 8 * (rr >> 2))];
        float m1 = fmaxf(fmaxf(a[0], a[1]), a[2]);
#pragma unroll
        for (int rr = 3; rr < 15; rr += 2) m1 = fmaxf(fmaxf(m1, a[rr]), a[rr + 1]);
        m1 = fmaxf(m1, a[15]);
        mx = fmaxf(m1, __shfl_xor(m1, 32));
        S[4] = a; }
    u32x4 ow[4];
    asm volatile("" ::: "memory");
    t_out2(c, prv, po, qb, wave, r32, hi, vkey, vch, ow);
#pragma unroll
    for (int s = 0; s < 4; s += 2) {
        bf16x8 kfa[4], kfb[4];
#pragma unroll
        for (int d0 = 0; d0 < 4; ++d0) { kfa[d0] = *(const LAS bf16x8*)(kt + s * 4096 + (((2 * d0 + hi) ^ kx) << 4)); kfb[d0] = *(const LAS bf16x8*)(kt + (s + 1) * 4096 + (((2 * d0 + hi) ^ kx) << 4)); }
        f32x16 a, b;
#pragma unroll
        for (int rr = 0; rr < 16; ++rr) { a[rr] = tb[-(32 * s + (rr & 3) + 8 * (rr >> 2))] - mx; b[rr] = tb[-(32 * (s + 1) + (rr & 3) + 8 * (rr >> 2))] - mx; }
#pragma unroll
        for (int d0 = 0; d0 < 4; ++d0) { a = __builtin_amdgcn_mfma_f32_32x32x16_bf16(kfa[d0], qr[d0], a, 0, 0, 0); b = __builtin_amdgcn_mfma_f32_32x32x16_bf16(kfb[d0], qr[d0], b, 0, 0, 0); }
        S[s] = a; S[s + 1] = b;
        if (s == 0) { asm volatile("" ::: "memory"); t_out3(c, prv, wave, vkey, vch, ow); }
    }
    asm volatile("s_waitcnt vmcnt(5) lgkmcnt(0)\n\ts_barrier" ::: "memory");
    if (has_next) { t_issue_tab(tabg, nxt, lds, wave, lane); t_issue_k(c, nxt, lds, wave, lane); t_issue_q(c, nxt, lds, wave, lane); }
    if (i0 < 128) {
#pragma unroll
        for (int s = 0; s < 5; ++s)
#pragma unroll
            for (int rr = 0; rr < 16; ++rr) if (i0 - 128 + 32 * s + crow(rr, hi) < 0) S[s][rr] = -1e30f;
    }
    bf16x8 pf[5][2];
#pragma unroll
    for (int s = 0; s < 5; ++s) {
#pragma unroll
        for (int rr = 0; rr < 16; ++rr) S[s][rr] = fast_exp2(s == 4 ? S[s][rr] - mx : S[s][rr]);
#pragma unroll
        for (int sp = 0; sp < 2; ++sp) { u32x4 pw; pw.x = pkbf(S[s][8 * sp + 0], S[s][8 * sp + 1]); pw.y = pkbf(S[s][8 * sp + 2], S[s][8 * sp + 3]); pw.z = pkbf(S[s][8 * sp + 4], S[s][8 * sp + 5]); pw.w = pkbf(S[s][8 * sp + 6], S[s][8 * sp + 7]);
            pf[s][sp] = __builtin_bit_cast(bf16x8, pw); asm volatile("" : "+v"(pf[s][sp])); }
    }
    f32x16 o[2]; o[0] = (f32x16){}; o[1] = (f32x16){};
    f32x16 ol = {};
    const bf16x8 ones = __builtin_bit_cast(bf16x8, (u32x4){0x3F803F80u, 0x3F803F80u, 0x3F803F80u, 0x3F803F80u});
    const LAS unsigned char* vt = lds + TV_OFF + (32 * wave + 4 * hi + ((lane & 15) >> 2)) * 64 + ((lane >> 4) & 1) * 32 + (lane & 3) * 8;
#pragma unroll
    for (int s = 0; s < 5; ++s)
#pragma unroll
        for (int sp = 0; sp < 2; ++sp)
#pragma unroll
            for (int dt = 0; dt < 2; ++dt) {
                const s16x4 lo = __builtin_bit_cast(s16x4, __builtin_amdgcn_ds_read_tr16_b64_v4i16((LAS s16x4*)(vt + dt * 24576 + s * 2048 + sp * 1024)));
                const s16x4 hh = __builtin_bit_cast(s16x4, __builtin_amdgcn_ds_read_tr16_b64_v4i16((LAS s16x4*)(vt + dt * 24576 + s * 2048 + sp * 1024 + 512)));
                const bf16x8 vf = (bf16x8){lo[0], lo[1], lo[2], lo[3], hh[0], hh[1], hh[2], hh[3]};
                o[dt] = __builtin_amdgcn_mfma_f32_32x32x16_bf16(vf, pf[s][sp], o[dt], 0, 0, 0);
                if (dt == 1) ol = __builtin_amdgcn_mfma_f32_32x32x16_bf16(ones, pf[s][sp], ol, 0, 0, 0);
            }
    const float l = ol[0];
    asm volatile("s_waitcnt lgkmcnt(0)\n\ts_barrier" ::: "memory");
    if (has_next) t_issue_v(c, nxt, lds, wave, lane);
    po.o[0] = o[0]; po.o[1] = o[1]; po.l = l; po.mx = mx;
}
__device__ __forceinline__ void t_flush(const Ctx& c, const TDesc& d, const TOut& po, LAS unsigned char* lds, int wave) {
    const int lane = fresh_lane(), r32 = lane & 31, hi = lane >> 5, vkey = lane >> 3, vch = lane & 7;
    LAS unsigned char* qb = lds + TB_OFF + wave * 4608;
    u32x4 ow[4];
    t_out1(po, qb, r32, hi); t_out2(c, d, po, qb, wave, r32, hi, vkey, vch, ow); t_out3(c, d, wave, vkey, vch, ow);
}
template <int NQ> __device__ __forceinline__ void sample_vblock(const Ctx& c, int n, int h, int g, int dil, int r, int i0, const LAS float* tab, LAS float* sbuf) {
    const int lane = fresh_lane(), sub = lane & 15, rgp = lane >> 4;
    constexpr int NT = (NQ + 3) / 4, NSA = 32 + NT;
    f32x4 q4[NQ];
#pragma unroll
    for (int qq = 0; qq < NQ; ++qq) { const size_t row = (size_t)MP + n * TS + (r + dil * (i0 + qq) - WBUF);
        const u32x2 w = *(const u32x2*)(c.QB + row * AW + h * HD + 4 * sub); q4[qq] = (f32x4){bf_lo(w.x), bf_hi(w.x), bf_lo(w.y), bf_hi(w.y)}; }
    const unsigned cbase = (unsigned)((((n * WBUF) + r + dil * (i0 - 128 + rgp)) * NH + h) * HD + 4 * sub) * 4u, cstep = (unsigned)(4 * dil * NH * HD * 4);
    auto new_row = [&](const bf16_t* B16, int tt) -> f32x4 { const int tc = tt < NQ ? tt : NQ - 1;
        const u32x2 w = *(const u32x2*)(B16 + ((size_t)MP + n * TS + (r + dil * (i0 + tc) - WBUF)) * AW + h * HD + 4 * sub);
        return (f32x4){bf_lo(w.x), bf_hi(w.x), bf_lo(w.y), bf_hi(w.y)}; };
    auto score = [&](const f32x4 kv, int kk) {
#pragma unroll
        for (int qq = 0; qq < NQ; ++qq) {
            float d = (kv[0] * q4[qq][0] + kv[1] * q4[qq][1]) + (kv[2] * q4[qq][2] + kv[3] * q4[qq][3]);
            d += __shfl_xor(d, 1); d += __shfl_xor(d, 2); d += __shfl_xor(d, 4); d += __shfl_xor(d, 8);
            if (sub == 0) sbuf[qq * 136 + kk] = (kk < 128 + NQ) ? d + tab[159 + qq - kk] : -1e30f;
        } };
    {   f32x4 nk[NT];
#pragma unroll
        for (int i = 0; i < NT; ++i) nk[i] = new_row(c.KB, 4 * i + rgp);
        {   f32x4 kv[32];
#pragma unroll
            for (int i = 0; i < 32; ++i) kv[i] = *(const f32x4*)((const char*)c.CK + cbase + (unsigned)i * cstep);
#pragma unroll
            for (int i = 0; i < 32; ++i) score(kv[i], 4 * i + rgp);
        }
#pragma unroll
        for (int i = 0; i < NT; ++i) score(nk[i], 128 + 4 * i + rgp);
    }
    asm volatile("s_waitcnt lgkmcnt(0)" ::: "memory");
    float lq[NQ], lse[NQ];
#pragma unroll
    for (int qq = 0; qq < NQ; ++qq) {
        float v[3]; float mx = -3.0e38f;
#pragma unroll
        for (int j = 0; j < 3; ++j) { const int kk = lane + 64 * j; v[j] = (kk < 4 * NSA) ? sbuf[qq * 136 + kk] : -1e30f; mx = fmaxf(mx, v[j]); }
#pragma unroll
        for (int o = 1; o < 64; o <<= 1) mx = fmaxf(mx, __shfl_xor(mx, o));
        float sm = 0.f;
#pragma unroll
        for (int j = 0; j < 3; ++j) { const int kk = lane + 64 * j; const float pv = fast_exp2(v[j] - mx); sm += pv; if (kk < 4 * NSA) sbuf[qq * 136 + kk] = pv; }
        sm = wave_sum(sm); lq[qq] = sm; lse[qq] = mx + __log2f(sm);
    }
    asm volatile("s_waitcnt lgkmcnt(0)" ::: "memory");
    f32x4 oa[NQ];
#pragma unroll
    for (int qq = 0; qq < NQ; ++qq) oa[qq] = (f32x4){0.f, 0.f, 0.f, 0.f};
    {   f32x4 nv[NT];
#pragma unroll
        for (int i = 0; i < NT; ++i) nv[i] = new_row(c.VB, 4 * i + rgp);
        {   f32x4 vv[32];
#pragma unroll
            for (int i = 0; i < 32; ++i) vv[i] = *(const f32x4*)((const char*)c.CV + cbase + (unsigned)i * cstep);
#pragma unroll
            for (int i = 0; i < 32; ++i) { const int kk = 4 * i + rgp;
#pragma unroll
                for (int qq = 0; qq < NQ; ++qq) { const float pv = sbuf[qq * 136 + kk]; oa[qq] += vv[i] * pv; } }
        }
#pragma unroll
        for (int i = 0; i < NT; ++i) { const int kk = 128 + 4 * i + rgp;
#pragma unroll
            for (int qq = 0; qq < NQ; ++qq) { const float pv = sbuf[qq * 136 + kk]; oa[qq] += nv[i] * pv; } }
    }
#pragma unroll
    for (int qq = 0; qq < NQ; ++qq) {
#pragma unroll
        for (int e = 0; e < 4; ++e) { float x = oa[qq][e]; x += __shfl_xor(x, 16); x += __shfl_xor(x, 32); oa[qq][e] = x; }
        const size_t tok = (size_t)MP + n * TS + (r + dil * (i0 + qq) - WBUF);
        if (rgp == 0) { const float inv = 1.0f / lq[qq]; u32x2 w; w.x = pkbf(oa[qq][0] * inv, oa[qq][1] * inv); w.y = pkbf(oa[qq][2] * inv, oa[qq][3] * inv);
            *(u32x2*)(c.OP + (size_t)g * OP_STRIDE + tok * AW + h * HD + 4 * sub) = w;
            if (sub == 0) c.LSE[(size_t)g * LSE_STRIDE + tok * NH + h] = lse[qq]; }
    }
    asm volatile("s_waitcnt lgkmcnt(0)" ::: "memory");
}
template <int NP> __device__ __forceinline__ void merge_pieces(const Ctx& c, size_t tok0, size_t tstride, int h, int piece) {
    float ls[NP][3]; u32x4 ov[NP][3];
#pragma unroll
    for (int q = 0; q < NP; ++q)
#pragma unroll
        for (int g = 0; g < 3; ++g) { const size_t tok = tok0 + q * tstride; ls[q][g] = c.LSE[(size_t)g * LSE_STRIDE + tok * NH + h]; ov[q][g] = *(const u32x4*)(c.OP + (size_t)g * OP_STRIDE + tok * AW + h * HD + piece * 8); }
#pragma unroll
    for (int q = 0; q < NP; ++q) {
        const float M = fmaxf(fmaxf(ls[q][0], ls[q][1]), ls[q][2]);
        float w0 = fast_exp2(ls[q][0] - M), w1 = fast_exp2(ls[q][1] - M), w2 = fast_exp2(ls[q][2] - M); const float inv = 1.0f / (w0 + w1 + w2); w0 *= inv; w1 *= inv; w2 *= inv;
        u32x4 o;
#pragma unroll
        for (int e = 0; e < 4; ++e) {
            const float lo = w0 * bf_lo(ov[q][0][e]) + w1 * bf_lo(ov[q][1][e]) + w2 * bf_lo(ov[q][2][e]);
            const float hi_ = w0 * bf_hi(ov[q][0][e]) + w1 * bf_hi(ov[q][1][e]) + w2 * bf_hi(ov[q][2][e]);
            o[e] = pkbf(lo, hi_);
        }
        *(u32x4*)(c.ATT + (tok0 + q * tstride) * DM + h * HD + piece * 8) = o;
    }
}
__device__ __forceinline__ void copy_slot(const float* ck, const float* cv, float* out, int sl, int lane) {
    const int sq = sl / 576, j0 = (sl - sq * 576) * 680, which = sq >> 5, n = sq & 31;
    const f32x4* src = (const f32x4*)((which ? cv : ck) + (size_t)n * WBUF * AW + (size_t)TS * AW) + j0 + lane;
    f32x4* dst = (f32x4*)(out + (which ? OFF_SWV : OFF_SWK) + (size_t)n * WBUF * AW) + j0 + lane;
    f32x4 v[11];
#pragma unroll
    for (int i = 0; i < 10; ++i) v[i] = __builtin_nontemporal_load(src + 64 * i);
    if (lane < 40) v[10] = __builtin_nontemporal_load(src + 640);
#pragma unroll
    for (int i = 0; i < 10; ++i) __builtin_nontemporal_store(v[i], dst + 64 * i);
    if (lane < 40) __builtin_nontemporal_store(v[10], dst + 640);
}
__device__ __forceinline__ void copy_range(const float* ck, const float* cv, float* out, unsigned first, unsigned count, int widx, int nw, int tid) {
    constexpr unsigned PER = (unsigned)(WBUF - TS) * AW / 4;
    const unsigned end = first + count;
    for (unsigned i0 = first + (unsigned)widx * 4096u + tid; i0 < end; i0 += (unsigned)nw * 4096u) {
        f32x4 v[8];
#pragma unroll
        for (int k = 0; k < 8; ++k) { const unsigned i = i0 + 512u * k; if (i < end) { const unsigned sq = i / PER, j = i - sq * PER, which = sq >> 5, n = sq & 31;
            v[k] = __builtin_nontemporal_load((const f32x4*)((which ? cv : ck) + (size_t)n * WBUF * AW + (size_t)TS * AW) + j); } }
#pragma unroll
        for (int k = 0; k < 8; ++k) { const unsigned i = i0 + 512u * k; if (i < end) { const unsigned sq = i / PER, j = i - sq * PER, which = sq >> 5, n = sq & 31;
            __builtin_nontemporal_store(v[k], (f32x4*)(out + (which ? OFF_SWV : OFF_SWK) + (size_t)n * WBUF * AW) + j); } }
    }
}
}

template <int NTW, bool SAMPLE> __device__ __forceinline__ void conv_unit(const float* U, const float* cache_conv, int seq, int t0, LAS float* tile, const LAS float* cw,
                                                                          const float* cb, const float* lg, const float* lb, bf16_t* ATT, int tid, int lane, int wave) {
    constexpr int NROW = 8 * NTW + 30;
    const size_t rowbase = SAMPLE ? (size_t)MP + (size_t)seq * TS : (size_t)seq * SEQ;
    for (int idx = tid; idx < NROW * 64; idx += 512) {
        const int rr = idx >> 6, c4 = idx & 63, tau = rr - 30; f32x4 v = (f32x4){0.f, 0.f, 0.f, 0.f};
        if (SAMPLE) { v = tau < 0 ? *(const f32x4*)(cache_conv + ((size_t)seq * 30 + (30 + tau)) * CWD + 4 * c4) : *(const f32x4*)(U + (rowbase + tau) * CWD + 4 * c4); }
        else if (t0 + tau >= 0) v = *(const f32x4*)(U + (rowbase + t0 + tau) * CWD + 4 * c4);
        *(LAS f32x4*)(tile + rr * CWD + 4 * c4) = v;
    }
    __syncthreads();
    f32x4 acc[NTW], uw[NTW];
    const LAS float* tw = tile + (NTW * wave) * CWD + 4 * lane;
#pragma unroll
    for (int i = 0; i < NTW; ++i) { acc[i] = (f32x4){0.f, 0.f, 0.f, 0.f}; uw[i] = *(const LAS f32x4*)(tw + i * CWD); }
#pragma unroll 1
    for (int j = 0; j < 31; ++j) {
        const f32x4 w = *(const LAS f32x4*)(cw + j * CWD + 4 * lane);
        const f32x4 nx = *(const LAS f32x4*)(tw + (NTW + j) * CWD);
#pragma unroll
        for (int i = 0; i < NTW; ++i) acc[i] += w * uw[i];
#pragma unroll
        for (int i = 0; i + 1 < NTW; ++i) uw[i] = uw[i + 1];
        uw[NTW - 1] = nx;
    }
    const f32x4 bv = *(const f32x4*)(cb + 4 * lane), gv = *(const f32x4*)(lg + 4 * lane), lv = *(const f32x4*)(lb + 4 * lane);
#pragma unroll
    for (int i = 0; i < NTW; ++i) {
        f32x4 y = acc[i] + bv;
        const float mean = wave_sum((y[0] + y[1]) + (y[2] + y[3])) * (1.0f / CWD);
        y = y - mean;
        const float var = wave_sum((y[0] * y[0] + y[1] * y[1]) + (y[2] * y[2] + y[3] * y[3])) * (1.0f / CWD);
        const float rstd = 1.0f / sqrtf(var + EPS);
        f32x4 z = y * rstd * gv + lv;
#pragma unroll
        for (int e = 0; e < 4; ++e) z[e] = z[e] * fast_rcp(1.f + fast_exp2(-z[e] * LOG2E));
        u32x2 w; w.x = pkbf(z[0], z[1]); w.y = pkbf(z[2], z[3]);
        *(u32x2*)(ATT + (rowbase + t0 + NTW * wave + i) * DM + AW + 4 * lane) = w;
    }
    __syncthreads();
}

__global__ void __launch_bounds__(512, 2) fwd_kernel(Params p) {
    extern __shared__ __attribute__((aligned(16))) unsigned char lds_raw[];
    LAS unsigned char* lds = (LAS unsigned char*)lds_raw;
    const int G = gridDim.x, bid = blockIdx.x;
    const int wave = __builtin_amdgcn_readfirstlane(threadIdx.x >> 6);
#define PHASE_IDS const int lane = fresh_lane(), tid = wave * 64 + lane; (void)tid
    unsigned char* ws = p.ws; float* out = p.out;
    bf16_t* WALL = (bf16_t*)(ws + WS_WALL); bf16_t* WOUT = (bf16_t*)(ws + WS_WOUT); bf16_t* WXQ = (bf16_t*)(ws + WS_WXQ); bf16_t* WXO = (bf16_t*)(ws + WS_WXO);
    bf16_t* WGU = (bf16_t*)(ws + WS_WGU); bf16_t* WDN = (bf16_t*)(ws + WS_WDN); bf16_t* XN = (bf16_t*)(ws + WS_XN);
    bf16_t* QB = (bf16_t*)(ws + WS_QB); bf16_t* KB = (bf16_t*)(ws + WS_KB); bf16_t* VB = (bf16_t*)(ws + WS_VB); float* U = (float*)(ws + WS_U);
    bf16_t* OP = (bf16_t*)(ws + WS_OP); float* LSE = (float*)(ws + WS_LSE); bf16_t* ATT = (bf16_t*)(ws + WS_ATT); float* X1 = (float*)(ws + WS_X1);
    float* SSQ = (float*)(ws + WS_SSQ); bf16_t* MKB = (bf16_t*)(ws + WS_MKB); bf16_t* MVT = (bf16_t*)(ws + WS_MVT); float* LSUM = (float*)(ws + WS_LSUM);
    bf16_t* XQ = (bf16_t*)(ws + WS_XQ); bf16_t* PB = (bf16_t*)(ws + WS_PB); bf16_t* XO = (bf16_t*)(ws + WS_XO); bf16_t* HB = (bf16_t*)(ws + WS_H);
    const int lo = p.ph_lo, hi = p.ph_hi;
    if (threadIdx.x < 4) ((volatile LAS unsigned*)(lds + MISC_OFF))[threadIdx.x] = 0u;
    __syncthreads();
    XcdBarrier xbar; xbar.bar = (unsigned*)(ws + WS_CTL); xbar.x = 0; xbar.st = nullptr;
    if (p.coop) xbar = xcd_barrier_post((unsigned*)(ws + WS_CTL), (volatile LAS unsigned*)(lds + MISC_OFF));
#ifndef PH_MASK
#define PH_MASK 0x7ff
#endif
#define IN(k) (((PH_MASK >> (k)) & 1) && lo <= (k) && (k) < hi)
#ifndef PROBE_DUP
#define PROBE_DUP 0
#endif
#define REP(k) for (int rep_ = 0; rep_ <= ((PROBE_DUP >> (k)) & 1); ++rep_)
#define REPSYNC if (rep_) xcd_barrier(xbar)
#define SEAM(k) do { if (IN(k) && IN((k) + 1)) { if (p.coop == 2) cg::this_grid().sync(); else xcd_barrier(xbar); } } while (0)

    if (IN(0)) REP(0) {
        REPSYNC;
        PHASE_IDS;
        LAS float* scr = (LAS float*)(lds + wave * 16384);
        const int gw = bid * 8 + wave, NGW = G * 8;
        constexpr int I_IN = 16 * 88, I_SQ = 16 * 32, I_FF = 16 * 88, I_DN = 44 * 32;
        constexpr int NITEMS = I_IN + 5 * I_SQ + 2 * I_FF + I_DN;
        for (int it = gw; it < NITEMS; it += NGW) {
            int r = it;
            if (r < I_IN) { transpose_item(p.in[10], DM, NIN, WALL, r, 1, scr, lane); continue; } r -= I_IN;
            if (r < I_SQ) { transpose_item(p.in[19], DM, DM, WALL + (size_t)2816 * DM, r, 0, scr, lane); continue; } r -= I_SQ;
            if (r < I_SQ) { transpose_item(p.in[20], DM, DM, WALL + (size_t)3840 * DM, r, 0, scr, lane); continue; } r -= I_SQ;
            if (r < I_SQ) { transpose_item(p.in[15], DM, DM, WOUT, r, 0, scr, lane); continue; } r -= I_SQ;
            if (r < I_SQ) { transpose_item(p.in[18], DM, DM, WXQ, r, 0, scr, lane); continue; } r -= I_SQ;
            if (r < I_SQ) { transpose_item(p.in[21], DM, DM, WXO, r, 0, scr, lane); continue; } r -= I_SQ;
            if (r < I_FF) { transpose_item(p.in[23], DM, DFF, WGU, r, 2, scr, lane); continue; } r -= I_FF;
            if (r < I_FF) { transpose_item(p.in[24], DM, DFF, WGU, r, 3, scr, lane); continue; } r -= I_FF;
            transpose_item(p.in[25], DFF, DM, WDN, r, 0, scr, lane);
        }
        for (int m0 = gw * 4; m0 < MALL; m0 += NGW * 4) {
            const float* base; const float* g;
            if (m0 < MP) { base = p.in[0] + (size_t)m0 * DM; g = p.in[9]; }
            else if (m0 < MTOK) { base = p.in[1] + (size_t)(m0 - MP) * DM; g = p.in[9]; }
            else { base = p.in[2] + (size_t)(m0 - MTOK) * DM; g = p.in[17]; }
            const float* const xr[4] = {base, base + DM, base + 2 * DM, base + 3 * DM};
            bf16_t* ob = XN + (size_t)m0 * DM; bf16_t* const orr[4] = {ob, ob + DM, ob + 2 * DM, ob + 3 * DM};
            rms_rows_bf16<4>(xr, g, orr, lane);
        }
        if (bid == 0) {
            float* tabg = (float*)(ws + WS_TABG);
            for (int i = tid; i < 36 * 192; i += 512) {
                const int gh = i / 192, e = i - gh * 192, g = gh / 12, h = gh - g * 12, dist = e - 31; float v = -1e30f;
                if (dist >= 0 && dist <= 128) { const int n = dist << (2 * g); int bk;
                    if (n < 16) bk = n; else { const float vv = logf((float)n / 16.0f) / 4.852030263919617f * 16.0f; bk = 16 + (int)vv; bk = bk > 31 ? 31 : bk; }
                    v = p.in[8][bk * NH + h] * LOG2E; }
                tabg[i] = v;
            }
        }
        {
            constexpr int CPER = (30 - TS) * CWD / 4;
            for (int i = bid * 512 + tid; i < NSEQ * CPER; i += G * 512) { const int n = i / CPER, j = i - n * CPER;
                ((f32x4*)(out + OFF_SCONV + (size_t)n * 30 * CWD))[j] = ((const f32x4*)(p.in[5] + (size_t)n * 30 * CWD + TS * CWD))[j]; }
        }
    }
    SEAM(0);
    if (IN(1)) REP(1) {
        REPSYNC;
#ifndef P1_NO_MAIN
        { pg8::SchedGrid S{129, 11, G, bid, (const char*)XN, (const char*)WALL, (size_t)256 * DM * 2, (size_t)256 * DM * 2};
          pg8::EpiIn E{ws, out};
          pg8::gemm_phase<pg8::EpiIn, pg8::SchedGrid, true>(lds, pg8::Cfg{DM, DM, DM}, S, E, wave); }
#endif
#ifndef P1_NO_MEM
        { const int cfirst = (129 * 11) % G;
          pg8::SchedMem S{(bid - cfirst + G) % G, (const char*)XN, (const char*)WALL};
          pg8::EpiMem E{ws, out};
          pg8::gemm_phase<pg8::EpiMem, pg8::SchedMem, true>(lds, pg8::Cfg{DM, DM, DM}, S, E, wave); }
        if (bid >= 187 && rep_ == 0) { PHASE_IDS; att::copy_range(p.in[3], p.in[4], out, 23777280u, 1290240u, bid - 187, G - 187, tid); }
#endif
    }
    SEAM(1);
    if (IN(2)) REP(2) {
        REPSYNC;
        PHASE_IDS;
        LAS float* tab = (LAS float*)(lds + ATT_TAB_OFF); LAS float* cw = (LAS float*)(lds + ATT_CW_OFF);
#ifndef MK_TILE_ATT
#define MK_TILE_ATT 1
#endif
        const float* tabg = (const float*)(ws + WS_TABG);
#if !MK_TILE_ATT
        for (int i = tid; i < 36 * 192; i += 512) tab[i] = tabg[i];
        __syncthreads();
#endif
        att::Ctx c{QB, KB, VB, p.in[3], p.in[4], OP, LSE, ATT};
        LAS unsigned char* vbuf = lds + ATT_V_OFF + wave * ATT_WBUF;
#ifndef PROBE_P2
#define PROBE_P2 0
#endif
#if MK_TILE_ATT
        {
            const int nl2 = __builtin_amdgcn_readfirstlane((int)((volatile LAS unsigned*)(lds + MISC_OFF))[0]), nx2 = __builtin_amdgcn_readfirstlane((int)((volatile LAS unsigned*)(lds + MISC_OFF))[1]);
            const int xi2 = __builtin_amdgcn_readfirstlane((int)((volatile LAS unsigned*)(lds + MISC_OFF))[2]), rk2 = __builtin_amdgcn_readfirstlane((int)((volatile LAS unsigned*)(lds + MISC_OFF))[3]);
            const int npair = (48 - xi2 + nx2 - 1) / nx2, nun = npair * 96;
            auto mk = [&](int Lx) -> att::TDesc { att::TDesc d; const int pair = Lx / 96, u = Lx - pair * 96, pp = xi2 + nx2 * pair; d.b = pp / 12; d.h = pp - d.b * 12; d.g = u >> 5; const int cj = u & 31;
                if (d.g == 0) { d.dil = 1; d.r = 0; d.j0 = 256 * cj; } else if (d.g == 1) { d.dil = 4; d.r = cj >> 3; d.j0 = 256 * (cj & 7); } else { d.dil = 16; d.r = cj >> 1; d.j0 = 256 * (cj & 1); }
                return d; };
            int Lx = rk2;
            att::TDesc cur = mk(Lx < nun ? Lx : 0), prv = cur;
            att::TOut po; po.o[0] = (f32x16){}; po.o[1] = (f32x16){}; po.l = 1.f; po.mx = 0.f;
            const bool any = Lx < nun;
            __builtin_amdgcn_s_waitcnt(0x0070);
            if (any) { att::t_issue_tab(tabg, cur, lds, wave, lane);
                att::t_issue_k(c, cur, lds, wave, lane); att::t_issue_q(c, cur, lds, wave, lane); att::t_issue_v(c, cur, lds, wave, lane); }
            while (Lx < nun) {
                const int Lx2 = Lx + nl2; const bool has_next = Lx2 < nun;
                const att::TDesc nxt = mk(has_next ? Lx2 : Lx);
                att::t_unit(c, prv, cur, nxt, has_next, tabg, lds, wave, po);
                prv = cur; cur = nxt; Lx = Lx2;
            }
            if (any) att::t_flush(c, prv, po, lds, wave);
            xl_barrier(xbar);
            for (int k = 0; k < npair; ++k) { const int pp = xi2 + nx2 * k, b = pp / 12, h = pp - b * 12;
                for (int ck = rk2; ck < 32; ck += nl2) att::merge_pieces<4>(c, (size_t)b * SEQ + ck * 256 + (tid >> 3), 64, h, tid & 7); }
            __syncthreads();
            for (int i = tid; i < 36 * 192; i += 512) tab[i] = tabg[i];
            __syncthreads();
        }
#endif
#if !defined(P2_NO_PROMPT) && !MK_TILE_ATT
        for (int rp_ = 0; rp_ <= (PROBE_P2 & 1) + ((PROBE_P2 >> 3) & 1); ++rp_) {
            auto mkdesc = [&](int un, int it) -> att::PDesc {
                att::PDesc d; d.b = un / 192; const int rem = un - d.b * 192; d.h = rem >> 4; const int ch = rem & 15; d.g = it >> 4; const int j = it & 15;
                if (d.g == 0) { d.dil = 1; d.r = 0; d.i0 = ch * 512 + 32 * j; } else if (d.g == 1) { d.dil = 4; d.r = j >> 2; d.i0 = ch * 128 + 32 * (j & 3); } else { d.dil = 16; d.r = j; d.i0 = ch * 32; }
                return d; };
            bf16x8 qv[4], kr[5][4];
            const int vkey_ = lane >> 3, vch_ = lane & 7;
            const int vcu = (G % 8 == 0) ? (bid & 7) * (G >> 3) + (bid >> 3) : bid;
            int un = vcu, it = wave;
            att::PDesc cur = mkdesc(un < 768 ? un : 0, it);
            if (un < 768) { att::p_load_q(c, cur, qv, vkey_, vch_);
#pragma unroll
                for (int s5 = 0; s5 < 2; ++s5) att::p_load_kv(c.KB, cur, s5, kr[s5], vkey_, vch_); }
            while (un < 768) {
                int un2 = un, it2 = it + 8; if (it2 >= 48) { it2 = wave; un2 = un + G; }
                const bool has_next = un2 < 768;
                const att::PDesc nxt = mkdesc(has_next ? un2 : un, has_next ? it2 : it);
                att::pblock(c, cur, nxt, has_next, qv, kr, tab, vbuf);
                if (un2 != un) {
                    __syncthreads();
                    const int b = un / 192, rem = un - b * 192, h = rem >> 4, ch = rem & 15;
#pragma unroll 1
                    for (int ps = 0; ps < 8; ps += 4) att::merge_pieces<4>(c, (size_t)b * SEQ + ch * 512 + ps * 64 + (tid >> 3), 64, h, tid & 7);
                }
                cur = nxt; un = un2; it = it2;
            }
        }
#endif
        {
            unsigned* cq = (unsigned*)(ws + WS_CTL) + 13200;
            volatile LAS unsigned* qw = (volatile LAS unsigned*)(lds + MISC_OFF) + 8;
            constexpr unsigned NSU = NSEQ * NH, NCP = (unsigned)(MP / 64), NIT = NSU + NCP + NSEQ;
            LAS float* cw8 = (LAS float*)(lds + 98304);
            unsigned tk_ = 0;
            if (threadIdx.x == 0) { tk_ = xb_add(cq, 1u); qw[0] = tk_; }
            __syncthreads();
            unsigned q = (unsigned)__builtin_amdgcn_readfirstlane((int)qw[0]);
            bool conv_ready = false;
            while (q < NIT) {
                __syncthreads();
                if (threadIdx.x == 0) tk_ = xb_add(cq, 1u);
                if (q < NSU) {
                    const int n = (int)q / NH, h = (int)q - n * NH;
                    if (wave == 0) att::wave_block<1>(c, n, h, 0, 1, 0, 2048, 8, tab + (0 * 12 + h) * 192, vbuf);
                    else for (int it = wave; it < 13; it += 7) {
                        LAS float* sb = (LAS float*)vbuf;
                        if (it < 5) att::sample_vblock<2>(c, n, h, 1, 4, it - 1, 512, tab + (1 * 12 + h) * 192, sb);
                        else att::sample_vblock<1>(c, n, h, 2, 16, it - 5, 128, tab + (2 * 12 + h) * 192, sb);
                    }
                    __syncthreads();
                    if (tid < 64) att::merge_pieces<1>(c, (size_t)MP + n * TS + (tid >> 3), 0, h, tid & 7);
                } else {
                    if (!conv_ready) { __syncthreads(); for (int i = tid; i < 31 * CWD; i += 512) cw8[i] = p.in[11][i]; conv_ready = true; }
                    const int un = (int)(q - NSU);
                    if (un < (int)NCP) conv_unit<8, false>(U, p.in[5], un >> 7, (un & 127) * 64, (LAS float*)(lds + ATT_V_OFF), cw8, p.in[12], p.in[13], p.in[14], ATT, tid, lane, wave);
                    else conv_unit<1, true>(U, p.in[5], un - (int)NCP, 0, (LAS float*)(lds + ATT_V_OFF), cw8, p.in[12], p.in[13], p.in[14], ATT, tid, lane, wave);
                }
                if (threadIdx.x == 0) qw[0] = tk_;
                __syncthreads();
                q = (unsigned)__builtin_amdgcn_readfirstlane((int)qw[0]);
            }
        }
    }
    SEAM(2);
    const int nl = __builtin_amdgcn_readfirstlane((int)((volatile LAS unsigned*)(lds + MISC_OFF))[0]), nx = __builtin_amdgcn_readfirstlane((int)((volatile LAS unsigned*)(lds + MISC_OFF))[1]);
    const int xi = __builtin_amdgcn_readfirstlane((int)((volatile LAS unsigned*)(lds + MISC_OFF))[2]), rk = __builtin_amdgcn_readfirstlane((int)((volatile LAS unsigned*)(lds + MISC_OFF))[3]);
    unsigned* xq_flag = (unsigned*)(ws + WS_CTL) + 3520; unsigned* xo_flag = (unsigned*)(ws + WS_CTL) + 13000;
    bool own128 = false;
    const int hxs_ = (nx == 8 && nl == 32) ? ((1 << (128 % nx)) | (1 << ((128 % nx + 1) % nx))) : 0;
    { for (int j = 0; j < 16; ++j) { const int Lx = j * nl + rk, pm = xi + nx * (Lx >> 2); if (pm >= 129) break; own128 |= (pm == 128); } }
    if (IN(3)) {
        pg8::SchedXL S{nl, rk, xi, nx, (const char*)ATT, (const char*)WOUT, (size_t)256 * DM * 2, (size_t)256 * DM * 2, 0};
        pg8::EpiRes<true> E{p.in[0], p.in[1], nullptr, XN, p.in[16], SSQ, pg8::HostCopy{p.in[3], p.in[4], out, 17436672u, 4, hxs_}};
        pg8::gemm_phase<pg8::EpiRes<true>, pg8::SchedXL, true>(lds, pg8::Cfg{DM, DM, DM}, S, E, wave);
    }
    xl_barrier(xbar);
    if (IN(4)) {
        {   pg8::SchedXL S{nl, rk, xi, nx, (const char*)XN, (const char*)WXQ, (size_t)256 * DM * 2, (size_t)256 * DM * 2, 0};
            pg8::EpiScale E{XQ, SSQ, XQSCALE, pg8::HostCopy{p.in[3], p.in[4], out, 21663744u, 4, hxs_}};
            pg8::gemm_phase<pg8::EpiScale, pg8::SchedXL, true>(lds, pg8::Cfg{DM, DM, DM}, S, E, wave); }
        if (own128 && threadIdx.x == 0) { __builtin_amdgcn_fence(__ATOMIC_RELEASE, "agent"); asm volatile("s_waitcnt vmcnt(0)" ::: "memory"); (void)xb_add(xq_flag, 1u); }
        {   pg8::SchedXLs S{nl, rk, xi, nx, (const char*)XQ, (const char*)MKB, 0};
            pg8::EpiSoftmax E{PB, LSUM, (LAS float*)(lds + XCH_OFF)};
            pg8::gemm_phase<pg8::EpiSoftmax, pg8::SchedXLs, true>(lds, pg8::Cfg{256, DM, DM}, S, E, wave); }
        {   pg8::SchedXLs S{nl, rk, xi, nx, (const char*)PB, (const char*)MVT, 1};
            pg8::EpiPV E{XO, LSUM, pg8::HostCopy{nullptr, nullptr, out, 0u, 4, hxs_}};
            pg8::gemm_phase<pg8::EpiPV, pg8::SchedXLs, true>(lds, pg8::Cfg{256, DM, DM}, S, E, wave); }
        PHASE_IDS;
        if (threadIdx.x == 0) { unsigned sp = 0; while (xb_ld(xq_flag) < 4u) { __builtin_amdgcn_s_sleep(2); if (++sp > (1u << 22)) break; }
            __builtin_amdgcn_fence(__ATOMIC_ACQUIRE, "agent"); asm volatile("s_waitcnt vmcnt(0)" ::: "memory"); }
        LAS float* qs = (LAS float*)lds;
        LAS float* sc = (LAS float*)(lds + 4096);
        LAS float* red = (LAS float*)(lds + 8192);
        const int xown_ = 128 % nx; const bool dense_ = (nx * nl == G && G == NSEQ * 4 * 2 && nl >= 8);
        int un0_ = -1, un1_ = -1;
        if (dense_) { if (!(xi == xown_ && rk < 4)) un0_ = xi * nl + rk; if (xi == xown_ && rk >= 4 && rk < 8) un1_ = xown_ * nl + (rk - 4); }
        for (int it_ = 0; ; ++it_) {
            int un;
            if (dense_) { if (it_ > 1) break; un = it_ == 0 ? un0_ : un1_; if (un < 0) continue; }
            else { un = bid + it_ * G; if (un >= NSEQ * 4 * 2) break; }
            const int n = un >> 3, h = (un >> 1) & 3, half = un & 1;
            __syncthreads();
            for (int i = tid; i < 4 * 256; i += 512) { const int t = i >> 8, d = i & 255; qs[i] = __uint_as_float((unsigned)XQ[((size_t)MP + n * TS + 4 * half + t) * DM + h * 256 + d] << 16); }
            __syncthreads();
            const float* Kc = p.in[6] + ((size_t)n * NMEM * 4 + h) * 256; const float* Vc = p.in[7] + ((size_t)n * NMEM * 4 + h) * 256;
            f32x4 qv[4];
#pragma unroll
            for (int t = 0; t < 4; ++t) qv[t] = *(const LAS f32x4*)(qs + t * 256 + 4 * lane);
            {
                f32x4 kv[32];
#pragma unroll
                for (int k = 0; k < 32; ++k) kv[k] = *(const f32x4*)(Kc + (size_t)(wave * 32 + k) * 1024 + 4 * lane);
#pragma unroll
                for (int k = 0; k < 32; ++k) {
                    float pt[4];
#pragma unroll
                    for (int t = 0; t < 4; ++t) pt[t] = wave_sum((kv[k][0] * qv[t][0] + kv[k][1] * qv[t][1]) + (kv[k][2] * qv[t][2] + kv[k][3] * qv[t][3]));
                    if (lane == 0) *(LAS f32x4*)(sc + (wave * 32 + k) * 4) = (f32x4){pt[0], pt[1], pt[2], pt[3]};
                }
            }
            const int d4 = tid & 63, mg = tid >> 6;
            f32x4 vv[32];
            {   const float* vp = Vc + (size_t)(mg * 32) * 1024 + 4 * d4;
#pragma unroll
                for (int m = 0; m < 32; ++m) vv[m] = *(const f32x4*)(vp + (size_t)m * 1024); }
            asm volatile("s_waitcnt lgkmcnt(0)\n\ts_barrier" ::: "memory");
            if (wave < 4) {
                const int t = wave; float v[4]; float mx = -3.0e38f;
#pragma unroll
                for (int j = 0; j < 4; ++j) { v[j] = sc[(lane + 64 * j) * 4 + t]; mx = fmaxf(mx, v[j]); }
#pragma unroll
                for (int o = 1; o < 64; o <<= 1) mx = fmaxf(mx, __shfl_xor(mx, o));
                float sm = 0.f;
#pragma unroll
                for (int j = 0; j < 4; ++j) { v[j] = fast_exp2(v[j] - mx); sm += v[j]; }
                sm = wave_sum(sm); const float inv = 1.0f / sm;
#pragma unroll
                for (int j = 0; j < 4; ++j) sc[(lane + 64 * j) * 4 + t] = v[j] * inv;
            }
            asm volatile("s_waitcnt lgkmcnt(0)\n\ts_barrier" ::: "memory");
            {
                f32x4 o[4];
#pragma unroll
                for (int t = 0; t < 4; ++t) o[t] = (f32x4){0.f, 0.f, 0.f, 0.f};
                const LAS float* pp = sc + (mg * 32) * 4;
#pragma unroll
                for (int m = 0; m < 32; ++m) { const f32x4 pw = *(const LAS f32x4*)(pp + m * 4);
#pragma unroll
                    for (int t = 0; t < 4; ++t) o[t] += vv[m] * pw[t]; }
                LAS float* red2 = red;
#pragma unroll
                for (int t = 0; t < 4; ++t) *(LAS f32x4*)(red2 + (mg * 4 + t) * 256 + 4 * d4) = o[t];
                __syncthreads();
                {
                    const int t = tid >> 7, d2 = (tid & 127) * 2; float s0 = 0.f, s1 = 0.f;
#pragma unroll
                    for (int g = 0; g < 8; ++g) { const f32x2 v2 = *(const LAS f32x2*)(red2 + (g * 4 + t) * 256 + d2); s0 += v2[0]; s1 += v2[1]; }
                    __hip_atomic_store((unsigned*)(XO + ((size_t)MP + n * TS + 4 * half + t) * DM + h * 256 + d2), pkbf(s0, s1), __ATOMIC_RELAXED, __HIP_MEMORY_SCOPE_AGENT);
                }
            }
            asm volatile("s_waitcnt vmcnt(0)" ::: "memory"); __syncthreads();
            if (threadIdx.x == 0) (void)xb_add(xo_flag, 1u);
        }
        __syncthreads();
    }
    xl_barrier(xbar);
    if (IN(7)) {
        if (own128) {
            if (threadIdx.x == 0) { unsigned sp = 0; while (xb_ld(xo_flag) < (unsigned)(NSEQ * 8)) { __builtin_amdgcn_s_sleep(2); if (++sp > (1u << 22)) break; }
                __builtin_amdgcn_fence(__ATOMIC_ACQUIRE, "agent"); asm volatile("s_waitcnt vmcnt(0)" ::: "memory"); }
            __syncthreads();
        }
        pg8::SchedXL S{nl, rk, xi, nx, (const char*)XO, (const char*)WXO, (size_t)256 * DM * 2, (size_t)256 * DM * 2, 0};
        pg8::EpiRes<false> E{nullptr, nullptr, p.in[16], XN, p.in[22], SSQ + SSQ_STRIDE, pg8::HostCopy{p.in[3], p.in[4], out, 19550208u, 4, hxs_}};
        pg8::gemm_phase<pg8::EpiRes<false>, pg8::SchedXL, true>(lds, pg8::Cfg{DM, DM, DM}, S, E, wave);
        if (hxs_ && own128 && threadIdx.x == 0) { __builtin_amdgcn_fence(__ATOMIC_RELEASE, "agent"); asm volatile("s_waitcnt vmcnt(0)" ::: "memory"); (void)xb_add((unsigned*)(ws + WS_CTL) + 13128, 1u); }
    }
    xl_barrier(xbar);
    const int xi0 = 128 % nx;
    const int xi9 = (nx > 1 && nl >= 4) ? (xi0 + 1) % nx : xi0;
    unsigned* h_flag = (unsigned*)(ws + WS_CTL) + 13064;
    if (IN(8)) {
        const int xi8 = hxs_ ? (xi0 + 2) % nx : -1;
        pg8::SchedXL22 S{nl, rk, xi, nx, (const char*)XN, (const char*)WGU, (size_t)256 * DM * 2, (size_t)256 * DM * 2, hxs_ ? 1 : 0};
        pg8::EpiSwiGLU E{HB, SSQ + SSQ_STRIDE, p.in[3], p.in[4], out, hxs_};
        pg8::gemm_phase<pg8::EpiSwiGLU, pg8::SchedXL22, true>(lds, pg8::Cfg{DM, DM, DM}, S, E, wave);
        bool had = false;
        if (!hxs_) { for (int j = 0; j < 16; ++j) { const int Lx = j * nl + rk, pm = xi + nx * (Lx / 22); if (pm >= 129) break; had |= (pm == 128); } }
        else if (xi == xi8 && rk < 22) {
            if (threadIdx.x == 0) { unsigned sp = 0; while (xb_ld((unsigned*)(ws + WS_CTL) + 13128) < 4u) { __builtin_amdgcn_s_sleep(2); if (++sp > (1u << 22)) break; }
                __builtin_amdgcn_fence(__ATOMIC_ACQUIRE, "agent"); asm volatile("s_waitcnt vmcnt(0)" ::: "memory"); }
            __syncthreads();
            pg8::SchedOne S1{128, rk, (const char*)XN, (const char*)WGU, (size_t)256 * DM * 2, (size_t)256 * DM * 2};
            pg8::gemm_phase<pg8::EpiSwiGLU, pg8::SchedOne, true>(lds, pg8::Cfg{DM, DM, DM}, S1, E, wave);
            had = true;
        }
        if (had && threadIdx.x == 0) { __builtin_amdgcn_fence(__ATOMIC_RELEASE, "agent"); asm volatile("s_waitcnt vmcnt(0)" ::: "memory"); (void)xb_add(h_flag, 1u); }
    }
    xl_barrier(xbar);
    if (IN(9)) {
        pg8::EpiFinal E{XN, p.in[22], out + OFF_Y, p.in[26], (float*)(ws + WS_SLOT), (unsigned*)(ws + WS_CTL) + 4096, (LAS float*)(lds + XCH_OFF), wave};
        {   pg8::SchedXL S{nl, rk, xi, nx, (const char*)HB, (const char*)WDN, (size_t)256 * DFF * 2, (size_t)256 * DFF * 2, 1};
            pg8::gemm_phase<pg8::EpiFinal, pg8::SchedXL, true>(lds, pg8::Cfg{DFF, DFF, DFF}, S, E, wave); }
        if (xi == xi9 && rk < 4) {
            if (threadIdx.x == 0) { unsigned sp = 0; while (xb_ld(h_flag) < 22u) { __builtin_amdgcn_s_sleep(2); if (++sp > (1u << 22)) break; }
                __builtin_amdgcn_fence(__ATOMIC_ACQUIRE, "agent"); asm volatile("s_waitcnt vmcnt(0)" ::: "memory"); }
            __syncthreads();
            pg8::SchedOne S{128, rk, (const char*)HB, (const char*)WDN, (size_t)256 * DFF * 2, (size_t)256 * DFF * 2};
            pg8::gemm_phase<pg8::EpiFinal, pg8::SchedOne, true>(lds, pg8::Cfg{DFF, DFF, DFF}, S, E, wave);
        }
    }
    {
        const bool all = (nx <= 1);
        const int xi8e = hxs_ ? (xi0 + 2) % nx : -1;
        int before = 0; for (int x = 0; x < xi; ++x) if (x != xi0 && x != xi8e) before += (x == xi9 && xi9 != xi0) ? nl - 4 : nl;
        const int mine = (xi == xi9 && xi9 != xi0) ? rk - 4 : rk;
        const int nfull = all ? nl : (nx - 1 - (hxs_ ? 1 : 0)) * nl - (xi9 != xi0 ? 4 : 0);
        const int nvw = hxs_ ? 4 * nfull + nl : nfull;
        int v0 = -1, npass = 1;
        if (all) v0 = rk; else if (xi == xi8e) v0 = 4 * nfull + rk; else if (xi != xi0 && mine >= 0) { if (hxs_) { v0 = 4 * (before + mine); npass = 4; } else v0 = before + mine; }
        for (int pass = 0; pass < npass; ++pass) { const int widx = v0 + pass; if (v0 < 0) break;
            PHASE_IDS;
            const int nun_ = hxs_ ? 33 * 34 : 0;
            for (int cc = widx; cc < nun_; cc += nvw) {
                const int q = cc / 34, r = cc - q * 34, pm = q < 17 ? xi0 + 8 * q : xi9 + 8 * (q - 17);
                if (r < 22) att::copy_range(p.in[3], p.in[4], out, (unsigned)(pm * 22 + r) * 6144u, 6144u, 0, 1, tid);
                else att::copy_range(p.in[3], p.in[4], out, 17436672u + 2113536u * (unsigned)((r - 22) >> 2) + (unsigned)(pm * 4 + ((r - 22) & 3)) * 4096u, 4096u, 0, 1, tid); } } }
#undef IN
#undef SEAM
}

extern "C" void kernel_launch(void* const* d_in, const int* in_sizes, int n_in, void* d_out, int out_size, void* d_ws, size_t ws_size, hipStream_t stream) {
    static int grid = 0;
    if (grid == 0) {
        if (n_in != 27 || (size_t)out_size != OUT_TOTAL || ws_size < WS_END) { fprintf(stderr, "kernel_launch: unexpected shapes: n_in %d out %d ws %zu\n", n_in, out_size, ws_size); grid = -1; return; }
        int dev = 0, cus = 0, per_cu = 0;
        (void)hipGetDevice(&dev); (void)hipDeviceGetAttribute(&cus, hipDeviceAttributeMultiprocessorCount, dev);
        if (hipFuncSetAttribute((const void*)fwd_kernel, hipFuncAttributeMaxDynamicSharedMemorySize, LDS_BYTES) != hipSuccess) { fprintf(stderr, "kernel_launch: hipFuncSetAttribute failed\n"); grid = -1; return; }
        if (hipOccupancyMaxActiveBlocksPerMultiprocessor(&per_cu, (const void*)fwd_kernel, 512, LDS_BYTES) != hipSuccess || per_cu < 1) { fprintf(stderr, "kernel_launch: occupancy query failed (%d)\n", per_cu); (void)hipGetLastError(); per_cu = 1; }
        grid = cus * 1;
        if (per_cu < 1) grid = -1;
    }
    if (grid < 0) return;
    Params p{};
    for (int i = 0; i < 27; ++i) p.in[i] = (const float*)d_in[i];
    p.out = (float*)d_out; p.ws = (unsigned char*)d_ws;
#if MK_COOP
    if (hipMemsetAsync((char*)d_ws + WS_CTL, 0, CTL_ZERO_BYTES, stream) != hipSuccess) { fprintf(stderr, "kernel_launch: memset of the barrier words failed\n"); return; }
    p.ph_lo = 0; p.ph_hi = 11; p.coop = 1;
    void* args[] = {&p};
    hipError_t e = hipLaunchCooperativeKernel((const void*)fwd_kernel, dim3(grid), dim3(512), args, LDS_BYTES, stream);
    if (e != hipSuccess) fprintf(stderr, "cooperative launch failed: %s (grid %d)\n", hipGetErrorString(e), grid);
#else
    for (int ph = 0; ph < 11; ++ph) {
        p.ph_lo = ph; p.ph_hi = ph + 1; p.coop = 0;
        hipLaunchKernelGGL(fwd_kernel, dim3(grid), dim3(512), LDS_BYTES, stream, p);
    }
#endif
}
```
